# Optimizing an MI355X kernel written in HIP

```python
import jax, jax.numpy as jnp
from jax import lax
import numpy as np

D_MODEL = 1024
BATCH = 2
SEQ = 8192
DEPTH = 2
DEC_BATCH = 8
DEC_SEQ = 32
PAST_LEN = 4096

CHUNK = 64
D_CONV = D_MODEL
CONV_WIDTH = 31
RET_HEADS = 4
RET_DK = D_MODEL // RET_HEADS
RET_DV = 2 * RET_DK
RET_QK = RET_HEADS * RET_DK
RET_V = RET_HEADS * RET_DV
D_FF = 4 * D_MODEL
ROPE_BASE = 10000.0
RMS_EPS = 1e-6
LN_EPS = 1e-5

OFF_Q = 2 * D_CONV
OFF_K = OFF_Q + RET_QK
OFF_V = OFF_K + RET_QK
OFF_G = OFF_V + RET_V
OFF_GC = OFF_G + RET_V
OFF_GR = OFF_GC + D_MODEL
D_IN = OFF_GR + D_MODEL

kernel_name = "gated_conformer_retention_streaming_step"


def rmsnorm(x, g):
    xf = x.astype(jnp.float32)
    y = xf * lax.rsqrt(jnp.mean(xf * xf, axis=-1, keepdims=True) + RMS_EPS)
    return (y * g.astype(jnp.float32)).astype(x.dtype)


def layernorm(x, g, b):
    xf = x.astype(jnp.float32)
    mu = jnp.mean(xf, axis=-1, keepdims=True)
    var = jnp.mean(jnp.square(xf - mu), axis=-1, keepdims=True)
    y = (xf - mu) * lax.rsqrt(var + LN_EPS)
    return (y * g.astype(jnp.float32) + b.astype(jnp.float32)).astype(x.dtype)


def rope(x, pos):
    dk = x.shape[-1]
    inv_freq = ROPE_BASE ** (-jnp.arange(0, dk, 2, dtype=jnp.float32) / dk)
    ang = pos[:, None] * inv_freq[None, :]
    cos = jnp.cos(ang)[None, :, None, :].astype(x.dtype)
    sin = jnp.sin(ang)[None, :, None, :].astype(x.dtype)
    x1, x2 = x[..., : dk // 2], x[..., dk // 2:]
    return jnp.concatenate([x1 * cos - x2 * sin, x2 * cos + x1 * sin], axis=-1)


def retention_log_decay():
    return jnp.log(1.0 - jnp.exp2(-5.0 - jnp.arange(RET_HEADS, dtype=jnp.float32)))


def retention_seq(q, k, v, S0):
    B, H, L, DK = q.shape
    DV = v.shape[-1]
    c = min(CHUNK, L)
    n_blk = L // c
    lg = retention_log_decay()[:, None, None]
    idx = jnp.arange(c, dtype=jnp.float32)
    diff = idx[:, None] - idx[None, :]
    dmask = jnp.where(diff >= 0, jnp.exp(jnp.maximum(diff, 0.0)[None] * lg), 0.0)
    q_dec = jnp.exp((idx + 1.0)[None, :, None] * lg)
    k_dec = jnp.exp((c - 1.0 - idx)[None, :, None] * lg)
    s_dec = jnp.exp(c * lg)

    def blk(S, qkv):
        qb, kb, vb = qkv
        att = jnp.einsum('bhnd,bhmd->bhnm', qb, kb) * dmask
        o = (jnp.einsum('bhnm,bhme->bhne', att, vb)
             + jnp.einsum('bhnd,bhde->bhne', qb, S) * q_dec)
        S = s_dec * S + jnp.einsum('bhmd,bhme->bhde', kb * k_dec, vb)
        return S, o

    def split(t):
        return jnp.moveaxis(t.astype(jnp.float32).reshape(B, H, n_blk, c, t.shape[-1]), 2, 0)

    S, o = lax.scan(blk, S0.astype(jnp.float32), (split(q), split(k), split(v)))
    o = jnp.moveaxis(o, 0, 2).reshape(B, H, L, DV)
    return o, S


def mixer(h, pos0, conv_state, ret_state, w_in, conv_w, conv_b, conv_ln_g, conv_ln_b,
          w_conv_out, ret_gn_g, w_ret_out, w_out):
    B, L, _ = h.shape
    P = h @ w_in

    a, b = P[..., :D_CONV], P[..., D_CONV:OFF_Q]
    glu = a * jax.nn.sigmoid(b)
    full = jnp.concatenate([conv_state.astype(glu.dtype), glu], axis=1)
    yc = lax.conv_general_dilated(full, conv_w[:, None, :].astype(full.dtype),
                                  window_strides=(1,), padding='VALID',
                                  dimension_numbers=('NWC', 'WIO', 'NWC'),
                                  feature_group_count=D_CONV) + conv_b
    new_conv_state = full[:, -(CONV_WIDTH - 1):, :]
    yc = jax.nn.silu(layernorm(yc, conv_ln_g, conv_ln_b))
    conv_out = yc @ w_conv_out

    pos = pos0 + jnp.arange(L, dtype=jnp.float32)
    q = rope(P[..., OFF_Q:OFF_K].reshape(B, L, RET_HEADS, RET_DK), pos)
    k = rope(P[..., OFF_K:OFF_V].reshape(B, L, RET_HEADS, RET_DK), pos) * (RET_DK ** -0.5)
    v = P[..., OFF_V:OFF_G].reshape(B, L, RET_HEADS, RET_DV)
    o, new_ret_state = retention_seq(q.transpose(0, 2, 1, 3), k.transpose(0, 2, 1, 3),
                                     v.transpose(0, 2, 1, 3), ret_state)
    o = o.transpose(0, 2, 1, 3)
    mu = jnp.mean(o, axis=-1, keepdims=True)
    var = jnp.mean(jnp.square(o - mu), axis=-1, keepdims=True)
    o = ((o - mu) * lax.rsqrt(var + LN_EPS)).reshape(B, L, RET_V)
    o = (o * ret_gn_g.astype(jnp.float32)).astype(h.dtype)
    ret_out = (jax.nn.silu(P[..., OFF_G:OFF_GC]) * o) @ w_ret_out

    g_conv = jax.nn.sigmoid(P[..., OFF_GC:OFF_GR])
    g_ret = jax.nn.sigmoid(P[..., OFF_GR:D_IN])
    out = (g_conv * conv_out + g_ret * ret_out) @ w_out
    return out, new_conv_state, new_ret_state


def trunk(x, pos0, conv_states, ret_states, norm1_g, w_in, conv_w, conv_b, conv_ln_g,
          conv_ln_b, w_conv_out, ret_gn_g, w_ret_out, w_out, norm2_g, w_mlp1, w_mlp2, final_g):
    new_conv, new_ret = [], []
    for l in range(DEPTH):
        m, cs, rs = mixer(rmsnorm(x, norm1_g[l]), pos0, conv_states[l], ret_states[l],
                          w_in[l], conv_w[l], conv_b[l], conv_ln_g[l], conv_ln_b[l],
                          w_conv_out[l], ret_gn_g[l], w_ret_out[l], w_out[l])
        x = x + m
        hm = rmsnorm(x, norm2_g[l]) @ w_mlp1[l]
        x = x + jnp.square(jax.nn.relu(hm)) @ w_mlp2[l]
        new_conv.append(cs)
        new_ret.append(rs.astype(x.dtype))
    return rmsnorm(x, final_g), jnp.stack(new_conv), jnp.stack(new_ret)


def setup_inputs(seed: int = 0) -> dict:
    key = jax.random.key(seed)
    ks = jax.random.split(key, 20)
    f32 = jnp.float32
    nrm = lambda k, s: jax.random.normal(k, s, f32)
    return {
        "x_prompt": nrm(ks[0], (BATCH, SEQ, D_MODEL)),
        "x_sample": nrm(ks[1], (DEC_BATCH, DEC_SEQ, D_MODEL)),
        "state_conv": 0.5 * nrm(ks[2], (DEPTH, DEC_BATCH, CONV_WIDTH - 1, D_CONV)),
        "state_ret": 0.1 * nrm(ks[3], (DEPTH, DEC_BATCH, RET_HEADS, RET_DK, RET_DV)),
        "norm1_g": 1.0 + 0.01 * nrm(ks[4], (DEPTH, D_MODEL)),
        "w_in": nrm(ks[5], (DEPTH, D_MODEL, D_IN)) * D_MODEL ** -0.5,
        "conv_w": nrm(ks[6], (DEPTH, CONV_WIDTH, D_CONV)) * CONV_WIDTH ** -0.5,
        "conv_b": 0.01 * nrm(ks[7], (DEPTH, D_CONV)),
        "conv_ln_g": 1.0 + 0.01 * nrm(ks[8], (DEPTH, D_CONV)),
        "conv_ln_b": 0.01 * nrm(ks[9], (DEPTH, D_CONV)),
        "w_conv_out": nrm(ks[10], (DEPTH, D_CONV, D_MODEL)) * D_CONV ** -0.5,
        "ret_gn_g": 1.0 + 0.01 * nrm(ks[11], (DEPTH, RET_V)),
        "w_ret_out": nrm(ks[12], (DEPTH, RET_V, D_MODEL)) * RET_V ** -0.5,
        "w_out": nrm(ks[13], (DEPTH, D_MODEL, D_MODEL)) * D_MODEL ** -0.5,
        "norm2_g": 1.0 + 0.01 * nrm(ks[14], (DEPTH, D_MODEL)),
        "w_mlp1": nrm(ks[15], (DEPTH, D_MODEL, D_FF)) * D_MODEL ** -0.5,
        "w_mlp2": nrm(ks[16], (DEPTH, D_FF, D_MODEL)) * D_FF ** -0.5,
        "final_g": 1.0 + 0.01 * nrm(ks[17], (D_MODEL,)),
    }


def reference(x_prompt, x_sample, state_conv, state_ret, norm1_g, w_in, conv_w, conv_b,
              conv_ln_g, conv_ln_b, w_conv_out, ret_gn_g, w_ret_out, w_out, norm2_g,
              w_mlp1, w_mlp2, final_g):
    weights = (norm1_g, w_in, conv_w, conv_b, conv_ln_g, conv_ln_b, w_conv_out,
               ret_gn_g, w_ret_out, w_out, norm2_g, w_mlp1, w_mlp2, final_g)
    zc = jnp.zeros((DEPTH, x_prompt.shape[0], CONV_WIDTH - 1, D_CONV), x_prompt.dtype)
    zr = jnp.zeros((DEPTH, x_prompt.shape[0], RET_HEADS, RET_DK, RET_DV), jnp.float32)
    y_prompt, conv_p, ret_p = trunk(x_prompt, 0.0, zc, zr, *weights)
    y_sample, conv_s, ret_s = trunk(x_sample, float(PAST_LEN), state_conv, state_ret, *weights)
    return (y_prompt, y_sample, conv_p, ret_p, conv_s, ret_s)
```

```cpp
#include <hip/hip_runtime.h>
#include <hip/hip_cooperative_groups.h>
#include <cstdio>
#include <cstdint>
namespace cg = cooperative_groups;

#define LAS __attribute__((address_space(3)))
typedef unsigned short bf16_t;
typedef short bf16x8 __attribute__((ext_vector_type(8)));
typedef float f32x4 __attribute__((ext_vector_type(4)));
typedef float f32x2 __attribute__((ext_vector_type(2)));
typedef float f32x16 __attribute__((ext_vector_type(16)));
typedef unsigned u32x4 __attribute__((ext_vector_type(4)));
typedef unsigned u32x2 __attribute__((ext_vector_type(2)));

constexpr int DM = 1024, SEQ = 8192, NPT = 16384, NTOK = 16640, DSEQ = 32, PAST = 4096;
constexpr int DFF = 4096, RV = 2048, CH = 256;
constexpr float RMS_EPS = 1e-6f, LN_EPS = 1e-5f;
constexpr size_t MiB = 1u << 20;
constexpr size_t TILEB = 256 * 1024 * 2;
constexpr size_t WS_STATS = 313 * MiB;
constexpr size_t WS_BAR = 640 * 1024;
constexpr size_t WS_SSQA = 315 * MiB, WS_SSQB = 316 * MiB;
constexpr size_t WS_TAB = 1 * MiB;
constexpr size_t WS_WIN = 9 * MiB;
constexpr size_t WS_WC = 29 * MiB, WS_WR = 31 * MiB, WS_WO = 35 * MiB, WS_WM1 = 37 * MiB, WS_WM2 = 45 * MiB;
constexpr size_t WS_H = 53 * MiB;
constexpr size_t WS_Q = WS_H + 32 * MiB + MiB / 2;
constexpr size_t WS_KB0 = 118 * MiB, WS_KTB0 = 134 * MiB, WS_KB1 = 150 * MiB, WS_KTB1 = 166 * MiB, WS_KS = 182 * MiB, WS_KTS = WS_KS + MiB / 2;
constexpr size_t WS_VTB0 = 183 * MiB, WS_VTB1 = 215 * MiB, WS_VTS = 247 * MiB;
constexpr size_t WS_ATT = 248 * MiB;
constexpr size_t WS_S = 280 * MiB;
constexpr size_t WS_OS = 312 * MiB;
constexpr size_t WS_END = 317 * MiB;
constexpr size_t WS_GLU = WS_Q, WS_T = WS_Q, WS_U = WS_Q, WS_GC = WS_VTB0, WS_GR = WS_VTB0 + 32 * MiB + MiB / 2, WS_YC = WS_ATT;
constexpr size_t WS_OB0 = WS_KB0, WS_OB1 = WS_KB1;
static_assert(WS_Q == 85 * MiB + MiB / 2 && WS_Q + 32 * MiB + MiB / 2 == WS_KB0, "map");
static_assert(WS_U + (size_t)NTOK * DFF * 2 <= WS_END, "map");
constexpr size_t OUT_CONVP = 17039360, OUT_RETP = 17162240, OUT_CONVS = 19259392, OUT_RETS = 19750912;

struct Params { const float* in[18]; float* out; unsigned char* ws; };

typedef __bf16 bf16x2_t __attribute__((ext_vector_type(2)));
__device__ __forceinline__ unsigned cvt_pk_bf16(float lo, float hi) { const f32x2 v = {lo, hi}; return __builtin_bit_cast(unsigned, __builtin_convertvector(v, bf16x2_t)); }
__device__ __forceinline__ float bflo(unsigned w) { return __uint_as_float(w << 16); }
__device__ __forceinline__ float bfhi(unsigned w) { return __uint_as_float(w & 0xffff0000u); }
__device__ __forceinline__ float bf2f(bf16_t v) { return __uint_as_float((unsigned)v << 16); }
__device__ __forceinline__ float lgdec(int h) { return h == 0 ? -0.0317486983145803f : (h == 1 ? -0.015748356968139168f : (h == 2 ? -0.007843177461025893f : -0.003913899321136329f)); }
typedef unsigned long long fx_t;
constexpr float FX_SCALE = 16777216.0f, FX_INV = 1.0f / 16777216.0f;
__device__ __forceinline__ fx_t fx_of(float v) { return (fx_t)(long long)(v * FX_SCALE); }
__device__ __forceinline__ void fx_add(fx_t* p, float v) { atomicAdd(p, fx_of(v)); }
__device__ __forceinline__ float fx_get(fx_t v) { return (float)(long long)v * FX_INV; }
__device__ __forceinline__ float rstd_of(float ssq) { return __builtin_amdgcn_rsqf(ssq * (1.0f / 1024.0f) + RMS_EPS); }
__device__ __forceinline__ float sigm(float x) { return __builtin_amdgcn_rcpf(1.0f + __expf(-x)); }
__device__ __forceinline__ u32x4 pack8(const f32x4 a, const f32x4 b) { u32x4 w; w.x = cvt_pk_bf16(a[0], a[1]); w.y = cvt_pk_bf16(a[2], a[3]); w.z = cvt_pk_bf16(b[0], b[1]); w.w = cvt_pk_bf16(b[2], b[3]); return w; }
__device__ __forceinline__ void unpack8(const u32x4 w, f32x4& a, f32x4& b) { a = (f32x4){bflo(w.x), bfhi(w.x), bflo(w.y), bfhi(w.y)}; b = (f32x4){bflo(w.z), bfhi(w.z), bflo(w.w), bfhi(w.w)}; }
__device__ __forceinline__ int lane_id() { return (int)__builtin_amdgcn_mbcnt_hi(~0u, __builtin_amdgcn_mbcnt_lo(~0u, 0u)); }
__device__ __forceinline__ int gdim() { int g = (int)gridDim.x; asm volatile("" : "+s"(g)); return g; }
template <int K> __device__ __forceinline__ float shx(float v) {
    if constexpr (K < 32) return __builtin_bit_cast(float, __builtin_amdgcn_ds_swizzle(__builtin_bit_cast(int, v), (K << 10) | 0x1f));
    else { int l = lane_id(); asm volatile("" : "+v"(l)); return __builtin_bit_cast(float, __builtin_amdgcn_ds_bpermute((l ^ 32) << 2, __builtin_bit_cast(int, v))); }
}
template <int CTRL> __device__ __forceinline__ float dpp_f(float v) { return __builtin_bit_cast(float, __builtin_amdgcn_update_dpp(0, __builtin_bit_cast(int, v), CTRL, 0xf, 0xf, true)); }
__device__ __forceinline__ float wave_sum(float v) {
    v += dpp_f<0xB1>(v);
    v += dpp_f<0x4E>(v);
    v += dpp_f<0x141>(v);
    v += dpp_f<0x140>(v);
    const int iv = __builtin_bit_cast(int, v);
    return (__builtin_bit_cast(float, __builtin_amdgcn_readlane(iv, 0)) + __builtin_bit_cast(float, __builtin_amdgcn_readlane(iv, 16))) +
           (__builtin_bit_cast(float, __builtin_amdgcn_readlane(iv, 32)) + __builtin_bit_cast(float, __builtin_amdgcn_readlane(iv, 48)));
}

namespace pg8 {
constexpr int BM = 256, BK = 64, HALF = 128, HTB = HALF * BK * 2, STAGE_BYTES = 8 * HTB;
__host__ __device__ __forceinline__ int lds_byte(int r, int c) { const int st = (r >> 4) * 2 + (c >> 5), rr = r & 15, cc = c & 31, ob = rr * 64 + cc * 2; return st * 1024 + (ob ^ (((ob >> 9) & 1) << 5)); }
__host__ __device__ __forceinline__ void stage_rc(int b, int& R, int& C) { const int st = b / 1024, sb = b % 1024, swz = sb ^ (((sb >> 9) & 1) << 5); R = (st >> 1) * 16 + swz / 64; C = (st & 1) * 32 + (swz % 64) / 2; }
__host__ __device__ __forceinline__ int perm32(int rho) { const int n = rho >> 4, i = rho & 15; return 8 * (i >> 2) + 4 * n + (i & 3); }

struct Unit { const char* a; const char* b; long a2d, b2d; int kind, pm, pn, aux; };
struct Gemm { int K, nt1, lda, ldb; };

__device__ __forceinline__ void xcd_remap(int& wgid, int nwg) { const int q = nwg / 8, r = nwg % 8, xcd = wgid % 8, off = wgid / 8; wgid = (xcd < r ? xcd * (q + 1) : r * (q + 1) + (xcd - r) * q) + off; }
__device__ __forceinline__ void grp_decode(int wgid, int nM, int nN, int& pm, int& pn) { const int nig = 8 * nN, gid = wgid / nig, fm = gid * 8, gsz = (nM - fm) < 8 ? (nM - fm) : 8; pm = fm + ((wgid % nig) % gsz); pn = (wgid % nig) / gsz; }

template <class Epi, class Sched>
__device__ __forceinline__ void gemm_phase(int wv, LAS unsigned char* lds, const Gemm g, const Sched& S, const Epi& E) {
    int wv_ = wv; asm volatile("" : "+s"(wv_)); int tid = wv_ * 64 + lane_id(); asm volatile("" : "+v"(tid));
    const int wid = __builtin_amdgcn_readfirstlane(tid >> 6), lane = tid & 63, wr = wid >> 2, wc = wid & 3, fr = lane & 15, fq = lane >> 4;
    const int nt = g.K / BK, nt1 = g.nt1;
    unsigned voffA[2], voffB[2];
#pragma unroll
    for (int i = 0; i < 2; ++i) { int R, C; stage_rc(tid * 16 + i * 8192, R, C); const int Rb = (R & ~31) + perm32(R & 31);
        voffA[i] = (unsigned)(R * g.lda + C) * 2u; voffB[i] = (unsigned)(Rb * g.ldb + C) * 2u; }
    const size_t kstep = (size_t)(BK * 2);
    const size_t hstepA = (size_t)HALF * g.lda * 2, hstepB = (size_t)HALF * g.ldb * 2;
    const unsigned ldsw = (unsigned)wid * 1024u;
    const int aoff = lds_byte(wr * 64 + fr, fq * 8), boff = lds_byte(wc * 32 + fr, fq * 8);
#define PG8_SA(b, h) (((b) * 2 + (h)) * HTB)
#define PG8_SB(b, h) ((4 + (b) * 2 + (h)) * HTB)
#define PG8_STAGE(bufoff, gbase, voff) do { _Pragma("unroll") for (int _i = 0; _i < 2; ++_i) \
        __builtin_amdgcn_global_load_lds((const unsigned*)((const char*)(gbase) + (voff)[_i]), (LAS unsigned*)(lds + (bufoff) + ldsw + _i * 8192), 16, 0, 0); } while (0)
#define PG8_LDA(dst, b, h) do { _Pragma("unroll") for (int m = 0; m < 4; ++m) _Pragma("unroll") for (int k = 0; k < 2; ++k) dst[m][k] = *(const LAS bf16x8*)(lds + PG8_SA(b, h) + aoff + m * 2048 + k * 1024); } while (0)
#define PG8_LDB(dst, b, h) do { _Pragma("unroll") for (int n = 0; n < 2; ++n) _Pragma("unroll") for (int k = 0; k < 2; ++k) dst[n][k] = *(const LAS bf16x8*)(lds + PG8_SB(b, h) + boff + n * 2048 + k * 1024); } while (0)
#define PG8_MMA(ai, bj, At, Bt) do { __builtin_amdgcn_s_setprio(1); _Pragma("unroll") for (int m = 0; m < 4; ++m) _Pragma("unroll") for (int n = 0; n < 2; ++n) _Pragma("unroll") for (int k = 0; k < 2; ++k) \
        acc[ai][bj][m][n] = __builtin_amdgcn_mfma_f32_16x16x32_bf16(Bt[n][k], At[m][k], acc[ai][bj][m][n], 0, 0, 0); __builtin_amdgcn_s_setprio(0); } while (0)
#define PG8_WAIT_V(n) asm volatile("s_waitcnt vmcnt(" #n ")" ::: "memory")
#define PG8_WAIT_L(n) asm volatile("s_waitcnt lgkmcnt(" #n ")" ::: "memory")
#define PG8_BAR __builtin_amdgcn_s_barrier()
#define PG8_SCHED __builtin_amdgcn_sched_barrier(0)
#define PG8_TPA(u, t) ((u).a + (size_t)(t) * kstep + (((t) >= nt1) ? (u).a2d : 0l))
#define PG8_TPB(u, t) ((u).b + (size_t)(t) * kstep + (((t) >= nt1) ? (u).b2d : 0l))
    Unit cur, nxt; int ui = 0;
    if (!S.next(0, cur)) return;
    {
        const char* cA = cur.a; const char* cB = cur.b;
        PG8_STAGE(PG8_SB(0, 0), cB, voffB); PG8_STAGE(PG8_SB(0, 1), cB + hstepB, voffB); PG8_STAGE(PG8_SA(0, 0), cA, voffA); PG8_STAGE(PG8_SA(0, 1), cA + hstepA, voffA);
        if (wr == 1) PG8_BAR;
        PG8_WAIT_V(2); PG8_BAR;
        PG8_STAGE(PG8_SB(1, 0), cB + kstep, voffB); PG8_STAGE(PG8_SA(1, 0), cA + kstep, voffA); PG8_STAGE(PG8_SB(1, 1), cB + hstepB + kstep, voffB);
        PG8_WAIT_V(6); PG8_BAR;
    }
    f32x4 acc[2][2][4][2];
#pragma unroll
    for (int a = 0; a < 2; ++a)
#pragma unroll
        for (int b = 0; b < 2; ++b)
#pragma unroll
            for (int m = 0; m < 4; ++m)
#pragma unroll
                for (int n = 0; n < 2; ++n) acc[a][b][m][n] = (f32x4){0.f, 0.f, 0.f, 0.f};
    bf16x8 At[4][2], B0[2][2], B1[2][2];
#pragma unroll 1
    for (;;) {
        const bool has_next = S.next(ui + 1, nxt);
        if (!has_next) nxt = cur;
#pragma unroll 1
        for (int t = 0; t < nt; t += 2) {
            const bool last = (t == nt - 2);
            const char* a1 = PG8_TPA(cur, t + 1);
            const char* a2 = last ? PG8_TPA(nxt, 0) : PG8_TPA(cur, t + 2); const char* b2 = last ? PG8_TPB(nxt, 0) : PG8_TPB(cur, t + 2);
            const char* a3 = a2 + kstep; const char* b3 = b2 + kstep;
            PG8_LDB(B0, 0, 0); PG8_LDB(B1, 0, 1); PG8_SCHED; PG8_LDA(At, 0, 0); PG8_STAGE(PG8_SA(1, 1), a1 + hstepA, voffA);
            PG8_WAIT_V(8); PG8_WAIT_L(0); PG8_BAR; PG8_MMA(0, 0, At, B0); PG8_MMA(0, 1, At, B1); PG8_BAR; PG8_SCHED;
            PG8_LDA(At, 0, 1); PG8_STAGE(PG8_SB(0, 0), b2, voffB); PG8_STAGE(PG8_SB(0, 1), b2 + hstepB, voffB); PG8_STAGE(PG8_SA(0, 0), a2, voffA);
            PG8_WAIT_V(8); PG8_WAIT_L(0); PG8_BAR; PG8_MMA(1, 0, At, B0); PG8_MMA(1, 1, At, B1); PG8_BAR; PG8_SCHED;
            PG8_LDB(B0, 1, 0); PG8_LDB(B1, 1, 1); PG8_SCHED; PG8_LDA(At, 1, 0); PG8_STAGE(PG8_SA(0, 1), a2 + hstepA, voffA);
            PG8_WAIT_V(8); PG8_WAIT_L(0); PG8_BAR; PG8_MMA(0, 0, At, B0); PG8_MMA(0, 1, At, B1); PG8_BAR; PG8_SCHED;
            PG8_LDA(At, 1, 1); PG8_STAGE(PG8_SB(1, 0), b3, voffB); PG8_STAGE(PG8_SB(1, 1), b3 + hstepB, voffB); PG8_STAGE(PG8_SA(1, 0), a3, voffA);
            PG8_WAIT_V(8); PG8_WAIT_L(0); PG8_BAR; PG8_MMA(1, 0, At, B0); PG8_MMA(1, 1, At, B1); PG8_BAR; PG8_SCHED;
        }
        if (wr == 0) PG8_BAR;
        { int fr2 = fr, fq2 = fq; asm volatile("" : "+v"(fr2), "+v"(fq2)); E(acc, cur, wr, wc, fr2, fq2); }
        if (!has_next) break;
#pragma unroll
        for (int a = 0; a < 2; ++a)
#pragma unroll
            for (int b = 0; b < 2; ++b)
#pragma unroll
                for (int m = 0; m < 4; ++m)
#pragma unroll
                    for (int n = 0; n < 2; ++n) acc[a][b][m][n] = (f32x4){0.f, 0.f, 0.f, 0.f};
        cur = nxt; ++ui;
        if (wr == 1) PG8_BAR;
    }
    PG8_WAIT_V(0);
    PG8_BAR;
    asm volatile("s_waitcnt vmcnt(0) lgkmcnt(0)" ::: "memory");
    __syncthreads();
#undef PG8_SA
#undef PG8_SB
#undef PG8_STAGE
#undef PG8_LDA
#undef PG8_LDB
#undef PG8_MMA
#undef PG8_WAIT_V
#undef PG8_WAIT_L
#undef PG8_BAR
#undef PG8_SCHED
#undef PG8_TPA
#undef PG8_TPB
}
}
using pg8::Unit;

__device__ __forceinline__ bf16_t* k_tile(unsigned char* ws, int pm) { return (bf16_t*)(ws + (pm < 32 ? WS_KB0 + (size_t)pm * TILEB : (pm < 64 ? WS_KB1 + (size_t)(pm - 32) * TILEB : WS_KS))); }
__device__ __forceinline__ bf16_t* o_tile(unsigned char* ws, int pm) { return (bf16_t*)(ws + (pm < 32 ? WS_OB0 + (size_t)pm * 2 * TILEB : (pm < 64 ? WS_OB1 + (size_t)(pm - 32) * 2 * TILEB : WS_OS))); }

__device__ __forceinline__ bf16_t* s_head(unsigned char* ws, int b, int h) {
    const size_t off = b == 0 ? WS_S + (size_t)h * 8 * MiB : (h == 0 ? WS_TAB : (h == 1 ? WS_WC : (h == 2 ? WS_WM1 : WS_WM2)));
    return (bf16_t*)(ws + off);
}
struct SchedB1 {
    int G, c; const char* H; const char* W;
    __device__ __forceinline__ bool next(int i, Unit& u) const {
        const long L = (long)i * G + c; if (L >= 1024) return false;
        int wgid = (int)L; pg8::xcd_remap(wgid, 1024);
        { const int x = wgid >> 7, w = wgid & 127; wgid = w < 64 ? x * 64 + w : 512 + x * 64 + (w - 64); }
        u.a2d = 0; u.b2d = 0; u.aux = 0;
        if (wgid < 512) { pg8::grp_decode(wgid, 64, 8, u.pm, u.pn); u.kind = 0; u.a = H + (size_t)u.pm * TILEB; u.b = W + (size_t)u.pn * TILEB; }
        else { pg8::grp_decode(wgid - 512, 8, 64, u.pm, u.pn); u.pm += 4; u.kind = 1; u.a = W + (size_t)(4 + u.pm) * TILEB; u.b = H + (size_t)u.pn * TILEB; }
        return true;
    }
};
struct SchedN {
    int G, c, nN, amode; const char* A; const char* B; size_t bTile; unsigned char* ws; size_t aTile;
    __device__ __forceinline__ bool next(int i, Unit& u) const {
        const int nwg = 64 * nN; const long L = (long)i * G + c; if (L >= nwg) return false;
        int wgid = (int)L; pg8::xcd_remap(wgid, nwg); pg8::grp_decode(wgid, 64, nN, u.pm, u.pn);
        u.a2d = 0; u.b2d = 0; u.aux = 0; u.kind = 0;
        u.a = amode ? (const char*)o_tile(ws, u.pm) : A + (size_t)u.pm * aTile; u.b = B + (size_t)u.pn * bTile;
        return true;
    }
};
struct SchedAtt {
    int G, c; unsigned char* ws;
    __device__ __forceinline__ bool next(int i, Unit& u) const {
        const int L = i * G + c; if (L >= 256) return false;
        const int h = L & 3, j = (L >> 2) & 31, b = L >> 7;
        u.a2d = 0; u.b2d = 0; u.kind = 0; u.pm = j; u.pn = b; u.aux = h;
        u.a = (const char*)(ws + WS_Q) + ((size_t)(b * SEQ + j * CH) * 1024 + h * 256) * 2;
        u.b = (const char*)(ws + (b ? WS_KB1 : WS_KB0)) + ((size_t)(j * CH) * 1024 + h * 256) * 2;
        return true;
    }
};
struct SchedU {
    int G, c; unsigned char* ws;
    __device__ __forceinline__ bool next(int i, Unit& u) const {
        const int L = i * G + c; if (L >= 512) return false;
        const int pmt = L & 1, h = (L >> 1) & 3, j = (L >> 3) & 31, b = L >> 8;
        u.a2d = 0; u.b2d = 0; u.kind = b; u.pm = j; u.pn = 0; u.aux = h * 2 + pmt;
        u.a = (const char*)(ws + (b ? WS_VTB1 : WS_VTB0)) + ((size_t)(h * 512 + pmt * 256) * SEQ + j * CH) * 2;
        u.b = (const char*)(ws + (b ? WS_KTB1 : WS_KTB0)) + ((size_t)(h * 256) * SEQ + j * CH) * 2;
        return true;
    }
};
struct SchedE {
    int G, c; unsigned char* ws;
    __device__ __forceinline__ bool next(int i, Unit& u) const {
        const int L = i * G + c; if (L >= 512) return false;
        const int pnt = L & 1, h = (L >> 1) & 3, j = (L >> 3) & 31, b = L >> 8;
        u.kind = b; u.pm = j; u.pn = pnt; u.aux = h;
        const char* a1 = (const char*)(ws + WS_ATT) + ((size_t)(b * SEQ + j * CH) * 1024 + h * 256) * 2;
        const char* a2 = (const char*)(ws + WS_Q) + ((size_t)(b * SEQ + j * CH) * 1024 + h * 256) * 2;
        const char* b1 = (const char*)(ws + (b ? WS_VTB1 : WS_VTB0)) + ((size_t)(h * 512 + pnt * 256) * SEQ + j * CH) * 2;
        const char* b2 = (const char*)(s_head(ws, b, h) + (size_t)(pnt * 256) * SEQ + j * CH);
        u.a = a1; u.b = b1; u.a2d = (long)(a2 - a1) - 4 * 128; u.b2d = (long)(b2 - b1) - 4 * 128;
        return true;
    }
};

#define EPI_FENCE asm volatile("" ::: "memory")
#define EPI_ARGS const f32x4 (&acc)[2][2][4][2], const Unit& u, int wr, int wc, int fr, int fq
struct EpiB1 {
    unsigned char* ws;
    __device__ __forceinline__ void operator()(EPI_ARGS) const {
        const f32x2* tab = (const f32x2*)(ws + WS_TAB); const fx_t* ssq = (const fx_t*)(ws + WS_SSQA);
        if (u.kind == 0) {
            const int head = u.pn & 3; const bool isk = u.pn >= 4;
            bf16_t* dst = isk ? k_tile(ws, u.pm) : (bf16_t*)(ws + WS_Q) + (size_t)u.pm * 256 * 1024;
            const float sc = isk ? 0.0625f : 1.0f;
            const __amdgpu_buffer_rsrc_t ktr = __builtin_amdgcn_make_buffer_rsrc((void*)(ws + (u.pm < 32 ? WS_KTB0 : WS_KTB1)), (short)0, (int)(16 * MiB), 0x00020000);
            const int d0 = wc * 32 + fq * 8;
#pragma unroll
            for (int aih = 0; aih < 2; ++aih) {
                const int ai = aih, mb = 0;
                f32x4 tb[4][4]; float rsq[4];
#pragma unroll
                for (int m = mb; m < mb + 4; ++m) {
                    const int row = ai * 128 + wr * 64 + m * 16 + fr;
                    const int pos = u.pm < 64 ? ((u.pm & 31) * 256 + row) : (PAST + (row & 31));
                    const f32x4* tp = (const f32x4*)(tab + (size_t)pos * 128 + d0);
                    tb[m][0] = tp[0]; tb[m][1] = tp[1]; tb[m][2] = tp[2]; tb[m][3] = tp[3];
                    rsq[m] = fx_get(ssq[(size_t)u.pm * 256 + row]);
                }
                EPI_FENCE;
#pragma unroll
                for (int m = mb; m < mb + 4; ++m) {
                    const int row = ai * 128 + wr * 64 + m * 16 + fr;
                    const f32x4 c01 = tb[m][0], c23 = tb[m][1], c45 = tb[m][2], c67 = tb[m][3];
                    const f32x4 cs0 = (f32x4){c01[0], c01[2], c23[0], c23[2]}, sn0 = (f32x4){c01[1], c01[3], c23[1], c23[3]};
                    const f32x4 cs1 = (f32x4){c45[0], c45[2], c67[0], c67[2]}, sn1 = (f32x4){c45[1], c45[3], c67[1], c67[3]};
                    const f32x4 x1a = acc[ai][0][m][0], x1b = acc[ai][0][m][1], x2a = acc[ai][1][m][0], x2b = acc[ai][1][m][1];
                    const float scr_ = sc * rstd_of(rsq[m]);
                    const f32x4 o1a = (x1a * cs0 - x2a * sn0) * scr_, o1b = (x1b * cs1 - x2b * sn1) * scr_;
                    const f32x4 o2a = (x2a * cs0 + x1a * sn0) * scr_, o2b = (x2b * cs1 + x1b * sn1) * scr_;
                    bf16_t* rp = dst + (size_t)row * 1024 + head * 256 + d0;
                    *(u32x4*)rp = pack8(o1a, o1b); *(u32x4*)(rp + 128) = pack8(o2a, o2b);
                    if (isk) {
                        const float dk = __expf(lgdec(head) * (float)(CH - 1 - (row & (CH - 1))));
                        const unsigned voff = (unsigned)((d0 * SEQ + row) * 2);
                        const unsigned sbase = (unsigned)(((head * 256) * SEQ + (u.pm & 31) * 256) * 2);
                        const u32x4 t1 = pack8(o1a * dk, o1b * dk);
#pragma unroll
                        for (int jj = 0; jj < 4; ++jj) {
                            __builtin_amdgcn_raw_buffer_store_b16((short)(t1[jj] & 0xffffu), ktr, voff, sbase + (unsigned)(2 * jj) * SEQ * 2u, 0);
                            __builtin_amdgcn_raw_buffer_store_b16((short)(t1[jj] >> 16), ktr, voff, sbase + (unsigned)(2 * jj + 1) * SEQ * 2u, 0); }
                        const u32x4 t2 = pack8(o2a * dk, o2b * dk);
#pragma unroll
                        for (int jj = 0; jj < 4; ++jj) {
                            __builtin_amdgcn_raw_buffer_store_b16((short)(t2[jj] & 0xffffu), ktr, voff, sbase + (unsigned)(128 + 2 * jj) * SEQ * 2u, 0);
                            __builtin_amdgcn_raw_buffer_store_b16((short)(t2[jj] >> 16), ktr, voff, sbase + (unsigned)(129 + 2 * jj) * SEQ * 2u, 0); }
                    }
                }
                EPI_FENCE;
            }
        } else {
            bf16_t* dst; int ld;
            if (u.pn < 32) { dst = (bf16_t*)(ws + WS_VTB0) + (size_t)u.pn * 256; ld = SEQ; }
            else if (u.pn < 64) { dst = (bf16_t*)(ws + WS_VTB1) + (size_t)(u.pn - 32) * 256; ld = SEQ; }
            else { dst = (bf16_t*)(ws + WS_VTS); ld = 256; }
            f32x4 rsv[2][2];
#pragma unroll
            for (int bj = 0; bj < 2; ++bj) { const fx_t* sp8 = ssq + (size_t)u.pn * 256 + bj * 128 + wc * 32 + fq * 8;
#pragma unroll
                for (int n = 0; n < 2; ++n) rsv[bj][n] = (f32x4){rstd_of(fx_get(sp8[4 * n])), rstd_of(fx_get(sp8[4 * n + 1])), rstd_of(fx_get(sp8[4 * n + 2])), rstd_of(fx_get(sp8[4 * n + 3]))}; }
#pragma unroll
            for (int ai = 0; ai < 2; ++ai)
#pragma unroll
                for (int m = 0; m < 4; ++m) {
                    const int e = (u.pm - 4) * 256 + ai * 128 + wr * 64 + m * 16 + fr;
                    bf16_t* rp = dst + (size_t)e * ld + wc * 32 + fq * 8;
#pragma unroll
                    for (int bj = 0; bj < 2; ++bj) *(u32x4*)(rp + bj * 128) = pack8(acc[ai][bj][m][0] * rsv[bj][0], acc[ai][bj][m][1] * rsv[bj][1]);
                    EPI_FENCE;
                }
        }
    }
};
struct EpiAtt {
    unsigned char* ws;
    __device__ __forceinline__ void operator()(EPI_ARGS) const {
        const int h = u.aux; const float lg = lgdec(h);
        bf16_t* dst = (bf16_t*)(ws + WS_ATT) + (size_t)(u.pn * SEQ + u.pm * CH) * 1024 + h * 256;
        float cf[2][8];
#pragma unroll
        for (int bj = 0; bj < 2; ++bj)
#pragma unroll
            for (int j = 0; j < 8; ++j) cf[bj][j] = __expf(-lg * (float)(bj * 128 + wc * 32 + fq * 8 + j + 1));
#pragma unroll
        for (int ai = 0; ai < 2; ++ai)
#pragma unroll
            for (int m = 0; m < 4; ++m) {
                const int n = ai * 128 + wr * 64 + m * 16 + fr;
#pragma unroll
                for (int bj = 0; bj < 2; ++bj) {
                    const int m0 = bj * 128 + wc * 32 + fq * 8;
                    float o[8];
#pragma unroll
                    for (int j = 0; j < 8; ++j) o[j] = __uint_as_float(__float_as_uint(acc[ai][bj][m][j >> 2][j & 3] * cf[bj][j]) & ~(unsigned)((n - m0 - j) >> 31));
                    *(u32x4*)(dst + (size_t)n * 1024 + m0) = pack8((f32x4){o[0], o[1], o[2], o[3]}, (f32x4){o[4], o[5], o[6], o[7]});
                }
                EPI_FENCE;
            }
    }
};
struct EpiU {
    unsigned char* ws;
    __device__ __forceinline__ void operator()(EPI_ARGS) const {
        bf16_t* dst = s_head(ws, u.kind, u.aux >> 1) + (size_t)((u.aux & 1) * 256) * SEQ + u.pm * CH;
#pragma unroll
        for (int ai = 0; ai < 2; ++ai)
#pragma unroll
            for (int m = 0; m < 4; ++m) {
                bf16_t* rp = dst + (size_t)(ai * 128 + wr * 64 + m * 16 + fr) * SEQ + wc * 32 + fq * 8;
#pragma unroll
                for (int bj = 0; bj < 2; ++bj) *(u32x4*)(rp + bj * 128) = pack8(acc[ai][bj][m][0], acc[ai][bj][m][1]);
                    EPI_FENCE;
            }
    }
};
struct EpiE {
    unsigned char* ws;
    __device__ __forceinline__ void operator()(EPI_ARGS) const {
        const int h = u.aux, b = u.kind; const float lg = lgdec(h);
        bf16_t* dst = (bf16_t*)(ws + (b ? WS_OB1 : WS_OB0)) + (size_t)(u.pm * CH) * 2048 + h * 512 + u.pn * 256;
        fx_t* st = (fx_t*)(ws + WS_STATS) + (size_t)(b * SEQ + u.pm * CH) * 8 + h * 2;
#pragma unroll
        for (int ai = 0; ai < 2; ++ai)
#pragma unroll
            for (int m = 0; m < 4; ++m) {
                const int n = ai * 128 + wr * 64 + m * 16 + fr; const float rs = __expf(lg * (float)(n + 1));
                float s = 0.f, q = 0.f;
#pragma unroll
                for (int bj = 0; bj < 2; ++bj) {
                    const f32x4 v0 = acc[ai][bj][m][0] * rs, v1 = acc[ai][bj][m][1] * rs;
                    s += (v0[0] + v0[1]) + (v0[2] + v0[3]) + (v1[0] + v1[1]) + (v1[2] + v1[3]);
                    q += (v0[0] * v0[0] + v0[1] * v0[1]) + (v0[2] * v0[2] + v0[3] * v0[3]) + (v1[0] * v1[0] + v1[1] * v1[1]) + (v1[2] * v1[2] + v1[3] * v1[3]);
                    *(u32x4*)(dst + (size_t)n * 2048 + bj * 128 + wc * 32 + fq * 8) = pack8(v0, v1);
                }
                s += shx<16>(s); s += shx<32>(s); q += shx<16>(q); q += shx<32>(q);
                if (fq == 0) { fx_add(st + (size_t)n * 8, s); fx_add(st + (size_t)n * 8 + 1, q); }
                EPI_FENCE;
            }
    }
};
struct EpiB2 {
    unsigned char* ws; const float* gn_g;
    __device__ __forceinline__ void operator()(EPI_ARGS) const {
        const fx_t* ssq = (const fx_t*)(ws + WS_SSQA) + (size_t)u.pm * 256;
        float rsr[2][4];
#pragma unroll
        for (int ai = 0; ai < 2; ++ai)
#pragma unroll
            for (int m = 0; m < 4; ++m) rsr[ai][m] = fx_get(ssq[ai * 128 + wr * 64 + m * 16 + fr]);
#pragma unroll
        for (int ai = 0; ai < 2; ++ai)
#pragma unroll
            for (int m = 0; m < 4; ++m) rsr[ai][m] = rstd_of(rsr[ai][m]);
        if (u.pn < 8) {
            bf16_t* dst = (bf16_t*)(ws + WS_GLU) + (size_t)u.pm * 256 * 1024 + u.pn * 128 + wc * 32 + fq * 8;
#pragma unroll
            for (int ai = 0; ai < 2; ++ai)
#pragma unroll
                for (int m = 0; m < 4; ++m) {
                    const int row = ai * 128 + wr * 64 + m * 16 + fr;
                    const float rs = rsr[ai][m];
                    f32x4 a0 = acc[ai][0][m][0] * rs, a1 = acc[ai][0][m][1] * rs; const f32x4 b0 = acc[ai][1][m][0] * rs, b1 = acc[ai][1][m][1] * rs;
#pragma unroll
                    for (int j = 0; j < 4; ++j) { a0[j] *= sigm(b0[j]); a1[j] *= sigm(b1[j]); }
                    *(u32x4*)(dst + (size_t)row * 1024) = pack8(a0, a1);
                    EPI_FENCE;
                }
        } else if (u.pn < 16) {
            const int t = u.pn - 8, head = t >> 1;
            bf16_t* ob = o_tile(ws, u.pm) + t * 256 + wc * 32 + fq * 8;
            const fx_t* st = (const fx_t*)(ws + WS_STATS) + (size_t)u.pm * 256 * 8 + head * 2;
            f32x4 gg[2][2];
#pragma unroll
            for (int bj = 0; bj < 2; ++bj) { const f32x4* gp = (const f32x4*)(gn_g + t * 256 + bj * 128 + wc * 32 + fq * 8); gg[bj][0] = gp[0]; gg[bj][1] = gp[1]; }
#pragma unroll
            for (int aih = 0; aih < 4; ++aih) {
                const int ai = aih >> 1, mb = (aih & 1) * 2;
                f32x2 sqv[4]; u32x4 ov[4][2];
#pragma unroll
                for (int m = mb; m < mb + 2; ++m) {
                    const int row = ai * 128 + wr * 64 + m * 16 + fr;
                    { const fx_t* sp2 = st + (size_t)row * 8; sqv[m] = (f32x2){fx_get(sp2[0]), fx_get(sp2[1])}; }
#pragma unroll
                    for (int bj = 0; bj < 2; ++bj) ov[m][bj] = *(const u32x4*)(ob + (size_t)row * 2048 + bj * 128);
                }
                EPI_FENCE;
#pragma unroll
                for (int m = mb; m < mb + 2; ++m) {
                    const int row = ai * 128 + wr * 64 + m * 16 + fr;
                    const f32x2 sq = sqv[m]; const float rsn = rsr[ai][m];
                    const float mu = sq.x * (1.0f / 512.0f); const float var = fmaxf(sq.y * (1.0f / 512.0f) - mu * mu, 0.f); const float rstd = __builtin_amdgcn_rsqf(var + LN_EPS);
#pragma unroll
                    for (int bj = 0; bj < 2; ++bj) {
                        bf16_t* rp = ob + (size_t)row * 2048 + bj * 128;
                        f32x4 o0, o1; unpack8(ov[m][bj], o0, o1);
                        f32x4 g0 = acc[ai][bj][m][0] * rsn, g1 = acc[ai][bj][m][1] * rsn;
#pragma unroll
                        for (int j = 0; j < 4; ++j) { g0[j] = g0[j] * sigm(g0[j]) * ((o0[j] - mu) * rstd * gg[bj][0][j]); g1[j] = g1[j] * sigm(g1[j]) * ((o1[j] - mu) * rstd * gg[bj][1][j]); }
                        *(u32x4*)rp = pack8(g0, g1);
                    }
                }
                EPI_FENCE;
            }
        } else {
            const int t = (u.pn - 16) & 3;
            bf16_t* dst = (bf16_t*)(ws + (u.pn < 20 ? WS_GC : WS_GR)) + (size_t)u.pm * 256 * 1024 + t * 256 + wc * 32 + fq * 8;
#pragma unroll
            for (int ai = 0; ai < 2; ++ai)
#pragma unroll
                for (int m = 0; m < 4; ++m) {
                    const int row = ai * 128 + wr * 64 + m * 16 + fr; const float rs = rsr[ai][m];
#pragma unroll
                    for (int bj = 0; bj < 2; ++bj) {
                        f32x4 a0 = acc[ai][bj][m][0] * rs, a1 = acc[ai][bj][m][1] * rs;
#pragma unroll
                        for (int j = 0; j < 4; ++j) { a0[j] = sigm(a0[j]); a1[j] = sigm(a1[j]); }
                        *(u32x4*)(dst + (size_t)row * 1024 + bj * 128) = pack8(a0, a1);
                    }
                    EPI_FENCE;
                }
        }
    }
};
template <int MODE> struct EpiEW {
    unsigned char* ws; float* x; fx_t* ssq;
    __device__ __forceinline__ void operator()(EPI_ARGS) const {
        const int c0 = u.pn * 256 + wc * 32 + fq * 8;
#pragma unroll
        for (int ai = 0; ai < 2; ++ai) {
            u32x4 gv[4][2], tv[4][2]; float sqs[4] = {0.f, 0.f, 0.f, 0.f}, rs3[4];
            if (MODE == 3) {
#pragma unroll
                for (int m = 0; m < 4; ++m) rs3[m] = rstd_of(fx_get(ssq[(size_t)u.pm * 256 + ai * 128 + wr * 64 + m * 16 + fr]));
            }
            if (MODE != 3) {
#pragma unroll
                for (int m = 0; m < 4; ++m) {
                    const size_t row = (size_t)u.pm * 256 + ai * 128 + wr * 64 + m * 16 + fr;
#pragma unroll
                    for (int bj = 0; bj < 2; ++bj) {
                        if (MODE == 0) gv[m][bj] = *(const u32x4*)((const bf16_t*)(ws + WS_GC) + row * 1024 + c0 + bj * 128);
                        if (MODE == 1) { gv[m][bj] = *(const u32x4*)((const bf16_t*)(ws + WS_GR) + row * 1024 + c0 + bj * 128); tv[m][bj] = *(const u32x4*)((const bf16_t*)(ws + WS_T) + row * 1024 + c0 + bj * 128); }
                        if (MODE == 2) tv[m][bj] = *(const u32x4*)((const bf16_t*)(ws + WS_H) + row * 1024 + c0 + bj * 128);
                    }
                }
                EPI_FENCE;
            }
#pragma unroll
            for (int m = 0; m < 4; ++m) {
                const size_t row = (size_t)u.pm * 256 + ai * 128 + wr * 64 + m * 16 + fr;
#pragma unroll
                for (int bj = 0; bj < 2; ++bj) {
                    f32x4 a0 = acc[ai][bj][m][0], a1 = acc[ai][bj][m][1];
                    if (MODE == 0) {
                        f32x4 g0, g1; unpack8(gv[m][bj], g0, g1);
                        *(u32x4*)((bf16_t*)(ws + WS_T) + row * 1024 + c0 + bj * 128) = pack8(a0 * g0, a1 * g1);
                    } else if (MODE == 1) {
                        f32x4 g0, g1, t0, t1; unpack8(gv[m][bj], g0, g1); unpack8(tv[m][bj], t0, t1);
                        *(u32x4*)((bf16_t*)(ws + WS_T) + row * 1024 + c0 + bj * 128) = pack8(t0 + a0 * g0, t1 + a1 * g1);
                    } else if (MODE == 2) {
                        f32x4 x0, x1; unpack8(tv[m][bj], x0, x1);
                        a0 = x0 + a0; a1 = x1 + a1;
                        *(u32x4*)((bf16_t*)(ws + WS_H) + row * 1024 + c0 + bj * 128) = pack8(a0, a1);
                        sqs[m] += (a0[0] * a0[0] + a0[1] * a0[1]) + (a0[2] * a0[2] + a0[3] * a0[3]) + (a1[0] * a1[0] + a1[1] * a1[1]) + (a1[2] * a1[2] + a1[3] * a1[3]);
                    } else {
#pragma unroll
                        for (int j = 0; j < 4; ++j) { const float r0 = fmaxf(a0[j], 0.f) * rs3[m], r1 = fmaxf(a1[j], 0.f) * rs3[m]; a0[j] = r0 * r0; a1[j] = r1 * r1; }
                        *(u32x4*)((bf16_t*)(ws + WS_U) + row * 4096 + c0 + bj * 128) = pack8(a0, a1);
                    }
                }
                if (MODE == 2) { float q = sqs[m]; q += shx<16>(q); q += shx<32>(q); if (fq == 0) fx_add(ssq + row, q); }
            }
            EPI_FENCE;
        }
    }
};

__device__ __forceinline__ void transpose_item(const float* W, int K, int N, bf16_t* WT, int k0, int n0, int drow0, LAS float* scr, int lane, const float* gk = nullptr) {
    float tv[32];
#pragma unroll
    for (int i = 0; i < 32; ++i) { const int kk = 2 * i + (lane >> 5); tv[i] = W[(size_t)(k0 + kk) * N + n0 + (lane & 31)]; }
#pragma unroll
    for (int i = 0; i < 32; ++i) { const int kk = 2 * i + (lane >> 5); scr[kk * 33 + (lane & 31)] = gk ? tv[i] * gk[k0 + kk] : tv[i]; }
    asm volatile("s_waitcnt lgkmcnt(0)" ::: "memory");
    const int c = lane & 7;
#pragma unroll
    for (int j = 0; j < 4; ++j) { const int n = (lane >> 3) + 8 * j; const LAS float* s = scr + (8 * c) * 33 + n;
        u32x4 o; o.x = cvt_pk_bf16(s[0 * 33], s[1 * 33]); o.y = cvt_pk_bf16(s[2 * 33], s[3 * 33]); o.z = cvt_pk_bf16(s[4 * 33], s[5 * 33]); o.w = cvt_pk_bf16(s[6 * 33], s[7 * 33]);
        *(u32x4*)(WT + (size_t)(drow0 + n) * K + k0 + 8 * c) = o; }
    asm volatile("s_waitcnt lgkmcnt(0)" ::: "memory");
}
struct TItem { const float* W; const float* gk; bf16_t* WT; int K, N, k0, n0, drow0; };
__device__ __forceinline__ void titem_load(const TItem& t, int lane, float (&tv)[32], f32x4& g0, f32x4& g1) {
#pragma unroll
    for (int i = 0; i < 32; ++i) { const int kk = 2 * i + (lane >> 5); tv[i] = t.W[(size_t)(t.k0 + kk) * t.N + t.n0 + (lane & 31)]; }
    g0 = (f32x4){1.f, 1.f, 1.f, 1.f}; g1 = g0;
    if (t.gk) { const f32x4* gp = (const f32x4*)(t.gk + t.k0 + 8 * (lane & 7)); g0 = gp[0]; g1 = gp[1]; }
}
__device__ __forceinline__ void titem_store(const TItem& t, int lane, const float (&tv)[32], const f32x4 g0, const f32x4 g1, LAS float* scr) {
#pragma unroll
    for (int i = 0; i < 32; ++i) { const int kk = 2 * i + (lane >> 5); scr[kk * 33 + (lane & 31)] = tv[i]; }
    asm volatile("s_waitcnt lgkmcnt(0)" ::: "memory");
    const int c = lane & 7;
#pragma unroll
    for (int j = 0; j < 4; ++j) { const int n = (lane >> 3) + 8 * j; const LAS float* sp = scr + (8 * c) * 33 + n;
        u32x4 o; o.x = cvt_pk_bf16(sp[0 * 33] * g0[0], sp[1 * 33] * g0[1]); o.y = cvt_pk_bf16(sp[2 * 33] * g0[2], sp[3 * 33] * g0[3]);
        o.z = cvt_pk_bf16(sp[4 * 33] * g1[0], sp[5 * 33] * g1[1]); o.w = cvt_pk_bf16(sp[6 * 33] * g1[2], sp[7 * 33] * g1[3]);
        *(u32x4*)(t.WT + (size_t)(t.drow0 + n) * t.K + t.k0 + 8 * c) = o; }
    asm volatile("s_waitcnt lgkmcnt(0)" ::: "memory");
}
__device__ __forceinline__ int win_drow(int n0) {
    if (n0 < 2048) { const int bj = n0 >> 10, jj = n0 & 1023; return 4096 + 256 * (jj >> 7) + 128 * bj + (jj & 127); }
    if (n0 < 6144) return n0 - 2048;
    return n0;
}
__device__ __forceinline__ void rms_row(const float* xrow, const float* g, bf16_t* orow, float* copy, int lane) {
    const f32x4* xr = (const f32x4*)xrow + lane; const f32x4* gr = (const f32x4*)g + lane;
    f32x4 v[4]; float s = 0.f;
#pragma unroll
    for (int j = 0; j < 4; ++j) { v[j] = xr[64 * j]; s += (v[j][0] * v[j][0] + v[j][1] * v[j][1]) + (v[j][2] * v[j][2] + v[j][3] * v[j][3]); }
    const float r = 1.0f / sqrtf(wave_sum(s) * (1.0f / 1024.0f) + RMS_EPS);
    u32x2* o8 = (u32x2*)orow + lane;
#pragma unroll
    for (int j = 0; j < 4; ++j) { const f32x4 gg = gr[64 * j]; if (copy) ((f32x4*)copy + lane)[64 * j] = v[j];
        u32x2 w; w.x = cvt_pk_bf16(v[j][0] * r * gg[0], v[j][1] * r * gg[1]); w.y = cvt_pk_bf16(v[j][2] * r * gg[2], v[j][3] * r * gg[3]); o8[64 * j] = w; }
}

__device__ __forceinline__ void phase0(int wv, const Params& p, int l, LAS unsigned char* lds, int part) {
    int wv_ = wv; asm volatile("" : "+s"(wv_)); int tid = wv_ * 64 + lane_id(); asm volatile("" : "+v"(tid));
    const int lane = tid & 63, wave = tid >> 6, G = gdim();
    const int gw = blockIdx.x * 8 + wave, NGW = G * 8;
    unsigned char* ws = p.ws;
    LAS float* scr = (LAS float*)(lds + wave * 16384);
    const float* w_in = p.in[5] + (size_t)l * 1024 * 10240; const float* w_c = p.in[10] + (size_t)l * 1024 * 1024; const float* w_r = p.in[12] + (size_t)l * 2048 * 1024;
    const float* w_o = p.in[13] + (size_t)l * 1024 * 1024; const float* w_1 = p.in[15] + (size_t)l * 1024 * 4096; const float* w_2 = p.in[16] + (size_t)l * 4096 * 1024;
    constexpr int I_IN = 16 * 320, I_C = 16 * 32, I_R = 32 * 32, I_O = 16 * 32, I_1 = 16 * 128, I_2 = 64 * 32, NIT = I_IN + I_C + I_R + I_O + I_1 + I_2;
#define TI_DECODE(it_, T_) do { int r = (it_); \
        if (r < I_IN) { const int kb = r / 320, nb = r % 320; T_ = TItem{w_in, p.in[4] + l * 1024, (bf16_t*)(ws + WS_WIN), 1024, 10240, kb * 64, nb * 32, win_drow(nb * 32)}; break; } r -= I_IN; \
        if (r < I_C) { const int kb = r / 32, nb = r % 32; T_ = TItem{w_c, nullptr, (bf16_t*)(ws + WS_WC), 1024, 1024, kb * 64, nb * 32, nb * 32}; break; } r -= I_C; \
        if (r < I_R) { const int kb = r / 32, nb = r % 32; T_ = TItem{w_r, nullptr, (bf16_t*)(ws + WS_WR), 2048, 1024, kb * 64, nb * 32, nb * 32}; break; } r -= I_R; \
        if (r < I_O) { const int kb = r / 32, nb = r % 32; T_ = TItem{w_o, nullptr, (bf16_t*)(ws + WS_WO), 1024, 1024, kb * 64, nb * 32, nb * 32}; break; } r -= I_O; \
        if (r < I_1) { const int kb = r / 128, nb = r % 128; T_ = TItem{w_1, p.in[14] + l * 1024, (bf16_t*)(ws + WS_WM1), 1024, 4096, kb * 64, nb * 32, nb * 32}; break; } r -= I_1; \
        { const int kb = r / 32, nb = r % 32; T_ = TItem{w_2, nullptr, (bf16_t*)(ws + WS_WM2), 4096, 1024, kb * 64, nb * 32, nb * 32}; } } while (0)
    const int it_first = part == 0 ? 0 : I_IN, it_last = part == 0 ? I_IN : NIT;
    if (it_first + gw < it_last) {
        int it = it_first + gw; TItem cur; TI_DECODE(it, cur);
        float tv[32]; f32x4 g0, g1; titem_load(cur, lane, tv, g0, g1);
#pragma unroll 1
        for (;;) {
            const int nit = it + NGW; const bool has = nit < it_last;
            TItem nx = cur; float tn[32]; f32x4 h0 = g0, h1 = g1;
            if (has) { TI_DECODE(nit, nx); titem_load(nx, lane, tn, h0, h1); }
            titem_store(cur, lane, tv, g0, g1, scr);
            if (!has) break;
            cur = nx; it = nit; g0 = h0; g1 = h1;
#pragma unroll
            for (int i = 0; i < 32; ++i) tv[i] = tn[i];
        }
    }
#undef TI_DECODE
    if (part != 0) { asm volatile("s_waitcnt vmcnt(0) lgkmcnt(0)" ::: "memory"); __syncthreads(); return; }
    if (l == 0) {
        for (int m = gw; m < NTOK; m += NGW) {
            const float* src = m < NPT ? p.in[0] + (size_t)m * 1024 : p.in[1] + (size_t)(m - NPT) * 1024;
            const f32x4* xr = (const f32x4*)src + lane; f32x4 v[4]; float sq = 0.f;
#pragma unroll
            for (int j = 0; j < 4; ++j) { v[j] = xr[64 * j]; sq += (v[j][0] * v[j][0] + v[j][1] * v[j][1]) + (v[j][2] * v[j][2] + v[j][3] * v[j][3]); }
            sq = wave_sum(sq);
            u32x2* o8 = (u32x2*)((bf16_t*)(ws + WS_H) + (size_t)m * 1024) + lane;
#pragma unroll
            for (int j = 0; j < 4; ++j) { u32x2 wv; wv.x = cvt_pk_bf16(v[j][0], v[j][1]); wv.y = cvt_pk_bf16(v[j][2], v[j][3]); o8[64 * j] = wv; }
            if (lane == 0) ((fx_t*)(ws + WS_SSQA))[m] = fx_of(sq);
        }
    }
    { unsigned z = 0u; asm volatile("" : "+v"(z)); unsigned* sb = (unsigned*)(ws + WS_SSQB); for (int i = blockIdx.x * 512 + tid; i < NTOK * 2; i += G * 512) sb[i] = z; }
    { unsigned z = 0u; asm volatile("" : "+v"(z)); unsigned* st = (unsigned*)(ws + WS_STATS); for (int i = blockIdx.x * 512 + tid; i < NTOK * 16; i += G * 512) st[i] = z; }
    {
        f32x2* tab = (f32x2*)(ws + WS_TAB);
        for (int i = blockIdx.x * 512 + tid; i < 8192 * 128; i += G * 512) {
            const int pos = i >> 7, k = i & 127;
            const float inv = powf(10000.0f, -(float)(2 * k) / 256.0f); const float ang = (float)pos * inv;
            float sn, cs; sincosf(ang, &sn, &cs); tab[i] = (f32x2){cs, sn};
        }
    }
}

__device__ __forceinline__ void phase_scan(int wv, const Params& p, int l) {
    int wv_ = wv; asm volatile("" : "+s"(wv_)); int tid = wv_ * 64 + lane_id(); asm volatile("" : "+v"(tid));
    const int gt = blockIdx.x * 512 + tid;
    if (gt >= 2048 * 64) return;
    const int row = gt >> 6, d4 = (gt & 63) * 4, h = row >> 9, e = row & 511;
    const float sd = __expf(lgdec(h) * (float)CH);
#pragma unroll 1
    for (int b = 0; b < 2; ++b) {
        bf16_t* sp = s_head(p.ws, b, h) + (size_t)e * SEQ + d4;
        float a[4] = {0.f, 0.f, 0.f, 0.f};
#pragma unroll 1
        for (int j0 = 0; j0 < 32; j0 += 16) {
            u32x2 w[16];
#pragma unroll
            for (int j = 0; j < 16; ++j) w[j] = *(const u32x2*)(sp + (j0 + j) * CH);
#pragma unroll
            for (int j = 0; j < 16; ++j) {
                u32x2 o; o.x = cvt_pk_bf16(a[0], a[1]); o.y = cvt_pk_bf16(a[2], a[3]);
                *(u32x2*)(sp + (j0 + j) * CH) = o;
                a[0] = a[0] * sd + bflo(w[j].x); a[1] = a[1] * sd + bfhi(w[j].x); a[2] = a[2] * sd + bflo(w[j].y); a[3] = a[3] * sd + bfhi(w[j].y);
            }
        }
        float* o = p.out + OUT_RETP + ((size_t)((l * 2 + b) * 4 + h) * 256 + d4) * 512 + e;
#pragma unroll
        for (int j = 0; j < 4; ++j) o[(size_t)j * 512] = a[j];
    }
}

__device__ __forceinline__ void phase_sret(int wv, const Params& p, int l, LAS unsigned char* lds) {
    int wv_ = wv; asm volatile("" : "+s"(wv_)); int tid = wv_ * 64 + lane_id(); asm volatile("" : "+v"(tid));
    const int lane = tid & 63, w = __builtin_amdgcn_readfirstlane(tid >> 6);
    unsigned char* ws = p.ws;
    LAS float* attL = (LAS float*)lds;
    LAS float* red = (LAS float*)(lds + 8192);
    for (int unit = blockIdx.x, GG = gdim(); unit < 256; unit += GG) {
        const int es = unit & 7, h = (unit >> 3) & 3, bs = unit >> 5;
        const float lg = lgdec(h);
        const bf16_t* q = (const bf16_t*)(ws + WS_Q) + (size_t)(NPT + bs * 32) * 1024 + h * 256;
        const bf16_t* k = (const bf16_t*)(ws + WS_KS) + (size_t)(bs * 32) * 1024 + h * 256;
        const bf16_t* kT = (const bf16_t*)(ws + WS_KTS) + (size_t)(h * 256) * 256 + bs * 32;
        const bf16_t* vT = (const bf16_t*)(ws + WS_VTS) + (size_t)(h * 512 + es * 64) * 256 + bs * 32;
        if (w == 0) {
            f32x16 accq;
#pragma unroll
            for (int r = 0; r < 16; ++r) accq[r] = 0.f;
            const bf16_t* qa = q + (size_t)(lane & 31) * 1024 + (lane >> 5) * 8; const bf16_t* kb = k + (size_t)(lane & 31) * 1024 + (lane >> 5) * 8;
#pragma unroll
            for (int sk = 0; sk < 16; ++sk) { const bf16x8 af = *(const bf16x8*)(qa + 16 * sk), bfr = *(const bf16x8*)(kb + 16 * sk); accq = __builtin_amdgcn_mfma_f32_32x32x16_bf16(af, bfr, accq, 0, 0, 0); }
            const int m = lane & 31;
#pragma unroll
            for (int r = 0; r < 16; ++r) { const int n = (r & 3) + 8 * (r >> 2) + 4 * (lane >> 5); attL[n * 33 + m] = (m <= n) ? accq[r] * __expf(lg * (float)(n - m)) : 0.f; }
        }
        const int e = es * 64 + lane;
        const float* S0 = p.in[3] + ((size_t)((l * 8 + bs) * 4 + h) * 256 + w * 32) * 512 + e;
        float s0[32];
#pragma unroll
        for (int dd = 0; dd < 32; ++dd) s0[dd] = S0[(size_t)dd * 512];
        float v[32];
        { const u32x4* vp = (const u32x4*)(vT + (size_t)lane * 256);
#pragma unroll
          for (int c = 0; c < 4; ++c) { f32x4 a, b2; unpack8(vp[c], a, b2); v[8 * c] = a[0]; v[8 * c + 1] = a[1]; v[8 * c + 2] = a[2]; v[8 * c + 3] = a[3]; v[8 * c + 4] = b2[0]; v[8 * c + 5] = b2[1]; v[8 * c + 6] = b2[2]; v[8 * c + 7] = b2[3]; } }
        {
            float* So = p.out + OUT_RETS + ((size_t)((l * 8 + bs) * 4 + h) * 256 + w * 32) * 512 + e;
            const float sd = __expf(lg * 32.0f);
#pragma unroll 4
            for (int dd = 0; dd < 32; ++dd) {
                const u32x4* kr = (const u32x4*)(kT + (size_t)(w * 32 + dd) * 256); float a = s0[dd] * sd;
#pragma unroll
                for (int c4 = 0; c4 < 4; ++c4) { f32x4 k0, k1; unpack8(kr[c4], k0, k1);
                    a += (k0[0] * v[8 * c4] + k0[1] * v[8 * c4 + 1]) + (k0[2] * v[8 * c4 + 2] + k0[3] * v[8 * c4 + 3]) + (k1[0] * v[8 * c4 + 4] + k1[1] * v[8 * c4 + 5]) + (k1[2] * v[8 * c4 + 6] + k1[3] * v[8 * c4 + 7]); }
                So[(size_t)dd * 512] = a;
            }
        }
#pragma unroll 2
        for (int n = 0; n < 32; ++n) {
            const u32x4* qr = (const u32x4*)(q + (size_t)n * 1024 + w * 32); float a = 0.f;
#pragma unroll
            for (int c4 = 0; c4 < 4; ++c4) { f32x4 k0, k1; unpack8(qr[c4], k0, k1);
                a += (k0[0] * s0[8 * c4] + k0[1] * s0[8 * c4 + 1]) + (k0[2] * s0[8 * c4 + 2] + k0[3] * s0[8 * c4 + 3]) + (k1[0] * s0[8 * c4 + 4] + k1[1] * s0[8 * c4 + 5]) + (k1[2] * s0[8 * c4 + 6] + k1[3] * s0[8 * c4 + 7]); }
            red[(w * 32 + n) * 64 + lane] = a * __expf(lg * (float)(n + 1));
        }
        __syncthreads();
        bf16_t* O = (bf16_t*)(ws + WS_OS) + (size_t)(bs * 32) * 2048 + h * 512 + e;
        fx_t* st = (fx_t*)(ws + WS_STATS) + (size_t)(NPT + bs * 32) * 8 + h * 2;
#pragma unroll
        for (int r = 0; r < 4; ++r) {
            const int n = w * 4 + r; float a = 0.f;
#pragma unroll
            for (int ww = 0; ww < 8; ++ww) a += red[(ww * 32 + n) * 64 + lane];
#pragma unroll
            for (int m = 0; m < 32; ++m) a += attL[n * 33 + m] * v[m];
            O[(size_t)n * 2048] = (bf16_t)(cvt_pk_bf16(a, 0.f) & 0xffffu);
            const float s = wave_sum(a), qq = wave_sum(a * a);
            if (lane == 0) { fx_add(st + (size_t)n * 8, s); fx_add(st + (size_t)n * 8 + 1, qq); }
        }
        __syncthreads();
    }
}

__device__ __forceinline__ void phase_conv(int wv, const Params& p, int l, LAS unsigned char* lds) {
    int wv_ = wv; asm volatile("" : "+s"(wv_)); int tid = wv_ * 64 + lane_id(); asm volatile("" : "+v"(tid));
    const int lane = tid & 63, wave = tid >> 6;
    unsigned char* ws = p.ws;
    LAS float* red = (LAS float*)lds;
    const int c0 = tid * 2;
    const float* cw = p.in[6] + (size_t)l * 31 * 1024 + c0;
    float w0[31], w1[31];
#pragma unroll
    for (int j = 0; j < 31; ++j) { const f32x2 t = *(const f32x2*)(cw + (size_t)j * 1024); w0[j] = t.x; w1[j] = t.y; }
    const f32x2 cb = *(const f32x2*)(p.in[7] + l * 1024 + c0), lg = *(const f32x2*)(p.in[8] + l * 1024 + c0), lb = *(const f32x2*)(p.in[9] + l * 1024 + c0);
    const int GG = gdim();
    { unsigned z = 0u; asm volatile("" : "+v"(z)); unsigned* sa = (unsigned*)(ws + WS_SSQA); for (int i = blockIdx.x * 512 + tid; i < NTOK * 2; i += GG * 512) sa[i] = z; }
    for (int tok = blockIdx.x; tok < 256; tok += GG) {
        const int sb = tok >> 5, t = tok & 31;
        const bf16_t* gl = (const bf16_t*)(ws + WS_GLU) + (size_t)(NPT + sb * 32) * 1024 + c0;
        const float* cst = p.in[2] + (size_t)(l * 8 + sb) * 30 * 1024 + c0;
        unsigned xg[31]; f32x2 xs[31];
#pragma unroll
        for (int j = 0; j < 31; ++j) { const int tt = t + j - 30; const int tg = tt < 0 ? 0 : tt, tsx = tt + 30 > 29 ? 29 : tt + 30;
            xg[j] = *(const unsigned*)(gl + (size_t)tg * 1024); xs[j] = *(const f32x2*)(cst + (size_t)tsx * 1024); }
        float a0 = cb.x, a1 = cb.y;
#pragma unroll
        for (int j = 0; j < 31; ++j) { const bool fromg = (t + j - 30) >= 0; const float x0 = fromg ? bflo(xg[j]) : xs[j].x, x1 = fromg ? bfhi(xg[j]) : xs[j].y; a0 += x0 * w0[j]; a1 += x1 * w1[j]; }
        if (t >= 2) *(f32x2*)(p.out + OUT_CONVS + ((size_t)(l * 8 + sb) * 30 + (t - 2)) * 1024 + c0) = (f32x2){bflo(xg[30]), bfhi(xg[30])};
        { const float s = wave_sum(a0 + a1), q = wave_sum(a0 * a0 + a1 * a1); if (lane == 0) { red[wave] = s; red[128 + wave] = q; } }
        __syncthreads();
        { float s = 0.f, q = 0.f;
#pragma unroll
          for (int ww = 0; ww < 8; ++ww) { s += red[ww]; q += red[128 + ww]; }
          const float mu = s * (1.0f / 1024.0f); const float var = fmaxf(q * (1.0f / 1024.0f) - mu * mu, 0.f); const float rstd = __builtin_amdgcn_rsqf(var + LN_EPS);
          float y0 = (a0 - mu) * rstd * lg.x + lb.x, y1 = (a1 - mu) * rstd * lg.y + lb.y; y0 *= sigm(y0); y1 *= sigm(y1);
          *(unsigned*)((bf16_t*)(ws + WS_YC) + (size_t)(NPT + tok) * 1024 + c0) = cvt_pk_bf16(y0, y1); }
        __syncthreads();
    }
    for (int unit = blockIdx.x; unit < NPT / 16; unit += GG) {
        const int g0 = unit * 16, t0 = g0 & (SEQ - 1), pb = g0 >> 13;
        const bool lastt = (t0 == SEQ - 16);
        const bf16_t* gl = (const bf16_t*)(ws + WS_GLU) + (size_t)g0 * 1024 + c0;
        float* cso = p.out + OUT_CONVP + (size_t)(l * 2 + pb) * 30 * 1024 + c0;
        unsigned xin[46];
#pragma unroll
        for (int r = 0; r < 46; ++r) { const int tt = t0 - 30 + r; const long off = tt >= 0 ? (long)(r - 30) : 0l; xin[r] = *(const unsigned*)(gl + off * 1024); if (tt < 0) xin[r] = 0u; }
        float a0[16], a1[16];
#pragma unroll
        for (int t = 0; t < 16; ++t) { a0[t] = cb.x; a1[t] = cb.y; }
#pragma unroll
        for (int r = 0; r < 46; ++r) {
            const float x0 = bflo(xin[r]), x1 = bfhi(xin[r]);
            if (r >= 16 && lastt) *(f32x2*)(cso + (size_t)(r - 16) * 1024) = (f32x2){x0, x1};
#pragma unroll
            for (int t = 0; t < 16; ++t) { const int j = r - t; if (j >= 0 && j <= 30) { a0[t] += x0 * w0[j]; a1[t] += x1 * w1[j]; } }
        }
#pragma unroll
        for (int t = 0; t < 16; ++t) { const float s = wave_sum(a0[t] + a1[t]), q = wave_sum(a0[t] * a0[t] + a1[t] * a1[t]); if (lane == 0) { red[t * 8 + wave] = s; red[128 + t * 8 + wave] = q; } }
        __syncthreads();
        bf16_t* yo = (bf16_t*)(ws + WS_YC) + (size_t)g0 * 1024 + c0;
#pragma unroll
        for (int t = 0; t < 16; ++t) { float s = 0.f, q = 0.f;
#pragma unroll
            for (int ww = 0; ww < 8; ++ww) { s += red[t * 8 + ww]; q += red[128 + t * 8 + ww]; }
            const float mu = s * (1.0f / 1024.0f); const float var = fmaxf(q * (1.0f / 1024.0f) - mu * mu, 0.f);
            const float rstd = __builtin_amdgcn_rsqf(var + LN_EPS);
            float y0 = (a0[t] - mu) * rstd * lg.x + lb.x, y1 = (a1[t] - mu) * rstd * lg.y + lb.y;
            y0 *= sigm(y0); y1 *= sigm(y1);
            *(unsigned*)(yo + (size_t)t * 1024) = cvt_pk_bf16(y0, y1); }
        __syncthreads();
    }
}

__device__ __forceinline__ void phase_rms2(int wv, const Params& p, int l) {
    int wv_ = wv; asm volatile("" : "+s"(wv_)); int tid = wv_ * 64 + lane_id(); asm volatile("" : "+v"(tid));
    const int lane = tid & 63, gw = blockIdx.x * 8 + (tid >> 6), NGW = gdim() * 8;
    const float* g2 = p.in[14] + l * 1024;
    for (int m = gw; m < NTOK; m += NGW) rms_row(p.out + (size_t)m * 1024, g2, (bf16_t*)(p.ws + WS_H) + (size_t)m * 1024, nullptr, lane);
}
__device__ __forceinline__ void phase_final(int wv, const Params& p) {
    int wv_ = wv; asm volatile("" : "+s"(wv_)); int tid = wv_ * 64 + lane_id(); asm volatile("" : "+v"(tid));
    const int lane = tid & 63, gw = blockIdx.x * 8 + (tid >> 6), NGW = gdim() * 8;
    const f32x4* gr = (const f32x4*)p.in[17] + lane; const fx_t* ssq = (const fx_t*)(p.ws + WS_SSQA);
    for (int m = gw; m < NTOK; m += NGW) {
        f32x4* yr = (f32x4*)(p.out + (size_t)m * 1024) + lane; const u32x2* xr = (const u32x2*)((const bf16_t*)(p.ws + WS_H) + (size_t)m * 1024) + lane; const float r = rstd_of(fx_get(ssq[m]));
#pragma unroll
        for (int j = 0; j < 4; ++j) { const u32x2 w = xr[64 * j]; const f32x4 xv = {bflo(w.x), bfhi(w.x), bflo(w.y), bfhi(w.y)}; yr[64 * j] = xv * r * gr[64 * j]; }
    }
}

#define SG_BAR() do { asm volatile("s_waitcnt lgkmcnt(0)" ::: "memory"); __builtin_amdgcn_s_barrier(); asm volatile("" ::: "memory"); } while (0)
template <bool PAIR, class EpiS>
__device__ __forceinline__ void sgemm_phase(int wv, LAS unsigned char* lds, const bf16_t* A, const bf16_t* Wt, int K, int nUnits, const EpiS& epi) {
    int wv_ = wv; asm volatile("" : "+s"(wv_)); int tid = wv_ * 64 + lane_id(); asm volatile("" : "+v"(tid));
    const int lane = tid & 63, w = __builtin_amdgcn_readfirstlane(tid >> 6);
    LAS float* red = (LAS float*)lds;
    const int kw = K >> 3, GG = gdim();
    const size_t loff = (size_t)(lane & 31) * K + w * kw + (lane >> 5) * 8;
    const int row = tid >> 4, jq = tid & 15;
    int unit = blockIdx.x;
    if (unit >= nUnits) return;
#define SG_PTRS(u_) const int rb_ = (u_) & 7, cp_ = (u_) >> 3, n0_ = PAIR ? ((cp_ >> 2) * 256 + (cp_ & 3) * 32) : cp_ * 32; \
        const bf16_t* ap = A + (size_t)(rb_ * 32) * K + loff; const bf16_t* bp0 = Wt + (size_t)n0_ * K + loff; const bf16_t* bp1 = bp0 + (size_t)128 * K;
#define SG_REDUCE(u_) do { \
        _Pragma("unroll") for (int r = 0; r < 16; ++r) { const int i = (r & 3) + 8 * (r >> 2) + 4 * (lane >> 5); \
            red[(w * 32 + i) * 64 + (lane & 31)] = acc0[r]; if (PAIR) red[(w * 32 + i) * 64 + 32 + (lane & 31)] = acc1[r]; } \
        SG_BAR(); \
        const int rbq = (u_) & 7, cpq = (u_) >> 3, n0q = PAIR ? ((cpq >> 2) * 256 + (cpq & 3) * 32) : cpq * 32; \
        float x1[2] = {0.f, 0.f}, x2[2] = {0.f, 0.f}; \
        _Pragma("unroll") for (int ww = 0; ww < 8; ++ww) { const f32x2 p0 = *(const LAS f32x2*)(red + (ww * 32 + row) * 64 + 2 * jq); x1[0] += p0.x; x1[1] += p0.y; \
            if (PAIR) { const f32x2 p1 = *(const LAS f32x2*)(red + (ww * 32 + row) * 64 + 32 + 2 * jq); x2[0] += p1.x; x2[1] += p1.y; } } \
        epi(rbq * 32 + row, n0q + 2 * jq, x1, x2); \
        SG_BAR(); } while (0)
    if (K == 1024) {
        bf16x8 ra[8], rb0[8], rb1[8];
        { SG_PTRS(unit)
#pragma unroll
          for (int s = 0; s < 8; ++s) { ra[s] = *(const bf16x8*)(ap + 16 * s); rb0[s] = *(const bf16x8*)(bp0 + 16 * s); if (PAIR) rb1[s] = *(const bf16x8*)(bp1 + 16 * s); } }
#pragma unroll 1
        for (;;) {
            f32x16 acc0, acc1;
#pragma unroll
            for (int r = 0; r < 16; ++r) { acc0[r] = 0.f; acc1[r] = 0.f; }
#pragma unroll
            for (int s = 0; s < 8; ++s) { acc0 = __builtin_amdgcn_mfma_f32_32x32x16_bf16(ra[s], rb0[s], acc0, 0, 0, 0); if (PAIR) acc1 = __builtin_amdgcn_mfma_f32_32x32x16_bf16(ra[s], rb1[s], acc1, 0, 0, 0); }
            const int cur = unit; unit += GG; const bool has = unit < nUnits;
            if (has) { SG_PTRS(unit)
#pragma unroll
                for (int s = 0; s < 8; ++s) { ra[s] = *(const bf16x8*)(ap + 16 * s); rb0[s] = *(const bf16x8*)(bp0 + 16 * s); if (PAIR) rb1[s] = *(const bf16x8*)(bp1 + 16 * s); } }
            SG_REDUCE(cur);
            if (!has) break;
        }
    } else {
#pragma unroll 1
        for (; unit < nUnits; unit += GG) {
            SG_PTRS(unit)
            f32x16 acc0, acc1;
#pragma unroll
            for (int r = 0; r < 16; ++r) { acc0[r] = 0.f; acc1[r] = 0.f; }
#pragma unroll 8
            for (int ks = 0; ks < kw; ks += 16) {
                const bf16x8 a = *(const bf16x8*)(ap + ks), b0 = *(const bf16x8*)(bp0 + ks);
                acc0 = __builtin_amdgcn_mfma_f32_32x32x16_bf16(a, b0, acc0, 0, 0, 0);
                if (PAIR) { const bf16x8 b1 = *(const bf16x8*)(bp1 + ks); acc1 = __builtin_amdgcn_mfma_f32_32x32x16_bf16(a, b1, acc1, 0, 0, 0); }
            }
            SG_REDUCE(unit);
        }
    }
    asm volatile("s_waitcnt vmcnt(0) lgkmcnt(0)" ::: "memory");
    __syncthreads();
#undef SG_PTRS
#undef SG_REDUCE
}
#define SEPI_ARGS int rl, int n, const float (&x1)[2], const float (&x2)[2]
struct SEpiB1 {
    unsigned char* ws;
    __device__ __forceinline__ void operator()(int rl, int n, const float (&y1)[2], const float (&y2)[2]) const {
        const float rs_ = rstd_of(fx_get(((const fx_t*)(ws + WS_SSQA))[NPT + rl]));
        const float x1[2] = {y1[0] * rs_, y1[1] * rs_}, x2[2] = {y2[0] * rs_, y2[1] * rs_};
        if (n < 2048) {
            const f32x2* tab = (const f32x2*)(ws + WS_TAB);
            const int head = (n >> 8) & 3, d = n & 255, pos = PAST + (rl & 31);
            const f32x2 c0 = tab[(size_t)pos * 128 + d], c1 = tab[(size_t)pos * 128 + d + 1];
            float o1[2], o2[2];
            o1[0] = x1[0] * c0.x - x2[0] * c0.y; o2[0] = x2[0] * c0.x + x1[0] * c0.y;
            o1[1] = x1[1] * c1.x - x2[1] * c1.y; o2[1] = x2[1] * c1.x + x1[1] * c1.y;
            if (n < 1024) {
                bf16_t* q = (bf16_t*)(ws + WS_Q) + (size_t)(NPT + rl) * 1024 + head * 256 + d;
                *(unsigned*)q = cvt_pk_bf16(o1[0], o1[1]); *(unsigned*)(q + 128) = cvt_pk_bf16(o2[0], o2[1]);
            } else {
                bf16_t* k = (bf16_t*)(ws + WS_KS) + (size_t)rl * 1024 + head * 256 + d;
                *(unsigned*)k = cvt_pk_bf16(o1[0] * 0.0625f, o1[1] * 0.0625f); *(unsigned*)(k + 128) = cvt_pk_bf16(o2[0] * 0.0625f, o2[1] * 0.0625f);
                const float dec = 0.0625f * __expf(lgdec(head) * (float)(DSEQ - 1 - (rl & 31)));
                bf16_t* kt = (bf16_t*)(ws + WS_KTS) + (size_t)(head * 256 + d) * 256 + rl;
                const unsigned wa = cvt_pk_bf16(o1[0] * dec, o1[1] * dec), wb = cvt_pk_bf16(o2[0] * dec, o2[1] * dec);
                kt[0] = (bf16_t)(wa & 0xffffu); kt[256] = (bf16_t)(wa >> 16); kt[128 * 256] = (bf16_t)(wb & 0xffffu); kt[129 * 256] = (bf16_t)(wb >> 16);
            }
        } else {
            bf16_t* vt = (bf16_t*)(ws + WS_VTS) + (size_t)(n - 2048) * 256 + rl;
            const unsigned wa = cvt_pk_bf16(x1[0], x1[1]), wb = cvt_pk_bf16(x2[0], x2[1]);
            vt[0] = (bf16_t)(wa & 0xffffu); vt[256] = (bf16_t)(wa >> 16); vt[128 * 256] = (bf16_t)(wb & 0xffffu); vt[129 * 256] = (bf16_t)(wb >> 16);
        }
    }
};
struct SEpiB2 {
    unsigned char* ws; const float* gn_g;
    __device__ __forceinline__ void operator()(int rl, int n, const float (&y1)[2], const float (&y2)[2]) const {
        const float rs_ = rstd_of(fx_get(((const fx_t*)(ws + WS_SSQA))[NPT + rl]));
        const float x1[2] = {y1[0] * rs_, y1[1] * rs_}, x2[2] = {y2[0] * rs_, y2[1] * rs_};
        if (n < 2048) {
            bf16_t* o = (bf16_t*)(ws + WS_GLU) + (size_t)(NPT + rl) * 1024 + (n >> 8) * 128 + (n & 127);
            *(unsigned*)o = cvt_pk_bf16(x1[0] * sigm(x2[0]), x1[1] * sigm(x2[1]));
        } else if (n < 4096) {
            const int col = n - 2048, head = col >> 9;
            const fx_t* sp2 = (const fx_t*)(ws + WS_STATS) + (size_t)(NPT + rl) * 8 + head * 2; const f32x2 sq = {fx_get(sp2[0]), fx_get(sp2[1])};
            const float mu = sq.x * (1.0f / 512.0f); const float var = fmaxf(sq.y * (1.0f / 512.0f) - mu * mu, 0.f); const float rstd = __builtin_amdgcn_rsqf(var + LN_EPS);
            bf16_t* o = (bf16_t*)(ws + WS_OS) + (size_t)rl * 2048 + col;
            const unsigned oa = *(const unsigned*)o, ob = *(const unsigned*)(o + 128);
            const f32x2 ga = *(const f32x2*)(gn_g + col), gb = *(const f32x2*)(gn_g + col + 128);
            *(unsigned*)o = cvt_pk_bf16(x1[0] * sigm(x1[0]) * ((bflo(oa) - mu) * rstd * ga.x), x1[1] * sigm(x1[1]) * ((bfhi(oa) - mu) * rstd * ga.y));
            *(unsigned*)(o + 128) = cvt_pk_bf16(x2[0] * sigm(x2[0]) * ((bflo(ob) - mu) * rstd * gb.x), x2[1] * sigm(x2[1]) * ((bfhi(ob) - mu) * rstd * gb.y));
        } else {
            bf16_t* o = (bf16_t*)(ws + (n < 5120 ? WS_GC : WS_GR)) + (size_t)(NPT + rl) * 1024 + ((n - 4096) & 1023);
            *(unsigned*)o = cvt_pk_bf16(sigm(x1[0]), sigm(x1[1])); *(unsigned*)(o + 128) = cvt_pk_bf16(sigm(x2[0]), sigm(x2[1]));
        }
    }
};
template <int MODE, bool PAIR> struct SEpiEW {
    unsigned char* ws; float* x; fx_t* ssq;
    __device__ __forceinline__ void operator()(SEPI_ARGS) const {
        const size_t row = (size_t)(NPT + rl);
        if (MODE == 0) {
            const bf16_t* g = (const bf16_t*)(ws + WS_GC) + row * 1024 + n; bf16_t* t = (bf16_t*)(ws + WS_T) + row * 1024 + n;
            const unsigned ga = *(const unsigned*)g, gb = *(const unsigned*)(g + 128);
            *(unsigned*)t = cvt_pk_bf16(x1[0] * bflo(ga), x1[1] * bfhi(ga)); if (PAIR) *(unsigned*)(t + 128) = cvt_pk_bf16(x2[0] * bflo(gb), x2[1] * bfhi(gb));
        } else if (MODE == 1) {
            const bf16_t* g = (const bf16_t*)(ws + WS_GR) + row * 1024 + n; bf16_t* t = (bf16_t*)(ws + WS_T) + row * 1024 + n;
            const unsigned ga = *(const unsigned*)g, gb = *(const unsigned*)(g + 128), ta = *(const unsigned*)t, tb = *(const unsigned*)(t + 128);
            *(unsigned*)t = cvt_pk_bf16(bflo(ta) + x1[0] * bflo(ga), bfhi(ta) + x1[1] * bfhi(ga)); if (PAIR) *(unsigned*)(t + 128) = cvt_pk_bf16(bflo(tb) + x2[0] * bflo(gb), bfhi(tb) + x2[1] * bfhi(gb));
        } else if (MODE == 2) {
            bf16_t* xb = (bf16_t*)(ws + WS_H) + row * 1024 + n; const unsigned xa = *(const unsigned*)xb, xc = PAIR ? *(const unsigned*)(xb + 128) : 0u;
            f32x2 a = {bflo(xa) + x1[0], bfhi(xa) + x1[1]}, b = {bflo(xc) + x2[0], bfhi(xc) + x2[1]};
            *(unsigned*)xb = cvt_pk_bf16(a.x, a.y); if (PAIR) *(unsigned*)(xb + 128) = cvt_pk_bf16(b.x, b.y);
            float q = a.x * a.x + a.y * a.y; if (PAIR) q += b.x * b.x + b.y * b.y;
            q += shx<1>(q); q += shx<2>(q); q += shx<4>(q); q += shx<8>(q);
            if ((lane_id() & 15) == 0) fx_add(ssq + row, q);
        } else {
            bf16_t* u = (bf16_t*)(ws + WS_U) + row * 4096 + n;
            const float r3 = rstd_of(fx_get(ssq[row]));
            const float a0 = fmaxf(x1[0], 0.f) * r3, a1 = fmaxf(x1[1], 0.f) * r3, b0 = fmaxf(x2[0], 0.f) * r3, b1 = fmaxf(x2[1], 0.f) * r3;
            *(unsigned*)u = cvt_pk_bf16(a0 * a0, a1 * a1); if (PAIR) *(unsigned*)(u + 128) = cvt_pk_bf16(b0 * b0, b1 * b1);
        }
    }
};

#define XB_TMO      128
#define XB_XCNT(j)  (256  + 64 * (j))
#define XB_XSUB(j)  (1280 + 64 * (j))
#define XB_XGEN(j)  (2304 + 64 * (j))
#define XB_TOP      3328
#define XB_TOPGEN   3392
#define XCD_BAR_WORDS 3456
#define XB_SPIN_CAP (1u << 18)

__device__ __forceinline__ unsigned xb_ld(unsigned* p)              { return __hip_atomic_load(p, __ATOMIC_RELAXED, __HIP_MEMORY_SCOPE_AGENT); }
__device__ __forceinline__ unsigned xb_add(unsigned* p, unsigned v) { return __hip_atomic_fetch_add(p, v, __ATOMIC_RELAXED, __HIP_MEMORY_SCOPE_AGENT); }
__device__ __forceinline__ unsigned xb_xcc_id() { return (unsigned)__builtin_amdgcn_s_getreg((3 << 11) | 20) & 0xFu; }
#define XB_SPIN(cond, bar) do { unsigned _sp = 0; while (cond) { __builtin_amdgcn_s_sleep(1); \
    if ((++_sp & 255u) == 0u) { if (xb_ld(&(bar)[XB_TMO])) break; if (_sp > XB_SPIN_CAP) { atomicAdd(&(bar)[XB_TMO], 1u); break; } } } } while (0)

struct XcdBarrier {
    unsigned* bar; unsigned x;
    volatile LAS unsigned* st;
};

__device__ __forceinline__ XcdBarrier xcd_barrier_post(unsigned* bar, volatile LAS unsigned* st, int wv) {
    XcdBarrier b; b.bar = bar; b.x = xb_xcc_id(); b.st = st;
    if (wv == 0 && lane_id() == 0) (void)xb_add(&bar[XB_XCNT(b.x)], 1u);
    return b;
}
__device__ __forceinline__ void xcd_barrier_complete(unsigned* bar, unsigned x, unsigned& nloc, unsigned& nx) {
    const unsigned G = gridDim.x * gridDim.y * gridDim.z;
    unsigned sum, cnt, mine, sp = 0u;
    for (;;) {
        sum = 0u; cnt = 0u; mine = 0u;
#pragma unroll
        for (unsigned j = 0; j < 16; ++j) { const unsigned c = xb_ld(&bar[XB_XCNT(j)]); sum += c; cnt += (c > 0u) ? 1u : 0u; mine = (j == x) ? c : mine; }
        if (sum == G) break;
        __builtin_amdgcn_s_sleep(1);
        if ((++sp & 255u) == 0u) { if (xb_ld(&bar[XB_TMO])) break; if (sp > XB_SPIN_CAP) { atomicAdd(&bar[XB_TMO], 1u); break; } }
    }
    nloc = mine > 0u ? mine : 1u; nx = cnt > 0u ? cnt : 1u;
}

__device__ __forceinline__ void xcd_barrier(const XcdBarrier& b, int wv) {
    asm volatile("s_waitcnt vmcnt(0)" ::: "memory");
    __syncthreads();
    if (wv == 0 && lane_id() == 0) {
        unsigned* bar = b.bar;
        __builtin_amdgcn_s_waitcnt(0);
        unsigned nloc = b.st[0], nx = b.st[1];
        if (nloc == 0u) { xcd_barrier_complete(bar, b.x, nloc, nx); b.st[0] = nloc; b.st[1] = nx; }
        const unsigned old = xb_add(&bar[XB_XSUB(b.x)], 1u);
        const unsigned gen = old / nloc;
        if (old + 1u == (gen + 1u) * nloc) {
            __builtin_amdgcn_fence(__ATOMIC_RELEASE, "agent");
            asm volatile("s_waitcnt vmcnt(0)" ::: "memory");
            const unsigned og = xb_add(&bar[XB_TOP], 1u);
            const unsigned tg = og / nx;
            if (og + 1u == (tg + 1u) * nx) xb_add(&bar[XB_TOPGEN], 1u);
            else XB_SPIN(xb_ld(&bar[XB_TOPGEN]) == tg, bar);
            __builtin_amdgcn_fence(__ATOMIC_ACQUIRE, "agent");
            xb_add(&bar[XB_XGEN(b.x)], 1u);
            asm volatile("s_waitcnt vmcnt(0)" ::: "memory");
        } else {
            XB_SPIN(xb_ld(&bar[XB_XGEN(b.x)]) == gen, bar);
            __builtin_amdgcn_fence(__ATOMIC_ACQUIRE, "agent");
            asm volatile("s_waitcnt vmcnt(0)" ::: "memory");
        }
    }
    __syncthreads();
}


constexpr int LDS_BYTES = 131072 + 4096;
#define LCV ({ int c_ = (int)blockIdx.x; asm volatile("" : "+s"(c_)); c_; })
__global__ void __launch_bounds__(512, 2) fwd_megakernel(Params p) {
    extern __shared__ __attribute__((aligned(16))) unsigned char lds_raw[];
    LAS unsigned char* lds = (LAS unsigned char*)lds_raw;
    cg::grid_group grid = cg::this_grid();
    const int G = gridDim.x, c = blockIdx.x;
    unsigned char* ws = p.ws;
    int wv = __builtin_amdgcn_readfirstlane((int)(threadIdx.x >> 6)); asm volatile("" : "+s"(wv));
    volatile LAS unsigned* stw = (volatile LAS unsigned*)(lds + 131072);
    if (wv == 0) stw[lane_id()] = 0u;
    __syncthreads();
    XcdBarrier xbar = xcd_barrier_post((unsigned*)(ws + WS_BAR), stw, wv);
    if (p.ws == nullptr) grid.sync();
#define GSYNC() xcd_barrier(xbar, wv)
#pragma unroll 1
    for (int l = 0; l < 2; ++l) {
        phase0(wv, p, l, lds, 0);
        GSYNC();
        {
            SchedB1 S{G, LCV, (const char*)(ws + WS_H), (const char*)(ws + WS_WIN)}; EpiB1 E{ws};
            pg8::gemm_phase(wv, lds, pg8::Gemm{1024, 16, 1024, 1024}, S, E);
            sgemm_phase<true>(wv, lds, (const bf16_t*)(ws + WS_H) + (size_t)NPT * 1024, (const bf16_t*)(ws + WS_WIN), 1024, 8 * 64, SEpiB1{ws});
        }
        GSYNC();
        {
            { SchedAtt S{G, LCV, ws}; EpiAtt E{ws}; pg8::gemm_phase(wv, lds, pg8::Gemm{256, 4, 1024, 1024}, S, E); }
            { SchedU S{G, LCV, ws}; EpiU E{ws}; pg8::gemm_phase(wv, lds, pg8::Gemm{256, 4, SEQ, SEQ}, S, E); }
            phase_sret(wv, p, l, lds);
            GSYNC();
            phase_scan(wv, p, l);
            GSYNC();
            { SchedE S{G, LCV, ws}; EpiE E{ws}; pg8::gemm_phase(wv, lds, pg8::Gemm{512, 4, 1024, SEQ}, S, E); }
            GSYNC();
        }
        {
            SchedN S{G, LCV, 24, 0, (const char*)(ws + WS_H), (const char*)(ws + WS_WIN) + (size_t)16 * TILEB, TILEB, ws, TILEB};
            EpiB2 E{ws, p.in[11] + l * 2048};
            pg8::gemm_phase(wv, lds, pg8::Gemm{1024, 16, 1024, 1024}, S, E);
            sgemm_phase<true>(wv, lds, (const bf16_t*)(ws + WS_H) + (size_t)NPT * 1024, (const bf16_t*)(ws + WS_WIN) + (size_t)4096 * 1024, 1024, 8 * 96, SEpiB2{ws, p.in[11] + l * 2048});
        }
        GSYNC();
        phase0(wv, p, l, lds, 1);
        phase_conv(wv, p, l, lds);
        GSYNC();
        { SchedN S{G, LCV, 4, 0, (const char*)(ws + WS_YC), (const char*)(ws + WS_WC), TILEB, ws, TILEB}; EpiEW<0> E{ws, p.out, nullptr}; pg8::gemm_phase(wv, lds, pg8::Gemm{1024, 16, 1024, 1024}, S, E); }
        sgemm_phase<false>(wv, lds, (const bf16_t*)(ws + WS_YC) + (size_t)NPT * 1024, (const bf16_t*)(ws + WS_WC), 1024, 8 * 32, SEpiEW<0, false>{ws, p.out, nullptr});
        { SchedN S{G, LCV, 4, 1, nullptr, (const char*)(ws + WS_WR), 2 * TILEB, ws, 0}; EpiEW<1> E{ws, p.out, nullptr}; pg8::gemm_phase(wv, lds, pg8::Gemm{2048, 32, 2048, 2048}, S, E); }
        sgemm_phase<false>(wv, lds, (const bf16_t*)(ws + WS_OS), (const bf16_t*)(ws + WS_WR), 2048, 8 * 32, SEpiEW<1, false>{ws, p.out, nullptr});
        GSYNC();
        { SchedN S{G, LCV, 4, 0, (const char*)(ws + WS_T), (const char*)(ws + WS_WO), TILEB, ws, TILEB}; EpiEW<2> E{ws, p.out, (fx_t*)(ws + WS_SSQB)}; pg8::gemm_phase(wv, lds, pg8::Gemm{1024, 16, 1024, 1024}, S, E); }
        sgemm_phase<false>(wv, lds, (const bf16_t*)(ws + WS_T) + (size_t)NPT * 1024, (const bf16_t*)(ws + WS_WO), 1024, 8 * 32, SEpiEW<2, false>{ws, p.out, (fx_t*)(ws + WS_SSQB)});
        GSYNC();
        { SchedN S{G, LCV, 16, 0, (const char*)(ws + WS_H), (const char*)(ws + WS_WM1), TILEB, ws, TILEB}; EpiEW<3> E{ws, p.out, (fx_t*)(ws + WS_SSQB)}; pg8::gemm_phase(wv, lds, pg8::Gemm{1024, 16, 1024, 1024}, S, E); }
        sgemm_phase<true>(wv, lds, (const bf16_t*)(ws + WS_H) + (size_t)NPT * 1024, (const bf16_t*)(ws + WS_WM1), 1024, 8 * 64, SEpiEW<3, true>{ws, p.out, (fx_t*)(ws + WS_SSQB)});
        GSYNC();
        { SchedN S{G, LCV, 4, 0, (const char*)(ws + WS_U), (const char*)(ws + WS_WM2), 4 * TILEB, ws, 4 * TILEB}; EpiEW<2> E{ws, p.out, (fx_t*)(ws + WS_SSQA)}; pg8::gemm_phase(wv, lds, pg8::Gemm{4096, 64, 4096, 4096}, S, E); }
        sgemm_phase<false>(wv, lds, (const bf16_t*)(ws + WS_U) + (size_t)NPT * 4096, (const bf16_t*)(ws + WS_WM2), 4096, 8 * 32, SEpiEW<2, false>{ws, p.out, (fx_t*)(ws + WS_SSQA)});
        GSYNC();
    }
    phase_final(wv, p);
}

extern "C" void kernel_launch(void* const* d_in, const int* in_sizes, int n_in, void* d_out, int out_size, void* d_ws, size_t ws_size, hipStream_t stream) {
    static int grid = 0;
    if (grid == 0) {
        if (n_in != 18 || ws_size < WS_END) { fprintf(stderr, "kernel_launch: unexpected n_in %d / ws_size %zu (need %zu)\n", n_in, ws_size, (size_t)WS_END); grid = -1; return; }
        int dev = 0, cus = 0, per_cu = 0;
        hipGetDevice(&dev); hipDeviceGetAttribute(&cus, hipDeviceAttributeMultiprocessorCount, dev);
        hipFuncSetAttribute((const void*)fwd_megakernel, hipFuncAttributeMaxDynamicSharedMemorySize, LDS_BYTES);
        hipOccupancyMaxActiveBlocksPerMultiprocessor(&per_cu, (const void*)fwd_megakernel, 512, LDS_BYTES);
        (void)hipGetLastError();
        if (per_cu < 1) per_cu = 1;
        grid = cus;
        fprintf(stderr, "kernel_launch: cus %d per_cu %d grid %d\n", cus, per_cu, grid);
    }
    if (grid < 0) return;
    if (hipMemsetAsync((char*)d_ws + WS_BAR, 0, 16384, stream) != hipSuccess) { fprintf(stderr, "memset failed\n"); return; }
    Params p{};
    for (int i = 0; i < 18; ++i) p.in[i] = (const float*)d_in[i];
    p.out = (float*)d_out; p.ws = (unsigned char*)d_ws;
    void* args[] = {&p};
    hipError_t e = hipLaunchCooperativeKernel((const void*)fwd_megakernel, dim3(grid), dim3(512), args, LDS_BYTES, stream);
    if (e != hipSuccess) fprintf(stderr, "cooperative launch failed: %s (grid %d)\n", hipGetErrorString(e), grid);
}
```

```cpp
#include <hip/hip_runtime.h>
#include <hip/hip_cooperative_groups.h>
#include <cstdio>
#include <cstdint>
namespace cg = cooperative_groups;

#define LAS __attribute__((address_space(3)))
typedef unsigned short bf16_t;
typedef short bf16x8 __attribute__((ext_vector_type(8)));
typedef float f32x4 __attribute__((ext_vector_type(4)));
typedef float f32x2 __attribute__((ext_vector_type(2)));
typedef float f32x16 __attribute__((ext_vector_type(16)));
typedef unsigned u32x4 __attribute__((ext_vector_type(4)));
typedef unsigned u32x2 __attribute__((ext_vector_type(2)));

constexpr int DM = 1024, SEQ = 8192, NPT = 16384, NTOK = 16640, DSEQ = 32, PAST = 4096;
constexpr int DFF = 4096, RV = 2048, CH = 256;
constexpr float RMS_EPS = 1e-6f, LN_EPS = 1e-5f;
constexpr size_t MiB = 1u << 20;
constexpr size_t TILEB = 256 * 1024 * 2;
constexpr size_t WS_STATS = 313 * MiB;
constexpr size_t WS_BAR = 640 * 1024;
constexpr size_t WS_SSQA = 315 * MiB, WS_SSQB = 316 * MiB;
constexpr size_t WS_TAB = 1 * MiB;
constexpr size_t WS_WIN = 9 * MiB;
constexpr size_t WS_WC = 29 * MiB, WS_WR = 31 * MiB, WS_WO = 35 * MiB, WS_WM1 = 37 * MiB, WS_WM2 = 45 * MiB;
constexpr size_t WS_H = 53 * MiB;
constexpr size_t WS_Q = WS_H + 32 * MiB + MiB / 2;
constexpr size_t WS_KB0 = 118 * MiB, WS_KTB0 = 134 * MiB, WS_KB1 = 150 * MiB, WS_KTB1 = 166 * MiB, WS_KS = 182 * MiB, WS_KTS = WS_KS + MiB / 2;
constexpr size_t WS_VTB0 = 183 * MiB, WS_VTB1 = 215 * MiB, WS_VTS = 247 * MiB;
constexpr size_t WS_ATT = 248 * MiB;
constexpr size_t WS_S = 280 * MiB;
constexpr size_t WS_OS = 312 * MiB;
constexpr size_t WS_END = 317 * MiB;
constexpr size_t WS_GLU = WS_Q, WS_T = WS_Q, WS_U = WS_Q, WS_GC = WS_VTB0, WS_GR = WS_VTB0 + 32 * MiB + MiB / 2, WS_YC = WS_ATT;
constexpr size_t WS_OB0 = WS_KB0, WS_OB1 = WS_KB1;
static_assert(WS_Q == 85 * MiB + MiB / 2 && WS_Q + 32 * MiB + MiB / 2 == WS_KB0, "map");
static_assert(WS_U + (size_t)NTOK * DFF * 2 <= WS_END, "map");
constexpr size_t OUT_CONVP = 17039360, OUT_RETP = 17162240, OUT_CONVS = 19259392, OUT_RETS = 19750912;

struct Params { const float* in[18]; float* out; unsigned char* ws; };

typedef __bf16 bf16x2_t __attribute__((ext_vector_type(2)));
__device__ __forceinline__ unsigned cvt_pk_bf16(float lo, float hi) { const f32x2 v = {lo, hi}; return __builtin_bit_cast(unsigned, __builtin_convertvector(v, bf16x2_t)); }
__device__ __forceinline__ float bflo(unsigned w) { return __uint_as_float(w << 16); }
__device__ __forceinline__ float bfhi(unsigned w) { return __uint_as_float(w & 0xffff0000u); }
__device__ __forceinline__ float bf2f(bf16_t v) { return __uint_as_float((unsigned)v << 16); }
__device__ __forceinline__ float lgdec(int h) { return h == 0 ? -0.0317486983145803f : (h == 1 ? -0.015748356968139168f : (h == 2 ? -0.007843177461025893f : -0.003913899321136329f)); }
typedef unsigned long long fx_t;
constexpr float FX_SCALE = 16777216.0f, FX_INV = 1.0f / 16777216.0f;
__device__ __forceinline__ fx_t fx_of(float v) { return (fx_t)(long long)(v * FX_SCALE); }
__device__ __forceinline__ void fx_add(fx_t* p, float v) { atomicAdd(p, fx_of(v)); }
__device__ __forceinline__ float fx_get(fx_t v) { return (float)(long long)v * FX_INV; }
__device__ __forceinline__ float rstd_of(float ssq) { return __builtin_amdgcn_rsqf(ssq * (1.0f / 1024.0f) + RMS_EPS); }
__device__ __forceinline__ float sigm(float x) { return __builtin_amdgcn_rcpf(1.0f + __expf(-x)); }
__device__ __forceinline__ u32x4 pack8(const f32x4 a, const f32x4 b) { u32x4 w; w.x = cvt_pk_bf16(a[0], a[1]); w.y = cvt_pk_bf16(a[2], a[3]); w.z = cvt_pk_bf16(b[0], b[1]); w.w = cvt_pk_bf16(b[2], b[3]); return w; }
__device__ __forceinline__ void unpack8(const u32x4 w, f32x4& a, f32x4& b) { a = (f32x4){bflo(w.x), bfhi(w.x), bflo(w.y), bfhi(w.y)}; b = (f32x4){bflo(w.z), bfhi(w.z), bflo(w.w), bfhi(w.w)}; }
__device__ __forceinline__ int lane_id() { return (int)__builtin_amdgcn_mbcnt_hi(~0u, __builtin_amdgcn_mbcnt_lo(~0u, 0u)); }
__device__ __forceinline__ int gdim() { int g = (int)gridDim.x; asm volatile("" : "+s"(g)); return g; }
template <int K> __device__ __forceinline__ float shx(float v) {
    if constexpr (K < 32) return __builtin_bit_cast(float, __builtin_amdgcn_ds_swizzle(__builtin_bit_cast(int, v), (K << 10) | 0x1f));
    else { int l = lane_id(); asm volatile("" : "+v"(l)); return __builtin_bit_cast(float, __builtin_amdgcn_ds_bpermute((l ^ 32) << 2, __builtin_bit_cast(int, v))); }
}
__device__ __forceinline__ float wave_sum(float v) { v += shx<1>(v); v += shx<2>(v); v += shx<4>(v); v += shx<8>(v); v += shx<16>(v); v += shx<32>(v); return v; }

namespace pg8 {
constexpr int BM = 256, BK = 64, HALF = 128, HTB = HALF * BK * 2, STAGE_BYTES = 8 * HTB;
__host__ __device__ __forceinline__ int lds_byte(int r, int c) { const int st = (r >> 4) * 2 + (c >> 5), rr = r & 15, cc = c & 31, ob = rr * 64 + cc * 2; return st * 1024 + (ob ^ (((ob >> 9) & 1) << 5)); }
__host__ __device__ __forceinline__ void stage_rc(int b, int& R, int& C) { const int st = b / 1024, sb = b % 1024, swz = sb ^ (((sb >> 9) & 1) << 5); R = (st >> 1) * 16 + swz / 64; C = (st & 1) * 32 + (swz % 64) / 2; }
__host__ __device__ __forceinline__ int perm32(int rho) { const int n = rho >> 4, i = rho & 15; return 8 * (i >> 2) + 4 * n + (i & 3); }

struct Unit { const char* a; const char* b; long a2d, b2d; int kind, pm, pn, aux; };
struct Gemm { int K, nt1, lda, ldb; };

__device__ __forceinline__ void xcd_remap(int& wgid, int nwg) { const int q = nwg / 8, r = nwg % 8, xcd = wgid % 8, off = wgid / 8; wgid = (xcd < r ? xcd * (q + 1) : r * (q + 1) + (xcd - r) * q) + off; }
__device__ __forceinline__ void grp_decode(int wgid, int nM, int nN, int& pm, int& pn) { const int nig = 8 * nN, gid = wgid / nig, fm = gid * 8, gsz = (nM - fm) < 8 ? (nM - fm) : 8; pm = fm + ((wgid % nig) % gsz); pn = (wgid % nig) / gsz; }

template <class Epi, class Sched>
__device__ __forceinline__ void gemm_phase(int wv, LAS unsigned char* lds, const Gemm g, const Sched& S, const Epi& E) {
    int wv_ = wv; asm volatile("" : "+s"(wv_)); int tid = wv_ * 64 + lane_id(); asm volatile("" : "+v"(tid));
    const int wid = __builtin_amdgcn_readfirstlane(tid >> 6), lane = tid & 63, wr = wid >> 2, wc = wid & 3, fr = lane & 15, fq = lane >> 4;
    const int nt = g.K / BK, nt1 = g.nt1;
    unsigned voffA[2], voffB[2];
#pragma unroll
    for (int i = 0; i < 2; ++i) { int R, C; stage_rc(tid * 16 + i * 8192, R, C); const int Rb = (R & ~31) + perm32(R & 31);
        voffA[i] = (unsigned)(R * g.lda + C) * 2u; voffB[i] = (unsigned)(Rb * g.ldb + C) * 2u; }
    const size_t kstep = (size_t)(BK * 2);
    const size_t hstepA = (size_t)HALF * g.lda * 2, hstepB = (size_t)HALF * g.ldb * 2;
    const unsigned ldsw = (unsigned)wid * 1024u;
    const int aoff = lds_byte(wr * 64 + fr, fq * 8), boff = lds_byte(wc * 32 + fr, fq * 8);
#define PG8_SA(b, h) (((b) * 2 + (h)) * HTB)
#define PG8_SB(b, h) ((4 + (b) * 2 + (h)) * HTB)
#define PG8_STAGE(bufoff, gbase, voff) do { _Pragma("unroll") for (int _i = 0; _i < 2; ++_i) \
        __builtin_amdgcn_global_load_lds((const unsigned*)((const char*)(gbase) + (voff)[_i]), (LAS unsigned*)(lds + (bufoff) + ldsw + _i * 8192), 16, 0, 0); } while (0)
#define PG8_LDA(dst, b, h) do { _Pragma("unroll") for (int m = 0; m < 4; ++m) _Pragma("unroll") for (int k = 0; k < 2; ++k) dst[m][k] = *(const LAS bf16x8*)(lds + PG8_SA(b, h) + aoff + m * 2048 + k * 1024); } while (0)
#define PG8_LDB(dst, b, h) do { _Pragma("unroll") for (int n = 0; n < 2; ++n) _Pragma("unroll") for (int k = 0; k < 2; ++k) dst[n][k] = *(const LAS bf16x8*)(lds + PG8_SB(b, h) + boff + n * 2048 + k * 1024); } while (0)
#define PG8_MMA(ai, bj, At, Bt) do { __builtin_amdgcn_s_setprio(1); _Pragma("unroll") for (int m = 0; m < 4; ++m) _Pragma("unroll") for (int n = 0; n < 2; ++n) _Pragma("unroll") for (int k = 0; k < 2; ++k) \
        acc[ai][bj][m][n] = __builtin_amdgcn_mfma_f32_16x16x32_bf16(Bt[n][k], At[m][k], acc[ai][bj][m][n], 0, 0, 0); __builtin_amdgcn_s_setprio(0); } while (0)
#define PG8_WAIT_V(n) asm volatile("s_waitcnt vmcnt(" #n ")" ::: "memory")
#define PG8_WAIT_L(n) asm volatile("s_waitcnt lgkmcnt(" #n ")" ::: "memory")
#define PG8_BAR __builtin_amdgcn_s_barrier()
#define PG8_SCHED __builtin_amdgcn_sched_barrier(0)
#define PG8_TPA(u, t) ((u).a + (size_t)(t) * kstep + (((t) >= nt1) ? (u).a2d : 0l))
#define PG8_TPB(u, t) ((u).b + (size_t)(t) * kstep + (((t) >= nt1) ? (u).b2d : 0l))
    Unit cur, nxt; int ui = 0;
    if (!S.next(0, cur)) return;
    {
        const char* cA = cur.a; const char* cB = cur.b;
        PG8_STAGE(PG8_SB(0, 0), cB, voffB); PG8_STAGE(PG8_SB(0, 1), cB + hstepB, voffB); PG8_STAGE(PG8_SA(0, 0), cA, voffA); PG8_STAGE(PG8_SA(0, 1), cA + hstepA, voffA);
        if (wr == 1) PG8_BAR;
        PG8_WAIT_V(2); PG8_BAR;
        PG8_STAGE(PG8_SB(1, 0), cB + kstep, voffB); PG8_STAGE(PG8_SA(1, 0), cA + kstep, voffA); PG8_STAGE(PG8_SB(1, 1), cB + hstepB + kstep, voffB);
        PG8_WAIT_V(6); PG8_BAR;
    }
    f32x4 acc[2][2][4][2];
#pragma unroll
    for (int a = 0; a < 2; ++a)
#pragma unroll
        for (int b = 0; b < 2; ++b)
#pragma unroll
            for (int m = 0; m < 4; ++m)
#pragma unroll
                for (int n = 0; n < 2; ++n) acc[a][b][m][n] = (f32x4){0.f, 0.f, 0.f, 0.f};
    bf16x8 At[4][2], B0[2][2], B1[2][2];
#pragma unroll 1
    for (;;) {
        const bool has_next = S.next(ui + 1, nxt);
        if (!has_next) nxt = cur;
#pragma unroll 1
        for (int t = 0; t < nt; t += 2) {
            const bool last = (t == nt - 2);
            const char* a1 = PG8_TPA(cur, t + 1);
            const char* a2 = last ? PG8_TPA(nxt, 0) : PG8_TPA(cur, t + 2); const char* b2 = last ? PG8_TPB(nxt, 0) : PG8_TPB(cur, t + 2);
            const char* a3 = a2 + kstep; const char* b3 = b2 + kstep;
            PG8_LDB(B0, 0, 0); PG8_LDB(B1, 0, 1); PG8_SCHED; PG8_LDA(At, 0, 0); PG8_STAGE(PG8_SA(1, 1), a1 + hstepA, voffA);
            PG8_WAIT_V(8); PG8_WAIT_L(0); PG8_BAR; PG8_MMA(0, 0, At, B0); PG8_MMA(0, 1, At, B1); PG8_BAR; PG8_SCHED;
            PG8_LDA(At, 0, 1); PG8_STAGE(PG8_SB(0, 0), b2, voffB); PG8_STAGE(PG8_SB(0, 1), b2 + hstepB, voffB); PG8_STAGE(PG8_SA(0, 0), a2, voffA);
            PG8_WAIT_V(8); PG8_WAIT_L(0); PG8_BAR; PG8_MMA(1, 0, At, B0); PG8_MMA(1, 1, At, B1); PG8_BAR; PG8_SCHED;
            PG8_LDB(B0, 1, 0); PG8_LDB(B1, 1, 1); PG8_SCHED; PG8_LDA(At, 1, 0); PG8_STAGE(PG8_SA(0, 1), a2 + hstepA, voffA);
            PG8_WAIT_V(8); PG8_WAIT_L(0); PG8_BAR; PG8_MMA(0, 0, At, B0); PG8_MMA(0, 1, At, B1); PG8_BAR; PG8_SCHED;
            PG8_LDA(At, 1, 1); PG8_STAGE(PG8_SB(1, 0), b3, voffB); PG8_STAGE(PG8_SB(1, 1), b3 + hstepB, voffB); PG8_STAGE(PG8_SA(1, 0), a3, voffA);
            PG8_WAIT_V(8); PG8_WAIT_L(0); PG8_BAR; PG8_MMA(1, 0, At, B0); PG8_MMA(1, 1, At, B1); PG8_BAR; PG8_SCHED;
        }
        if (wr == 0) PG8_BAR;
        { int fr2 = fr, fq2 = fq; asm volatile("" : "+v"(fr2), "+v"(fq2)); E(acc, cur, wr, wc, fr2, fq2); }
        if (!has_next) break;
#pragma unroll
        for (int a = 0; a < 2; ++a)
#pragma unroll
            for (int b = 0; b < 2; ++b)
#pragma unroll
                for (int m = 0; m < 4; ++m)
#pragma unroll
                    for (int n = 0; n < 2; ++n) acc[a][b][m][n] = (f32x4){0.f, 0.f, 0.f, 0.f};
        cur = nxt; ++ui;
        if (wr == 1) PG8_BAR;
    }
    PG8_WAIT_V(0);
    PG8_BAR;
    asm volatile("s_waitcnt vmcnt(0) lgkmcnt(0)" ::: "memory");
    __syncthreads();
#undef PG8_SA
#undef PG8_SB
#undef PG8_STAGE
#undef PG8_LDA
#undef PG8_LDB
#undef PG8_MMA
#undef PG8_WAIT_V
#undef PG8_WAIT_L
#undef PG8_BAR
#undef PG8_SCHED
#undef PG8_TPA
#undef PG8_TPB
}
}
using pg8::Unit;

__device__ __forceinline__ bf16_t* k_tile(unsigned char* ws, int pm) { return (bf16_t*)(ws + (pm < 32 ? WS_KB0 + (size_t)pm * TILEB : (pm < 64 ? WS_KB1 + (size_t)(pm - 32) * TILEB : WS_KS))); }
__device__ __forceinline__ bf16_t* o_tile(unsigned char* ws, int pm) { return (bf16_t*)(ws + (pm < 32 ? WS_OB0 + (size_t)pm * 2 * TILEB : (pm < 64 ? WS_OB1 + (size_t)(pm - 32) * 2 * TILEB : WS_OS))); }

__device__ __forceinline__ bf16_t* s_head(unsigned char* ws, int b, int h) {
    const size_t off = b == 0 ? WS_S + (size_t)h * 8 * MiB : (h == 0 ? WS_TAB : (h == 1 ? WS_WC : (h == 2 ? WS_WM1 : WS_WM2)));
    return (bf16_t*)(ws + off);
}
struct SchedB1 {
    int G, c; const char* H; const char* W;
    __device__ __forceinline__ bool next(int i, Unit& u) const {
        const long L = (long)i * G + c; if (L >= 1024) return false;
        int wgid = (int)L; pg8::xcd_remap(wgid, 1024);
        { const int x = wgid >> 7, w = wgid & 127; wgid = w < 64 ? x * 64 + w : 512 + x * 64 + (w - 64); }
        u.a2d = 0; u.b2d = 0; u.aux = 0;
        if (wgid < 512) { pg8::grp_decode(wgid, 64, 8, u.pm, u.pn); u.kind = 0; u.a = H + (size_t)u.pm * TILEB; u.b = W + (size_t)u.pn * TILEB; }
        else { pg8::grp_decode(wgid - 512, 8, 64, u.pm, u.pn); u.pm += 4; u.kind = 1; u.a = W + (size_t)(4 + u.pm) * TILEB; u.b = H + (size_t)u.pn * TILEB; }
        return true;
    }
};
struct SchedN {
    int G, c, nN, amode; const char* A; const char* B; size_t bTile; unsigned char* ws; size_t aTile;
    __device__ __forceinline__ bool next(int i, Unit& u) const {
        const int nwg = 64 * nN; const long L = (long)i * G + c; if (L >= nwg) return false;
        int wgid = (int)L; pg8::xcd_remap(wgid, nwg); pg8::grp_decode(wgid, 64, nN, u.pm, u.pn);
        u.a2d = 0; u.b2d = 0; u.aux = 0; u.kind = 0;
        u.a = amode ? (const char*)o_tile(ws, u.pm) : A + (size_t)u.pm * aTile; u.b = B + (size_t)u.pn * bTile;
        return true;
    }
};
struct SchedAtt {
    int G, c; unsigned char* ws;
    __device__ __forceinline__ bool next(int i, Unit& u) const {
        const int L = i * G + c; if (L >= 256) return false;
        const int h = L & 3, j = (L >> 2) & 31, b = L >> 7;
        u.a2d = 0; u.b2d = 0; u.kind = 0; u.pm = j; u.pn = b; u.aux = h;
        u.a = (const char*)(ws + WS_Q) + ((size_t)(b * SEQ + j * CH) * 1024 + h * 256) * 2;
        u.b = (const char*)(ws + (b ? WS_KB1 : WS_KB0)) + ((size_t)(j * CH) * 1024 + h * 256) * 2;
        return true;
    }
};
struct SchedU {
    int G, c; unsigned char* ws;
    __device__ __forceinline__ bool next(int i, Unit& u) const {
        const int L = i * G + c; if (L >= 512) return false;
        const int pmt = L & 1, h = (L >> 1) & 3, j = (L >> 3) & 31, b = L >> 8;
        u.a2d = 0; u.b2d = 0; u.kind = b; u.pm = j; u.pn = 0; u.aux = h * 2 + pmt;
        u.a = (const char*)(ws + (b ? WS_VTB1 : WS_VTB0)) + ((size_t)(h * 512 + pmt * 256) * SEQ + j * CH) * 2;
        u.b = (const char*)(ws + (b ? WS_KTB1 : WS_KTB0)) + ((size_t)(h * 256) * SEQ + j * CH) * 2;
        return true;
    }
};
struct SchedE {
    int G, c; unsigned char* ws;
    __device__ __forceinline__ bool next(int i, Unit& u) const {
        const int L = i * G + c; if (L >= 512) return false;
        const int pnt = L & 1, h = (L >> 1) & 3, j = (L >> 3) & 31, b = L >> 8;
        u.kind = b; u.pm = j; u.pn = pnt; u.aux = h;
        const char* a1 = (const char*)(ws + WS_ATT) + ((size_t)(b * SEQ + j * CH) * 1024 + h * 256) * 2;
        const char* a2 = (const char*)(ws + WS_Q) + ((size_t)(b * SEQ + j * CH) * 1024 + h * 256) * 2;
        const char* b1 = (const char*)(ws + (b ? WS_VTB1 : WS_VTB0)) + ((size_t)(h * 512 + pnt * 256) * SEQ + j * CH) * 2;
        const char* b2 = (const char*)(s_head(ws, b, h) + (size_t)(pnt * 256) * SEQ + j * CH);
        u.a = a1; u.b = b1; u.a2d = (long)(a2 - a1) - 4 * 128; u.b2d = (long)(b2 - b1) - 4 * 128;
        return true;
    }
};

#define EPI_FENCE asm volatile("" ::: "memory")
#define EPI_ARGS const f32x4 (&acc)[2][2][4][2], const Unit& u, int wr, int wc, int fr, int fq
struct EpiB1 {
    unsigned char* ws;
    __device__ __forceinline__ void operator()(EPI_ARGS) const {
        const f32x2* tab = (const f32x2*)(ws + WS_TAB); const fx_t* ssq = (const fx_t*)(ws + WS_SSQA);
        if (u.kind == 0) {
            const int head = u.pn & 3; const bool isk = u.pn >= 4;
            bf16_t* dst = isk ? k_tile(ws, u.pm) : (bf16_t*)(ws + WS_Q) + (size_t)u.pm * 256 * 1024;
            const float sc = isk ? 0.0625f : 1.0f;
            const __amdgpu_buffer_rsrc_t ktr = __builtin_amdgcn_make_buffer_rsrc((void*)(ws + (u.pm < 32 ? WS_KTB0 : WS_KTB1)), (short)0, (int)(16 * MiB), 0x00020000);
            const int d0 = wc * 32 + fq * 8;
#pragma unroll
            for (int aih = 0; aih < 2; ++aih) {
                const int ai = aih, mb = 0;
                f32x4 tb[4][4]; float rsq[4];
#pragma unroll
                for (int m = mb; m < mb + 4; ++m) {
                    const int row = ai * 128 + wr * 64 + m * 16 + fr;
                    const int pos = u.pm < 64 ? ((u.pm & 31) * 256 + row) : (PAST + (row & 31));
                    const f32x4* tp = (const f32x4*)(tab + (size_t)pos * 128 + d0);
                    tb[m][0] = tp[0]; tb[m][1] = tp[1]; tb[m][2] = tp[2]; tb[m][3] = tp[3];
                    rsq[m] = fx_get(ssq[(size_t)u.pm * 256 + row]);
                }
                EPI_FENCE;
#pragma unroll
                for (int m = mb; m < mb + 4; ++m) {
                    const int row = ai * 128 + wr * 64 + m * 16 + fr;
                    const f32x4 c01 = tb[m][0], c23 = tb[m][1], c45 = tb[m][2], c67 = tb[m][3];
                    const f32x4 cs0 = (f32x4){c01[0], c01[2], c23[0], c23[2]}, sn0 = (f32x4){c01[1], c01[3], c23[1], c23[3]};
                    const f32x4 cs1 = (f32x4){c45[0], c45[2], c67[0], c67[2]}, sn1 = (f32x4){c45[1], c45[3], c67[1], c67[3]};
                    const f32x4 x1a = acc[ai][0][m][0], x1b = acc[ai][0][m][1], x2a = acc[ai][1][m][0], x2b = acc[ai][1][m][1];
                    const float scr_ = sc * rstd_of(rsq[m]);
                    const f32x4 o1a = (x1a * cs0 - x2a * sn0) * scr_, o1b = (x1b * cs1 - x2b * sn1) * scr_;
                    const f32x4 o2a = (x2a * cs0 + x1a * sn0) * scr_, o2b = (x2b * cs1 + x1b * sn1) * scr_;
                    bf16_t* rp = dst + (size_t)row * 1024 + head * 256 + d0;
                    *(u32x4*)rp = pack8(o1a, o1b); *(u32x4*)(rp + 128) = pack8(o2a, o2b);
                    if (isk) {
                        const float dk = __expf(lgdec(head) * (float)(CH - 1 - (row & (CH - 1))));
                        const unsigned voff = (unsigned)((d0 * SEQ + row) * 2);
                        const unsigned sbase = (unsigned)(((head * 256) * SEQ + (u.pm & 31) * 256) * 2);
                        const u32x4 t1 = pack8(o1a * dk, o1b * dk);
#pragma unroll
                        for (int jj = 0; jj < 4; ++jj) {
                            __builtin_amdgcn_raw_buffer_store_b16((short)(t1[jj] & 0xffffu), ktr, voff, sbase + (unsigned)(2 * jj) * SEQ * 2u, 0);
                            __builtin_amdgcn_raw_buffer_store_b16((short)(t1[jj] >> 16), ktr, voff, sbase + (unsigned)(2 * jj + 1) * SEQ * 2u, 0); }
                        const u32x4 t2 = pack8(o2a * dk, o2b * dk);
#pragma unroll
                        for (int jj = 0; jj < 4; ++jj) {
                            __builtin_amdgcn_raw_buffer_store_b16((short)(t2[jj] & 0xffffu), ktr, voff, sbase + (unsigned)(128 + 2 * jj) * SEQ * 2u, 0);
                            __builtin_amdgcn_raw_buffer_store_b16((short)(t2[jj] >> 16), ktr, voff, sbase + (unsigned)(129 + 2 * jj) * SEQ * 2u, 0); }
                    }
                }
                EPI_FENCE;
            }
        } else {
            bf16_t* dst; int ld;
            if (u.pn < 32) { dst = (bf16_t*)(ws + WS_VTB0) + (size_t)u.pn * 256; ld = SEQ; }
            else if (u.pn < 64) { dst = (bf16_t*)(ws + WS_VTB1) + (size_t)(u.pn - 32) * 256; ld = SEQ; }
            else { dst = (bf16_t*)(ws + WS_VTS); ld = 256; }
            f32x4 rsv[2][2];
#pragma unroll
            for (int bj = 0; bj < 2; ++bj) { const fx_t* sp8 = ssq + (size_t)u.pn * 256 + bj * 128 + wc * 32 + fq * 8;
#pragma unroll
                for (int n = 0; n < 2; ++n) rsv[bj][n] = (f32x4){rstd_of(fx_get(sp8[4 * n])), rstd_of(fx_get(sp8[4 * n + 1])), rstd_of(fx_get(sp8[4 * n + 2])), rstd_of(fx_get(sp8[4 * n + 3]))}; }
#pragma unroll
            for (int ai = 0; ai < 2; ++ai)
#pragma unroll
                for (int m = 0; m < 4; ++m) {
                    const int e = (u.pm - 4) * 256 + ai * 128 + wr * 64 + m * 16 + fr;
                    bf16_t* rp = dst + (size_t)e * ld + wc * 32 + fq * 8;
#pragma unroll
                    for (int bj = 0; bj < 2; ++bj) *(u32x4*)(rp + bj * 128) = pack8(acc[ai][bj][m][0] * rsv[bj][0], acc[ai][bj][m][1] * rsv[bj][1]);
                    EPI_FENCE;
                }
        }
    }
};
struct EpiAtt {
    unsigned char* ws;
    __device__ __forceinline__ void operator()(EPI_ARGS) const {
        const int h = u.aux; const float lg = lgdec(h);
        bf16_t* dst = (bf16_t*)(ws + WS_ATT) + (size_t)(u.pn * SEQ + u.pm * CH) * 1024 + h * 256;
        float cf[2][8];
#pragma unroll
        for (int bj = 0; bj < 2; ++bj)
#pragma unroll
            for (int j = 0; j < 8; ++j) cf[bj][j] = __expf(-lg * (float)(bj * 128 + wc * 32 + fq * 8 + j + 1));
#pragma unroll
        for (int ai = 0; ai < 2; ++ai)
#pragma unroll
            for (int m = 0; m < 4; ++m) {
                const int n = ai * 128 + wr * 64 + m * 16 + fr;
#pragma unroll
                for (int bj = 0; bj < 2; ++bj) {
                    const int m0 = bj * 128 + wc * 32 + fq * 8;
                    float o[8];
#pragma unroll
                    for (int j = 0; j < 8; ++j) o[j] = __uint_as_float(__float_as_uint(acc[ai][bj][m][j >> 2][j & 3] * cf[bj][j]) & ~(unsigned)((n - m0 - j) >> 31));
                    *(u32x4*)(dst + (size_t)n * 1024 + m0) = pack8((f32x4){o[0], o[1], o[2], o[3]}, (f32x4){o[4], o[5], o[6], o[7]});
                }
                EPI_FENCE;
            }
    }
};
struct EpiU {
    unsigned char* ws;
    __device__ __forceinline__ void operator()(EPI_ARGS) const {
        bf16_t* dst = s_head(ws, u.kind, u.aux >> 1) + (size_t)((u.aux & 1) * 256) * SEQ + u.pm * CH;
#pragma unroll
        for (int ai = 0; ai < 2; ++ai)
#pragma unroll
            for (int m = 0; m < 4; ++m) {
                bf16_t* rp = dst + (size_t)(ai * 128 + wr * 64 + m * 16 + fr) * SEQ + wc * 32 + fq * 8;
#pragma unroll
                for (int bj = 0; bj < 2; ++bj) *(u32x4*)(rp + bj * 128) = pack8(acc[ai][bj][m][0], acc[ai][bj][m][1]);
                    EPI_FENCE;
            }
    }
};
struct EpiE {
    unsigned char* ws;
    __device__ __forceinline__ void operator()(EPI_ARGS) const {
        const int h = u.aux, b = u.kind; const float lg = lgdec(h);
        bf16_t* dst = (bf16_t*)(ws + (b ? WS_OB1 : WS_OB0)) + (size_t)(u.pm * CH) * 2048 + h * 512 + u.pn * 256;
        fx_t* st = (fx_t*)(ws + WS_STATS) + (size_t)(b * SEQ + u.pm * CH) * 8 + h * 2;
#pragma unroll
        for (int ai = 0; ai < 2; ++ai)
#pragma unroll
            for (int m = 0; m < 4; ++m) {
                const int n = ai * 128 + wr * 64 + m * 16 + fr; const float rs = __expf(lg * (float)(n + 1));
                float s = 0.f, q = 0.f;
#pragma unroll
                for (int bj = 0; bj < 2; ++bj) {
                    const f32x4 v0 = acc[ai][bj][m][0] * rs, v1 = acc[ai][bj][m][1] * rs;
                    s += (v0[0] + v0[1]) + (v0[2] + v0[3]) + (v1[0] + v1[1]) + (v1[2] + v1[3]);
                    q += (v0[0] * v0[0] + v0[1] * v0[1]) + (v0[2] * v0[2] + v0[3] * v0[3]) + (v1[0] * v1[0] + v1[1] * v1[1]) + (v1[2] * v1[2] + v1[3] * v1[3]);
                    *(u32x4*)(dst + (size_t)n * 2048 + bj * 128 + wc * 32 + fq * 8) = pack8(v0, v1);
                }
                s += shx<16>(s); s += shx<32>(s); q += shx<16>(q); q += shx<32>(q);
                if (fq == 0) { fx_add(st + (size_t)n * 8, s); fx_add(st + (size_t)n * 8 + 1, q); }
                EPI_FENCE;
            }
    }
};
struct EpiB2 {
    unsigned char* ws; const float* gn_g;
    __device__ __forceinline__ void operator()(EPI_ARGS) const {
        const fx_t* ssq = (const fx_t*)(ws + WS_SSQA) + (size_t)u.pm * 256;
        float rsr[2][4];
#pragma unroll
        for (int ai = 0; ai < 2; ++ai)
#pragma unroll
            for (int m = 0; m < 4; ++m) rsr[ai][m] = fx_get(ssq[ai * 128 + wr * 64 + m * 16 + fr]);
#pragma unroll
        for (int ai = 0; ai < 2; ++ai)
#pragma unroll
            for (int m = 0; m < 4; ++m) rsr[ai][m] = rstd_of(rsr[ai][m]);
        if (u.pn < 8) {
            bf16_t* dst = (bf16_t*)(ws + WS_GLU) + (size_t)u.pm * 256 * 1024 + u.pn * 128 + wc * 32 + fq * 8;
#pragma unroll
            for (int ai = 0; ai < 2; ++ai)
#pragma unroll
                for (int m = 0; m < 4; ++m) {
                    const int row = ai * 128 + wr * 64 + m * 16 + fr;
                    const float rs = rsr[ai][m];
                    f32x4 a0 = acc[ai][0][m][0] * rs, a1 = acc[ai][0][m][1] * rs; const f32x4 b0 = acc[ai][1][m][0] * rs, b1 = acc[ai][1][m][1] * rs;
#pragma unroll
                    for (int j = 0; j < 4; ++j) { a0[j] *= sigm(b0[j]); a1[j] *= sigm(b1[j]); }
                    *(u32x4*)(dst + (size_t)row * 1024) = pack8(a0, a1);
                    EPI_FENCE;
                }
        } else if (u.pn < 16) {
            const int t = u.pn - 8, head = t >> 1;
            bf16_t* ob = o_tile(ws, u.pm) + t * 256 + wc * 32 + fq * 8;
            const fx_t* st = (const fx_t*)(ws + WS_STATS) + (size_t)u.pm * 256 * 8 + head * 2;
            f32x4 gg[2][2];
#pragma unroll
            for (int bj = 0; bj < 2; ++bj) { const f32x4* gp = (const f32x4*)(gn_g + t * 256 + bj * 128 + wc * 32 + fq * 8); gg[bj][0] = gp[0]; gg[bj][1] = gp[1]; }
#pragma unroll
            for (int aih = 0; aih < 4; ++aih) {
                const int ai = aih >> 1, mb = (aih & 1) * 2;
                f32x2 sqv[4]; u32x4 ov[4][2];
#pragma unroll
                for (int m = mb; m < mb + 2; ++m) {
                    const int row = ai * 128 + wr * 64 + m * 16 + fr;
                    { const fx_t* sp2 = st + (size_t)row * 8; sqv[m] = (f32x2){fx_get(sp2[0]), fx_get(sp2[1])}; }
#pragma unroll
                    for (int bj = 0; bj < 2; ++bj) ov[m][bj] = *(const u32x4*)(ob + (size_t)row * 2048 + bj * 128);
                }
                EPI_FENCE;
#pragma unroll
                for (int m = mb; m < mb + 2; ++m) {
                    const int row = ai * 128 + wr * 64 + m * 16 + fr;
                    const f32x2 sq = sqv[m]; const float rsn = rsr[ai][m];
                    const float mu = sq.x * (1.0f / 512.0f); const float var = fmaxf(sq.y * (1.0f / 512.0f) - mu * mu, 0.f); const float rstd = __builtin_amdgcn_rsqf(var + LN_EPS);
#pragma unroll
                    for (int bj = 0; bj < 2; ++bj) {
                        bf16_t* rp = ob + (size_t)row * 2048 + bj * 128;
                        f32x4 o0, o1; unpack8(ov[m][bj], o0, o1);
                        f32x4 g0 = acc[ai][bj][m][0] * rsn, g1 = acc[ai][bj][m][1] * rsn;
#pragma unroll
                        for (int j = 0; j < 4; ++j) { g0[j] = g0[j] * sigm(g0[j]) * ((o0[j] - mu) * rstd * gg[bj][0][j]); g1[j] = g1[j] * sigm(g1[j]) * ((o1[j] - mu) * rstd * gg[bj][1][j]); }
                        *(u32x4*)rp = pack8(g0, g1);
                    }
                }
                EPI_FENCE;
            }
        } else {
            const int t = (u.pn - 16) & 3;
            bf16_t* dst = (bf16_t*)(ws + (u.pn < 20 ? WS_GC : WS_GR)) + (size_t)u.pm * 256 * 1024 + t * 256 + wc * 32 + fq * 8;
#pragma unroll
            for (int ai = 0; ai < 2; ++ai)
#pragma unroll
                for (int m = 0; m < 4; ++m) {
                    const int row = ai * 128 + wr * 64 + m * 16 + fr; const float rs = rsr[ai][m];
#pragma unroll
                    for (int bj = 0; bj < 2; ++bj) {
                        f32x4 a0 = acc[ai][bj][m][0] * rs, a1 = acc[ai][bj][m][1] * rs;
#pragma unroll
                        for (int j = 0; j < 4; ++j) { a0[j] = sigm(a0[j]); a1[j] = sigm(a1[j]); }
                        *(u32x4*)(dst + (size_t)row * 1024 + bj * 128) = pack8(a0, a1);
                    }
                    EPI_FENCE;
                }
        }
    }
};
template <int MODE> struct EpiEW {
    unsigned char* ws; float* x; fx_t* ssq;
    __device__ __forceinline__ void operator()(EPI_ARGS) const {
        const int c0 = u.pn * 256 + wc * 32 + fq * 8;
#pragma unroll
        for (int ai = 0; ai < 2; ++ai) {
            u32x4 gv[4][2], tv[4][2]; float sqs[4] = {0.f, 0.f, 0.f, 0.f}, rs3[4];
            if (MODE == 3) {
#pragma unroll
                for (int m = 0; m < 4; ++m) rs3[m] = rstd_of(fx_get(ssq[(size_t)u.pm * 256 + ai * 128 + wr * 64 + m * 16 + fr]));
            }
            if (MODE != 3) {
#pragma unroll
                for (int m = 0; m < 4; ++m) {
                    const size_t row = (size_t)u.pm * 256 + ai * 128 + wr * 64 + m * 16 + fr;
#pragma unroll
                    for (int bj = 0; bj < 2; ++bj) {
                        if (MODE == 0) gv[m][bj] = *(const u32x4*)((const bf16_t*)(ws + WS_GC) + row * 1024 + c0 + bj * 128);
                        if (MODE == 1) { gv[m][bj] = *(const u32x4*)((const bf16_t*)(ws + WS_GR) + row * 1024 + c0 + bj * 128); tv[m][bj] = *(const u32x4*)((const bf16_t*)(ws + WS_T) + row * 1024 + c0 + bj * 128); }
                        if (MODE == 2) tv[m][bj] = *(const u32x4*)((const bf16_t*)(ws + WS_H) + row * 1024 + c0 + bj * 128);
                    }
                }
                EPI_FENCE;
            }
#pragma unroll
            for (int m = 0; m < 4; ++m) {
                const size_t row = (size_t)u.pm * 256 + ai * 128 + wr * 64 + m * 16 + fr;
#pragma unroll
                for (int bj = 0; bj < 2; ++bj) {
                    f32x4 a0 = acc[ai][bj][m][0], a1 = acc[ai][bj][m][1];
                    if (MODE == 0) {
                        f32x4 g0, g1; unpack8(gv[m][bj], g0, g1);
                        *(u32x4*)((bf16_t*)(ws + WS_T) + row * 1024 + c0 + bj * 128) = pack8(a0 * g0, a1 * g1);
                    } else if (MODE == 1) {
                        f32x4 g0, g1, t0, t1; unpack8(gv[m][bj], g0, g1); unpack8(tv[m][bj], t0, t1);
                        *(u32x4*)((bf16_t*)(ws + WS_T) + row * 1024 + c0 + bj * 128) = pack8(t0 + a0 * g0, t1 + a1 * g1);
                    } else if (MODE == 2) {
                        f32x4 x0, x1; unpack8(tv[m][bj], x0, x1);
                        a0 = x0 + a0; a1 = x1 + a1;
                        *(u32x4*)((bf16_t*)(ws + WS_H) + row * 1024 + c0 + bj * 128) = pack8(a0, a1);
                        sqs[m] += (a0[0] * a0[0] + a0[1] * a0[1]) + (a0[2] * a0[2] + a0[3] * a0[3]) + (a1[0] * a1[0] + a1[1] * a1[1]) + (a1[2] * a1[2] + a1[3] * a1[3]);
                    } else {
#pragma unroll
                        for (int j = 0; j < 4; ++j) { const float r0 = fmaxf(a0[j], 0.f) * rs3[m], r1 = fmaxf(a1[j], 0.f) * rs3[m]; a0[j] = r0 * r0; a1[j] = r1 * r1; }
                        *(u32x4*)((bf16_t*)(ws + WS_U) + row * 4096 + c0 + bj * 128) = pack8(a0, a1);
                    }
                }
                if (MODE == 2) { float q = sqs[m]; q += shx<16>(q); q += shx<32>(q); if (fq == 0) fx_add(ssq + row, q); }
            }
            EPI_FENCE;
        }
    }
};

__device__ __forceinline__ void transpose_item(const float* W, int K, int N, bf16_t* WT, int k0, int n0, int drow0, LAS float* scr, int lane, const float* gk = nullptr) {
    float tv[32];
#pragma unroll
    for (int i = 0; i < 32; ++i) { const int kk = 2 * i + (lane >> 5); tv[i] = W[(size_t)(k0 + kk) * N + n0 + (lane & 31)]; }
#pragma unroll
    for (int i = 0; i < 32; ++i) { const int kk = 2 * i + (lane >> 5); scr[kk * 33 + (lane & 31)] = gk ? tv[i] * gk[k0 + kk] : tv[i]; }
    asm volatile("s_waitcnt lgkmcnt(0)" ::: "memory");
    const int c = lane & 7;
#pragma unroll
    for (int j = 0; j < 4; ++j) { const int n = (lane >> 3) + 8 * j; const LAS float* s = scr + (8 * c) * 33 + n;
        u32x4 o; o.x = cvt_pk_bf16(s[0 * 33], s[1 * 33]); o.y = cvt_pk_bf16(s[2 * 33], s[3 * 33]); o.z = cvt_pk_bf16(s[4 * 33], s[5 * 33]); o.w = cvt_pk_bf16(s[6 * 33], s[7 * 33]);
        *(u32x4*)(WT + (size_t)(drow0 + n) * K + k0 + 8 * c) = o; }
    asm volatile("s_waitcnt lgkmcnt(0)" ::: "memory");
}
struct TItem { const float* W; const float* gk; bf16_t* WT; int K, N, k0, n0, drow0; };
__device__ __forceinline__ void titem_load(const TItem& t, int lane, float (&tv)[32], f32x4& g0, f32x4& g1) {
#pragma unroll
    for (int i = 0; i < 32; ++i) { const int kk = 2 * i + (lane >> 5); tv[i] = t.W[(size_t)(t.k0 + kk) * t.N + t.n0 + (lane & 31)]; }
    g0 = (f32x4){1.f, 1.f, 1.f, 1.f}; g1 = g0;
    if (t.gk) { const f32x4* gp = (const f32x4*)(t.gk + t.k0 + 8 * (lane & 7)); g0 = gp[0]; g1 = gp[1]; }
}
__device__ __forceinline__ void titem_store(const TItem& t, int lane, const float (&tv)[32], const f32x4 g0, const f32x4 g1, LAS float* scr) {
#pragma unroll
    for (int i = 0; i < 32; ++i) { const int kk = 2 * i + (lane >> 5); scr[kk * 33 + (lane & 31)] = tv[i]; }
    asm volatile("s_waitcnt lgkmcnt(0)" ::: "memory");
    const int c = lane & 7;
#pragma unroll
    for (int j = 0; j < 4; ++j) { const int n = (lane >> 3) + 8 * j; const LAS float* sp = scr + (8 * c) * 33 + n;
        u32x4 o; o.x = cvt_pk_bf16(sp[0 * 33] * g0[0], sp[1 * 33] * g0[1]); o.y = cvt_pk_bf16(sp[2 * 33] * g0[2], sp[3 * 33] * g0[3]);
        o.z = cvt_pk_bf16(sp[4 * 33] * g1[0], sp[5 * 33] * g1[1]); o.w = cvt_pk_bf16(sp[6 * 33] * g1[2], sp[7 * 33] * g1[3]);
        *(u32x4*)(t.WT + (size_t)(t.drow0 + n) * t.K + t.k0 + 8 * c) = o; }
    asm volatile("s_waitcnt lgkmcnt(0)" ::: "memory");
}
__device__ __forceinline__ int win_drow(int n0) {
    if (n0 < 2048) { const int bj = n0 >> 10, jj = n0 & 1023; return 4096 + 256 * (jj >> 7) + 128 * bj + (jj & 127); }
    if (n0 < 6144) return n0 - 2048;
    return n0;
}
__device__ __forceinline__ void rms_row(const float* xrow, const float* g, bf16_t* orow, float* copy, int lane) {
    const f32x4* xr = (const f32x4*)xrow + lane; const f32x4* gr = (const f32x4*)g + lane;
    f32x4 v[4]; float s = 0.f;
#pragma unroll
    for (int j = 0; j < 4; ++j) { v[j] = xr[64 * j]; s += (v[j][0] * v[j][0] + v[j][1] * v[j][1]) + (v[j][2] * v[j][2] + v[j][3] * v[j][3]); }
    const float r = 1.0f / sqrtf(wave_sum(s) * (1.0f / 1024.0f) + RMS_EPS);
    u32x2* o8 = (u32x2*)orow + lane;
#pragma unroll
    for (int j = 0; j < 4; ++j) { const f32x4 gg = gr[64 * j]; if (copy) ((f32x4*)copy + lane)[64 * j] = v[j];
        u32x2 w; w.x = cvt_pk_bf16(v[j][0] * r * gg[0], v[j][1] * r * gg[1]); w.y = cvt_pk_bf16(v[j][2] * r * gg[2], v[j][3] * r * gg[3]); o8[64 * j] = w; }
}

__device__ __forceinline__ void phase0(int wv, const Params& p, int l, LAS unsigned char* lds, int part) {
    int wv_ = wv; asm volatile("" : "+s"(wv_)); int tid = wv_ * 64 + lane_id(); asm volatile("" : "+v"(tid));
    const int lane = tid & 63, wave = tid >> 6, G = gdim();
    const int gw = blockIdx.x * 8 + wave, NGW = G * 8;
    unsigned char* ws = p.ws;
    LAS float* scr = (LAS float*)(lds + wave * 16384);
    const float* w_in = p.in[5] + (size_t)l * 1024 * 10240; const float* w_c = p.in[10] + (size_t)l * 1024 * 1024; const float* w_r = p.in[12] + (size_t)l * 2048 * 1024;
    const float* w_o = p.in[13] + (size_t)l * 1024 * 1024; const float* w_1 = p.in[15] + (size_t)l * 1024 * 4096; const float* w_2 = p.in[16] + (size_t)l * 4096 * 1024;
    constexpr int I_IN = 16 * 320, I_C = 16 * 32, I_R = 32 * 32, I_O = 16 * 32, I_1 = 16 * 128, I_2 = 64 * 32, NIT = I_IN + I_C + I_R + I_O + I_1 + I_2;
#define TI_DECODE(it_, T_) do { int r = (it_); \
        if (r < I_IN) { const int kb = r / 320, nb = r % 320; T_ = TItem{w_in, p.in[4] + l * 1024, (bf16_t*)(ws + WS_WIN), 1024, 10240, kb * 64, nb * 32, win_drow(nb * 32)}; break; } r -= I_IN; \
        if (r < I_C) { const int kb = r / 32, nb = r % 32; T_ = TItem{w_c, nullptr, (bf16_t*)(ws + WS_WC), 1024, 1024, kb * 64, nb * 32, nb * 32}; break; } r -= I_C; \
        if (r < I_R) { const int kb = r / 32, nb = r % 32; T_ = TItem{w_r, nullptr, (bf16_t*)(ws + WS_WR), 2048, 1024, kb * 64, nb * 32, nb * 32}; break; } r -= I_R; \
        if (r < I_O) { const int kb = r / 32, nb = r % 32; T_ = TItem{w_o, nullptr, (bf16_t*)(ws + WS_WO), 1024, 1024, kb * 64, nb * 32, nb * 32}; break; } r -= I_O; \
        if (r < I_1) { const int kb = r / 128, nb = r % 128; T_ = TItem{w_1, p.in[14] + l * 1024, (bf16_t*)(ws + WS_WM1), 1024, 4096, kb * 64, nb * 32, nb * 32}; break; } r -= I_1; \
        { const int kb = r / 32, nb = r % 32; T_ = TItem{w_2, nullptr, (bf16_t*)(ws + WS_WM2), 4096, 1024, kb * 64, nb * 32, nb * 32}; } } while (0)
    const int it_first = part == 0 ? 0 : I_IN, it_last = part == 0 ? I_IN : NIT;
    if (it_first + gw < it_last) {
        int it = it_first + gw; TItem cur; TI_DECODE(it, cur);
        float tv[32]; f32x4 g0, g1; titem_load(cur, lane, tv, g0, g1);
#pragma unroll 1
        for (;;) {
            const int nit = it + NGW; const bool has = nit < it_last;
            TItem nx = cur; float tn[32]; f32x4 h0 = g0, h1 = g1;
            if (has) { TI_DECODE(nit, nx); titem_load(nx, lane, tn, h0, h1); }
            titem_store(cur, lane, tv, g0, g1, scr);
            if (!has) break;
            cur = nx; it = nit; g0 = h0; g1 = h1;
#pragma unroll
            for (int i = 0; i < 32; ++i) tv[i] = tn[i];
        }
    }
#undef TI_DECODE
    if (part != 0) { asm volatile("s_waitcnt vmcnt(0) lgkmcnt(0)" ::: "memory"); __syncthreads(); return; }
    if (l == 0) {
        for (int m = gw; m < NTOK; m += NGW) {
            const float* src = m < NPT ? p.in[0] + (size_t)m * 1024 : p.in[1] + (size_t)(m - NPT) * 1024;
            const f32x4* xr = (const f32x4*)src + lane; f32x4 v[4]; float sq = 0.f;
#pragma unroll
            for (int j = 0; j < 4; ++j) { v[j] = xr[64 * j]; sq += (v[j][0] * v[j][0] + v[j][1] * v[j][1]) + (v[j][2] * v[j][2] + v[j][3] * v[j][3]); }
            sq = wave_sum(sq);
            u32x2* o8 = (u32x2*)((bf16_t*)(ws + WS_H) + (size_t)m * 1024) + lane;
#pragma unroll
            for (int j = 0; j < 4; ++j) { u32x2 wv; wv.x = cvt_pk_bf16(v[j][0], v[j][1]); wv.y = cvt_pk_bf16(v[j][2], v[j][3]); o8[64 * j] = wv; }
            if (lane == 0) ((fx_t*)(ws + WS_SSQA))[m] = fx_of(sq);
        }
    }
    { unsigned z = 0u; asm volatile("" : "+v"(z)); unsigned* sb = (unsigned*)(ws + WS_SSQB); for (int i = blockIdx.x * 512 + tid; i < NTOK * 2; i += G * 512) sb[i] = z; }
    { unsigned z = 0u; asm volatile("" : "+v"(z)); unsigned* st = (unsigned*)(ws + WS_STATS); for (int i = blockIdx.x * 512 + tid; i < NTOK * 16; i += G * 512) st[i] = z; }
    {
        f32x2* tab = (f32x2*)(ws + WS_TAB);
        for (int i = blockIdx.x * 512 + tid; i < 8192 * 128; i += G * 512) {
            const int pos = i >> 7, k = i & 127;
            const float inv = powf(10000.0f, -(float)(2 * k) / 256.0f); const float ang = (float)pos * inv;
            float sn, cs; sincosf(ang, &sn, &cs); tab[i] = (f32x2){cs, sn};
        }
    }
}

__device__ __forceinline__ void phase_scan(int wv, const Params& p, int l) {
    int wv_ = wv; asm volatile("" : "+s"(wv_)); int tid = wv_ * 64 + lane_id(); asm volatile("" : "+v"(tid));
    const int gt = blockIdx.x * 512 + tid;
    if (gt >= 2048 * 64) return;
    const int row = gt >> 6, d4 = (gt & 63) * 4, h = row >> 9, e = row & 511;
    const float sd = __expf(lgdec(h) * (float)CH);
#pragma unroll 1
    for (int b = 0; b < 2; ++b) {
        bf16_t* sp = s_head(p.ws, b, h) + (size_t)e * SEQ + d4;
        float a[4] = {0.f, 0.f, 0.f, 0.f};
#pragma unroll 1
        for (int j0 = 0; j0 < 32; j0 += 16) {
            u32x2 w[16];
#pragma unroll
            for (int j = 0; j < 16; ++j) w[j] = *(const u32x2*)(sp + (j0 + j) * CH);
#pragma unroll
            for (int j = 0; j < 16; ++j) {
                u32x2 o; o.x = cvt_pk_bf16(a[0], a[1]); o.y = cvt_pk_bf16(a[2], a[3]);
                *(u32x2*)(sp + (j0 + j) * CH) = o;
                a[0] = a[0] * sd + bflo(w[j].x); a[1] = a[1] * sd + bfhi(w[j].x); a[2] = a[2] * sd + bflo(w[j].y); a[3] = a[3] * sd + bfhi(w[j].y);
            }
        }
        float* o = p.out + OUT_RETP + ((size_t)((l * 2 + b) * 4 + h) * 256 + d4) * 512 + e;
#pragma unroll
        for (int j = 0; j < 4; ++j) o[(size_t)j * 512] = a[j];
    }
}

__device__ __forceinline__ void phase_sret(int wv, const Params& p, int l, LAS unsigned char* lds) {
    int wv_ = wv; asm volatile("" : "+s"(wv_)); int tid = wv_ * 64 + lane_id(); asm volatile("" : "+v"(tid));
    const int lane = tid & 63, w = __builtin_amdgcn_readfirstlane(tid >> 6);
    unsigned char* ws = p.ws;
    LAS float* attL = (LAS float*)lds;
    LAS float* red = (LAS float*)(lds + 8192);
    for (int unit = blockIdx.x, GG = gdim(); unit < 256; unit += GG) {
        const int es = unit & 7, h = (unit >> 3) & 3, bs = unit >> 5;
        const float lg = lgdec(h);
        const bf16_t* q = (const bf16_t*)(ws + WS_Q) + (size_t)(NPT + bs * 32) * 1024 + h * 256;
        const bf16_t* k = (const bf16_t*)(ws + WS_KS) + (size_t)(bs * 32) * 1024 + h * 256;
        const bf16_t* kT = (const bf16_t*)(ws + WS_KTS) + (size_t)(h * 256) * 256 + bs * 32;
        const bf16_t* vT = (const bf16_t*)(ws + WS_VTS) + (size_t)(h * 512 + es * 64) * 256 + bs * 32;
        if (w == 0) {
            f32x16 accq;
#pragma unroll
            for (int r = 0; r < 16; ++r) accq[r] = 0.f;
            const bf16_t* qa = q + (size_t)(lane & 31) * 1024 + (lane >> 5) * 8; const bf16_t* kb = k + (size_t)(lane & 31) * 1024 + (lane >> 5) * 8;
#pragma unroll
            for (int sk = 0; sk < 16; ++sk) { const bf16x8 af = *(const bf16x8*)(qa + 16 * sk), bfr = *(const bf16x8*)(kb + 16 * sk); accq = __builtin_amdgcn_mfma_f32_32x32x16_bf16(af, bfr, accq, 0, 0, 0); }
            const int m = lane & 31;
#pragma unroll
            for (int r = 0; r < 16; ++r) { const int n = (r & 3) + 8 * (r >> 2) + 4 * (lane >> 5); attL[n * 33 + m] = (m <= n) ? accq[r] * __expf(lg * (float)(n - m)) : 0.f; }
        }
        const int e = es * 64 + lane;
        const float* S0 = p.in[3] + ((size_t)((l * 8 + bs) * 4 + h) * 256 + w * 32) * 512 + e;
        float s0[32];
#pragma unroll
        for (int dd = 0; dd < 32; ++dd) s0[dd] = S0[(size_t)dd * 512];
        float v[32];
        { const u32x4* vp = (const u32x4*)(vT + (size_t)lane * 256);
#pragma unroll
          for (int c = 0; c < 4; ++c) { f32x4 a, b2; unpack8(vp[c], a, b2); v[8 * c] = a[0]; v[8 * c + 1] = a[1]; v[8 * c + 2] = a[2]; v[8 * c + 3] = a[3]; v[8 * c + 4] = b2[0]; v[8 * c + 5] = b2[1]; v[8 * c + 6] = b2[2]; v[8 * c + 7] = b2[3]; } }
        {
            float* So = p.out + OUT_RETS + ((size_t)((l * 8 + bs) * 4 + h) * 256 + w * 32) * 512 + e;
            const float sd = __expf(lg * 32.0f);
#pragma unroll 4
            for (int dd = 0; dd < 32; ++dd) {
                const u32x4* kr = (const u32x4*)(kT + (size_t)(w * 32 + dd) * 256); float a = s0[dd] * sd;
#pragma unroll
                for (int c4 = 0; c4 < 4; ++c4) { f32x4 k0, k1; unpack8(kr[c4], k0, k1);
                    a += (k0[0] * v[8 * c4] + k0[1] * v[8 * c4 + 1]) + (k0[2] * v[8 * c4 + 2] + k0[3] * v[8 * c4 + 3]) + (k1[0] * v[8 * c4 + 4] + k1[1] * v[8 * c4 + 5]) + (k1[2] * v[8 * c4 + 6] + k1[3] * v[8 * c4 + 7]); }
                So[(size_t)dd * 512] = a;
            }
        }
#pragma unroll 2
        for (int n = 0; n < 32; ++n) {
            const u32x4* qr = (const u32x4*)(q + (size_t)n * 1024 + w * 32); float a = 0.f;
#pragma unroll
            for (int c4 = 0; c4 < 4; ++c4) { f32x4 k0, k1; unpack8(qr[c4], k0, k1);
                a += (k0[0] * s0[8 * c4] + k0[1] * s0[8 * c4 + 1]) + (k0[2] * s0[8 * c4 + 2] + k0[3] * s0[8 * c4 + 3]) + (k1[0] * s0[8 * c4 + 4] + k1[1] * s0[8 * c4 + 5]) + (k1[2] * s0[8 * c4 + 6] + k1[3] * s0[8 * c4 + 7]); }
            red[(w * 32 + n) * 64 + lane] = a * __expf(lg * (float)(n + 1));
        }
        __syncthreads();
        bf16_t* O = (bf16_t*)(ws + WS_OS) + (size_t)(bs * 32) * 2048 + h * 512 + e;
        fx_t* st = (fx_t*)(ws + WS_STATS) + (size_t)(NPT + bs * 32) * 8 + h * 2;
#pragma unroll
        for (int r = 0; r < 4; ++r) {
            const int n = w * 4 + r; float a = 0.f;
#pragma unroll
            for (int ww = 0; ww < 8; ++ww) a += red[(ww * 32 + n) * 64 + lane];
#pragma unroll
            for (int m = 0; m < 32; ++m) a += attL[n * 33 + m] * v[m];
            O[(size_t)n * 2048] = (bf16_t)(cvt_pk_bf16(a, 0.f) & 0xffffu);
            const float s = wave_sum(a), qq = wave_sum(a * a);
            if (lane == 0) { fx_add(st + (size_t)n * 8, s); fx_add(st + (size_t)n * 8 + 1, qq); }
        }
        __syncthreads();
    }
}

__device__ __forceinline__ void phase_conv(int wv, const Params& p, int l, LAS unsigned char* lds) {
    int wv_ = wv; asm volatile("" : "+s"(wv_)); int tid = wv_ * 64 + lane_id(); asm volatile("" : "+v"(tid));
    const int lane = tid & 63, wave = tid >> 6;
    unsigned char* ws = p.ws;
    LAS float* red = (LAS float*)lds;
    const int c0 = tid * 2;
    const float* cw = p.in[6] + (size_t)l * 31 * 1024 + c0;
    float w0[31], w1[31];
#pragma unroll
    for (int j = 0; j < 31; ++j) { const f32x2 t = *(const f32x2*)(cw + (size_t)j * 1024); w0[j] = t.x; w1[j] = t.y; }
    const f32x2 cb = *(const f32x2*)(p.in[7] + l * 1024 + c0), lg = *(const f32x2*)(p.in[8] + l * 1024 + c0), lb = *(const f32x2*)(p.in[9] + l * 1024 + c0);
    const int GG = gdim();
    { unsigned z = 0u; asm volatile("" : "+v"(z)); unsigned* sa = (unsigned*)(ws + WS_SSQA); for (int i = blockIdx.x * 512 + tid; i < NTOK * 2; i += GG * 512) sa[i] = z; }
    for (int tok = blockIdx.x; tok < 256; tok += GG) {
        const int sb = tok >> 5, t = tok & 31;
        const bf16_t* gl = (const bf16_t*)(ws + WS_GLU) + (size_t)(NPT + sb * 32) * 1024 + c0;
        const float* cst = p.in[2] + (size_t)(l * 8 + sb) * 30 * 1024 + c0;
        unsigned xg[31]; f32x2 xs[31];
#pragma unroll
        for (int j = 0; j < 31; ++j) { const int tt = t + j - 30; const int tg = tt < 0 ? 0 : tt, tsx = tt + 30 > 29 ? 29 : tt + 30;
            xg[j] = *(const unsigned*)(gl + (size_t)tg * 1024); xs[j] = *(const f32x2*)(cst + (size_t)tsx * 1024); }
        float a0 = cb.x, a1 = cb.y;
#pragma unroll
        for (int j = 0; j < 31; ++j) { const bool fromg = (t + j - 30) >= 0; const float x0 = fromg ? bflo(xg[j]) : xs[j].x, x1 = fromg ? bfhi(xg[j]) : xs[j].y; a0 += x0 * w0[j]; a1 += x1 * w1[j]; }
        if (t >= 2) *(f32x2*)(p.out + OUT_CONVS + ((size_t)(l * 8 + sb) * 30 + (t - 2)) * 1024 + c0) = (f32x2){bflo(xg[30]), bfhi(xg[30])};
        { const float s = wave_sum(a0 + a1), q = wave_sum(a0 * a0 + a1 * a1); if (lane == 0) { red[wave] = s; red[128 + wave] = q; } }
        __syncthreads();
        { float s = 0.f, q = 0.f;
#pragma unroll
          for (int ww = 0; ww < 8; ++ww) { s += red[ww]; q += red[128 + ww]; }
          const float mu = s * (1.0f / 1024.0f); const float var = fmaxf(q * (1.0f / 1024.0f) - mu * mu, 0.f); const float rstd = __builtin_amdgcn_rsqf(var + LN_EPS);
          float y0 = (a0 - mu) * rstd * lg.x + lb.x, y1 = (a1 - mu) * rstd * lg.y + lb.y; y0 *= sigm(y0); y1 *= sigm(y1);
          *(unsigned*)((bf16_t*)(ws + WS_YC) + (size_t)(NPT + tok) * 1024 + c0) = cvt_pk_bf16(y0, y1); }
        __syncthreads();
    }
    for (int unit = blockIdx.x; unit < NPT / 16; unit += GG) {
        const int g0 = unit * 16, t0 = g0 & (SEQ - 1), pb = g0 >> 13;
        const bool lastt = (t0 == SEQ - 16);
        const bf16_t* gl = (const bf16_t*)(ws + WS_GLU) + (size_t)g0 * 1024 + c0;
        float* cso = p.out + OUT_CONVP + (size_t)(l * 2 + pb) * 30 * 1024 + c0;
        unsigned xin[46];
#pragma unroll
        for (int r = 0; r < 46; ++r) { const int tt = t0 - 30 + r; const long off = tt >= 0 ? (long)(r - 30) : 0l; xin[r] = *(const unsigned*)(gl + off * 1024); if (tt < 0) xin[r] = 0u; }
        float a0[16], a1[16];
#pragma unroll
        for (int t = 0; t < 16; ++t) { a0[t] = cb.x; a1[t] = cb.y; }
#pragma unroll
        for (int r = 0; r < 46; ++r) {
            const float x0 = bflo(xin[r]), x1 = bfhi(xin[r]);
            if (r >= 16 && lastt) *(f32x2*)(cso + (size_t)(r - 16) * 1024) = (f32x2){x0, x1};
#pragma unroll
            for (int t = 0; t < 16; ++t) { const int j = r - t; if (j >= 0 && j <= 30) { a0[t] += x0 * w0[j]; a1[t] += x1 * w1[j]; } }
        }
#pragma unroll
        for (int t = 0; t < 16; ++t) { const float s = wave_sum(a0[t] + a1[t]), q = wave_sum(a0[t] * a0[t] + a1[t] * a1[t]); if (lane == 0) { red[t * 8 + wave] = s; red[128 + t * 8 + wave] = q; } }
        asm volatile("s_waitcnt lgkmcnt(0)" ::: "memory"); __builtin_amdgcn_s_barrier(); asm volatile("" ::: "memory");
        bf16_t* yo = (bf16_t*)(ws + WS_YC) + (size_t)g0 * 1024 + c0;
#pragma unroll
        for (int t = 0; t < 16; ++t) { float s = 0.f, q = 0.f;
#pragma unroll
            for (int ww = 0; ww < 8; ++ww) { s += red[t * 8 + ww]; q += red[128 + t * 8 + ww]; }
            const float mu = s * (1.0f / 1024.0f); const float var = fmaxf(q * (1.0f / 1024.0f) - mu * mu, 0.f);
            const float rstd = __builtin_amdgcn_rsqf(var + LN_EPS);
            float y0 = (a0[t] - mu) * rstd * lg.x + lb.x, y1 = (a1[t] - mu) * rstd * lg.y + lb.y;
            y0 *= sigm(y0); y1 *= sigm(y1);
            *(unsigned*)(yo + (size_t)t * 1024) = cvt_pk_bf16(y0, y1); }
        asm volatile("s_waitcnt lgkmcnt(0)" ::: "memory"); __builtin_amdgcn_s_barrier(); asm volatile("" ::: "memory");
    }
    asm volatile("s_waitcnt vmcnt(0) lgkmcnt(0)" ::: "memory");
    __syncthreads();
}

__device__ __forceinline__ void phase_rms2(int wv, const Params& p, int l) {
    int wv_ = wv; asm volatile("" : "+s"(wv_)); int tid = wv_ * 64 + lane_id(); asm volatile("" : "+v"(tid));
    const int lane = tid & 63, gw = blockIdx.x * 8 + (tid >> 6), NGW = gdim() * 8;
    const float* g2 = p.in[14] + l * 1024;
    for (int m = gw; m < NTOK; m += NGW) rms_row(p.out + (size_t)m * 1024, g2, (bf16_t*)(p.ws + WS_H) + (size_t)m * 1024, nullptr, lane);
}
__device__ __forceinline__ void phase_final(int wv, const Params& p) {
    int wv_ = wv; asm volatile("" : "+s"(wv_)); int tid = wv_ * 64 + lane_id(); asm volatile("" : "+v"(tid));
    const int lane = tid & 63, gw = blockIdx.x * 8 + (tid >> 6), NGW = gdim() * 8;
    const f32x4* gr = (const f32x4*)p.in[17] + lane; const fx_t* ssq = (const fx_t*)(p.ws + WS_SSQA);
    for (int m = gw; m < NTOK; m += NGW) {
        f32x4* yr = (f32x4*)(p.out + (size_t)m * 1024) + lane; const u32x2* xr = (const u32x2*)((const bf16_t*)(p.ws + WS_H) + (size_t)m * 1024) + lane; const float r = rstd_of(fx_get(ssq[m]));
#pragma unroll
        for (int j = 0; j < 4; ++j) { const u32x2 w = xr[64 * j]; const f32x4 xv = {bflo(w.x), bfhi(w.x), bflo(w.y), bfhi(w.y)}; yr[64 * j] = xv * r * gr[64 * j]; }
    }
}

#define SG_BAR() do { asm volatile("s_waitcnt lgkmcnt(0)" ::: "memory"); __builtin_amdgcn_s_barrier(); asm volatile("" ::: "memory"); } while (0)
template <bool PAIR, class EpiS>
__device__ __forceinline__ void sgemm_phase(int wv, LAS unsigned char* lds, const bf16_t* A, const bf16_t* Wt, int K, int nUnits, const EpiS& epi) {
    int wv_ = wv; asm volatile("" : "+s"(wv_)); int tid = wv_ * 64 + lane_id(); asm volatile("" : "+v"(tid));
    const int lane = tid & 63, w = __builtin_amdgcn_readfirstlane(tid >> 6);
    LAS float* red = (LAS float*)lds;
    const int kw = K >> 3, GG = gdim();
    const size_t loff = (size_t)(lane & 31) * K + w * kw + (lane >> 5) * 8;
    const int row = tid >> 4, jq = tid & 15;
    int unit = blockIdx.x;
    if (unit >= nUnits) return;
#define SG_PTRS(u_) const int rb_ = (u_) & 7, cp_ = (u_) >> 3, n0_ = PAIR ? ((cp_ >> 2) * 256 + (cp_ & 3) * 32) : cp_ * 32; \
        const bf16_t* ap = A + (size_t)(rb_ * 32) * K + loff; const bf16_t* bp0 = Wt + (size_t)n0_ * K + loff; const bf16_t* bp1 = bp0 + (size_t)128 * K;
#define SG_REDUCE(u_) do { \
        _Pragma("unroll") for (int r = 0; r < 16; ++r) { const int i = (r & 3) + 8 * (r >> 2) + 4 * (lane >> 5); \
            red[(w * 32 + i) * 64 + (lane & 31)] = acc0[r]; if (PAIR) red[(w * 32 + i) * 64 + 32 + (lane & 31)] = acc1[r]; } \
        SG_BAR(); \
        const int rbq = (u_) & 7, cpq = (u_) >> 3, n0q = PAIR ? ((cpq >> 2) * 256 + (cpq & 3) * 32) : cpq * 32; \
        float x1[2] = {0.f, 0.f}, x2[2] = {0.f, 0.f}; \
        _Pragma("unroll") for (int ww = 0; ww < 8; ++ww) { const f32x2 p0 = *(const LAS f32x2*)(red + (ww * 32 + row) * 64 + 2 * jq); x1[0] += p0.x; x1[1] += p0.y; \
            if (PAIR) { const f32x2 p1 = *(const LAS f32x2*)(red + (ww * 32 + row) * 64 + 32 + 2 * jq); x2[0] += p1.x; x2[1] += p1.y; } } \
        epi(rbq * 32 + row, n0q + 2 * jq, x1, x2); \
        SG_BAR(); } while (0)
    if (K == 1024) {
        bf16x8 ra[8], rb0[8], rb1[8];
        { SG_PTRS(unit)
#pragma unroll
          for (int s = 0; s < 8; ++s) { ra[s] = *(const bf16x8*)(ap + 16 * s); rb0[s] = *(const bf16x8*)(bp0 + 16 * s); if (PAIR) rb1[s] = *(const bf16x8*)(bp1 + 16 * s); } }
#pragma unroll 1
        for (;;) {
            f32x16 acc0, acc1;
#pragma unroll
            for (int r = 0; r < 16; ++r) { acc0[r] = 0.f; acc1[r] = 0.f; }
#pragma unroll
            for (int s = 0; s < 8; ++s) { acc0 = __builtin_amdgcn_mfma_f32_32x32x16_bf16(ra[s], rb0[s], acc0, 0, 0, 0); if (PAIR) acc1 = __builtin_amdgcn_mfma_f32_32x32x16_bf16(ra[s], rb1[s], acc1, 0, 0, 0); }
            const int cur = unit; unit += GG; const bool has = unit < nUnits;
            if (has) { SG_PTRS(unit)
#pragma unroll
                for (int s = 0; s < 8; ++s) { ra[s] = *(const bf16x8*)(ap + 16 * s); rb0[s] = *(const bf16x8*)(bp0 + 16 * s); if (PAIR) rb1[s] = *(const bf16x8*)(bp1 + 16 * s); } }
            SG_REDUCE(cur);
            if (!has) break;
        }
    } else {
#pragma unroll 1
        for (; unit < nUnits; unit += GG) {
            SG_PTRS(unit)
            f32x16 acc0, acc1;
#pragma unroll
            for (int r = 0; r < 16; ++r) { acc0[r] = 0.f; acc1[r] = 0.f; }
#pragma unroll 8
            for (int ks = 0; ks < kw; ks += 16) {
                const bf16x8 a = *(const bf16x8*)(ap + ks), b0 = *(const bf16x8*)(bp0 + ks);
                acc0 = __builtin_amdgcn_mfma_f32_32x32x16_bf16(a, b0, acc0, 0, 0, 0);
                if (PAIR) { const bf16x8 b1 = *(const bf16x8*)(bp1 + ks); acc1 = __builtin_amdgcn_mfma_f32_32x32x16_bf16(a, b1, acc1, 0, 0, 0); }
            }
            SG_REDUCE(unit);
        }
    }
    asm volatile("s_waitcnt vmcnt(0) lgkmcnt(0)" ::: "memory");
    __syncthreads();
#undef SG_PTRS
#undef SG_REDUCE
}
#define SEPI_ARGS int rl, int n, const float (&x1)[2], const float (&x2)[2]
struct SEpiB1 {
    unsigned char* ws;
    __device__ __forceinline__ void operator()(int rl, int n, const float (&y1)[2], const float (&y2)[2]) const {
        const float rs_ = rstd_of(fx_get(((const fx_t*)(ws + WS_SSQA))[NPT + rl]));
        const float x1[2] = {y1[0] * rs_, y1[1] * rs_}, x2[2] = {y2[0] * rs_, y2[1] * rs_};
        if (n < 2048) {
            const f32x2* tab = (const f32x2*)(ws + WS_TAB);
            const int head = (n >> 8) & 3, d = n & 255, pos = PAST + (rl & 31);
            const f32x2 c0 = tab[(size_t)pos * 128 + d], c1 = tab[(size_t)pos * 128 + d + 1];
            float o1[2], o2[2];
            o1[0] = x1[0] * c0.x - x2[0] * c0.y; o2[0] = x2[0] * c0.x + x1[0] * c0.y;
            o1[1] = x1[1] * c1.x - x2[1] * c1.y; o2[1] = x2[1] * c1.x + x1[1] * c1.y;
            if (n < 1024) {
                bf16_t* q = (bf16_t*)(ws + WS_Q) + (size_t)(NPT + rl) * 1024 + head * 256 + d;
                *(unsigned*)q = cvt_pk_bf16(o1[0], o1[1]); *(unsigned*)(q + 128) = cvt_pk_bf16(o2[0], o2[1]);
            } else {
                bf16_t* k = (bf16_t*)(ws + WS_KS) + (size_t)rl * 1024 + head * 256 + d;
                *(unsigned*)k = cvt_pk_bf16(o1[0] * 0.0625f, o1[1] * 0.0625f); *(unsigned*)(k + 128) = cvt_pk_bf16(o2[0] * 0.0625f, o2[1] * 0.0625f);
                const float dec = 0.0625f * __expf(lgdec(head) * (float)(DSEQ - 1 - (rl & 31)));
                bf16_t* kt = (bf16_t*)(ws + WS_KTS) + (size_t)(head * 256 + d) * 256 + rl;
                const unsigned wa = cvt_pk_bf16(o1[0] * dec, o1[1] * dec), wb = cvt_pk_bf16(o2[0] * dec, o2[1] * dec);
                kt[0] = (bf16_t)(wa & 0xffffu); kt[256] = (bf16_t)(wa >> 16); kt[128 * 256] = (bf16_t)(wb & 0xffffu); kt[129 * 256] = (bf16_t)(wb >> 16);
            }
        } else {
            bf16_t* vt = (bf16_t*)(ws + WS_VTS) + (size_t)(n - 2048) * 256 + rl;
            const unsigned wa = cvt_pk_bf16(x1[0], x1[1]), wb = cvt_pk_bf16(x2[0], x2[1]);
            vt[0] = (bf16_t)(wa & 0xffffu); vt[256] = (bf16_t)(wa >> 16); vt[128 * 256] = (bf16_t)(wb & 0xffffu); vt[129 * 256] = (bf16_t)(wb >> 16);
        }
    }
};
struct SEpiB2 {
    unsigned char* ws; const float* gn_g;
    __device__ __forceinline__ void operator()(int rl, int n, const float (&y1)[2], const float (&y2)[2]) const {
        const float rs_ = rstd_of(fx_get(((const fx_t*)(ws + WS_SSQA))[NPT + rl]));
        const float x1[2] = {y1[0] * rs_, y1[1] * rs_}, x2[2] = {y2[0] * rs_, y2[1] * rs_};
        if (n < 2048) {
            bf16_t* o = (bf16_t*)(ws + WS_GLU) + (size_t)(NPT + rl) * 1024 + (n >> 8) * 128 + (n & 127);
            *(unsigned*)o = cvt_pk_bf16(x1[0] * sigm(x2[0]), x1[1] * sigm(x2[1]));
        } else if (n < 4096) {
            const int col = n - 2048, head = col >> 9;
            const fx_t* sp2 = (const fx_t*)(ws + WS_STATS) + (size_t)(NPT + rl) * 8 + head * 2; const f32x2 sq = {fx_get(sp2[0]), fx_get(sp2[1])};
            const float mu = sq.x * (1.0f / 512.0f); const float var = fmaxf(sq.y * (1.0f / 512.0f) - mu * mu, 0.f); const float rstd = __builtin_amdgcn_rsqf(var + LN_EPS);
            bf16_t* o = (bf16_t*)(ws + WS_OS) + (size_t)rl * 2048 + col;
            const unsigned oa = *(const unsigned*)o, ob = *(const unsigned*)(o + 128);
            const f32x2 ga = *(const f32x2*)(gn_g + col), gb = *(const f32x2*)(gn_g + col + 128);
            *(unsigned*)o = cvt_pk_bf16(x1[0] * sigm(x1[0]) * ((bflo(oa) - mu) * rstd * ga.x), x1[1] * sigm(x1[1]) * ((bfhi(oa) - mu) * rstd * ga.y));
            *(unsigned*)(o + 128) = cvt_pk_bf16(x2[0] * sigm(x2[0]) * ((bflo(ob) - mu) * rstd * gb.x), x2[1] * sigm(x2[1]) * ((bfhi(ob) - mu) * rstd * gb.y));
        } else {
            bf16_t* o = (bf16_t*)(ws + (n < 5120 ? WS_GC : WS_GR)) + (size_t)(NPT + rl) * 1024 + ((n - 4096) & 1023);
            *(unsigned*)o = cvt_pk_bf16(sigm(x1[0]), sigm(x1[1])); *(unsigned*)(o + 128) = cvt_pk_bf16(sigm(x2[0]), sigm(x2[1]));
        }
    }
};
template <int MODE, bool PAIR> struct SEpiEW {
    unsigned char* ws; float* x; fx_t* ssq;
    __device__ __forceinline__ void operator()(SEPI_ARGS) const {
        const size_t row = (size_t)(NPT + rl);
        if (MODE == 0) {
            const bf16_t* g = (const bf16_t*)(ws + WS_GC) + row * 1024 + n; bf16_t* t = (bf16_t*)(ws + WS_T) + row * 1024 + n;
            const unsigned ga = *(const unsigned*)g, gb = *(const unsigned*)(g + 128);
            *(unsigned*)t = cvt_pk_bf16(x1[0] * bflo(ga), x1[1] * bfhi(ga)); if (PAIR) *(unsigned*)(t + 128) = cvt_pk_bf16(x2[0] * bflo(gb), x2[1] * bfhi(gb));
        } else if (MODE == 1) {
            const bf16_t* g = (const bf16_t*)(ws + WS_GR) + row * 1024 + n; bf16_t* t = (bf16_t*)(ws + WS_T) + row * 1024 + n;
            const unsigned ga = *(const unsigned*)g, gb = *(const unsigned*)(g + 128), ta = *(const unsigned*)t, tb = *(const unsigned*)(t + 128);
            *(unsigned*)t = cvt_pk_bf16(bflo(ta) + x1[0] * bflo(ga), bfhi(ta) + x1[1] * bfhi(ga)); if (PAIR) *(unsigned*)(t + 128) = cvt_pk_bf16(bflo(tb) + x2[0] * bflo(gb), bfhi(tb) + x2[1] * bfhi(gb));
        } else if (MODE == 2) {
            bf16_t* xb = (bf16_t*)(ws + WS_H) + row * 1024 + n; const unsigned xa = *(const unsigned*)xb, xc = PAIR ? *(const unsigned*)(xb + 128) : 0u;
            f32x2 a = {bflo(xa) + x1[0], bfhi(xa) + x1[1]}, b = {bflo(xc) + x2[0], bfhi(xc) + x2[1]};
            *(unsigned*)xb = cvt_pk_bf16(a.x, a.y); if (PAIR) *(unsigned*)(xb + 128) = cvt_pk_bf16(b.x, b.y);
            float q = a.x * a.x + a.y * a.y; if (PAIR) q += b.x * b.x + b.y * b.y;
            q += shx<1>(q); q += shx<2>(q); q += shx<4>(q); q += shx<8>(q);
            if ((lane_id() & 15) == 0) fx_add(ssq + row, q);
        } else {
            bf16_t* u = (bf16_t*)(ws + WS_U) + row * 4096 + n;
            const float r3 = rstd_of(fx_get(ssq[row]));
            const float a0 = fmaxf(x1[0], 0.f) * r3, a1 = fmaxf(x1[1], 0.f) * r3, b0 = fmaxf(x2[0], 0.f) * r3, b1 = fmaxf(x2[1], 0.f) * r3;
            *(unsigned*)u = cvt_pk_bf16(a0 * a0, a1 * a1); if (PAIR) *(unsigned*)(u + 128) = cvt_pk_bf16(b0 * b0, b1 * b1);
        }
    }
};

#define XB_TMO      128
#define XB_XCNT(j)  (256  + 64 * (j))
#define XB_XSUB(j)  (1280 + 64 * (j))
#define XB_XGEN(j)  (2304 + 64 * (j))
#define XB_TOP      3328
#define XB_TOPGEN   3392
#define XCD_BAR_WORDS 3456
#define XB_SPIN_CAP (1u << 18)

__device__ __forceinline__ unsigned xb_ld(unsigned* p)              { return __hip_atomic_load(p, __ATOMIC_RELAXED, __HIP_MEMORY_SCOPE_AGENT); }
__device__ __forceinline__ unsigned xb_add(unsigned* p, unsigned v) { return __hip_atomic_fetch_add(p, v, __ATOMIC_RELAXED, __HIP_MEMORY_SCOPE_AGENT); }
__device__ __forceinline__ unsigned xb_xcc_id() { return (unsigned)__builtin_amdgcn_s_getreg((3 << 11) | 20) & 0xFu; }
#define XB_SPIN(cond, bar) do { unsigned _sp = 0; while (cond) { __builtin_amdgcn_s_sleep(1); \
    if ((++_sp & 255u) == 0u) { if (xb_ld(&(bar)[XB_TMO])) break; if (_sp > XB_SPIN_CAP) { atomicAdd(&(bar)[XB_TMO], 1u); break; } } } } while (0)

struct XcdBarrier {
    unsigned* bar; unsigned x;
    volatile LAS unsigned* st;
};

__device__ __forceinline__ XcdBarrier xcd_barrier_post(unsigned* bar, volatile LAS unsigned* st, int wv) {
    XcdBarrier b; b.bar = bar; b.x = xb_xcc_id(); b.st = st;
    if (wv == 0 && lane_id() == 0) (void)xb_add(&bar[XB_XCNT(b.x)], 1u);
    return b;
}
__device__ __forceinline__ void xcd_barrier_complete(unsigned* bar, unsigned x, unsigned& nloc, unsigned& nx) {
    const unsigned G = gridDim.x * gridDim.y * gridDim.z;
    unsigned sum, cnt, mine, sp = 0u;
    for (;;) {
        sum = 0u; cnt = 0u; mine = 0u;
#pragma unroll
        for (unsigned j = 0; j < 16; ++j) { const unsigned c = xb_ld(&bar[XB_XCNT(j)]); sum += c; cnt += (c > 0u) ? 1u : 0u; mine = (j == x) ? c : mine; }
        if (sum == G) break;
        __builtin_amdgcn_s_sleep(1);
        if ((++sp & 255u) == 0u) { if (xb_ld(&bar[XB_TMO])) break; if (sp > XB_SPIN_CAP) { atomicAdd(&bar[XB_TMO], 1u); break; } }
    }
    nloc = mine > 0u ? mine : 1u; nx = cnt > 0u ? cnt : 1u;
}

__device__ __forceinline__ void xcd_barrier(const XcdBarrier& b, int wv) {
    asm volatile("s_waitcnt vmcnt(0)" ::: "memory");
    __syncthreads();
    if (wv == 0 && lane_id() == 0) {
        unsigned* bar = b.bar;
        __builtin_amdgcn_s_waitcnt(0);
        unsigned nloc = b.st[0], nx = b.st[1];
        if (nloc == 0u) { xcd_barrier_complete(bar, b.x, nloc, nx); b.st[0] = nloc; b.st[1] = nx; }
        const unsigned old = xb_add(&bar[XB_XSUB(b.x)], 1u);
        const unsigned gen = old / nloc;
        if (old + 1u == (gen + 1u) * nloc) {
            __builtin_amdgcn_fence(__ATOMIC_RELEASE, "agent");
            asm volatile("s_waitcnt vmcnt(0)" ::: "memory");
            const unsigned og = xb_add(&bar[XB_TOP], 1u);
            const unsigned tg = og / nx;
            if (og + 1u == (tg + 1u) * nx) xb_add(&bar[XB_TOPGEN], 1u);
            else XB_SPIN(xb_ld(&bar[XB_TOPGEN]) == tg, bar);
            __builtin_amdgcn_fence(__ATOMIC_ACQUIRE, "agent");
            xb_add(&bar[XB_XGEN(b.x)], 1u);
            asm volatile("s_waitcnt vmcnt(0)" ::: "memory");
        } else {
            XB_SPIN(xb_ld(&bar[XB_XGEN(b.x)]) == gen, bar);
            __builtin_amdgcn_fence(__ATOMIC_ACQUIRE, "agent");
            asm volatile("s_waitcnt vmcnt(0)" ::: "memory");
        }
    }
    __syncthreads();
}


constexpr int LDS_BYTES = 131072 + 4096;
#define LCV ({ int c_ = (int)blockIdx.x; asm volatile("" : "+s"(c_)); c_; })
__global__ void __launch_bounds__(512, 2) fwd_megakernel(Params p) {
    extern __shared__ __attribute__((aligned(16))) unsigned char lds_raw[];
    LAS unsigned char* lds = (LAS unsigned char*)lds_raw;
    cg::grid_group grid = cg::this_grid();
    const int G = gridDim.x, c = blockIdx.x;
    unsigned char* ws = p.ws;
    int wv = __builtin_amdgcn_readfirstlane((int)(threadIdx.x >> 6)); asm volatile("" : "+s"(wv));
    volatile LAS unsigned* stw = (volatile LAS unsigned*)(lds + 131072);
    if (wv == 0) stw[lane_id()] = 0u;
    __syncthreads();
    XcdBarrier xbar = xcd_barrier_post((unsigned*)(ws + WS_BAR), stw, wv);
    if (p.ws == nullptr) grid.sync();
#define GSYNC() xcd_barrier(xbar, wv)
#pragma unroll 1
    for (int l = 0; l < 2; ++l) {
        phase0(wv, p, l, lds, 0);
        GSYNC();
        {
            SchedB1 S{G, LCV, (const char*)(ws + WS_H), (const char*)(ws + WS_WIN)}; EpiB1 E{ws};
            pg8::gemm_phase(wv, lds, pg8::Gemm{1024, 16, 1024, 1024}, S, E);
            sgemm_phase<true>(wv, lds, (const bf16_t*)(ws + WS_H) + (size_t)NPT * 1024, (const bf16_t*)(ws + WS_WIN), 1024, 8 * 64, SEpiB1{ws});
        }
        GSYNC();
        {
            { SchedAtt S{G, LCV, ws}; EpiAtt E{ws}; pg8::gemm_phase(wv, lds, pg8::Gemm{256, 4, 1024, 1024}, S, E); }
            { SchedU S{G, LCV, ws}; EpiU E{ws}; pg8::gemm_phase(wv, lds, pg8::Gemm{256, 4, SEQ, SEQ}, S, E); }
            phase_sret(wv, p, l, lds);
            GSYNC();
            phase_scan(wv, p, l);
            GSYNC();
            { SchedE S{G, LCV, ws}; EpiE E{ws}; pg8::gemm_phase(wv, lds, pg8::Gemm{512, 4, 1024, SEQ}, S, E); }
            GSYNC();
        }
        {
            SchedN S{G, LCV, 24, 0, (const char*)(ws + WS_H), (const char*)(ws + WS_WIN) + (size_t)16 * TILEB, TILEB, ws, TILEB};
            EpiB2 E{ws, p.in[11] + l * 2048};
            pg8::gemm_phase(wv, lds, pg8::Gemm{1024, 16, 1024, 1024}, S, E);
            sgemm_phase<true>(wv, lds, (const bf16_t*)(ws + WS_H) + (size_t)NPT * 1024, (const bf16_t*)(ws + WS_WIN) + (size_t)4096 * 1024, 1024, 8 * 96, SEpiB2{ws, p.in[11] + l * 2048});
        }
        GSYNC();
        phase0(wv, p, l, lds, 1);
        phase_conv(wv, p, l, lds);
        GSYNC();
        { SchedN S{G, LCV, 4, 0, (const char*)(ws + WS_YC), (const char*)(ws + WS_WC), TILEB, ws, TILEB}; EpiEW<0> E{ws, p.out, nullptr}; pg8::gemm_phase(wv, lds, pg8::Gemm{1024, 16, 1024, 1024}, S, E); }
        sgemm_phase<false>(wv, lds, (const bf16_t*)(ws + WS_YC) + (size_t)NPT * 1024, (const bf16_t*)(ws + WS_WC), 1024, 8 * 32, SEpiEW<0, false>{ws, p.out, nullptr});
        { SchedN S{G, LCV, 4, 1, nullptr, (const char*)(ws + WS_WR), 2 * TILEB, ws, 0}; EpiEW<1> E{ws, p.out, nullptr}; pg8::gemm_phase(wv, lds, pg8::Gemm{2048, 32, 2048, 2048}, S, E); }
        sgemm_phase<false>(wv, lds, (const bf16_t*)(ws + WS_OS), (const bf16_t*)(ws + WS_WR), 2048, 8 * 32, SEpiEW<1, false>{ws, p.out, nullptr});
        GSYNC();
        { SchedN S{G, LCV, 4, 0, (const char*)(ws + WS_T), (const char*)(ws + WS_WO), TILEB, ws, TILEB}; EpiEW<2> E{ws, p.out, (fx_t*)(ws + WS_SSQB)}; pg8::gemm_phase(wv, lds, pg8::Gemm{1024, 16, 1024, 1024}, S, E); }
        sgemm_phase<false>(wv, lds, (const bf16_t*)(ws + WS_T) + (size_t)NPT * 1024, (const bf16_t*)(ws + WS_WO), 1024, 8 * 32, SEpiEW<2, false>{ws, p.out, (fx_t*)(ws + WS_SSQB)});
        GSYNC();
        { SchedN S{G, LCV, 16, 0, (const char*)(ws + WS_H), (const char*)(ws + WS_WM1), TILEB, ws, TILEB}; EpiEW<3> E{ws, p.out, (fx_t*)(ws + WS_SSQB)}; pg8::gemm_phase(wv, lds, pg8::Gemm{1024, 16, 1024, 1024}, S, E); }
        sgemm_phase<true>(wv, lds, (const bf16_t*)(ws + WS_H) + (size_t)NPT * 1024, (const bf16_t*)(ws + WS_WM1), 1024, 8 * 64, SEpiEW<3, true>{ws, p.out, (fx_t*)(ws + WS_SSQB)});
        GSYNC();
        { SchedN S{G, LCV, 4, 0, (const char*)(ws + WS_U), (const char*)(ws + WS_WM2), 4 * TILEB, ws, 4 * TILEB}; EpiEW<2> E{ws, p.out, (fx_t*)(ws + WS_SSQA)}; pg8::gemm_phase(wv, lds, pg8::Gemm{4096, 64, 4096, 4096}, S, E); }
        sgemm_phase<false>(wv, lds, (const bf16_t*)(ws + WS_U) + (size_t)NPT * 4096, (const bf16_t*)(ws + WS_WM2), 4096, 8 * 32, SEpiEW<2, false>{ws, p.out, (fx_t*)(ws + WS_SSQA)});
        GSYNC();
    }
    phase_final(wv, p);
}

extern "C" void kernel_launch(void* const* d_in, const int* in_sizes, int n_in, void* d_out, int out_size, void* d_ws, size_t ws_size, hipStream_t stream) {
    static int grid = 0;
    if (grid == 0) {
        if (n_in != 18 || ws_size < WS_END) { fprintf(stderr, "kernel_launch: unexpected n_in %d / ws_size %zu (need %zu)\n", n_in, ws_size, (size_t)WS_END); grid = -1; return; }
        int dev = 0, cus = 0, per_cu = 0;
        hipGetDevice(&dev); hipDeviceGetAttribute(&cus, hipDeviceAttributeMultiprocessorCount, dev);
        hipFuncSetAttribute((const void*)fwd_megakernel, hipFuncAttributeMaxDynamicSharedMemorySize, LDS_BYTES);
        hipOccupancyMaxActiveBlocksPerMultiprocessor(&per_cu, (const void*)fwd_megakernel, 512, LDS_BYTES);
        (void)hipGetLastError();
        if (per_cu < 1) per_cu = 1;
        grid = cus;
        fprintf(stderr, "kernel_launch: cus %d per_cu %d grid %d\n", cus, per_cu, grid);
    }
    if (grid < 0) return;
    if (hipMemsetAsync((char*)d_ws + WS_BAR, 0, 16384, stream) != hipSuccess) { fprintf(stderr, "memset failed\n"); return; }
    Params p{};
    for (int i = 0; i < 18; ++i) p.in[i] = (const float*)d_in[i];
    p.out = (float*)d_out; p.ws = (unsigned char*)d_ws;
    void* args[] = {&p};
    hipError_t e = hipLaunchCooperativeKernel((const void*)fwd_megakernel, dim3(grid), dim3(512), args, LDS_BYTES, stream);
    if (e != hipSuccess) fprintf(stderr, "cooperative launch failed: %s (grid %d)\n", hipGetErrorString(e), grid);
}
```

```cpp
#include <hip/hip_runtime.h>
#include <hip/hip_cooperative_groups.h>
#include <cstdio>
#include <cstdint>
namespace cg = cooperative_groups;

#define LAS __attribute__((address_space(3)))
typedef unsigned short bf16_t;
typedef short bf16x8 __attribute__((ext_vector_type(8)));
typedef float f32x4 __attribute__((ext_vector_type(4)));
typedef float f32x2 __attribute__((ext_vector_type(2)));
typedef float f32x16 __attribute__((ext_vector_type(16)));
typedef unsigned u32x4 __attribute__((ext_vector_type(4)));
typedef unsigned u32x2 __attribute__((ext_vector_type(2)));

constexpr int DM = 1024, SEQ = 8192, NPT = 16384, NTOK = 16640, DSEQ = 32, PAST = 4096;
constexpr int DFF = 4096, RV = 2048, CH = 256;
constexpr float RMS_EPS = 1e-6f, LN_EPS = 1e-5f;
constexpr size_t MiB = 1u << 20;
constexpr size_t TILEB = 256 * 1024 * 2;
constexpr size_t WS_STATF = 313 * MiB + MiB / 2;
constexpr size_t WS_SLOTS = 314 * MiB;
constexpr size_t WS_STATS = 313 * MiB;
constexpr size_t WS_BAR = 640 * 1024;
constexpr size_t WS_SSQA = 318 * MiB, WS_SSQB = 319 * MiB;
constexpr size_t WS_TAB = 1 * MiB;
constexpr size_t WS_WIN = 9 * MiB;
constexpr size_t WS_WC = 29 * MiB, WS_WR = 31 * MiB, WS_WO = 35 * MiB, WS_WM1 = 37 * MiB, WS_WM2 = 45 * MiB;
constexpr size_t WS_H = 53 * MiB;
constexpr size_t WS_Q = WS_H + 32 * MiB + MiB / 2;
constexpr size_t WS_KB0 = 118 * MiB, WS_KTB0 = 134 * MiB, WS_KB1 = 150 * MiB, WS_KTB1 = 166 * MiB, WS_KS = 182 * MiB, WS_KTS = WS_KS + MiB / 2;
constexpr size_t WS_VTB0 = 183 * MiB, WS_VTB1 = 215 * MiB, WS_VTS = 247 * MiB;
constexpr size_t WS_ATT = 248 * MiB;
constexpr size_t WS_S = 280 * MiB;
constexpr size_t WS_OS = 312 * MiB;
constexpr size_t WS_END = 320 * MiB;
constexpr size_t WS_GLU = WS_Q, WS_T = WS_Q, WS_U = WS_Q, WS_GC = WS_VTB0, WS_GR = WS_VTB0 + 32 * MiB + MiB / 2, WS_YC = WS_ATT;
constexpr size_t WS_OB0 = WS_KB0, WS_OB1 = WS_KB1;
static_assert(WS_Q == 85 * MiB + MiB / 2 && WS_Q + 32 * MiB + MiB / 2 == WS_KB0, "map");
static_assert(WS_U + (size_t)NTOK * DFF * 2 <= WS_END, "map");
constexpr size_t OUT_CONVP = 17039360, OUT_RETP = 17162240, OUT_CONVS = 19259392, OUT_RETS = 19750912;

struct Params { const float* in[18]; float* out; unsigned char* ws; };

typedef __bf16 bf16x2_t __attribute__((ext_vector_type(2)));
__device__ __forceinline__ unsigned cvt_pk_bf16(float lo, float hi) { const f32x2 v = {lo, hi}; return __builtin_bit_cast(unsigned, __builtin_convertvector(v, bf16x2_t)); }
__device__ __forceinline__ float bflo(unsigned w) { return __uint_as_float(w << 16); }
__device__ __forceinline__ float bfhi(unsigned w) { return __uint_as_float(w & 0xffff0000u); }
__device__ __forceinline__ float bf2f(bf16_t v) { return __uint_as_float((unsigned)v << 16); }
__device__ __forceinline__ float lgdec(int h) { return h == 0 ? -0.0317486983145803f : (h == 1 ? -0.015748356968139168f : (h == 2 ? -0.007843177461025893f : -0.003913899321136329f)); }
typedef unsigned long long fx_t;
constexpr float FX_SCALE = 16777216.0f, FX_INV = 1.0f / 16777216.0f;
__device__ __forceinline__ fx_t fx_of(float v) { return (fx_t)(long long)(v * FX_SCALE); }
__device__ __forceinline__ void fx_add(fx_t* p, float v) { atomicAdd(p, fx_of(v)); }
__device__ __forceinline__ float fx_get(fx_t v) { return (float)(long long)v * FX_INV; }
__device__ __forceinline__ float rstd_of(float ssq) { return __builtin_amdgcn_rsqf(ssq * (1.0f / 1024.0f) + RMS_EPS); }
__device__ __forceinline__ float sigm(float x) { return __builtin_amdgcn_rcpf(1.0f + __expf(-x)); }
__device__ __forceinline__ u32x4 pack8(const f32x4 a, const f32x4 b) { u32x4 w; w.x = cvt_pk_bf16(a[0], a[1]); w.y = cvt_pk_bf16(a[2], a[3]); w.z = cvt_pk_bf16(b[0], b[1]); w.w = cvt_pk_bf16(b[2], b[3]); return w; }
__device__ __forceinline__ void unpack8(const u32x4 w, f32x4& a, f32x4& b) { a = (f32x4){bflo(w.x), bfhi(w.x), bflo(w.y), bfhi(w.y)}; b = (f32x4){bflo(w.z), bfhi(w.z), bflo(w.w), bfhi(w.w)}; }
__device__ __forceinline__ int lane_id() { return (int)__builtin_amdgcn_mbcnt_hi(~0u, __builtin_amdgcn_mbcnt_lo(~0u, 0u)); }
__device__ __forceinline__ int gdim() { int g = (int)gridDim.x; asm volatile("" : "+s"(g)); return g; }
template <int K> __device__ __forceinline__ float shx(float v) {
    if constexpr (K < 32) return __builtin_bit_cast(float, __builtin_amdgcn_ds_swizzle(__builtin_bit_cast(int, v), (K << 10) | 0x1f));
    else { int l = lane_id(); asm volatile("" : "+v"(l)); return __builtin_bit_cast(float, __builtin_amdgcn_ds_bpermute((l ^ 32) << 2, __builtin_bit_cast(int, v))); }
}
__device__ __forceinline__ float wave_sum(float v) { v += shx<1>(v); v += shx<2>(v); v += shx<4>(v); v += shx<8>(v); v += shx<16>(v); v += shx<32>(v); return v; }

namespace pg8 {
constexpr int BM = 256, BK = 64, HALF = 128, HTB = HALF * BK * 2, STAGE_BYTES = 8 * HTB;
__host__ __device__ __forceinline__ int lds_byte(int r, int c) { const int st = (r >> 4) * 2 + (c >> 5), rr = r & 15, cc = c & 31, ob = rr * 64 + cc * 2; return st * 1024 + (ob ^ (((ob >> 9) & 1) << 5)); }
__host__ __device__ __forceinline__ void stage_rc(int b, int& R, int& C) { const int st = b / 1024, sb = b % 1024, swz = sb ^ (((sb >> 9) & 1) << 5); R = (st >> 1) * 16 + swz / 64; C = (st & 1) * 32 + (swz % 64) / 2; }
__host__ __device__ __forceinline__ int perm32(int rho) { const int n = rho >> 4, i = rho & 15; return 8 * (i >> 2) + 4 * n + (i & 3); }

struct Unit { const char* a; const char* b; long a2d, b2d; int kind, pm, pn, aux; };
struct Gemm { int K, nt1, lda, ldb; };

__device__ __forceinline__ void xcd_remap(int& wgid, int nwg) { const int q = nwg / 8, r = nwg % 8, xcd = wgid % 8, off = wgid / 8; wgid = (xcd < r ? xcd * (q + 1) : r * (q + 1) + (xcd - r) * q) + off; }
__device__ __forceinline__ void grp_decode(int wgid, int nM, int nN, int& pm, int& pn) { const int nig = 8 * nN, gid = wgid / nig, fm = gid * 8, gsz = (nM - fm) < 8 ? (nM - fm) : 8; pm = fm + ((wgid % nig) % gsz); pn = (wgid % nig) / gsz; }

template <class Epi, class Sched>
__device__ __forceinline__ void gemm_phase(int wv, LAS unsigned char* lds, const Gemm g, const Sched& S, const Epi& E) {
    int wv_ = wv; asm volatile("" : "+s"(wv_)); int tid = wv_ * 64 + lane_id(); asm volatile("" : "+v"(tid));
    const int wid = __builtin_amdgcn_readfirstlane(tid >> 6), lane = tid & 63, wr = wid >> 2, wc = wid & 3, fr = lane & 15, fq = lane >> 4;
    const int nt = g.K / BK, nt1 = g.nt1;
    unsigned voffA[2], voffB[2];
#pragma unroll
    for (int i = 0; i < 2; ++i) { int R, C; stage_rc(tid * 16 + i * 8192, R, C); const int Rb = (R & ~31) + perm32(R & 31);
        voffA[i] = (unsigned)(R * g.lda + C) * 2u; voffB[i] = (unsigned)(Rb * g.ldb + C) * 2u; }
    const size_t kstep = (size_t)(BK * 2);
    const size_t hstepA = (size_t)HALF * g.lda * 2, hstepB = (size_t)HALF * g.ldb * 2;
    const unsigned ldsw = (unsigned)wid * 1024u;
    const int aoff = lds_byte(wr * 64 + fr, fq * 8), boff = lds_byte(wc * 32 + fr, fq * 8);
#define PG8_SA(b, h) (((b) * 2 + (h)) * HTB)
#define PG8_SB(b, h) ((4 + (b) * 2 + (h)) * HTB)
#define PG8_STAGE(bufoff, gbase, voff) do { _Pragma("unroll") for (int _i = 0; _i < 2; ++_i) \
        __builtin_amdgcn_global_load_lds((const unsigned*)((const char*)(gbase) + (voff)[_i]), (LAS unsigned*)(lds + (bufoff) + ldsw + _i * 8192), 16, 0, 0); } while (0)
#define PG8_LDA(dst, b, h) do { _Pragma("unroll") for (int m = 0; m < 4; ++m) _Pragma("unroll") for (int k = 0; k < 2; ++k) dst[m][k] = *(const LAS bf16x8*)(lds + PG8_SA(b, h) + aoff + m * 2048 + k * 1024); } while (0)
#define PG8_LDB(dst, b, h) do { _Pragma("unroll") for (int n = 0; n < 2; ++n) _Pragma("unroll") for (int k = 0; k < 2; ++k) dst[n][k] = *(const LAS bf16x8*)(lds + PG8_SB(b, h) + boff + n * 2048 + k * 1024); } while (0)
#define PG8_MMA(ai, bj, At, Bt) do { __builtin_amdgcn_s_setprio(1); _Pragma("unroll") for (int m = 0; m < 4; ++m) _Pragma("unroll") for (int n = 0; n < 2; ++n) _Pragma("unroll") for (int k = 0; k < 2; ++k) \
        acc[ai][bj][m][n] = __builtin_amdgcn_mfma_f32_16x16x32_bf16(Bt[n][k], At[m][k], acc[ai][bj][m][n], 0, 0, 0); __builtin_amdgcn_s_setprio(0); } while (0)
#define PG8_WAIT_V(n) asm volatile("s_waitcnt vmcnt(" #n ")" ::: "memory")
#define PG8_WAIT_L(n) asm volatile("s_waitcnt lgkmcnt(" #n ")" ::: "memory")
#define PG8_BAR __builtin_amdgcn_s_barrier()
#define PG8_SCHED __builtin_amdgcn_sched_barrier(0)
#define PG8_TPA(u, t) ((u).a + (size_t)(t) * kstep + (((t) >= nt1) ? (u).a2d : 0l))
#define PG8_TPB(u, t) ((u).b + (size_t)(t) * kstep + (((t) >= nt1) ? (u).b2d : 0l))
    Unit cur, nxt; int ui = 0;
    if (!S.next(0, cur)) return;
    {
        const char* cA = cur.a; const char* cB = cur.b;
        PG8_STAGE(PG8_SB(0, 0), cB, voffB); PG8_STAGE(PG8_SB(0, 1), cB + hstepB, voffB); PG8_STAGE(PG8_SA(0, 0), cA, voffA); PG8_STAGE(PG8_SA(0, 1), cA + hstepA, voffA);
        if (wr == 1) PG8_BAR;
        PG8_WAIT_V(2); PG8_BAR;
        PG8_STAGE(PG8_SB(1, 0), cB + kstep, voffB); PG8_STAGE(PG8_SA(1, 0), cA + kstep, voffA); PG8_STAGE(PG8_SB(1, 1), cB + hstepB + kstep, voffB);
        PG8_WAIT_V(6); PG8_BAR;
    }
    f32x4 acc[2][2][4][2];
#pragma unroll
    for (int a = 0; a < 2; ++a)
#pragma unroll
        for (int b = 0; b < 2; ++b)
#pragma unroll
            for (int m = 0; m < 4; ++m)
#pragma unroll
                for (int n = 0; n < 2; ++n) acc[a][b][m][n] = (f32x4){0.f, 0.f, 0.f, 0.f};
    bf16x8 At[4][2], B0[2][2], B1[2][2];
#pragma unroll 1
    for (;;) {
        const bool has_next = S.next(ui + 1, nxt);
        if (!has_next) nxt = cur;
#pragma unroll 1
        for (int t = 0; t < nt; t += 2) {
            const bool last = (t == nt - 2);
            const char* a1 = PG8_TPA(cur, t + 1);
            const char* a2 = last ? PG8_TPA(nxt, 0) : PG8_TPA(cur, t + 2); const char* b2 = last ? PG8_TPB(nxt, 0) : PG8_TPB(cur, t + 2);
            const char* a3 = a2 + kstep; const char* b3 = b2 + kstep;
            PG8_LDB(B0, 0, 0); PG8_LDB(B1, 0, 1); PG8_SCHED; PG8_LDA(At, 0, 0); PG8_STAGE(PG8_SA(1, 1), a1 + hstepA, voffA);
            PG8_WAIT_V(8); PG8_WAIT_L(0); PG8_BAR; PG8_MMA(0, 0, At, B0); PG8_MMA(0, 1, At, B1); PG8_BAR; PG8_SCHED;
            PG8_LDA(At, 0, 1); PG8_STAGE(PG8_SB(0, 0), b2, voffB); PG8_STAGE(PG8_SB(0, 1), b2 + hstepB, voffB); PG8_STAGE(PG8_SA(0, 0), a2, voffA);
            PG8_WAIT_V(8); PG8_WAIT_L(0); PG8_BAR; PG8_MMA(1, 0, At, B0); PG8_MMA(1, 1, At, B1); PG8_BAR; PG8_SCHED;
            PG8_LDB(B0, 1, 0); PG8_LDB(B1, 1, 1); PG8_SCHED; PG8_LDA(At, 1, 0); PG8_STAGE(PG8_SA(0, 1), a2 + hstepA, voffA);
            PG8_WAIT_V(8); PG8_WAIT_L(0); PG8_BAR; PG8_MMA(0, 0, At, B0); PG8_MMA(0, 1, At, B1); PG8_BAR; PG8_SCHED;
            PG8_LDA(At, 1, 1); PG8_STAGE(PG8_SB(1, 0), b3, voffB); PG8_STAGE(PG8_SB(1, 1), b3 + hstepB, voffB); PG8_STAGE(PG8_SA(1, 0), a3, voffA);
            PG8_WAIT_V(8); PG8_WAIT_L(0); PG8_BAR; PG8_MMA(1, 0, At, B0); PG8_MMA(1, 1, At, B1); PG8_BAR; PG8_SCHED;
        }
        if (wr == 0) PG8_BAR;
        { int fr2 = fr, fq2 = fq; asm volatile("" : "+v"(fr2), "+v"(fq2)); E(acc, cur, wr, wc, fr2, fq2); }
        if (!has_next) break;
#pragma unroll
        for (int a = 0; a < 2; ++a)
#pragma unroll
            for (int b = 0; b < 2; ++b)
#pragma unroll
                for (int m = 0; m < 4; ++m)
#pragma unroll
                    for (int n = 0; n < 2; ++n) acc[a][b][m][n] = (f32x4){0.f, 0.f, 0.f, 0.f};
        cur = nxt; ++ui;
        if (wr == 1) PG8_BAR;
    }
    PG8_WAIT_V(0);
    PG8_BAR;
    asm volatile("s_waitcnt vmcnt(0) lgkmcnt(0)" ::: "memory");
    __syncthreads();
#undef PG8_SA
#undef PG8_SB
#undef PG8_STAGE
#undef PG8_LDA
#undef PG8_LDB
#undef PG8_MMA
#undef PG8_WAIT_V
#undef PG8_WAIT_L
#undef PG8_BAR
#undef PG8_SCHED
#undef PG8_TPA
#undef PG8_TPB
}
}
using pg8::Unit;

__device__ __forceinline__ bf16_t* k_tile(unsigned char* ws, int pm) { return (bf16_t*)(ws + (pm < 32 ? WS_KB0 + (size_t)pm * TILEB : (pm < 64 ? WS_KB1 + (size_t)(pm - 32) * TILEB : WS_KS))); }
__device__ __forceinline__ bf16_t* o_tile(unsigned char* ws, int pm) { return (bf16_t*)(ws + (pm < 32 ? WS_OB0 + (size_t)pm * 2 * TILEB : (pm < 64 ? WS_OB1 + (size_t)(pm - 32) * 2 * TILEB : WS_OS))); }

__device__ __forceinline__ bf16_t* s_head(unsigned char* ws, int b, int h) {
    const size_t off = b == 0 ? WS_S + (size_t)h * 8 * MiB : (h == 0 ? WS_TAB : (h == 1 ? WS_WC : (h == 2 ? WS_WM1 : WS_WM2)));
    return (bf16_t*)(ws + off);
}
struct SchedB1 {
    int G, c; const char* H; const char* W;
    __device__ __forceinline__ bool next(int i, Unit& u) const {
        const long L = (long)i * G + c; if (L >= 1024) return false;
        int wgid = (int)L; pg8::xcd_remap(wgid, 1024);
        { const int x = wgid >> 7, w = wgid & 127; wgid = w < 64 ? x * 64 + w : 512 + x * 64 + (w - 64); }
        u.a2d = 0; u.b2d = 0; u.aux = 0;
        if (wgid < 512) { pg8::grp_decode(wgid, 64, 8, u.pm, u.pn); u.kind = 0; u.a = H + (size_t)u.pm * TILEB; u.b = W + (size_t)u.pn * TILEB; }
        else { pg8::grp_decode(wgid - 512, 8, 64, u.pm, u.pn); u.pm += 4; u.kind = 1; u.a = W + (size_t)(4 + u.pm) * TILEB; u.b = H + (size_t)u.pn * TILEB; }
        return true;
    }
};
struct SchedN {
    int G, c, nN, amode; const char* A; const char* B; size_t bTile; unsigned char* ws; size_t aTile;
    __device__ __forceinline__ bool next(int i, Unit& u) const {
        const int nwg = 64 * nN; const long L = (long)i * G + c; if (L >= nwg) return false;
        int wgid = (int)L; pg8::xcd_remap(wgid, nwg); pg8::grp_decode(wgid, 64, nN, u.pm, u.pn);
        u.a2d = 0; u.b2d = 0; u.aux = 0; u.kind = 0;
        u.a = amode ? (const char*)o_tile(ws, u.pm) : A + (size_t)u.pm * aTile; u.b = B + (size_t)u.pn * bTile;
        return true;
    }
};
struct SchedAtt {
    int G, c; unsigned char* ws;
    __device__ __forceinline__ bool next(int i, Unit& u) const {
        const int L = i * G + c; if (L >= 256) return false;
        const int h = L & 3, j = (L >> 2) & 31, b = L >> 7;
        u.a2d = 0; u.b2d = 0; u.kind = 0; u.pm = j; u.pn = b; u.aux = h;
        u.a = (const char*)(ws + WS_Q) + ((size_t)(b * SEQ + j * CH) * 1024 + h * 256) * 2;
        u.b = (const char*)(ws + (b ? WS_KB1 : WS_KB0)) + ((size_t)(j * CH) * 1024 + h * 256) * 2;
        return true;
    }
};
struct SchedU {
    int G, c; unsigned char* ws;
    __device__ __forceinline__ bool next(int i, Unit& u) const {
        const int L = i * G + c; if (L >= 512) return false;
        const int pmt = L & 1, h = (L >> 1) & 3, j = (L >> 3) & 31, b = L >> 8;
        u.a2d = 0; u.b2d = 0; u.kind = b; u.pm = j; u.pn = 0; u.aux = h * 2 + pmt;
        u.a = (const char*)(ws + (b ? WS_VTB1 : WS_VTB0)) + ((size_t)(h * 512 + pmt * 256) * SEQ + j * CH) * 2;
        u.b = (const char*)(ws + (b ? WS_KTB1 : WS_KTB0)) + ((size_t)(h * 256) * SEQ + j * CH) * 2;
        return true;
    }
};
struct SchedE {
    int G, c; unsigned char* ws;
    __device__ __forceinline__ bool next(int i, Unit& u) const {
        const int L = i * G + c; if (L >= 512) return false;
        const int idx = L & 255, pnt = L >> 8, h = idx & 3, j = (idx >> 2) & 31, b = idx >> 7;
        u.kind = b; u.pm = j; u.pn = pnt; u.aux = h;
        const char* a1 = (const char*)(ws + WS_ATT) + ((size_t)(b * SEQ + j * CH) * 1024 + h * 256) * 2;
        const char* a2 = (const char*)(ws + WS_Q) + ((size_t)(b * SEQ + j * CH) * 1024 + h * 256) * 2;
        const char* b1 = (const char*)(ws + (b ? WS_VTB1 : WS_VTB0)) + ((size_t)(h * 512 + pnt * 256) * SEQ + j * CH) * 2;
        const char* b2 = (const char*)(s_head(ws, b, h) + (size_t)(pnt * 256) * SEQ + j * CH);
        u.a = a1; u.b = b1; u.a2d = (long)(a2 - a1) - 4 * 128; u.b2d = (long)(b2 - b1) - 4 * 128;
        return true;
    }
};

#define EPI_FENCE asm volatile("" ::: "memory")
#define EPI_ARGS const f32x4 (&acc)[2][2][4][2], const Unit& u, int wr, int wc, int fr, int fq
struct EpiB1 {
    unsigned char* ws;
    __device__ __forceinline__ void operator()(EPI_ARGS) const {
        const f32x2* tab = (const f32x2*)(ws + WS_TAB); const fx_t* ssq = (const fx_t*)(ws + WS_SSQA);
        if (u.kind == 0) {
            const int head = u.pn & 3; const bool isk = u.pn >= 4;
            bf16_t* dst = isk ? k_tile(ws, u.pm) : (bf16_t*)(ws + WS_Q) + (size_t)u.pm * 256 * 1024;
            const float sc = isk ? 0.0625f : 1.0f;
            const __amdgpu_buffer_rsrc_t ktr = __builtin_amdgcn_make_buffer_rsrc((void*)(ws + (u.pm < 32 ? WS_KTB0 : WS_KTB1)), (short)0, (int)(16 * MiB), 0x00020000);
            const int d0 = wc * 32 + fq * 8;
#pragma unroll
            for (int aih = 0; aih < 2; ++aih) {
                const int ai = aih, mb = 0;
                f32x4 tb[4][4]; float rsq[4];
#pragma unroll
                for (int m = mb; m < mb + 4; ++m) {
                    const int row = ai * 128 + wr * 64 + m * 16 + fr;
                    const int pos = u.pm < 64 ? ((u.pm & 31) * 256 + row) : (PAST + (row & 31));
                    const f32x4* tp = (const f32x4*)(tab + (size_t)pos * 128 + d0);
                    tb[m][0] = tp[0]; tb[m][1] = tp[1]; tb[m][2] = tp[2]; tb[m][3] = tp[3];
                    rsq[m] = fx_get(ssq[(size_t)u.pm * 256 + row]);
                }
                EPI_FENCE;
#pragma unroll
                for (int m = mb; m < mb + 4; ++m) {
                    const int row = ai * 128 + wr * 64 + m * 16 + fr;
                    const f32x4 c01 = tb[m][0], c23 = tb[m][1], c45 = tb[m][2], c67 = tb[m][3];
                    const f32x4 cs0 = (f32x4){c01[0], c01[2], c23[0], c23[2]}, sn0 = (f32x4){c01[1], c01[3], c23[1], c23[3]};
                    const f32x4 cs1 = (f32x4){c45[0], c45[2], c67[0], c67[2]}, sn1 = (f32x4){c45[1], c45[3], c67[1], c67[3]};
                    const f32x4 x1a = acc[ai][0][m][0], x1b = acc[ai][0][m][1], x2a = acc[ai][1][m][0], x2b = acc[ai][1][m][1];
                    const float scr_ = sc * rstd_of(rsq[m]);
                    const f32x4 o1a = (x1a * cs0 - x2a * sn0) * scr_, o1b = (x1b * cs1 - x2b * sn1) * scr_;
                    const f32x4 o2a = (x2a * cs0 + x1a * sn0) * scr_, o2b = (x2b * cs1 + x1b * sn1) * scr_;
                    bf16_t* rp = dst + (size_t)row * 1024 + head * 256 + d0;
                    *(u32x4*)rp = pack8(o1a, o1b); *(u32x4*)(rp + 128) = pack8(o2a, o2b);
                    if (isk) {
                        const float dk = __expf(lgdec(head) * (float)(CH - 1 - (row & (CH - 1))));
                        const unsigned voff = (unsigned)((d0 * SEQ + row) * 2);
                        const unsigned sbase = (unsigned)(((head * 256) * SEQ + (u.pm & 31) * 256) * 2);
                        const u32x4 t1 = pack8(o1a * dk, o1b * dk);
#pragma unroll
                        for (int jj = 0; jj < 4; ++jj) {
                            __builtin_amdgcn_raw_buffer_store_b16((short)(t1[jj] & 0xffffu), ktr, voff, sbase + (unsigned)(2 * jj) * SEQ * 2u, 0);
                            __builtin_amdgcn_raw_buffer_store_b16((short)(t1[jj] >> 16), ktr, voff, sbase + (unsigned)(2 * jj + 1) * SEQ * 2u, 0); }
                        const u32x4 t2 = pack8(o2a * dk, o2b * dk);
#pragma unroll
                        for (int jj = 0; jj < 4; ++jj) {
                            __builtin_amdgcn_raw_buffer_store_b16((short)(t2[jj] & 0xffffu), ktr, voff, sbase + (unsigned)(128 + 2 * jj) * SEQ * 2u, 0);
                            __builtin_amdgcn_raw_buffer_store_b16((short)(t2[jj] >> 16), ktr, voff, sbase + (unsigned)(129 + 2 * jj) * SEQ * 2u, 0); }
                    }
                }
                EPI_FENCE;
            }
        } else {
            bf16_t* dst; int ld;
            if (u.pn < 32) { dst = (bf16_t*)(ws + WS_VTB0) + (size_t)u.pn * 256; ld = SEQ; }
            else if (u.pn < 64) { dst = (bf16_t*)(ws + WS_VTB1) + (size_t)(u.pn - 32) * 256; ld = SEQ; }
            else { dst = (bf16_t*)(ws + WS_VTS); ld = 256; }
            f32x4 rsv[2][2];
#pragma unroll
            for (int bj = 0; bj < 2; ++bj) { const fx_t* sp8 = ssq + (size_t)u.pn * 256 + bj * 128 + wc * 32 + fq * 8;
#pragma unroll
                for (int n = 0; n < 2; ++n) rsv[bj][n] = (f32x4){rstd_of(fx_get(sp8[4 * n])), rstd_of(fx_get(sp8[4 * n + 1])), rstd_of(fx_get(sp8[4 * n + 2])), rstd_of(fx_get(sp8[4 * n + 3]))}; }
#pragma unroll
            for (int ai = 0; ai < 2; ++ai)
#pragma unroll
                for (int m = 0; m < 4; ++m) {
                    const int e = (u.pm - 4) * 256 + ai * 128 + wr * 64 + m * 16 + fr;
                    bf16_t* rp = dst + (size_t)e * ld + wc * 32 + fq * 8;
#pragma unroll
                    for (int bj = 0; bj < 2; ++bj) *(u32x4*)(rp + bj * 128) = pack8(acc[ai][bj][m][0] * rsv[bj][0], acc[ai][bj][m][1] * rsv[bj][1]);
                    EPI_FENCE;
                }
        }
    }
};
struct EpiAtt {
    unsigned char* ws;
    __device__ __forceinline__ void operator()(EPI_ARGS) const {
        const int h = u.aux; const float lg = lgdec(h);
        bf16_t* dst = (bf16_t*)(ws + WS_ATT) + (size_t)(u.pn * SEQ + u.pm * CH) * 1024 + h * 256;
        float cf[2][8];
#pragma unroll
        for (int bj = 0; bj < 2; ++bj)
#pragma unroll
            for (int j = 0; j < 8; ++j) cf[bj][j] = __expf(-lg * (float)(bj * 128 + wc * 32 + fq * 8 + j + 1));
#pragma unroll
        for (int ai = 0; ai < 2; ++ai)
#pragma unroll
            for (int m = 0; m < 4; ++m) {
                const int n = ai * 128 + wr * 64 + m * 16 + fr;
#pragma unroll
                for (int bj = 0; bj < 2; ++bj) {
                    const int m0 = bj * 128 + wc * 32 + fq * 8;
                    float o[8];
#pragma unroll
                    for (int j = 0; j < 8; ++j) o[j] = __uint_as_float(__float_as_uint(acc[ai][bj][m][j >> 2][j & 3] * cf[bj][j]) & ~(unsigned)((n - m0 - j) >> 31));
                    *(u32x4*)(dst + (size_t)n * 1024 + m0) = pack8((f32x4){o[0], o[1], o[2], o[3]}, (f32x4){o[4], o[5], o[6], o[7]});
                }
                EPI_FENCE;
            }
    }
};
struct EpiU {
    unsigned char* ws;
    __device__ __forceinline__ void operator()(EPI_ARGS) const {
        bf16_t* dst = s_head(ws, u.kind, u.aux >> 1) + (size_t)((u.aux & 1) * 256) * SEQ + u.pm * CH;
#pragma unroll
        for (int ai = 0; ai < 2; ++ai)
#pragma unroll
            for (int m = 0; m < 4; ++m) {
                bf16_t* rp = dst + (size_t)(ai * 128 + wr * 64 + m * 16 + fr) * SEQ + wc * 32 + fq * 8;
#pragma unroll
                for (int bj = 0; bj < 2; ++bj) *(u32x4*)(rp + bj * 128) = pack8(acc[ai][bj][m][0], acc[ai][bj][m][1]);
                    EPI_FENCE;
            }
    }
};
struct EpiE {
    unsigned char* ws;
    __device__ __forceinline__ void operator()(EPI_ARGS) const {
        const int h = u.aux, b = u.kind; const float lg = lgdec(h);
        bf16_t* dst = (bf16_t*)(ws + (b ? WS_OB1 : WS_OB0)) + (size_t)(u.pm * CH) * 2048 + h * 512 + u.pn * 256;
        float* sl = (float*)(ws + WS_SLOTS) + (size_t)blockIdx.x * 4096 + (u.pn * 4 + wc) * 2;
#pragma unroll
        for (int ai = 0; ai < 2; ++ai)
#pragma unroll
            for (int m = 0; m < 4; ++m) {
                const int n = ai * 128 + wr * 64 + m * 16 + fr; const float rs = __expf(lg * (float)(n + 1));
                float s = 0.f, q = 0.f;
#pragma unroll
                for (int bj = 0; bj < 2; ++bj) {
                    const f32x4 v0 = acc[ai][bj][m][0] * rs, v1 = acc[ai][bj][m][1] * rs;
                    s += (v0[0] + v0[1]) + (v0[2] + v0[3]) + (v1[0] + v1[1]) + (v1[2] + v1[3]);
                    q += (v0[0] * v0[0] + v0[1] * v0[1]) + (v0[2] * v0[2] + v0[3] * v0[3]) + (v1[0] * v1[0] + v1[1] * v1[1]) + (v1[2] * v1[2] + v1[3] * v1[3]);
                    *(u32x4*)(dst + (size_t)n * 2048 + bj * 128 + wc * 32 + fq * 8) = pack8(v0, v1);
                }
                s += shx<16>(s); s += shx<32>(s); q += shx<16>(q); q += shx<32>(q);
                if (fq == 0) *(f32x2*)(sl + (size_t)n * 16) = (f32x2){s, q};
                EPI_FENCE;
            }
    }
};
struct EpiB2 {
    unsigned char* ws; const float* gn_g;
    __device__ __forceinline__ void operator()(EPI_ARGS) const {
        const fx_t* ssq = (const fx_t*)(ws + WS_SSQA) + (size_t)u.pm * 256;
        float rsr[2][4];
#pragma unroll
        for (int ai = 0; ai < 2; ++ai)
#pragma unroll
            for (int m = 0; m < 4; ++m) rsr[ai][m] = fx_get(ssq[ai * 128 + wr * 64 + m * 16 + fr]);
#pragma unroll
        for (int ai = 0; ai < 2; ++ai)
#pragma unroll
            for (int m = 0; m < 4; ++m) rsr[ai][m] = rstd_of(rsr[ai][m]);
        if (u.pn < 8) {
            bf16_t* dst = (bf16_t*)(ws + WS_GLU) + (size_t)u.pm * 256 * 1024 + u.pn * 128 + wc * 32 + fq * 8;
#pragma unroll
            for (int ai = 0; ai < 2; ++ai)
#pragma unroll
                for (int m = 0; m < 4; ++m) {
                    const int row = ai * 128 + wr * 64 + m * 16 + fr;
                    const float rs = rsr[ai][m];
                    f32x4 a0 = acc[ai][0][m][0] * rs, a1 = acc[ai][0][m][1] * rs; const f32x4 b0 = acc[ai][1][m][0] * rs, b1 = acc[ai][1][m][1] * rs;
#pragma unroll
                    for (int j = 0; j < 4; ++j) { a0[j] *= sigm(b0[j]); a1[j] *= sigm(b1[j]); }
                    *(u32x4*)(dst + (size_t)row * 1024) = pack8(a0, a1);
                    EPI_FENCE;
                }
        } else if (u.pn < 16) {
            const int t = u.pn - 8, head = t >> 1;
            bf16_t* ob = o_tile(ws, u.pm) + t * 256 + wc * 32 + fq * 8;
            const float* st = (const float*)(ws + WS_STATF) + (size_t)u.pm * 256 * 8 + head * 2;
            f32x4 gg[2][2];
#pragma unroll
            for (int bj = 0; bj < 2; ++bj) { const f32x4* gp = (const f32x4*)(gn_g + t * 256 + bj * 128 + wc * 32 + fq * 8); gg[bj][0] = gp[0]; gg[bj][1] = gp[1]; }
#pragma unroll
            for (int aih = 0; aih < 4; ++aih) {
                const int ai = aih >> 1, mb = (aih & 1) * 2;
                f32x2 sqv[4]; u32x4 ov[4][2];
#pragma unroll
                for (int m = mb; m < mb + 2; ++m) {
                    const int row = ai * 128 + wr * 64 + m * 16 + fr;
                    sqv[m] = *(const f32x2*)(st + (size_t)row * 8);
#pragma unroll
                    for (int bj = 0; bj < 2; ++bj) ov[m][bj] = *(const u32x4*)(ob + (size_t)row * 2048 + bj * 128);
                }
                EPI_FENCE;
#pragma unroll
                for (int m = mb; m < mb + 2; ++m) {
                    const int row = ai * 128 + wr * 64 + m * 16 + fr;
                    const f32x2 sq = sqv[m]; const float rsn = rsr[ai][m];
                    const float mu = sq.x * (1.0f / 512.0f); const float var = fmaxf(sq.y * (1.0f / 512.0f) - mu * mu, 0.f); const float rstd = __builtin_amdgcn_rsqf(var + LN_EPS);
#pragma unroll
                    for (int bj = 0; bj < 2; ++bj) {
                        bf16_t* rp = ob + (size_t)row * 2048 + bj * 128;
                        f32x4 o0, o1; unpack8(ov[m][bj], o0, o1);
                        f32x4 g0 = acc[ai][bj][m][0] * rsn, g1 = acc[ai][bj][m][1] * rsn;
#pragma unroll
                        for (int j = 0; j < 4; ++j) { g0[j] = g0[j] * sigm(g0[j]) * ((o0[j] - mu) * rstd * gg[bj][0][j]); g1[j] = g1[j] * sigm(g1[j]) * ((o1[j] - mu) * rstd * gg[bj][1][j]); }
                        *(u32x4*)rp = pack8(g0, g1);
                    }
                }
                EPI_FENCE;
            }
        } else {
            const int t = (u.pn - 16) & 3;
            bf16_t* dst = (bf16_t*)(ws + (u.pn < 20 ? WS_GC : WS_GR)) + (size_t)u.pm * 256 * 1024 + t * 256 + wc * 32 + fq * 8;
#pragma unroll
            for (int ai = 0; ai < 2; ++ai)
#pragma unroll
                for (int m = 0; m < 4; ++m) {
                    const int row = ai * 128 + wr * 64 + m * 16 + fr; const float rs = rsr[ai][m];
#pragma unroll
                    for (int bj = 0; bj < 2; ++bj) {
                        f32x4 a0 = acc[ai][bj][m][0] * rs, a1 = acc[ai][bj][m][1] * rs;
#pragma unroll
                        for (int j = 0; j < 4; ++j) { a0[j] = sigm(a0[j]); a1[j] = sigm(a1[j]); }
                        *(u32x4*)(dst + (size_t)row * 1024 + bj * 128) = pack8(a0, a1);
                    }
                    EPI_FENCE;
                }
        }
    }
};
template <int MODE> struct EpiEW {
    unsigned char* ws; float* x; fx_t* ssq;
    __device__ __forceinline__ void operator()(EPI_ARGS) const {
        const int c0 = u.pn * 256 + wc * 32 + fq * 8;
#pragma unroll
        for (int ai = 0; ai < 2; ++ai) {
            u32x4 gv[4][2], tv[4][2]; float sqs[4] = {0.f, 0.f, 0.f, 0.f}, rs3[4];
            if (MODE == 3) {
#pragma unroll
                for (int m = 0; m < 4; ++m) rs3[m] = rstd_of(fx_get(ssq[(size_t)u.pm * 256 + ai * 128 + wr * 64 + m * 16 + fr]));
            }
            if (MODE != 3) {
#pragma unroll
                for (int m = 0; m < 4; ++m) {
                    const size_t row = (size_t)u.pm * 256 + ai * 128 + wr * 64 + m * 16 + fr;
#pragma unroll
                    for (int bj = 0; bj < 2; ++bj) {
                        if (MODE == 0) gv[m][bj] = *(const u32x4*)((const bf16_t*)(ws + WS_GC) + row * 1024 + c0 + bj * 128);
                        if (MODE == 1) { gv[m][bj] = *(const u32x4*)((const bf16_t*)(ws + WS_GR) + row * 1024 + c0 + bj * 128); tv[m][bj] = *(const u32x4*)((const bf16_t*)(ws + WS_T) + row * 1024 + c0 + bj * 128); }
                        if (MODE == 2) tv[m][bj] = *(const u32x4*)((const bf16_t*)(ws + WS_H) + row * 1024 + c0 + bj * 128);
                    }
                }
                EPI_FENCE;
            }
#pragma unroll
            for (int m = 0; m < 4; ++m) {
                const size_t row = (size_t)u.pm * 256 + ai * 128 + wr * 64 + m * 16 + fr;
#pragma unroll
                for (int bj = 0; bj < 2; ++bj) {
                    f32x4 a0 = acc[ai][bj][m][0], a1 = acc[ai][bj][m][1];
                    if (MODE == 0) {
                        f32x4 g0, g1; unpack8(gv[m][bj], g0, g1);
                        *(u32x4*)((bf16_t*)(ws + WS_T) + row * 1024 + c0 + bj * 128) = pack8(a0 * g0, a1 * g1);
                    } else if (MODE == 1) {
                        f32x4 g0, g1, t0, t1; unpack8(gv[m][bj], g0, g1); unpack8(tv[m][bj], t0, t1);
                        *(u32x4*)((bf16_t*)(ws + WS_T) + row * 1024 + c0 + bj * 128) = pack8(t0 + a0 * g0, t1 + a1 * g1);
                    } else if (MODE == 2) {
                        f32x4 x0, x1; unpack8(tv[m][bj], x0, x1);
                        a0 = x0 + a0; a1 = x1 + a1;
                        *(u32x4*)((bf16_t*)(ws + WS_H) + row * 1024 + c0 + bj * 128) = pack8(a0, a1);
                        sqs[m] += (a0[0] * a0[0] + a0[1] * a0[1]) + (a0[2] * a0[2] + a0[3] * a0[3]) + (a1[0] * a1[0] + a1[1] * a1[1]) + (a1[2] * a1[2] + a1[3] * a1[3]);
                    } else {
#pragma unroll
                        for (int j = 0; j < 4; ++j) { const float r0 = fmaxf(a0[j], 0.f) * rs3[m], r1 = fmaxf(a1[j], 0.f) * rs3[m]; a0[j] = r0 * r0; a1[j] = r1 * r1; }
                        *(u32x4*)((bf16_t*)(ws + WS_U) + row * 4096 + c0 + bj * 128) = pack8(a0, a1);
                    }
                }
                if (MODE == 2) { float q = sqs[m]; q += shx<16>(q); q += shx<32>(q); if (fq == 0) fx_add(ssq + row, q); }
            }
            EPI_FENCE;
        }
    }
};

__device__ __forceinline__ void transpose_item(const float* W, int K, int N, bf16_t* WT, int k0, int n0, int drow0, LAS float* scr, int lane, const float* gk = nullptr) {
    float tv[32];
#pragma unroll
    for (int i = 0; i < 32; ++i) { const int kk = 2 * i + (lane >> 5); tv[i] = W[(size_t)(k0 + kk) * N + n0 + (lane & 31)]; }
#pragma unroll
    for (int i = 0; i < 32; ++i) { const int kk = 2 * i + (lane >> 5); scr[kk * 33 + (lane & 31)] = gk ? tv[i] * gk[k0 + kk] : tv[i]; }
    asm volatile("s_waitcnt lgkmcnt(0)" ::: "memory");
    const int c = lane & 7;
#pragma unroll
    for (int j = 0; j < 4; ++j) { const int n = (lane >> 3) + 8 * j; const LAS float* s = scr + (8 * c) * 33 + n;
        u32x4 o; o.x = cvt_pk_bf16(s[0 * 33], s[1 * 33]); o.y = cvt_pk_bf16(s[2 * 33], s[3 * 33]); o.z = cvt_pk_bf16(s[4 * 33], s[5 * 33]); o.w = cvt_pk_bf16(s[6 * 33], s[7 * 33]);
        *(u32x4*)(WT + (size_t)(drow0 + n) * K + k0 + 8 * c) = o; }
    asm volatile("s_waitcnt lgkmcnt(0)" ::: "memory");
}
struct TItem { const float* W; const float* gk; bf16_t* WT; int K, N, k0, n0, drow0; };
__device__ __forceinline__ void titem_load(const TItem& t, int lane, float (&tv)[32], f32x4& g0, f32x4& g1) {
#pragma unroll
    for (int i = 0; i < 32; ++i) { const int kk = 2 * i + (lane >> 5); tv[i] = t.W[(size_t)(t.k0 + kk) * t.N + t.n0 + (lane & 31)]; }
    g0 = (f32x4){1.f, 1.f, 1.f, 1.f}; g1 = g0;
    if (t.gk) { const f32x4* gp = (const f32x4*)(t.gk + t.k0 + 8 * (lane & 7)); g0 = gp[0]; g1 = gp[1]; }
}
__device__ __forceinline__ void titem_store(const TItem& t, int lane, const float (&tv)[32], const f32x4 g0, const f32x4 g1, LAS float* scr) {
#pragma unroll
    for (int i = 0; i < 32; ++i) { const int kk = 2 * i + (lane >> 5); scr[kk * 33 + (lane & 31)] = tv[i]; }
    asm volatile("s_waitcnt lgkmcnt(0)" ::: "memory");
    const int c = lane & 7;
#pragma unroll
    for (int j = 0; j < 4; ++j) { const int n = (lane >> 3) + 8 * j; const LAS float* sp = scr + (8 * c) * 33 + n;
        u32x4 o; o.x = cvt_pk_bf16(sp[0 * 33] * g0[0], sp[1 * 33] * g0[1]); o.y = cvt_pk_bf16(sp[2 * 33] * g0[2], sp[3 * 33] * g0[3]);
        o.z = cvt_pk_bf16(sp[4 * 33] * g1[0], sp[5 * 33] * g1[1]); o.w = cvt_pk_bf16(sp[6 * 33] * g1[2], sp[7 * 33] * g1[3]);
        *(u32x4*)(t.WT + (size_t)(t.drow0 + n) * t.K + t.k0 + 8 * c) = o; }
    asm volatile("s_waitcnt lgkmcnt(0)" ::: "memory");
}
__device__ __forceinline__ int win_drow(int n0) {
    if (n0 < 2048) { const int bj = n0 >> 10, jj = n0 & 1023; return 4096 + 256 * (jj >> 7) + 128 * bj + (jj & 127); }
    if (n0 < 6144) return n0 - 2048;
    return n0;
}
__device__ __forceinline__ void rms_row(const float* xrow, const float* g, bf16_t* orow, float* copy, int lane) {
    const f32x4* xr = (const f32x4*)xrow + lane; const f32x4* gr = (const f32x4*)g + lane;
    f32x4 v[4]; float s = 0.f;
#pragma unroll
    for (int j = 0; j < 4; ++j) { v[j] = xr[64 * j]; s += (v[j][0] * v[j][0] + v[j][1] * v[j][1]) + (v[j][2] * v[j][2] + v[j][3] * v[j][3]); }
    const float r = 1.0f / sqrtf(wave_sum(s) * (1.0f / 1024.0f) + RMS_EPS);
    u32x2* o8 = (u32x2*)orow + lane;
#pragma unroll
    for (int j = 0; j < 4; ++j) { const f32x4 gg = gr[64 * j]; if (copy) ((f32x4*)copy + lane)[64 * j] = v[j];
        u32x2 w; w.x = cvt_pk_bf16(v[j][0] * r * gg[0], v[j][1] * r * gg[1]); w.y = cvt_pk_bf16(v[j][2] * r * gg[2], v[j][3] * r * gg[3]); o8[64 * j] = w; }
}

__device__ __forceinline__ void phase0(int wv, const Params& p, int l, LAS unsigned char* lds, int part) {
    int wv_ = wv; asm volatile("" : "+s"(wv_)); int tid = wv_ * 64 + lane_id(); asm volatile("" : "+v"(tid));
    const int lane = tid & 63, wave = tid >> 6, G = gdim();
    const int gw = blockIdx.x * 8 + wave, NGW = G * 8;
    unsigned char* ws = p.ws;
    LAS float* scr = (LAS float*)(lds + wave * 16384);
    const float* w_in = p.in[5] + (size_t)l * 1024 * 10240; const float* w_c = p.in[10] + (size_t)l * 1024 * 1024; const float* w_r = p.in[12] + (size_t)l * 2048 * 1024;
    const float* w_o = p.in[13] + (size_t)l * 1024 * 1024; const float* w_1 = p.in[15] + (size_t)l * 1024 * 4096; const float* w_2 = p.in[16] + (size_t)l * 4096 * 1024;
    constexpr int I_IN = 16 * 320, I_C = 16 * 32, I_R = 32 * 32, I_O = 16 * 32, I_1 = 16 * 128, I_2 = 64 * 32, NIT = I_IN + I_C + I_R + I_O + I_1 + I_2;
#define TI_DECODE(it_, T_) do { int r = (it_); \
        if (r < I_IN) { const int kb = r / 320, nb = r % 320; T_ = TItem{w_in, p.in[4] + l * 1024, (bf16_t*)(ws + WS_WIN), 1024, 10240, kb * 64, nb * 32, win_drow(nb * 32)}; break; } r -= I_IN; \
        if (r < I_C) { const int kb = r / 32, nb = r % 32; T_ = TItem{w_c, nullptr, (bf16_t*)(ws + WS_WC), 1024, 1024, kb * 64, nb * 32, nb * 32}; break; } r -= I_C; \
        if (r < I_R) { const int kb = r / 32, nb = r % 32; T_ = TItem{w_r, nullptr, (bf16_t*)(ws + WS_WR), 2048, 1024, kb * 64, nb * 32, nb * 32}; break; } r -= I_R; \
        if (r < I_O) { const int kb = r / 32, nb = r % 32; T_ = TItem{w_o, nullptr, (bf16_t*)(ws + WS_WO), 1024, 1024, kb * 64, nb * 32, nb * 32}; break; } r -= I_O; \
        if (r < I_1) { const int kb = r / 128, nb = r % 128; T_ = TItem{w_1, p.in[14] + l * 1024, (bf16_t*)(ws + WS_WM1), 1024, 4096, kb * 64, nb * 32, nb * 32}; break; } r -= I_1; \
        { const int kb = r / 32, nb = r % 32; T_ = TItem{w_2, nullptr, (bf16_t*)(ws + WS_WM2), 4096, 1024, kb * 64, nb * 32, nb * 32}; } } while (0)
    const int it_first = part == 0 ? 0 : I_IN, it_last = part == 0 ? I_IN : NIT;
    if (it_first + gw < it_last) {
        int it = it_first + gw; TItem cur; TI_DECODE(it, cur);
        float tv[32]; f32x4 g0, g1; titem_load(cur, lane, tv, g0, g1);
#pragma unroll 1
        for (;;) {
            const int nit = it + NGW; const bool has = nit < it_last;
            TItem nx = cur; float tn[32]; f32x4 h0 = g0, h1 = g1;
            if (has) { TI_DECODE(nit, nx); titem_load(nx, lane, tn, h0, h1); }
            titem_store(cur, lane, tv, g0, g1, scr);
            if (!has) break;
            cur = nx; it = nit; g0 = h0; g1 = h1;
#pragma unroll
            for (int i = 0; i < 32; ++i) tv[i] = tn[i];
        }
    }
#undef TI_DECODE
    if (part != 0) { asm volatile("s_waitcnt vmcnt(0) lgkmcnt(0)" ::: "memory"); __syncthreads(); return; }
    if (l == 0) {
        for (int m = gw; m < NTOK; m += NGW) {
            const float* src = m < NPT ? p.in[0] + (size_t)m * 1024 : p.in[1] + (size_t)(m - NPT) * 1024;
            const f32x4* xr = (const f32x4*)src + lane; f32x4 v[4]; float sq = 0.f;
#pragma unroll
            for (int j = 0; j < 4; ++j) { v[j] = xr[64 * j]; sq += (v[j][0] * v[j][0] + v[j][1] * v[j][1]) + (v[j][2] * v[j][2] + v[j][3] * v[j][3]); }
            sq = wave_sum(sq);
            u32x2* o8 = (u32x2*)((bf16_t*)(ws + WS_H) + (size_t)m * 1024) + lane;
#pragma unroll
            for (int j = 0; j < 4; ++j) { u32x2 wv; wv.x = cvt_pk_bf16(v[j][0], v[j][1]); wv.y = cvt_pk_bf16(v[j][2], v[j][3]); o8[64 * j] = wv; }
            if (lane == 0) ((fx_t*)(ws + WS_SSQA))[m] = fx_of(sq);
        }
    }
    { unsigned z = 0u; asm volatile("" : "+v"(z)); unsigned* sb = (unsigned*)(ws + WS_SSQB); for (int i = blockIdx.x * 512 + tid; i < NTOK * 2; i += G * 512) sb[i] = z; }
    { unsigned z = 0u; asm volatile("" : "+v"(z)); unsigned* st = (unsigned*)(ws + WS_STATS); for (int i = blockIdx.x * 512 + tid; i < 256 * 16; i += G * 512) st[i] = z; }
    {
        f32x2* tab = (f32x2*)(ws + WS_TAB);
        for (int i = blockIdx.x * 512 + tid; i < 8192 * 128; i += G * 512) {
            const int pos = i >> 7, k = i & 127;
            const float inv = powf(10000.0f, -(float)(2 * k) / 256.0f); const float ang = (float)pos * inv;
            float sn, cs; sincosf(ang, &sn, &cs); tab[i] = (f32x2){cs, sn};
        }
    }
}

__device__ __forceinline__ void phase_scan(int wv, const Params& p, int l) {
    int wv_ = wv; asm volatile("" : "+s"(wv_)); int tid = wv_ * 64 + lane_id(); asm volatile("" : "+v"(tid));
    const int gt = blockIdx.x * 512 + tid;
    if (gt >= 2048 * 64) return;
    const int row = gt >> 6, d4 = (gt & 63) * 4, h = row >> 9, e = row & 511;
    const float sd = __expf(lgdec(h) * (float)CH);
#pragma unroll 1
    for (int b = 0; b < 2; ++b) {
        bf16_t* sp = s_head(p.ws, b, h) + (size_t)e * SEQ + d4;
        float a[4] = {0.f, 0.f, 0.f, 0.f};
#pragma unroll 1
        for (int j0 = 0; j0 < 32; j0 += 16) {
            u32x2 w[16];
#pragma unroll
            for (int j = 0; j < 16; ++j) w[j] = *(const u32x2*)(sp + (j0 + j) * CH);
#pragma unroll
            for (int j = 0; j < 16; ++j) {
                u32x2 o; o.x = cvt_pk_bf16(a[0], a[1]); o.y = cvt_pk_bf16(a[2], a[3]);
                *(u32x2*)(sp + (j0 + j) * CH) = o;
                a[0] = a[0] * sd + bflo(w[j].x); a[1] = a[1] * sd + bfhi(w[j].x); a[2] = a[2] * sd + bflo(w[j].y); a[3] = a[3] * sd + bfhi(w[j].y);
            }
        }
        float* o = p.out + OUT_RETP + ((size_t)((l * 2 + b) * 4 + h) * 256 + d4) * 512 + e;
#pragma unroll
        for (int j = 0; j < 4; ++j) o[(size_t)j * 512] = a[j];
    }
}

__device__ __forceinline__ void phase_sret(int wv, const Params& p, int l, LAS unsigned char* lds) {
    int wv_ = wv; asm volatile("" : "+s"(wv_)); int tid = wv_ * 64 + lane_id(); asm volatile("" : "+v"(tid));
    const int lane = tid & 63, w = __builtin_amdgcn_readfirstlane(tid >> 6);
    unsigned char* ws = p.ws;
    LAS float* attL = (LAS float*)lds;
    LAS float* red = (LAS float*)(lds + 8192);
    for (int unit = blockIdx.x, GG = gdim(); unit < 256; unit += GG) {
        const int es = unit & 7, h = (unit >> 3) & 3, bs = unit >> 5;
        const float lg = lgdec(h);
        const bf16_t* q = (const bf16_t*)(ws + WS_Q) + (size_t)(NPT + bs * 32) * 1024 + h * 256;
        const bf16_t* k = (const bf16_t*)(ws + WS_KS) + (size_t)(bs * 32) * 1024 + h * 256;
        const bf16_t* kT = (const bf16_t*)(ws + WS_KTS) + (size_t)(h * 256) * 256 + bs * 32;
        const bf16_t* vT = (const bf16_t*)(ws + WS_VTS) + (size_t)(h * 512 + es * 64) * 256 + bs * 32;
        if (w == 0) {
            f32x16 accq;
#pragma unroll
            for (int r = 0; r < 16; ++r) accq[r] = 0.f;
            const bf16_t* qa = q + (size_t)(lane & 31) * 1024 + (lane >> 5) * 8; const bf16_t* kb = k + (size_t)(lane & 31) * 1024 + (lane >> 5) * 8;
#pragma unroll
            for (int sk = 0; sk < 16; ++sk) { const bf16x8 af = *(const bf16x8*)(qa + 16 * sk), bfr = *(const bf16x8*)(kb + 16 * sk); accq = __builtin_amdgcn_mfma_f32_32x32x16_bf16(af, bfr, accq, 0, 0, 0); }
            const int m = lane & 31;
#pragma unroll
            for (int r = 0; r < 16; ++r) { const int n = (r & 3) + 8 * (r >> 2) + 4 * (lane >> 5); attL[n * 33 + m] = (m <= n) ? accq[r] * __expf(lg * (float)(n - m)) : 0.f; }
        }
        const int e = es * 64 + lane;
        const float* S0 = p.in[3] + ((size_t)((l * 8 + bs) * 4 + h) * 256 + w * 32) * 512 + e;
        float s0[32];
#pragma unroll
        for (int dd = 0; dd < 32; ++dd) s0[dd] = S0[(size_t)dd * 512];
        float v[32];
        { const u32x4* vp = (const u32x4*)(vT + (size_t)lane * 256);
#pragma unroll
          for (int c = 0; c < 4; ++c) { f32x4 a, b2; unpack8(vp[c], a, b2); v[8 * c] = a[0]; v[8 * c + 1] = a[1]; v[8 * c + 2] = a[2]; v[8 * c + 3] = a[3]; v[8 * c + 4] = b2[0]; v[8 * c + 5] = b2[1]; v[8 * c + 6] = b2[2]; v[8 * c + 7] = b2[3]; } }
        {
            float* So = p.out + OUT_RETS + ((size_t)((l * 8 + bs) * 4 + h) * 256 + w * 32) * 512 + e;
            const float sd = __expf(lg * 32.0f);
#pragma unroll 4
            for (int dd = 0; dd < 32; ++dd) {
                const u32x4* kr = (const u32x4*)(kT + (size_t)(w * 32 + dd) * 256); float a = s0[dd] * sd;
#pragma unroll
                for (int c4 = 0; c4 < 4; ++c4) { f32x4 k0, k1; unpack8(kr[c4], k0, k1);
                    a += (k0[0] * v[8 * c4] + k0[1] * v[8 * c4 + 1]) + (k0[2] * v[8 * c4 + 2] + k0[3] * v[8 * c4 + 3]) + (k1[0] * v[8 * c4 + 4] + k1[1] * v[8 * c4 + 5]) + (k1[2] * v[8 * c4 + 6] + k1[3] * v[8 * c4 + 7]); }
                So[(size_t)dd * 512] = a;
            }
        }
#pragma unroll 2
        for (int n = 0; n < 32; ++n) {
            const u32x4* qr = (const u32x4*)(q + (size_t)n * 1024 + w * 32); float a = 0.f;
#pragma unroll
            for (int c4 = 0; c4 < 4; ++c4) { f32x4 k0, k1; unpack8(qr[c4], k0, k1);
                a += (k0[0] * s0[8 * c4] + k0[1] * s0[8 * c4 + 1]) + (k0[2] * s0[8 * c4 + 2] + k0[3] * s0[8 * c4 + 3]) + (k1[0] * s0[8 * c4 + 4] + k1[1] * s0[8 * c4 + 5]) + (k1[2] * s0[8 * c4 + 6] + k1[3] * s0[8 * c4 + 7]); }
            red[(w * 32 + n) * 64 + lane] = a * __expf(lg * (float)(n + 1));
        }
        __syncthreads();
        bf16_t* O = (bf16_t*)(ws + WS_OS) + (size_t)(bs * 32) * 2048 + h * 512 + e;
        fx_t* st = (fx_t*)(ws + WS_STATS) + (size_t)(bs * 32) * 8 + h * 2;
#pragma unroll
        for (int r = 0; r < 4; ++r) {
            const int n = w * 4 + r; float a = 0.f;
#pragma unroll
            for (int ww = 0; ww < 8; ++ww) a += red[(ww * 32 + n) * 64 + lane];
#pragma unroll
            for (int m = 0; m < 32; ++m) a += attL[n * 33 + m] * v[m];
            O[(size_t)n * 2048] = (bf16_t)(cvt_pk_bf16(a, 0.f) & 0xffffu);
            const float s = wave_sum(a), qq = wave_sum(a * a);
            if (lane == 0) { fx_add(st + (size_t)n * 8, s); fx_add(st + (size_t)n * 8 + 1, qq); }
        }
        __syncthreads();
    }
}

__device__ __forceinline__ void phase_conv(int wv, const Params& p, int l, LAS unsigned char* lds) {
    int wv_ = wv; asm volatile("" : "+s"(wv_)); int tid = wv_ * 64 + lane_id(); asm volatile("" : "+v"(tid));
    const int lane = tid & 63, wave = tid >> 6;
    unsigned char* ws = p.ws;
    LAS float* red = (LAS float*)lds;
    const int c0 = tid * 2;
    const float* cw = p.in[6] + (size_t)l * 31 * 1024 + c0;
    float w0[31], w1[31];
#pragma unroll
    for (int j = 0; j < 31; ++j) { const f32x2 t = *(const f32x2*)(cw + (size_t)j * 1024); w0[j] = t.x; w1[j] = t.y; }
    const f32x2 cb = *(const f32x2*)(p.in[7] + l * 1024 + c0), lg = *(const f32x2*)(p.in[8] + l * 1024 + c0), lb = *(const f32x2*)(p.in[9] + l * 1024 + c0);
    const int GG = gdim();
    { unsigned z = 0u; asm volatile("" : "+v"(z)); unsigned* sa = (unsigned*)(ws + WS_SSQA); for (int i = blockIdx.x * 512 + tid; i < NTOK * 2; i += GG * 512) sa[i] = z; }
    for (int tok = blockIdx.x; tok < 256; tok += GG) {
        const int sb = tok >> 5, t = tok & 31;
        const bf16_t* gl = (const bf16_t*)(ws + WS_GLU) + (size_t)(NPT + sb * 32) * 1024 + c0;
        const float* cst = p.in[2] + (size_t)(l * 8 + sb) * 30 * 1024 + c0;
        unsigned xg[31]; f32x2 xs[31];
#pragma unroll
        for (int j = 0; j < 31; ++j) { const int tt = t + j - 30; const int tg = tt < 0 ? 0 : tt, tsx = tt + 30 > 29 ? 29 : tt + 30;
            xg[j] = *(const unsigned*)(gl + (size_t)tg * 1024); xs[j] = *(const f32x2*)(cst + (size_t)tsx * 1024); }
        float a0 = cb.x, a1 = cb.y;
#pragma unroll
        for (int j = 0; j < 31; ++j) { const bool fromg = (t + j - 30) >= 0; const float x0 = fromg ? bflo(xg[j]) : xs[j].x, x1 = fromg ? bfhi(xg[j]) : xs[j].y; a0 += x0 * w0[j]; a1 += x1 * w1[j]; }
        if (t >= 2) *(f32x2*)(p.out + OUT_CONVS + ((size_t)(l * 8 + sb) * 30 + (t - 2)) * 1024 + c0) = (f32x2){bflo(xg[30]), bfhi(xg[30])};
        { const float s = wave_sum(a0 + a1), q = wave_sum(a0 * a0 + a1 * a1); if (lane == 0) { red[wave] = s; red[128 + wave] = q; } }
        __syncthreads();
        { float s = 0.f, q = 0.f;
#pragma unroll
          for (int ww = 0; ww < 8; ++ww) { s += red[ww]; q += red[128 + ww]; }
          const float mu = s * (1.0f / 1024.0f); const float var = fmaxf(q * (1.0f / 1024.0f) - mu * mu, 0.f); const float rstd = __builtin_amdgcn_rsqf(var + LN_EPS);
          float y0 = (a0 - mu) * rstd * lg.x + lb.x, y1 = (a1 - mu) * rstd * lg.y + lb.y; y0 *= sigm(y0); y1 *= sigm(y1);
          *(unsigned*)((bf16_t*)(ws + WS_YC) + (size_t)(NPT + tok) * 1024 + c0) = cvt_pk_bf16(y0, y1); }
        __syncthreads();
    }
    for (int unit = blockIdx.x; unit < NPT / 16; unit += GG) {
        const int g0 = unit * 16, t0 = g0 & (SEQ - 1), pb = g0 >> 13;
        const bool lastt = (t0 == SEQ - 16);
        const bf16_t* gl = (const bf16_t*)(ws + WS_GLU) + (size_t)g0 * 1024 + c0;
        float* cso = p.out + OUT_CONVP + (size_t)(l * 2 + pb) * 30 * 1024 + c0;
        unsigned xin[46];
#pragma unroll
        for (int r = 0; r < 46; ++r) { const int tt = t0 - 30 + r; const long off = tt >= 0 ? (long)(r - 30) : 0l; xin[r] = *(const unsigned*)(gl + off * 1024); if (tt < 0) xin[r] = 0u; }
        float a0[16], a1[16];
#pragma unroll
        for (int t = 0; t < 16; ++t) { a0[t] = cb.x; a1[t] = cb.y; }
#pragma unroll
        for (int r = 0; r < 46; ++r) {
            const float x0 = bflo(xin[r]), x1 = bfhi(xin[r]);
            if (r >= 16 && lastt) *(f32x2*)(cso + (size_t)(r - 16) * 1024) = (f32x2){x0, x1};
#pragma unroll
            for (int t = 0; t < 16; ++t) { const int j = r - t; if (j >= 0 && j <= 30) { a0[t] += x0 * w0[j]; a1[t] += x1 * w1[j]; } }
        }
#pragma unroll
        for (int t = 0; t < 16; ++t) { const float s = wave_sum(a0[t] + a1[t]), q = wave_sum(a0[t] * a0[t] + a1[t] * a1[t]); if (lane == 0) { red[t * 8 + wave] = s; red[128 + t * 8 + wave] = q; } }
        __syncthreads();
        bf16_t* yo = (bf16_t*)(ws + WS_YC) + (size_t)g0 * 1024 + c0;
#pragma unroll
        for (int t = 0; t < 16; ++t) { float s = 0.f, q = 0.f;
#pragma unroll
            for (int ww = 0; ww < 8; ++ww) { s += red[t * 8 + ww]; q += red[128 + t * 8 + ww]; }
            const float mu = s * (1.0f / 1024.0f); const float var = fmaxf(q * (1.0f / 1024.0f) - mu * mu, 0.f);
            const float rstd = __builtin_amdgcn_rsqf(var + LN_EPS);
            float y0 = (a0[t] - mu) * rstd * lg.x + lb.x, y1 = (a1[t] - mu) * rstd * lg.y + lb.y;
            y0 *= sigm(y0); y1 *= sigm(y1);
            *(unsigned*)(yo + (size_t)t * 1024) = cvt_pk_bf16(y0, y1); }
        __syncthreads();
    }
}

__device__ __forceinline__ void phase_rms2(int wv, const Params& p, int l) {
    int wv_ = wv; asm volatile("" : "+s"(wv_)); int tid = wv_ * 64 + lane_id(); asm volatile("" : "+v"(tid));
    const int lane = tid & 63, gw = blockIdx.x * 8 + (tid >> 6), NGW = gdim() * 8;
    const float* g2 = p.in[14] + l * 1024;
    for (int m = gw; m < NTOK; m += NGW) rms_row(p.out + (size_t)m * 1024, g2, (bf16_t*)(p.ws + WS_H) + (size_t)m * 1024, nullptr, lane);
}
__device__ __forceinline__ void phase_final(int wv, const Params& p) {
    int wv_ = wv; asm volatile("" : "+s"(wv_)); int tid = wv_ * 64 + lane_id(); asm volatile("" : "+v"(tid));
    const int lane = tid & 63, gw = blockIdx.x * 8 + (tid >> 6), NGW = gdim() * 8;
    const f32x4* gr = (const f32x4*)p.in[17] + lane; const fx_t* ssq = (const fx_t*)(p.ws + WS_SSQA);
    for (int m = gw; m < NTOK; m += NGW) {
        f32x4* yr = (f32x4*)(p.out + (size_t)m * 1024) + lane; const u32x2* xr = (const u32x2*)((const bf16_t*)(p.ws + WS_H) + (size_t)m * 1024) + lane; const float r = rstd_of(fx_get(ssq[m]));
#pragma unroll
        for (int j = 0; j < 4; ++j) { const u32x2 w = xr[64 * j]; const f32x4 xv = {bflo(w.x), bfhi(w.x), bflo(w.y), bfhi(w.y)}; yr[64 * j] = xv * r * gr[64 * j]; }
    }
}

#define SG_BAR() do { asm volatile("s_waitcnt lgkmcnt(0)" ::: "memory"); __builtin_amdgcn_s_barrier(); asm volatile("" ::: "memory"); } while (0)
template <bool PAIR, class EpiS>
__device__ __forceinline__ void sgemm_phase(int wv, LAS unsigned char* lds, const bf16_t* A, const bf16_t* Wt, int K, int nUnits, const EpiS& epi) {
    int wv_ = wv; asm volatile("" : "+s"(wv_)); int tid = wv_ * 64 + lane_id(); asm volatile("" : "+v"(tid));
    const int lane = tid & 63, w = __builtin_amdgcn_readfirstlane(tid >> 6);
    LAS float* red = (LAS float*)lds;
    const int kw = K >> 3, GG = gdim();
    const size_t loff = (size_t)(lane & 31) * K + w * kw + (lane >> 5) * 8;
    const int row = tid >> 4, jq = tid & 15;
    int unit = blockIdx.x;
    if (unit >= nUnits) return;
#define SG_PTRS(u_) const int rb_ = (u_) & 7, cp_ = (u_) >> 3, n0_ = PAIR ? ((cp_ >> 2) * 256 + (cp_ & 3) * 32) : cp_ * 32; \
        const bf16_t* ap = A + (size_t)(rb_ * 32) * K + loff; const bf16_t* bp0 = Wt + (size_t)n0_ * K + loff; const bf16_t* bp1 = bp0 + (size_t)128 * K;
#define SG_REDUCE(u_) do { \
        _Pragma("unroll") for (int r = 0; r < 16; ++r) { const int i = (r & 3) + 8 * (r >> 2) + 4 * (lane >> 5); \
            red[(w * 32 + i) * 64 + (lane & 31)] = acc0[r]; if (PAIR) red[(w * 32 + i) * 64 + 32 + (lane & 31)] = acc1[r]; } \
        SG_BAR(); \
        const int rbq = (u_) & 7, cpq = (u_) >> 3, n0q = PAIR ? ((cpq >> 2) * 256 + (cpq & 3) * 32) : cpq * 32; \
        float x1[2] = {0.f, 0.f}, x2[2] = {0.f, 0.f}; \
        _Pragma("unroll") for (int ww = 0; ww < 8; ++ww) { const f32x2 p0 = *(const LAS f32x2*)(red + (ww * 32 + row) * 64 + 2 * jq); x1[0] += p0.x; x1[1] += p0.y; \
            if (PAIR) { const f32x2 p1 = *(const LAS f32x2*)(red + (ww * 32 + row) * 64 + 32 + 2 * jq); x2[0] += p1.x; x2[1] += p1.y; } } \
        epi(rbq * 32 + row, n0q + 2 * jq, x1, x2); \
        SG_BAR(); } while (0)
    if (K == 1024) {
        bf16x8 ra[8], rb0[8], rb1[8];
        { SG_PTRS(unit)
#pragma unroll
          for (int s = 0; s < 8; ++s) { ra[s] = *(const bf16x8*)(ap + 16 * s); rb0[s] = *(const bf16x8*)(bp0 + 16 * s); if (PAIR) rb1[s] = *(const bf16x8*)(bp1 + 16 * s); } }
#pragma unroll 1
        for (;;) {
            f32x16 acc0, acc1;
#pragma unroll
            for (int r = 0; r < 16; ++r) { acc0[r] = 0.f; acc1[r] = 0.f; }
#pragma unroll
            for (int s = 0; s < 8; ++s) { acc0 = __builtin_amdgcn_mfma_f32_32x32x16_bf16(ra[s], rb0[s], acc0, 0, 0, 0); if (PAIR) acc1 = __builtin_amdgcn_mfma_f32_32x32x16_bf16(ra[s], rb1[s], acc1, 0, 0, 0); }
            const int cur = unit; unit += GG; const bool has = unit < nUnits;
            if (has) { SG_PTRS(unit)
#pragma unroll
                for (int s = 0; s < 8; ++s) { ra[s] = *(const bf16x8*)(ap + 16 * s); rb0[s] = *(const bf16x8*)(bp0 + 16 * s); if (PAIR) rb1[s] = *(const bf16x8*)(bp1 + 16 * s); } }
            SG_REDUCE(cur);
            if (!has) break;
        }
    } else {
#pragma unroll 1
        for (; unit < nUnits; unit += GG) {
            SG_PTRS(unit)
            f32x16 acc0, acc1;
#pragma unroll
            for (int r = 0; r < 16; ++r) { acc0[r] = 0.f; acc1[r] = 0.f; }
#pragma unroll 8
            for (int ks = 0; ks < kw; ks += 16) {
                const bf16x8 a = *(const bf16x8*)(ap + ks), b0 = *(const bf16x8*)(bp0 + ks);
                acc0 = __builtin_amdgcn_mfma_f32_32x32x16_bf16(a, b0, acc0, 0, 0, 0);
                if (PAIR) { const bf16x8 b1 = *(const bf16x8*)(bp1 + ks); acc1 = __builtin_amdgcn_mfma_f32_32x32x16_bf16(a, b1, acc1, 0, 0, 0); }
            }
            SG_REDUCE(unit);
        }
    }
    asm volatile("s_waitcnt vmcnt(0) lgkmcnt(0)" ::: "memory");
    __syncthreads();
#undef SG_PTRS
#undef SG_REDUCE
}
#define SEPI_ARGS int rl, int n, const float (&x1)[2], const float (&x2)[2]
struct SEpiB1 {
    unsigned char* ws;
    __device__ __forceinline__ void operator()(int rl, int n, const float (&y1)[2], const float (&y2)[2]) const {
        const float rs_ = rstd_of(fx_get(((const fx_t*)(ws + WS_SSQA))[NPT + rl]));
        const float x1[2] = {y1[0] * rs_, y1[1] * rs_}, x2[2] = {y2[0] * rs_, y2[1] * rs_};
        if (n < 2048) {
            const f32x2* tab = (const f32x2*)(ws + WS_TAB);
            const int head = (n >> 8) & 3, d = n & 255, pos = PAST + (rl & 31);
            const f32x2 c0 = tab[(size_t)pos * 128 + d], c1 = tab[(size_t)pos * 128 + d + 1];
            float o1[2], o2[2];
            o1[0] = x1[0] * c0.x - x2[0] * c0.y; o2[0] = x2[0] * c0.x + x1[0] * c0.y;
            o1[1] = x1[1] * c1.x - x2[1] * c1.y; o2[1] = x2[1] * c1.x + x1[1] * c1.y;
            if (n < 1024) {
                bf16_t* q = (bf16_t*)(ws + WS_Q) + (size_t)(NPT + rl) * 1024 + head * 256 + d;
                *(unsigned*)q = cvt_pk_bf16(o1[0], o1[1]); *(unsigned*)(q + 128) = cvt_pk_bf16(o2[0], o2[1]);
            } else {
                bf16_t* k = (bf16_t*)(ws + WS_KS) + (size_t)rl * 1024 + head * 256 + d;
                *(unsigned*)k = cvt_pk_bf16(o1[0] * 0.0625f, o1[1] * 0.0625f); *(unsigned*)(k + 128) = cvt_pk_bf16(o2[0] * 0.0625f, o2[1] * 0.0625f);
                const float dec = 0.0625f * __expf(lgdec(head) * (float)(DSEQ - 1 - (rl & 31)));
                bf16_t* kt = (bf16_t*)(ws + WS_KTS) + (size_t)(head * 256 + d) * 256 + rl;
                const unsigned wa = cvt_pk_bf16(o1[0] * dec, o1[1] * dec), wb = cvt_pk_bf16(o2[0] * dec, o2[1] * dec);
                kt[0] = (bf16_t)(wa & 0xffffu); kt[256] = (bf16_t)(wa >> 16); kt[128 * 256] = (bf16_t)(wb & 0xffffu); kt[129 * 256] = (bf16_t)(wb >> 16);
            }
        } else {
            bf16_t* vt = (bf16_t*)(ws + WS_VTS) + (size_t)(n - 2048) * 256 + rl;
            const unsigned wa = cvt_pk_bf16(x1[0], x1[1]), wb = cvt_pk_bf16(x2[0], x2[1]);
            vt[0] = (bf16_t)(wa & 0xffffu); vt[256] = (bf16_t)(wa >> 16); vt[128 * 256] = (bf16_t)(wb & 0xffffu); vt[129 * 256] = (bf16_t)(wb >> 16);
        }
    }
};
struct SEpiB2 {
    unsigned char* ws; const float* gn_g;
    __device__ __forceinline__ void operator()(int rl, int n, const float (&y1)[2], const float (&y2)[2]) const {
        const float rs_ = rstd_of(fx_get(((const fx_t*)(ws + WS_SSQA))[NPT + rl]));
        const float x1[2] = {y1[0] * rs_, y1[1] * rs_}, x2[2] = {y2[0] * rs_, y2[1] * rs_};
        if (n < 2048) {
            bf16_t* o = (bf16_t*)(ws + WS_GLU) + (size_t)(NPT + rl) * 1024 + (n >> 8) * 128 + (n & 127);
            *(unsigned*)o = cvt_pk_bf16(x1[0] * sigm(x2[0]), x1[1] * sigm(x2[1]));
        } else if (n < 4096) {
            const int col = n - 2048, head = col >> 9;
            const fx_t* sp2 = (const fx_t*)(ws + WS_STATS) + (size_t)rl * 8 + head * 2; const f32x2 sq = {fx_get(sp2[0]), fx_get(sp2[1])};
            const float mu = sq.x * (1.0f / 512.0f); const float var = fmaxf(sq.y * (1.0f / 512.0f) - mu * mu, 0.f); const float rstd = __builtin_amdgcn_rsqf(var + LN_EPS);
            bf16_t* o = (bf16_t*)(ws + WS_OS) + (size_t)rl * 2048 + col;
            const unsigned oa = *(const unsigned*)o, ob = *(const unsigned*)(o + 128);
            const f32x2 ga = *(const f32x2*)(gn_g + col), gb = *(const f32x2*)(gn_g + col + 128);
            *(unsigned*)o = cvt_pk_bf16(x1[0] * sigm(x1[0]) * ((bflo(oa) - mu) * rstd * ga.x), x1[1] * sigm(x1[1]) * ((bfhi(oa) - mu) * rstd * ga.y));
            *(unsigned*)(o + 128) = cvt_pk_bf16(x2[0] * sigm(x2[0]) * ((bflo(ob) - mu) * rstd * gb.x), x2[1] * sigm(x2[1]) * ((bfhi(ob) - mu) * rstd * gb.y));
        } else {
            bf16_t* o = (bf16_t*)(ws + (n < 5120 ? WS_GC : WS_GR)) + (size_t)(NPT + rl) * 1024 + ((n - 4096) & 1023);
            *(unsigned*)o = cvt_pk_bf16(sigm(x1[0]), sigm(x1[1])); *(unsigned*)(o + 128) = cvt_pk_bf16(sigm(x2[0]), sigm(x2[1]));
        }
    }
};
template <int MODE, bool PAIR> struct SEpiEW {
    unsigned char* ws; float* x; fx_t* ssq;
    __device__ __forceinline__ void operator()(SEPI_ARGS) const {
        const size_t row = (size_t)(NPT + rl);
        if (MODE == 0) {
            const bf16_t* g = (const bf16_t*)(ws + WS_GC) + row * 1024 + n; bf16_t* t = (bf16_t*)(ws + WS_T) + row * 1024 + n;
            const unsigned ga = *(const unsigned*)g, gb = *(const unsigned*)(g + 128);
            *(unsigned*)t = cvt_pk_bf16(x1[0] * bflo(ga), x1[1] * bfhi(ga)); if (PAIR) *(unsigned*)(t + 128) = cvt_pk_bf16(x2[0] * bflo(gb), x2[1] * bfhi(gb));
        } else if (MODE == 1) {
            const bf16_t* g = (const bf16_t*)(ws + WS_GR) + row * 1024 + n; bf16_t* t = (bf16_t*)(ws + WS_T) + row * 1024 + n;
            const unsigned ga = *(const unsigned*)g, gb = *(const unsigned*)(g + 128), ta = *(const unsigned*)t, tb = *(const unsigned*)(t + 128);
            *(unsigned*)t = cvt_pk_bf16(bflo(ta) + x1[0] * bflo(ga), bfhi(ta) + x1[1] * bfhi(ga)); if (PAIR) *(unsigned*)(t + 128) = cvt_pk_bf16(bflo(tb) + x2[0] * bflo(gb), bfhi(tb) + x2[1] * bfhi(gb));
        } else if (MODE == 2) {
            bf16_t* xb = (bf16_t*)(ws + WS_H) + row * 1024 + n; const unsigned xa = *(const unsigned*)xb, xc = PAIR ? *(const unsigned*)(xb + 128) : 0u;
            f32x2 a = {bflo(xa) + x1[0], bfhi(xa) + x1[1]}, b = {bflo(xc) + x2[0], bfhi(xc) + x2[1]};
            *(unsigned*)xb = cvt_pk_bf16(a.x, a.y); if (PAIR) *(unsigned*)(xb + 128) = cvt_pk_bf16(b.x, b.y);
            float q = a.x * a.x + a.y * a.y; if (PAIR) q += b.x * b.x + b.y * b.y;
            q += shx<1>(q); q += shx<2>(q); q += shx<4>(q); q += shx<8>(q);
            if ((lane_id() & 15) == 0) fx_add(ssq + row, q);
        } else {
            bf16_t* u = (bf16_t*)(ws + WS_U) + row * 4096 + n;
            const float r3 = rstd_of(fx_get(ssq[row]));
            const float a0 = fmaxf(x1[0], 0.f) * r3, a1 = fmaxf(x1[1], 0.f) * r3, b0 = fmaxf(x2[0], 0.f) * r3, b1 = fmaxf(x2[1], 0.f) * r3;
            *(unsigned*)u = cvt_pk_bf16(a0 * a0, a1 * a1); if (PAIR) *(unsigned*)(u + 128) = cvt_pk_bf16(b0 * b0, b1 * b1);
        }
    }
};

#define XB_TMO      128
#define XB_XCNT(j)  (256  + 64 * (j))
#define XB_XSUB(j)  (1280 + 64 * (j))
#define XB_XGEN(j)  (2304 + 64 * (j))
#define XB_TOP      3328
#define XB_TOPGEN   3392
#define XCD_BAR_WORDS 3456
#define XB_SPIN_CAP (1u << 18)

__device__ __forceinline__ unsigned xb_ld(unsigned* p)              { return __hip_atomic_load(p, __ATOMIC_RELAXED, __HIP_MEMORY_SCOPE_AGENT); }
__device__ __forceinline__ unsigned xb_add(unsigned* p, unsigned v) { return __hip_atomic_fetch_add(p, v, __ATOMIC_RELAXED, __HIP_MEMORY_SCOPE_AGENT); }
__device__ __forceinline__ unsigned xb_xcc_id() { return (unsigned)__builtin_amdgcn_s_getreg((3 << 11) | 20) & 0xFu; }
#define XB_SPIN(cond, bar) do { unsigned _sp = 0; while (cond) { __builtin_amdgcn_s_sleep(1); \
    if ((++_sp & 255u) == 0u) { if (xb_ld(&(bar)[XB_TMO])) break; if (_sp > XB_SPIN_CAP) { atomicAdd(&(bar)[XB_TMO], 1u); break; } } } } while (0)

struct XcdBarrier {
    unsigned* bar; unsigned x;
    volatile LAS unsigned* st;
};

__device__ __forceinline__ XcdBarrier xcd_barrier_post(unsigned* bar, volatile LAS unsigned* st, int wv) {
    XcdBarrier b; b.bar = bar; b.x = xb_xcc_id(); b.st = st;
    if (wv == 0 && lane_id() == 0) (void)xb_add(&bar[XB_XCNT(b.x)], 1u);
    return b;
}
__device__ __forceinline__ void xcd_barrier_complete(unsigned* bar, unsigned x, unsigned& nloc, unsigned& nx) {
    const unsigned G = gridDim.x * gridDim.y * gridDim.z;
    unsigned sum, cnt, mine, sp = 0u;
    for (;;) {
        sum = 0u; cnt = 0u; mine = 0u;
#pragma unroll
        for (unsigned j = 0; j < 16; ++j) { const unsigned c = xb_ld(&bar[XB_XCNT(j)]); sum += c; cnt += (c > 0u) ? 1u : 0u; mine = (j == x) ? c : mine; }
        if (sum == G) break;
        __builtin_amdgcn_s_sleep(1);
        if ((++sp & 255u) == 0u) { if (xb_ld(&bar[XB_TMO])) break; if (sp > XB_SPIN_CAP) { atomicAdd(&bar[XB_TMO], 1u); break; } }
    }
    nloc = mine > 0u ? mine : 1u; nx = cnt > 0u ? cnt : 1u;
}

__device__ __forceinline__ void xcd_barrier(const XcdBarrier& b, int wv) {
    asm volatile("s_waitcnt vmcnt(0)" ::: "memory");
    __syncthreads();
    if (wv == 0 && lane_id() == 0) {
        unsigned* bar = b.bar;
        __builtin_amdgcn_s_waitcnt(0);
        unsigned nloc = b.st[0], nx = b.st[1];
        if (nloc == 0u) { xcd_barrier_complete(bar, b.x, nloc, nx); b.st[0] = nloc; b.st[1] = nx; }
        const unsigned old = xb_add(&bar[XB_XSUB(b.x)], 1u);
        const unsigned gen = old / nloc;
        if (old + 1u == (gen + 1u) * nloc) {
            __builtin_amdgcn_fence(__ATOMIC_RELEASE, "agent");
            asm volatile("s_waitcnt vmcnt(0)" ::: "memory");
            const unsigned og = xb_add(&bar[XB_TOP], 1u);
            const unsigned tg = og / nx;
            if (og + 1u == (tg + 1u) * nx) xb_add(&bar[XB_TOPGEN], 1u);
            else XB_SPIN(xb_ld(&bar[XB_TOPGEN]) == tg, bar);
            __builtin_amdgcn_fence(__ATOMIC_ACQUIRE, "agent");
            xb_add(&bar[XB_XGEN(b.x)], 1u);
            asm volatile("s_waitcnt vmcnt(0)" ::: "memory");
        } else {
            XB_SPIN(xb_ld(&bar[XB_XGEN(b.x)]) == gen, bar);
            __builtin_amdgcn_fence(__ATOMIC_ACQUIRE, "agent");
            asm volatile("s_waitcnt vmcnt(0)" ::: "memory");
        }
    }
    __syncthreads();
}


constexpr int LDS_BYTES = 131072 + 4096;
#define LCV ({ int c_ = (int)blockIdx.x; asm volatile("" : "+s"(c_)); c_; })
__global__ void __launch_bounds__(512, 2) fwd_megakernel(Params p) {
    extern __shared__ __attribute__((aligned(16))) unsigned char lds_raw[];
    LAS unsigned char* lds = (LAS unsigned char*)lds_raw;
    cg::grid_group grid = cg::this_grid();
    const int G = gridDim.x, c = blockIdx.x;
    unsigned char* ws = p.ws;
    int wv = __builtin_amdgcn_readfirstlane((int)(threadIdx.x >> 6)); asm volatile("" : "+s"(wv));
    volatile LAS unsigned* stw = (volatile LAS unsigned*)(lds + 131072);
    if (wv == 0) stw[lane_id()] = 0u;
    __syncthreads();
    XcdBarrier xbar = xcd_barrier_post((unsigned*)(ws + WS_BAR), stw, wv);
    if (p.ws == nullptr) grid.sync();
#define GSYNC() xcd_barrier(xbar, wv)
#pragma unroll 1
    for (int l = 0; l < 2; ++l) {
        phase0(wv, p, l, lds, 0);
        GSYNC();
        {
            SchedB1 S{G, LCV, (const char*)(ws + WS_H), (const char*)(ws + WS_WIN)}; EpiB1 E{ws};
            pg8::gemm_phase(wv, lds, pg8::Gemm{1024, 16, 1024, 1024}, S, E);
            sgemm_phase<true>(wv, lds, (const bf16_t*)(ws + WS_H) + (size_t)NPT * 1024, (const bf16_t*)(ws + WS_WIN), 1024, 8 * 64, SEpiB1{ws});
        }
        GSYNC();
        {
            { SchedAtt S{G, LCV, ws}; EpiAtt E{ws}; pg8::gemm_phase(wv, lds, pg8::Gemm{256, 4, 1024, 1024}, S, E); }
            { SchedU S{G, LCV, ws}; EpiU E{ws}; pg8::gemm_phase(wv, lds, pg8::Gemm{256, 4, SEQ, SEQ}, S, E); }
            phase_sret(wv, p, l, lds);
            GSYNC();
            phase_scan(wv, p, l);
            GSYNC();
            { SchedE S{G, LCV, ws}; EpiE E{ws}; pg8::gemm_phase(wv, lds, pg8::Gemm{512, 4, 1024, SEQ}, S, E); }
            {
                const int t_ = wv * 64 + lane_id(), row_ = t_ >> 1, which_ = t_ & 1, idx_ = (int)blockIdx.x, h_ = idx_ & 3, j_ = (idx_ >> 2) & 31, b_ = idx_ >> 7;
                if (idx_ < 256) {
                    const float* sl_ = (const float*)(ws + WS_SLOTS) + (size_t)idx_ * 4096 + row_ * 16 + which_;
                    float a_ = 0.f;
#pragma unroll
                    for (int k_ = 0; k_ < 8; ++k_) a_ += sl_[k_ * 2];
                    ((float*)(ws + WS_STATF))[(size_t)(b_ * SEQ + j_ * CH + row_) * 8 + h_ * 2 + which_] = a_;
                }
            }
            GSYNC();
        }
        {
            SchedN S{G, LCV, 24, 0, (const char*)(ws + WS_H), (const char*)(ws + WS_WIN) + (size_t)16 * TILEB, TILEB, ws, TILEB};
            EpiB2 E{ws, p.in[11] + l * 2048};
            pg8::gemm_phase(wv, lds, pg8::Gemm{1024, 16, 1024, 1024}, S, E);
            sgemm_phase<true>(wv, lds, (const bf16_t*)(ws + WS_H) + (size_t)NPT * 1024, (const bf16_t*)(ws + WS_WIN) + (size_t)4096 * 1024, 1024, 8 * 96, SEpiB2{ws, p.in[11] + l * 2048});
        }
        GSYNC();
        phase0(wv, p, l, lds, 1);
        phase_conv(wv, p, l, lds);
        GSYNC();
        { SchedN S{G, LCV, 4, 0, (const char*)(ws + WS_YC), (const char*)(ws + WS_WC), TILEB, ws, TILEB}; EpiEW<0> E{ws, p.out, nullptr}; pg8::gemm_phase(wv, lds, pg8::Gemm{1024, 16, 1024, 1024}, S, E); }
        sgemm_phase<false>(wv, lds, (const bf16_t*)(ws + WS_YC) + (size_t)NPT * 1024, (const bf16_t*)(ws + WS_WC), 1024, 8 * 32, SEpiEW<0, false>{ws, p.out, nullptr});
        { SchedN S{G, LCV, 4, 1, nullptr, (const char*)(ws + WS_WR), 2 * TILEB, ws, 0}; EpiEW<1> E{ws, p.out, nullptr}; pg8::gemm_phase(wv, lds, pg8::Gemm{2048, 32, 2048, 2048}, S, E); }
        sgemm_phase<false>(wv, lds, (const bf16_t*)(ws + WS_OS), (const bf16_t*)(ws + WS_WR), 2048, 8 * 32, SEpiEW<1, false>{ws, p.out, nullptr});
        GSYNC();
        { SchedN S{G, LCV, 4, 0, (const char*)(ws + WS_T), (const char*)(ws + WS_WO), TILEB, ws, TILEB}; EpiEW<2> E{ws, p.out, (fx_t*)(ws + WS_SSQB)}; pg8::gemm_phase(wv, lds, pg8::Gemm{1024, 16, 1024, 1024}, S, E); }
        sgemm_phase<false>(wv, lds, (const bf16_t*)(ws + WS_T) + (size_t)NPT * 1024, (const bf16_t*)(ws + WS_WO), 1024, 8 * 32, SEpiEW<2, false>{ws, p.out, (fx_t*)(ws + WS_SSQB)});
        GSYNC();
        { SchedN S{G, LCV, 16, 0, (const char*)(ws + WS_H), (const char*)(ws + WS_WM1), TILEB, ws, TILEB}; EpiEW<3> E{ws, p.out, (fx_t*)(ws + WS_SSQB)}; pg8::gemm_phase(wv, lds, pg8::Gemm{1024, 16, 1024, 1024}, S, E); }
        sgemm_phase<true>(wv, lds, (const bf16_t*)(ws + WS_H) + (size_t)NPT * 1024, (const bf16_t*)(ws + WS_WM1), 1024, 8 * 64, SEpiEW<3, true>{ws, p.out, (fx_t*)(ws + WS_SSQB)});
        GSYNC();
        { SchedN S{G, LCV, 4, 0, (const char*)(ws + WS_U), (const char*)(ws + WS_WM2), 4 * TILEB, ws, 4 * TILEB}; EpiEW<2> E{ws, p.out, (fx_t*)(ws + WS_SSQA)}; pg8::gemm_phase(wv, lds, pg8::Gemm{4096, 64, 4096, 4096}, S, E); }
        sgemm_phase<false>(wv, lds, (const bf16_t*)(ws + WS_U) + (size_t)NPT * 4096, (const bf16_t*)(ws + WS_WM2), 4096, 8 * 32, SEpiEW<2, false>{ws, p.out, (fx_t*)(ws + WS_SSQA)});
        GSYNC();
    }
    phase_final(wv, p);
}

extern "C" void kernel_launch(void* const* d_in, const int* in_sizes, int n_in, void* d_out, int out_size, void* d_ws, size_t ws_size, hipStream_t stream) {
    static int grid = 0;
    if (grid == 0) {
        if (n_in != 18 || ws_size < WS_END) { fprintf(stderr, "kernel_launch: unexpected n_in %d / ws_size %zu (need %zu)\n", n_in, ws_size, (size_t)WS_END); grid = -1; return; }
        int dev = 0, cus = 0, per_cu = 0;
        hipGetDevice(&dev); hipDeviceGetAttribute(&cus, hipDeviceAttributeMultiprocessorCount, dev);
        hipFuncSetAttribute((const void*)fwd_megakernel, hipFuncAttributeMaxDynamicSharedMemorySize, LDS_BYTES);
        hipOccupancyMaxActiveBlocksPerMultiprocessor(&per_cu, (const void*)fwd_megakernel, 512, LDS_BYTES);
        (void)hipGetLastError();
        if (per_cu < 1) per_cu = 1;
        grid = cus;
        fprintf(stderr, "kernel_launch: cus %d per_cu %d grid %d\n", cus, per_cu, grid);
    }
    if (grid < 0) return;
    if (hipMemsetAsync((char*)d_ws + WS_BAR, 0, 16384, stream) != hipSuccess) { fprintf(stderr, "memset failed\n"); return; }
    Params p{};
    for (int i = 0; i < 18; ++i) p.in[i] = (const float*)d_in[i];
    p.out = (float*)d_out; p.ws = (unsigned char*)d_ws;
    void* args[] = {&p};
    hipError_t e = hipLaunchCooperativeKernel((const void*)fwd_megakernel, dim3(grid), dim3(512), args, LDS_BYTES, stream);
    if (e != hipSuccess) fprintf(stderr, "cooperative launch failed: %s (grid %d)\n", hipGetErrorString(e), grid);
}
```

```cpp
#include <hip/hip_runtime.h>
#include <hip/hip_cooperative_groups.h>
#include <cstdio>
#include <cstdint>
namespace cg = cooperative_groups;

#define LAS __attribute__((address_space(3)))
typedef unsigned short bf16_t;
typedef short bf16x8 __attribute__((ext_vector_type(8)));
typedef float f32x4 __attribute__((ext_vector_type(4)));
typedef float f32x2 __attribute__((ext_vector_type(2)));
typedef float f32x16 __attribute__((ext_vector_type(16)));
typedef unsigned u32x4 __attribute__((ext_vector_type(4)));
typedef unsigned u32x2 __attribute__((ext_vector_type(2)));

constexpr int DM = 1024, SEQ = 8192, NPT = 16384, NTOK = 16640, DSEQ = 32, PAST = 4096;
constexpr int DFF = 4096, RV = 2048, CH = 256;
constexpr float RMS_EPS = 1e-6f, LN_EPS = 1e-5f;
constexpr size_t MiB = 1u << 20;
constexpr size_t TILEB = 256 * 1024 * 2;
constexpr size_t WS_STATF = 313 * MiB + MiB / 2;
constexpr size_t WS_SLOTS = 314 * MiB;
constexpr size_t WS_STATS = 313 * MiB;
constexpr size_t WS_BAR = 640 * 1024;
constexpr size_t WS_SSQA = 318 * MiB, WS_SSQB = 319 * MiB;
constexpr size_t WS_TAB = 1 * MiB;
constexpr size_t WS_WIN = 9 * MiB;
constexpr size_t WS_WC = 29 * MiB, WS_WR = 31 * MiB, WS_WO = 35 * MiB, WS_WM1 = 37 * MiB, WS_WM2 = 45 * MiB;
constexpr size_t WS_H = 53 * MiB;
constexpr size_t WS_Q = WS_H + 32 * MiB + MiB / 2;
constexpr size_t WS_KB0 = 118 * MiB, WS_KTB0 = 134 * MiB, WS_KB1 = 150 * MiB, WS_KTB1 = 166 * MiB, WS_KS = 182 * MiB, WS_KTS = WS_KS + MiB / 2;
constexpr size_t WS_VTB0 = 183 * MiB, WS_VTB1 = 215 * MiB, WS_VTS = 247 * MiB;
constexpr size_t WS_ATT = 248 * MiB;
constexpr size_t WS_S = 280 * MiB;
constexpr size_t WS_OS = 312 * MiB;
constexpr size_t WS_END = 320 * MiB;
constexpr size_t WS_GLU = WS_Q, WS_T = WS_Q, WS_U = WS_Q, WS_GC = WS_VTB0, WS_GR = WS_VTB0 + 32 * MiB + MiB / 2, WS_YC = WS_ATT;
constexpr size_t WS_OB0 = WS_KB0, WS_OB1 = WS_KB1;
static_assert(WS_Q == 85 * MiB + MiB / 2 && WS_Q + 32 * MiB + MiB / 2 == WS_KB0, "map");
static_assert(WS_U + (size_t)NTOK * DFF * 2 <= WS_END, "map");
constexpr size_t OUT_CONVP = 17039360, OUT_RETP = 17162240, OUT_CONVS = 19259392, OUT_RETS = 19750912;

struct Params { const float* in[18]; float* out; unsigned char* ws; };

typedef __bf16 bf16x2_t __attribute__((ext_vector_type(2)));
__device__ __forceinline__ unsigned cvt_pk_bf16(float lo, float hi) { const f32x2 v = {lo, hi}; return __builtin_bit_cast(unsigned, __builtin_convertvector(v, bf16x2_t)); }
__device__ __forceinline__ float bflo(unsigned w) { return __uint_as_float(w << 16); }
__device__ __forceinline__ float bfhi(unsigned w) { return __uint_as_float(w & 0xffff0000u); }
__device__ __forceinline__ float bf2f(bf16_t v) { return __uint_as_float((unsigned)v << 16); }
__device__ __forceinline__ float lgdec(int h) { return h == 0 ? -0.0317486983145803f : (h == 1 ? -0.015748356968139168f : (h == 2 ? -0.007843177461025893f : -0.003913899321136329f)); }
typedef unsigned long long fx_t;
constexpr float FX_SCALE = 16777216.0f, FX_INV = 1.0f / 16777216.0f;
__device__ __forceinline__ fx_t fx_of(float v) { return (fx_t)(long long)(v * FX_SCALE); }
__device__ __forceinline__ void fx_add(fx_t* p, float v) { atomicAdd(p, fx_of(v)); }
__device__ __forceinline__ float fx_get(fx_t v) { return (float)(long long)v * FX_INV; }
__device__ __forceinline__ float rstd_of(float ssq) { return __builtin_amdgcn_rsqf(ssq * (1.0f / 1024.0f) + RMS_EPS); }
__device__ __forceinline__ float sigm(float x) { return __builtin_amdgcn_rcpf(1.0f + __expf(-x)); }
__device__ __forceinline__ u32x4 pack8(const f32x4 a, const f32x4 b) { u32x4 w; w.x = cvt_pk_bf16(a[0], a[1]); w.y = cvt_pk_bf16(a[2], a[3]); w.z = cvt_pk_bf16(b[0], b[1]); w.w = cvt_pk_bf16(b[2], b[3]); return w; }
__device__ __forceinline__ void unpack8(const u32x4 w, f32x4& a, f32x4& b) { a = (f32x4){bflo(w.x), bfhi(w.x), bflo(w.y), bfhi(w.y)}; b = (f32x4){bflo(w.z), bfhi(w.z), bflo(w.w), bfhi(w.w)}; }
__device__ __forceinline__ int lane_id() { return (int)__builtin_amdgcn_mbcnt_hi(~0u, __builtin_amdgcn_mbcnt_lo(~0u, 0u)); }
__device__ __forceinline__ int gdim() { int g = (int)gridDim.x; asm volatile("" : "+s"(g)); return g; }
template <int K> __device__ __forceinline__ float shx(float v) {
    if constexpr (K < 32) return __builtin_bit_cast(float, __builtin_amdgcn_ds_swizzle(__builtin_bit_cast(int, v), (K << 10) | 0x1f));
    else { int l = lane_id(); asm volatile("" : "+v"(l)); return __builtin_bit_cast(float, __builtin_amdgcn_ds_bpermute((l ^ 32) << 2, __builtin_bit_cast(int, v))); }
}
__device__ __forceinline__ float wave_sum(float v) { v += shx<1>(v); v += shx<2>(v); v += shx<4>(v); v += shx<8>(v); v += shx<16>(v); v += shx<32>(v); return v; }

namespace pg8 {
constexpr int BM = 256, BK = 64, HALF = 128, HTB = HALF * BK * 2, STAGE_BYTES = 8 * HTB;
__host__ __device__ __forceinline__ int lds_byte(int r, int c) { const int st = (r >> 4) * 2 + (c >> 5), rr = r & 15, cc = c & 31, ob = rr * 64 + cc * 2; return st * 1024 + (ob ^ (((ob >> 9) & 1) << 5)); }
__host__ __device__ __forceinline__ void stage_rc(int b, int& R, int& C) { const int st = b / 1024, sb = b % 1024, swz = sb ^ (((sb >> 9) & 1) << 5); R = (st >> 1) * 16 + swz / 64; C = (st & 1) * 32 + (swz % 64) / 2; }
__host__ __device__ __forceinline__ int perm32(int rho) { const int n = rho >> 4, i = rho & 15; return 8 * (i >> 2) + 4 * n + (i & 3); }

struct Unit { const char* a; const char* b; long a2d, b2d; int kind, pm, pn, aux; };
struct Gemm { int K, nt1, lda, ldb; };

__device__ __forceinline__ void xcd_remap(int& wgid, int nwg) { const int q = nwg / 8, r = nwg % 8, xcd = wgid % 8, off = wgid / 8; wgid = (xcd < r ? xcd * (q + 1) : r * (q + 1) + (xcd - r) * q) + off; }
__device__ __forceinline__ void grp_decode(int wgid, int nM, int nN, int& pm, int& pn) { const int nig = 8 * nN, gid = wgid / nig, fm = gid * 8, gsz = (nM - fm) < 8 ? (nM - fm) : 8; pm = fm + ((wgid % nig) % gsz); pn = (wgid % nig) / gsz; }

template <class Epi, class Sched>
__device__ __forceinline__ void gemm_phase(int wv, LAS unsigned char* lds, const Gemm g, const Sched& S, const Epi& E) {
    int wv_ = wv; asm volatile("" : "+s"(wv_)); int tid = wv_ * 64 + lane_id(); asm volatile("" : "+v"(tid));
    const int wid = __builtin_amdgcn_readfirstlane(tid >> 6), lane = tid & 63, wr = wid >> 2, wc = wid & 3, fr = lane & 15, fq = lane >> 4;
    const int nt = g.K / BK, nt1 = g.nt1;
    unsigned voffA[2], voffB[2];
#pragma unroll
    for (int i = 0; i < 2; ++i) { int R, C; stage_rc(tid * 16 + i * 8192, R, C); const int Rb = (R & ~31) + perm32(R & 31);
        voffA[i] = (unsigned)(R * g.lda + C) * 2u; voffB[i] = (unsigned)(Rb * g.ldb + C) * 2u; }
    const size_t kstep = (size_t)(BK * 2);
    const size_t hstepA = (size_t)HALF * g.lda * 2, hstepB = (size_t)HALF * g.ldb * 2;
    const unsigned ldsw = (unsigned)wid * 1024u;
    const int aoff = lds_byte(wr * 64 + fr, fq * 8), boff = lds_byte(wc * 32 + fr, fq * 8);
#define PG8_SA(b, h) (((b) * 2 + (h)) * HTB)
#define PG8_SB(b, h) ((4 + (b) * 2 + (h)) * HTB)
#define PG8_STAGE(bufoff, gbase, voff) do { _Pragma("unroll") for (int _i = 0; _i < 2; ++_i) \
        __builtin_amdgcn_global_load_lds((const unsigned*)((const char*)(gbase) + (voff)[_i]), (LAS unsigned*)(lds + (bufoff) + ldsw + _i * 8192), 16, 0, 0); } while (0)
#define PG8_LDA(dst, b, h) do { _Pragma("unroll") for (int m = 0; m < 4; ++m) _Pragma("unroll") for (int k = 0; k < 2; ++k) dst[m][k] = *(const LAS bf16x8*)(lds + PG8_SA(b, h) + aoff + m * 2048 + k * 1024); } while (0)
#define PG8_LDB(dst, b, h) do { _Pragma("unroll") for (int n = 0; n < 2; ++n) _Pragma("unroll") for (int k = 0; k < 2; ++k) dst[n][k] = *(const LAS bf16x8*)(lds + PG8_SB(b, h) + boff + n * 2048 + k * 1024); } while (0)
#define PG8_MMA(ai, bj, At, Bt) do { __builtin_amdgcn_s_setprio(1); _Pragma("unroll") for (int m = 0; m < 4; ++m) _Pragma("unroll") for (int n = 0; n < 2; ++n) _Pragma("unroll") for (int k = 0; k < 2; ++k) \
        acc[ai][bj][m][n] = __builtin_amdgcn_mfma_f32_16x16x32_bf16(Bt[n][k], At[m][k], acc[ai][bj][m][n], 0, 0, 0); __builtin_amdgcn_s_setprio(0); } while (0)
#define PG8_WAIT_V(n) asm volatile("s_waitcnt vmcnt(" #n ")" ::: "memory")
#define PG8_WAIT_L(n) asm volatile("s_waitcnt lgkmcnt(" #n ")" ::: "memory")
#define PG8_BAR __builtin_amdgcn_s_barrier()
#define PG8_SCHED __builtin_amdgcn_sched_barrier(0)
#define PG8_TPA(u, t) ((u).a + (size_t)(t) * kstep + (((t) >= nt1) ? (u).a2d : 0l))
#define PG8_TPB(u, t) ((u).b + (size_t)(t) * kstep + (((t) >= nt1) ? (u).b2d : 0l))
    Unit cur, nxt; int ui = 0;
    if (!S.next(0, cur)) return;
    {
        const char* cA = cur.a; const char* cB = cur.b;
        PG8_STAGE(PG8_SB(0, 0), cB, voffB); PG8_STAGE(PG8_SB(0, 1), cB + hstepB, voffB); PG8_STAGE(PG8_SA(0, 0), cA, voffA); PG8_STAGE(PG8_SA(0, 1), cA + hstepA, voffA);
        if (wr == 1) PG8_BAR;
        PG8_WAIT_V(2); PG8_BAR;
        PG8_STAGE(PG8_SB(1, 0), cB + kstep, voffB); PG8_STAGE(PG8_SA(1, 0), cA + kstep, voffA); PG8_STAGE(PG8_SB(1, 1), cB + hstepB + kstep, voffB);
        PG8_WAIT_V(6); PG8_BAR;
    }
    f32x4 acc[2][2][4][2];
#pragma unroll
    for (int a = 0; a < 2; ++a)
#pragma unroll
        for (int b = 0; b < 2; ++b)
#pragma unroll
            for (int m = 0; m < 4; ++m)
#pragma unroll
                for (int n = 0; n < 2; ++n) acc[a][b][m][n] = (f32x4){0.f, 0.f, 0.f, 0.f};
    bf16x8 At[4][2], B0[2][2], B1[2][2];
#pragma unroll 1
    for (;;) {
        const bool has_next = S.next(ui + 1, nxt);
        if (!has_next) nxt = cur;
#pragma unroll 1
        for (int t = 0; t < nt; t += 2) {
            const bool last = (t == nt - 2);
            const char* a1 = PG8_TPA(cur, t + 1);
            const char* a2 = last ? PG8_TPA(nxt, 0) : PG8_TPA(cur, t + 2); const char* b2 = last ? PG8_TPB(nxt, 0) : PG8_TPB(cur, t + 2);
            const char* a3 = a2 + kstep; const char* b3 = b2 + kstep;
            PG8_LDB(B0, 0, 0); PG8_LDB(B1, 0, 1); PG8_SCHED; PG8_LDA(At, 0, 0); PG8_STAGE(PG8_SA(1, 1), a1 + hstepA, voffA);
            PG8_WAIT_V(8); PG8_WAIT_L(0); PG8_BAR; PG8_MMA(0, 0, At, B0); PG8_MMA(0, 1, At, B1); PG8_BAR; PG8_SCHED;
            PG8_LDA(At, 0, 1); PG8_STAGE(PG8_SB(0, 0), b2, voffB); PG8_STAGE(PG8_SB(0, 1), b2 + hstepB, voffB); PG8_STAGE(PG8_SA(0, 0), a2, voffA);
            PG8_WAIT_V(8); PG8_WAIT_L(0); PG8_BAR; PG8_MMA(1, 0, At, B0); PG8_MMA(1, 1, At, B1); PG8_BAR; PG8_SCHED;
            PG8_LDB(B0, 1, 0); PG8_LDB(B1, 1, 1); PG8_SCHED; PG8_LDA(At, 1, 0); PG8_STAGE(PG8_SA(0, 1), a2 + hstepA, voffA);
            PG8_WAIT_V(8); PG8_WAIT_L(0); PG8_BAR; PG8_MMA(0, 0, At, B0); PG8_MMA(0, 1, At, B1); PG8_BAR; PG8_SCHED;
            PG8_LDA(At, 1, 1); PG8_STAGE(PG8_SB(1, 0), b3, voffB); PG8_STAGE(PG8_SB(1, 1), b3 + hstepB, voffB); PG8_STAGE(PG8_SA(1, 0), a3, voffA);
            PG8_WAIT_V(8); PG8_WAIT_L(0); PG8_BAR; PG8_MMA(1, 0, At, B0); PG8_MMA(1, 1, At, B1); PG8_BAR; PG8_SCHED;
        }
        if (wr == 0) PG8_BAR;
        { int fr2 = fr, fq2 = fq; asm volatile("" : "+v"(fr2), "+v"(fq2)); E(acc, cur, wr, wc, fr2, fq2); }
        if (!has_next) break;
#pragma unroll
        for (int a = 0; a < 2; ++a)
#pragma unroll
            for (int b = 0; b < 2; ++b)
#pragma unroll
                for (int m = 0; m < 4; ++m)
#pragma unroll
                    for (int n = 0; n < 2; ++n) acc[a][b][m][n] = (f32x4){0.f, 0.f, 0.f, 0.f};
        cur = nxt; ++ui;
        if (wr == 1) PG8_BAR;
    }
    PG8_WAIT_V(0);
    PG8_BAR;
    asm volatile("s_waitcnt vmcnt(0) lgkmcnt(0)" ::: "memory");
    __syncthreads();
#undef PG8_SA
#undef PG8_SB
#undef PG8_STAGE
#undef PG8_LDA
#undef PG8_LDB
#undef PG8_MMA
#undef PG8_WAIT_V
#undef PG8_WAIT_L
#undef PG8_BAR
#undef PG8_SCHED
#undef PG8_TPA
#undef PG8_TPB
}
}
using pg8::Unit;

__device__ __forceinline__ bf16_t* k_tile(unsigned char* ws, int pm) { return (bf16_t*)(ws + (pm < 32 ? WS_KB0 + (size_t)pm * TILEB : (pm < 64 ? WS_KB1 + (size_t)(pm - 32) * TILEB : WS_KS))); }
__device__ __forceinline__ bf16_t* o_tile(unsigned char* ws, int pm) { return (bf16_t*)(ws + (pm < 32 ? WS_OB0 + (size_t)pm * 2 * TILEB : (pm < 64 ? WS_OB1 + (size_t)(pm - 32) * 2 * TILEB : WS_OS))); }

__device__ __forceinline__ bf16_t* s_head(unsigned char* ws, int b, int h) {
    const size_t off = b == 0 ? WS_S + (size_t)h * 8 * MiB : (h == 0 ? WS_TAB : (h == 1 ? WS_WC : (h == 2 ? WS_WM1 : WS_WM2)));
    return (bf16_t*)(ws + off);
}
struct SchedB1 {
    int G, c; const char* H; const char* W;
    __device__ __forceinline__ bool next(int i, Unit& u) const {
        const long L = (long)i * G + c; if (L >= 1024) return false;
        int wgid = (int)L; pg8::xcd_remap(wgid, 1024);
        { const int x = wgid >> 7, w = wgid & 127; wgid = w < 64 ? x * 64 + w : 512 + x * 64 + (w - 64); }
        u.a2d = 0; u.b2d = 0; u.aux = 0;
        if (wgid < 512) { pg8::grp_decode(wgid, 64, 8, u.pm, u.pn); u.kind = 0; u.a = H + (size_t)u.pm * TILEB; u.b = W + (size_t)u.pn * TILEB; }
        else { pg8::grp_decode(wgid - 512, 8, 64, u.pm, u.pn); u.pm += 4; u.kind = 1; u.a = W + (size_t)(4 + u.pm) * TILEB; u.b = H + (size_t)u.pn * TILEB; }
        return true;
    }
};
struct SchedN {
    int G, c, nN, amode; const char* A; const char* B; size_t bTile; unsigned char* ws; size_t aTile;
    __device__ __forceinline__ bool next(int i, Unit& u) const {
        const int nwg = 64 * nN; const long L = (long)i * G + c; if (L >= nwg) return false;
        int wgid = (int)L; pg8::xcd_remap(wgid, nwg); pg8::grp_decode(wgid, 64, nN, u.pm, u.pn);
        u.a2d = 0; u.b2d = 0; u.aux = 0; u.kind = 0;
        u.a = amode ? (const char*)o_tile(ws, u.pm) : A + (size_t)u.pm * aTile; u.b = B + (size_t)u.pn * bTile;
        return true;
    }
};
struct SchedAtt {
    int G, c; unsigned char* ws;
    __device__ __forceinline__ bool next(int i, Unit& u) const {
        const int L = i * G + c; if (L >= 256) return false;
        const int h = L & 3, j = (L >> 2) & 31, b = L >> 7;
        u.a2d = 0; u.b2d = 0; u.kind = 0; u.pm = j; u.pn = b; u.aux = h;
        u.a = (const char*)(ws + WS_Q) + ((size_t)(b * SEQ + j * CH) * 1024 + h * 256) * 2;
        u.b = (const char*)(ws + (b ? WS_KB1 : WS_KB0)) + ((size_t)(j * CH) * 1024 + h * 256) * 2;
        return true;
    }
};
struct SchedU {
    int G, c; unsigned char* ws;
    __device__ __forceinline__ bool next(int i, Unit& u) const {
        const int L = i * G + c; if (L >= 512) return false;
        const int pmt = L & 1, h = (L >> 1) & 3, j = (L >> 3) & 31, b = L >> 8;
        u.a2d = 0; u.b2d = 0; u.kind = b; u.pm = j; u.pn = 0; u.aux = h * 2 + pmt;
        u.a = (const char*)(ws + (b ? WS_VTB1 : WS_VTB0)) + ((size_t)(h * 512 + pmt * 256) * SEQ + j * CH) * 2;
        u.b = (const char*)(ws + (b ? WS_KTB1 : WS_KTB0)) + ((size_t)(h * 256) * SEQ + j * CH) * 2;
        return true;
    }
};
struct SchedE {
    int G, c; unsigned char* ws;
    __device__ __forceinline__ bool next(int i, Unit& u) const {
        const int L = i * G + c; if (L >= 512) return false;
        const int idx = L & 255, pnt = L >> 8, h = idx & 3, j = (idx >> 2) & 31, b = idx >> 7;
        u.kind = b; u.pm = j; u.pn = pnt; u.aux = h;
        const char* a1 = (const char*)(ws + WS_ATT) + ((size_t)(b * SEQ + j * CH) * 1024 + h * 256) * 2;
        const char* a2 = (const char*)(ws + WS_Q) + ((size_t)(b * SEQ + j * CH) * 1024 + h * 256) * 2;
        const char* b1 = (const char*)(ws + (b ? WS_VTB1 : WS_VTB0)) + ((size_t)(h * 512 + pnt * 256) * SEQ + j * CH) * 2;
        const char* b2 = (const char*)(s_head(ws, b, h) + (size_t)(pnt * 256) * SEQ + j * CH);
        u.a = a1; u.b = b1; u.a2d = (long)(a2 - a1) - 4 * 128; u.b2d = (long)(b2 - b1) - 4 * 128;
        return true;
    }
};

#define EPI_FENCE asm volatile("" ::: "memory")
#define EPI_ARGS const f32x4 (&acc)[2][2][4][2], const Unit& u, int wr, int wc, int fr, int fq
struct EpiB1 {
    unsigned char* ws;
    __device__ __forceinline__ void operator()(EPI_ARGS) const {
        const f32x2* tab = (const f32x2*)(ws + WS_TAB); const fx_t* ssq = (const fx_t*)(ws + WS_SSQA);
        if (u.kind == 0) {
            const int head = u.pn & 3; const bool isk = u.pn >= 4;
            bf16_t* dst = isk ? k_tile(ws, u.pm) : (bf16_t*)(ws + WS_Q) + (size_t)u.pm * 256 * 1024;
            const float sc = isk ? 0.0625f : 1.0f;
            const __amdgpu_buffer_rsrc_t ktr = __builtin_amdgcn_make_buffer_rsrc((void*)(ws + (u.pm < 32 ? WS_KTB0 : WS_KTB1)), (short)0, (int)(16 * MiB), 0x00020000);
            const int d0 = wc * 32 + fq * 8;
#pragma unroll
            for (int aih = 0; aih < 2; ++aih) {
                const int ai = aih, mb = 0;
                f32x4 tb[4][4]; float rsq[4];
#pragma unroll
                for (int m = mb; m < mb + 4; ++m) {
                    const int row = ai * 128 + wr * 64 + m * 16 + fr;
                    const int pos = u.pm < 64 ? ((u.pm & 31) * 256 + row) : (PAST + (row & 31));
                    const f32x4* tp = (const f32x4*)(tab + (size_t)pos * 128 + d0);
                    tb[m][0] = tp[0]; tb[m][1] = tp[1]; tb[m][2] = tp[2]; tb[m][3] = tp[3];
                    rsq[m] = fx_get(ssq[(size_t)u.pm * 256 + row]);
                }
                EPI_FENCE;
#pragma unroll
                for (int m = mb; m < mb + 4; ++m) {
                    const int row = ai * 128 + wr * 64 + m * 16 + fr;
                    const f32x4 c01 = tb[m][0], c23 = tb[m][1], c45 = tb[m][2], c67 = tb[m][3];
                    const f32x4 cs0 = (f32x4){c01[0], c01[2], c23[0], c23[2]}, sn0 = (f32x4){c01[1], c01[3], c23[1], c23[3]};
                    const f32x4 cs1 = (f32x4){c45[0], c45[2], c67[0], c67[2]}, sn1 = (f32x4){c45[1], c45[3], c67[1], c67[3]};
                    const f32x4 x1a = acc[ai][0][m][0], x1b = acc[ai][0][m][1], x2a = acc[ai][1][m][0], x2b = acc[ai][1][m][1];
                    const float scr_ = sc * rstd_of(rsq[m]);
                    const f32x4 o1a = (x1a * cs0 - x2a * sn0) * scr_, o1b = (x1b * cs1 - x2b * sn1) * scr_;
                    const f32x4 o2a = (x2a * cs0 + x1a * sn0) * scr_, o2b = (x2b * cs1 + x1b * sn1) * scr_;
                    bf16_t* rp = dst + (size_t)row * 1024 + head * 256 + d0;
                    *(u32x4*)rp = pack8(o1a, o1b); *(u32x4*)(rp + 128) = pack8(o2a, o2b);
                    if (isk) {
                        const float dk = __expf(lgdec(head) * (float)(CH - 1 - (row & (CH - 1))));
                        const unsigned voff = (unsigned)((d0 * SEQ + row) * 2);
                        const unsigned sbase = (unsigned)(((head * 256) * SEQ + (u.pm & 31) * 256) * 2);
                        const u32x4 t1 = pack8(o1a * dk, o1b * dk);
#pragma unroll
                        for (int jj = 0; jj < 4; ++jj) {
                            __builtin_amdgcn_raw_buffer_store_b16((short)(t1[jj] & 0xffffu), ktr, voff, sbase + (unsigned)(2 * jj) * SEQ * 2u, 0);
                            __builtin_amdgcn_raw_buffer_store_b16((short)(t1[jj] >> 16), ktr, voff, sbase + (unsigned)(2 * jj + 1) * SEQ * 2u, 0); }
                        const u32x4 t2 = pack8(o2a * dk, o2b * dk);
#pragma unroll
                        for (int jj = 0; jj < 4; ++jj) {
                            __builtin_amdgcn_raw_buffer_store_b16((short)(t2[jj] & 0xffffu), ktr, voff, sbase + (unsigned)(128 + 2 * jj) * SEQ * 2u, 0);
                            __builtin_amdgcn_raw_buffer_store_b16((short)(t2[jj] >> 16), ktr, voff, sbase + (unsigned)(129 + 2 * jj) * SEQ * 2u, 0); }
                    }
                }
                EPI_FENCE;
            }
        } else {
            bf16_t* dst; int ld;
            if (u.pn < 32) { dst = (bf16_t*)(ws + WS_VTB0) + (size_t)u.pn * 256; ld = SEQ; }
            else if (u.pn < 64) { dst = (bf16_t*)(ws + WS_VTB1) + (size_t)(u.pn - 32) * 256; ld = SEQ; }
            else { dst = (bf16_t*)(ws + WS_VTS); ld = 256; }
            f32x4 rsv[2][2];
#pragma unroll
            for (int bj = 0; bj < 2; ++bj) { const fx_t* sp8 = ssq + (size_t)u.pn * 256 + bj * 128 + wc * 32 + fq * 8;
#pragma unroll
                for (int n = 0; n < 2; ++n) rsv[bj][n] = (f32x4){rstd_of(fx_get(sp8[4 * n])), rstd_of(fx_get(sp8[4 * n + 1])), rstd_of(fx_get(sp8[4 * n + 2])), rstd_of(fx_get(sp8[4 * n + 3]))}; }
#pragma unroll
            for (int ai = 0; ai < 2; ++ai)
#pragma unroll
                for (int m = 0; m < 4; ++m) {
                    const int e = (u.pm - 4) * 256 + ai * 128 + wr * 64 + m * 16 + fr;
                    bf16_t* rp = dst + (size_t)e * ld + wc * 32 + fq * 8;
#pragma unroll
                    for (int bj = 0; bj < 2; ++bj) *(u32x4*)(rp + bj * 128) = pack8(acc[ai][bj][m][0] * rsv[bj][0], acc[ai][bj][m][1] * rsv[bj][1]);
                    EPI_FENCE;
                }
        }
    }
};
struct EpiAtt {
    unsigned char* ws;
    __device__ __forceinline__ void operator()(EPI_ARGS) const {
        const int h = u.aux; const float lg = lgdec(h);
        bf16_t* dst = (bf16_t*)(ws + WS_ATT) + (size_t)(u.pn * SEQ + u.pm * CH) * 1024 + h * 256;
        float cf[2][8];
#pragma unroll
        for (int bj = 0; bj < 2; ++bj)
#pragma unroll
            for (int j = 0; j < 8; ++j) cf[bj][j] = __expf(-lg * (float)(bj * 128 + wc * 32 + fq * 8 + j + 1));
#pragma unroll
        for (int ai = 0; ai < 2; ++ai)
#pragma unroll
            for (int m = 0; m < 4; ++m) {
                const int n = ai * 128 + wr * 64 + m * 16 + fr;
#pragma unroll
                for (int bj = 0; bj < 2; ++bj) {
                    const int m0 = bj * 128 + wc * 32 + fq * 8;
                    float o[8];
#pragma unroll
                    for (int j = 0; j < 8; ++j) o[j] = __uint_as_float(__float_as_uint(acc[ai][bj][m][j >> 2][j & 3] * cf[bj][j]) & ~(unsigned)((n - m0 - j) >> 31));
                    *(u32x4*)(dst + (size_t)n * 1024 + m0) = pack8((f32x4){o[0], o[1], o[2], o[3]}, (f32x4){o[4], o[5], o[6], o[7]});
                }
                EPI_FENCE;
            }
    }
};
struct EpiU {
    unsigned char* ws;
    __device__ __forceinline__ void operator()(EPI_ARGS) const {
        bf16_t* dst = s_head(ws, u.kind, u.aux >> 1) + (size_t)((u.aux & 1) * 256) * SEQ + u.pm * CH;
#pragma unroll
        for (int ai = 0; ai < 2; ++ai)
#pragma unroll
            for (int m = 0; m < 4; ++m) {
                bf16_t* rp = dst + (size_t)(ai * 128 + wr * 64 + m * 16 + fr) * SEQ + wc * 32 + fq * 8;
#pragma unroll
                for (int bj = 0; bj < 2; ++bj) *(u32x4*)(rp + bj * 128) = pack8(acc[ai][bj][m][0], acc[ai][bj][m][1]);
                    EPI_FENCE;
            }
    }
};
struct EpiE {
    unsigned char* ws;
    __device__ __forceinline__ void operator()(EPI_ARGS) const {
        const int h = u.aux, b = u.kind; const float lg = lgdec(h);
        bf16_t* dst = (bf16_t*)(ws + (b ? WS_OB1 : WS_OB0)) + (size_t)(u.pm * CH) * 2048 + h * 512 + u.pn * 256;
        float* sl = (float*)(ws + WS_SLOTS) + (size_t)blockIdx.x * 4096 + (u.pn * 4 + wc) * 2;
#pragma unroll
        for (int ai = 0; ai < 2; ++ai)
#pragma unroll
            for (int m = 0; m < 4; ++m) {
                const int n = ai * 128 + wr * 64 + m * 16 + fr; const float rs = __expf(lg * (float)(n + 1));
                float s = 0.f, q = 0.f;
#pragma unroll
                for (int bj = 0; bj < 2; ++bj) {
                    const f32x4 v0 = acc[ai][bj][m][0] * rs, v1 = acc[ai][bj][m][1] * rs;
                    s += (v0[0] + v0[1]) + (v0[2] + v0[3]) + (v1[0] + v1[1]) + (v1[2] + v1[3]);
                    q += (v0[0] * v0[0] + v0[1] * v0[1]) + (v0[2] * v0[2] + v0[3] * v0[3]) + (v1[0] * v1[0] + v1[1] * v1[1]) + (v1[2] * v1[2] + v1[3] * v1[3]);
                    *(u32x4*)(dst + (size_t)n * 2048 + bj * 128 + wc * 32 + fq * 8) = pack8(v0, v1);
                }
                s += shx<16>(s); s += shx<32>(s); q += shx<16>(q); q += shx<32>(q);
                if (fq == 0) *(f32x2*)(sl + (size_t)n * 16) = (f32x2){s, q};
                EPI_FENCE;
            }
    }
};
struct EpiB2 {
    unsigned char* ws; const float* gn_g;
    __device__ __forceinline__ void operator()(EPI_ARGS) const {
        const fx_t* ssq = (const fx_t*)(ws + WS_SSQA) + (size_t)u.pm * 256;
        float rsr[2][4];
#pragma unroll
        for (int ai = 0; ai < 2; ++ai)
#pragma unroll
            for (int m = 0; m < 4; ++m) rsr[ai][m] = fx_get(ssq[ai * 128 + wr * 64 + m * 16 + fr]);
#pragma unroll
        for (int ai = 0; ai < 2; ++ai)
#pragma unroll
            for (int m = 0; m < 4; ++m) rsr[ai][m] = rstd_of(rsr[ai][m]);
        if (u.pn < 8) {
            bf16_t* dst = (bf16_t*)(ws + WS_GLU) + (size_t)u.pm * 256 * 1024 + u.pn * 128 + wc * 32 + fq * 8;
#pragma unroll
            for (int ai = 0; ai < 2; ++ai)
#pragma unroll
                for (int m = 0; m < 4; ++m) {
                    const int row = ai * 128 + wr * 64 + m * 16 + fr;
                    const float rs = rsr[ai][m];
                    f32x4 a0 = acc[ai][0][m][0] * rs, a1 = acc[ai][0][m][1] * rs; const f32x4 b0 = acc[ai][1][m][0] * rs, b1 = acc[ai][1][m][1] * rs;
#pragma unroll
                    for (int j = 0; j < 4; ++j) { a0[j] *= sigm(b0[j]); a1[j] *= sigm(b1[j]); }
                    *(u32x4*)(dst + (size_t)row * 1024) = pack8(a0, a1);
                    EPI_FENCE;
                }
        } else if (u.pn < 16) {
            const int t = u.pn - 8, head = t >> 1;
            bf16_t* ob = o_tile(ws, u.pm) + t * 256 + wc * 32 + fq * 8;
            const float* st = (const float*)(ws + WS_STATF) + (size_t)u.pm * 256 * 8 + head * 2;
            f32x4 gg[2][2];
#pragma unroll
            for (int bj = 0; bj < 2; ++bj) { const f32x4* gp = (const f32x4*)(gn_g + t * 256 + bj * 128 + wc * 32 + fq * 8); gg[bj][0] = gp[0]; gg[bj][1] = gp[1]; }
#pragma unroll
            for (int aih = 0; aih < 4; ++aih) {
                const int ai = aih >> 1, mb = (aih & 1) * 2;
                f32x2 sqv[4]; u32x4 ov[4][2];
#pragma unroll
                for (int m = mb; m < mb + 2; ++m) {
                    const int row = ai * 128 + wr * 64 + m * 16 + fr;
                    sqv[m] = *(const f32x2*)(st + (size_t)row * 8);
#pragma unroll
                    for (int bj = 0; bj < 2; ++bj) ov[m][bj] = *(const u32x4*)(ob + (size_t)row * 2048 + bj * 128);
                }
                EPI_FENCE;
#pragma unroll
                for (int m = mb; m < mb + 2; ++m) {
                    const int row = ai * 128 + wr * 64 + m * 16 + fr;
                    const f32x2 sq = sqv[m]; const float rsn = rsr[ai][m];
                    const float mu = sq.x * (1.0f / 512.0f); const float var = fmaxf(sq.y * (1.0f / 512.0f) - mu * mu, 0.f); const float rstd = __builtin_amdgcn_rsqf(var + LN_EPS);
#pragma unroll
                    for (int bj = 0; bj < 2; ++bj) {
                        bf16_t* rp = ob + (size_t)row * 2048 + bj * 128;
                        f32x4 o0, o1; unpack8(ov[m][bj], o0, o1);
                        f32x4 g0 = acc[ai][bj][m][0] * rsn, g1 = acc[ai][bj][m][1] * rsn;
#pragma unroll
                        for (int j = 0; j < 4; ++j) { g0[j] = g0[j] * sigm(g0[j]) * ((o0[j] - mu) * rstd * gg[bj][0][j]); g1[j] = g1[j] * sigm(g1[j]) * ((o1[j] - mu) * rstd * gg[bj][1][j]); }
                        *(u32x4*)rp = pack8(g0, g1);
                    }
                }
                EPI_FENCE;
            }
        } else {
            const int t = (u.pn - 16) & 3;
            bf16_t* dst = (bf16_t*)(ws + (u.pn < 20 ? WS_GC : WS_GR)) + (size_t)u.pm * 256 * 1024 + t * 256 + wc * 32 + fq * 8;
#pragma unroll
            for (int ai = 0; ai < 2; ++ai)
#pragma unroll
                for (int m = 0; m < 4; ++m) {
                    const int row = ai * 128 + wr * 64 + m * 16 + fr; const float rs = rsr[ai][m];
#pragma unroll
                    for (int bj = 0; bj < 2; ++bj) {
                        f32x4 a0 = acc[ai][bj][m][0] * rs, a1 = acc[ai][bj][m][1] * rs;
#pragma unroll
                        for (int j = 0; j < 4; ++j) { a0[j] = sigm(a0[j]); a1[j] = sigm(a1[j]); }
                        *(u32x4*)(dst + (size_t)row * 1024 + bj * 128) = pack8(a0, a1);
                    }
                    EPI_FENCE;
                }
        }
    }
};
template <int MODE> struct EpiEW {
    unsigned char* ws; float* x; fx_t* ssq;
    __device__ __forceinline__ void operator()(EPI_ARGS) const {
        const int c0 = u.pn * 256 + wc * 32 + fq * 8;
#pragma unroll
        for (int ai = 0; ai < 2; ++ai) {
            u32x4 gv[4][2], tv[4][2]; float sqs[4] = {0.f, 0.f, 0.f, 0.f}, rs3[4];
            if (MODE == 3) {
#pragma unroll
                for (int m = 0; m < 4; ++m) rs3[m] = rstd_of(fx_get(ssq[(size_t)u.pm * 256 + ai * 128 + wr * 64 + m * 16 + fr]));
            }
            if (MODE != 3) {
#pragma unroll
                for (int m = 0; m < 4; ++m) {
                    const size_t row = (size_t)u.pm * 256 + ai * 128 + wr * 64 + m * 16 + fr;
#pragma unroll
                    for (int bj = 0; bj < 2; ++bj) {
                        if (MODE == 0) gv[m][bj] = *(const u32x4*)((const bf16_t*)(ws + WS_GC) + row * 1024 + c0 + bj * 128);
                        if (MODE == 1) { gv[m][bj] = *(const u32x4*)((const bf16_t*)(ws + WS_GR) + row * 1024 + c0 + bj * 128); tv[m][bj] = *(const u32x4*)((const bf16_t*)(ws + WS_T) + row * 1024 + c0 + bj * 128); }
                        if (MODE == 2) tv[m][bj] = *(const u32x4*)((const bf16_t*)(ws + WS_H) + row * 1024 + c0 + bj * 128);
                    }
                }
                EPI_FENCE;
            }
#pragma unroll
            for (int m = 0; m < 4; ++m) {
                const size_t row = (size_t)u.pm * 256 + ai * 128 + wr * 64 + m * 16 + fr;
#pragma unroll
                for (int bj = 0; bj < 2; ++bj) {
                    f32x4 a0 = acc[ai][bj][m][0], a1 = acc[ai][bj][m][1];
                    if (MODE == 0) {
                        f32x4 g0, g1; unpack8(gv[m][bj], g0, g1);
                        *(u32x4*)((bf16_t*)(ws + WS_T) + row * 1024 + c0 + bj * 128) = pack8(a0 * g0, a1 * g1);
                    } else if (MODE == 1) {
                        f32x4 g0, g1, t0, t1; unpack8(gv[m][bj], g0, g1); unpack8(tv[m][bj], t0, t1);
                        *(u32x4*)((bf16_t*)(ws + WS_T) + row * 1024 + c0 + bj * 128) = pack8(t0 + a0 * g0, t1 + a1 * g1);
                    } else if (MODE == 2) {
                        f32x4 x0, x1; unpack8(tv[m][bj], x0, x1);
                        a0 = x0 + a0; a1 = x1 + a1;
                        *(u32x4*)((bf16_t*)(ws + WS_H) + row * 1024 + c0 + bj * 128) = pack8(a0, a1);
                        sqs[m] += (a0[0] * a0[0] + a0[1] * a0[1]) + (a0[2] * a0[2] + a0[3] * a0[3]) + (a1[0] * a1[0] + a1[1] * a1[1]) + (a1[2] * a1[2] + a1[3] * a1[3]);
                    } else {
#pragma unroll
                        for (int j = 0; j < 4; ++j) { const float r0 = fmaxf(a0[j], 0.f) * rs3[m], r1 = fmaxf(a1[j], 0.f) * rs3[m]; a0[j] = r0 * r0; a1[j] = r1 * r1; }
                        *(u32x4*)((bf16_t*)(ws + WS_U) + row * 4096 + c0 + bj * 128) = pack8(a0, a1);
                    }
                }
                if (MODE == 2) { float q = sqs[m]; q += shx<16>(q); q += shx<32>(q); if (fq == 0) fx_add(ssq + row, q); }
            }
            EPI_FENCE;
        }
    }
};

__device__ __forceinline__ void transpose_item(const float* W, int K, int N, bf16_t* WT, int k0, int n0, int drow0, LAS float* scr, int lane, const float* gk = nullptr) {
    float tv[32];
#pragma unroll
    for (int i = 0; i < 32; ++i) { const int kk = 2 * i + (lane >> 5); tv[i] = W[(size_t)(k0 + kk) * N + n0 + (lane & 31)]; }
#pragma unroll
    for (int i = 0; i < 32; ++i) { const int kk = 2 * i + (lane >> 5); scr[kk * 33 + (lane & 31)] = gk ? tv[i] * gk[k0 + kk] : tv[i]; }
    asm volatile("s_waitcnt lgkmcnt(0)" ::: "memory");
    const int c = lane & 7;
#pragma unroll
    for (int j = 0; j < 4; ++j) { const int n = (lane >> 3) + 8 * j; const LAS float* s = scr + (8 * c) * 33 + n;
        u32x4 o; o.x = cvt_pk_bf16(s[0 * 33], s[1 * 33]); o.y = cvt_pk_bf16(s[2 * 33], s[3 * 33]); o.z = cvt_pk_bf16(s[4 * 33], s[5 * 33]); o.w = cvt_pk_bf16(s[6 * 33], s[7 * 33]);
        *(u32x4*)(WT + (size_t)(drow0 + n) * K + k0 + 8 * c) = o; }
    asm volatile("s_waitcnt lgkmcnt(0)" ::: "memory");
}
struct TItem { const float* W; const float* gk; bf16_t* WT; int K, N, k0, n0, drow0; };
__device__ __forceinline__ void titem_load(const TItem& t, int lane, float (&tv)[32], f32x4& g0, f32x4& g1) {
#pragma unroll
    for (int i = 0; i < 32; ++i) { const int kk = 2 * i + (lane >> 5); tv[i] = t.W[(size_t)(t.k0 + kk) * t.N + t.n0 + (lane & 31)]; }
    g0 = (f32x4){1.f, 1.f, 1.f, 1.f}; g1 = g0;
    if (t.gk) { const f32x4* gp = (const f32x4*)(t.gk + t.k0 + 8 * (lane & 7)); g0 = gp[0]; g1 = gp[1]; }
}
__device__ __forceinline__ void titem_store(const TItem& t, int lane, const float (&tv)[32], const f32x4 g0, const f32x4 g1, LAS float* scr) {
#pragma unroll
    for (int i = 0; i < 32; ++i) { const int kk = 2 * i + (lane >> 5); scr[kk * 33 + (lane & 31)] = tv[i]; }
    asm volatile("s_waitcnt lgkmcnt(0)" ::: "memory");
    const int c = lane & 7;
#pragma unroll
    for (int j = 0; j < 4; ++j) { const int n = (lane >> 3) + 8 * j; const LAS float* sp = scr + (8 * c) * 33 + n;
        u32x4 o; o.x = cvt_pk_bf16(sp[0 * 33] * g0[0], sp[1 * 33] * g0[1]); o.y = cvt_pk_bf16(sp[2 * 33] * g0[2], sp[3 * 33] * g0[3]);
        o.z = cvt_pk_bf16(sp[4 * 33] * g1[0], sp[5 * 33] * g1[1]); o.w = cvt_pk_bf16(sp[6 * 33] * g1[2], sp[7 * 33] * g1[3]);
        *(u32x4*)(t.WT + (size_t)(t.drow0 + n) * t.K + t.k0 + 8 * c) = o; }
    asm volatile("s_waitcnt lgkmcnt(0)" ::: "memory");
}
__device__ __forceinline__ int win_drow(int n0) {
    if (n0 < 2048) { const int bj = n0 >> 10, jj = n0 & 1023; return 4096 + 256 * (jj >> 7) + 128 * bj + (jj & 127); }
    if (n0 < 6144) return n0 - 2048;
    return n0;
}
__device__ __forceinline__ void rms_row(const float* xrow, const float* g, bf16_t* orow, float* copy, int lane) {
    const f32x4* xr = (const f32x4*)xrow + lane; const f32x4* gr = (const f32x4*)g + lane;
    f32x4 v[4]; float s = 0.f;
#pragma unroll
    for (int j = 0; j < 4; ++j) { v[j] = xr[64 * j]; s += (v[j][0] * v[j][0] + v[j][1] * v[j][1]) + (v[j][2] * v[j][2] + v[j][3] * v[j][3]); }
    const float r = 1.0f / sqrtf(wave_sum(s) * (1.0f / 1024.0f) + RMS_EPS);
    u32x2* o8 = (u32x2*)orow + lane;
#pragma unroll
    for (int j = 0; j < 4; ++j) { const f32x4 gg = gr[64 * j]; if (copy) ((f32x4*)copy + lane)[64 * j] = v[j];
        u32x2 w; w.x = cvt_pk_bf16(v[j][0] * r * gg[0], v[j][1] * r * gg[1]); w.y = cvt_pk_bf16(v[j][2] * r * gg[2], v[j][3] * r * gg[3]); o8[64 * j] = w; }
}

__device__ __forceinline__ void phase0(int wv, const Params& p, int l, LAS unsigned char* lds, int part) {
    int wv_ = wv; asm volatile("" : "+s"(wv_)); int tid = wv_ * 64 + lane_id(); asm volatile("" : "+v"(tid));
    const int lane = tid & 63, wave = tid >> 6, G = gdim();
    const int gw = blockIdx.x * 8 + wave, NGW = G * 8;
    unsigned char* ws = p.ws;
    LAS float* scr = (LAS float*)(lds + wave * 16384);
    const float* w_in = p.in[5] + (size_t)l * 1024 * 10240; const float* w_c = p.in[10] + (size_t)l * 1024 * 1024; const float* w_r = p.in[12] + (size_t)l * 2048 * 1024;
    const float* w_o = p.in[13] + (size_t)l * 1024 * 1024; const float* w_1 = p.in[15] + (size_t)l * 1024 * 4096; const float* w_2 = p.in[16] + (size_t)l * 4096 * 1024;
    constexpr int I_IN = 16 * 320, I_C = 16 * 32, I_R = 32 * 32, I_O = 16 * 32, I_1 = 16 * 128, I_2 = 64 * 32, NIT = I_IN + I_C + I_R + I_O + I_1 + I_2;
#define TI_DECODE(it_, T_) do { int r = (it_); \
        if (r < I_IN) { const int kb = r / 320, nb = r % 320; T_ = TItem{w_in, p.in[4] + l * 1024, (bf16_t*)(ws + WS_WIN), 1024, 10240, kb * 64, nb * 32, win_drow(nb * 32)}; break; } r -= I_IN; \
        if (r < I_C) { const int kb = r / 32, nb = r % 32; T_ = TItem{w_c, nullptr, (bf16_t*)(ws + WS_WC), 1024, 1024, kb * 64, nb * 32, nb * 32}; break; } r -= I_C; \
        if (r < I_R) { const int kb = r / 32, nb = r % 32; T_ = TItem{w_r, nullptr, (bf16_t*)(ws + WS_WR), 2048, 1024, kb * 64, nb * 32, nb * 32}; break; } r -= I_R; \
        if (r < I_O) { const int kb = r / 32, nb = r % 32; T_ = TItem{w_o, nullptr, (bf16_t*)(ws + WS_WO), 1024, 1024, kb * 64, nb * 32, nb * 32}; break; } r -= I_O; \
        if (r < I_1) { const int kb = r / 128, nb = r % 128; T_ = TItem{w_1, p.in[14] + l * 1024, (bf16_t*)(ws + WS_WM1), 1024, 4096, kb * 64, nb * 32, nb * 32}; break; } r -= I_1; \
        { const int kb = r / 32, nb = r % 32; T_ = TItem{w_2, nullptr, (bf16_t*)(ws + WS_WM2), 4096, 1024, kb * 64, nb * 32, nb * 32}; } } while (0)
    const int it_first = part == 0 ? 0 : I_IN, it_last = part == 0 ? I_IN : NIT;
    if (it_first + gw < it_last) {
        int it = it_first + gw; TItem cur; TI_DECODE(it, cur);
        float tv[32]; f32x4 g0, g1; titem_load(cur, lane, tv, g0, g1);
#pragma unroll 1
        for (;;) {
            const int nit = it + NGW; const bool has = nit < it_last;
            TItem nx = cur; float tn[32]; f32x4 h0 = g0, h1 = g1;
            if (has) { TI_DECODE(nit, nx); titem_load(nx, lane, tn, h0, h1); }
            titem_store(cur, lane, tv, g0, g1, scr);
            if (!has) break;
            cur = nx; it = nit; g0 = h0; g1 = h1;
#pragma unroll
            for (int i = 0; i < 32; ++i) tv[i] = tn[i];
        }
    }
#undef TI_DECODE
    if (part != 0) { asm volatile("s_waitcnt vmcnt(0) lgkmcnt(0)" ::: "memory"); __syncthreads(); return; }
    if (l == 0) {
        for (int m = gw; m < NTOK; m += NGW) {
            const float* src = m < NPT ? p.in[0] + (size_t)m * 1024 : p.in[1] + (size_t)(m - NPT) * 1024;
            const f32x4* xr = (const f32x4*)src + lane; f32x4 v[4]; float sq = 0.f;
#pragma unroll
            for (int j = 0; j < 4; ++j) { v[j] = xr[64 * j]; sq += (v[j][0] * v[j][0] + v[j][1] * v[j][1]) + (v[j][2] * v[j][2] + v[j][3] * v[j][3]); }
            sq = wave_sum(sq);
            u32x2* o8 = (u32x2*)((bf16_t*)(ws + WS_H) + (size_t)m * 1024) + lane;
#pragma unroll
            for (int j = 0; j < 4; ++j) { u32x2 wv; wv.x = cvt_pk_bf16(v[j][0], v[j][1]); wv.y = cvt_pk_bf16(v[j][2], v[j][3]); o8[64 * j] = wv; }
            if (lane == 0) ((fx_t*)(ws + WS_SSQA))[m] = fx_of(sq);
        }
    }
    { unsigned z = 0u; asm volatile("" : "+v"(z)); unsigned* sb = (unsigned*)(ws + WS_SSQB); for (int i = blockIdx.x * 512 + tid; i < NTOK * 2; i += G * 512) sb[i] = z; }
    { unsigned z = 0u; asm volatile("" : "+v"(z)); unsigned* st = (unsigned*)(ws + WS_STATS); for (int i = blockIdx.x * 512 + tid; i < 256 * 16; i += G * 512) st[i] = z; }
    {
        f32x2* tab = (f32x2*)(ws + WS_TAB);
        for (int i = blockIdx.x * 512 + tid; i < 8192 * 128; i += G * 512) {
            const int pos = i >> 7, k = i & 127;
            const float inv = powf(10000.0f, -(float)(2 * k) / 256.0f); const float ang = (float)pos * inv;
            float sn, cs; sincosf(ang, &sn, &cs); tab[i] = (f32x2){cs, sn};
        }
    }
}

__device__ __forceinline__ void phase_scan(int wv, const Params& p, int l) {
    int wv_ = wv; asm volatile("" : "+s"(wv_)); int tid = wv_ * 64 + lane_id(); asm volatile("" : "+v"(tid));
    const int gt = blockIdx.x * 512 + tid;
    if (gt >= 2048 * 64) return;
    const int row = gt >> 6, d4 = (gt & 63) * 4, h = row >> 9, e = row & 511;
    const float sd = __expf(lgdec(h) * (float)CH);
#pragma unroll 1
    for (int b = 0; b < 2; ++b) {
        bf16_t* sp = s_head(p.ws, b, h) + (size_t)e * SEQ + d4;
        float a[4] = {0.f, 0.f, 0.f, 0.f};
#pragma unroll 1
        for (int j0 = 0; j0 < 32; j0 += 16) {
            u32x2 w[16];
#pragma unroll
            for (int j = 0; j < 16; ++j) w[j] = *(const u32x2*)(sp + (j0 + j) * CH);
#pragma unroll
            for (int j = 0; j < 16; ++j) {
                u32x2 o; o.x = cvt_pk_bf16(a[0], a[1]); o.y = cvt_pk_bf16(a[2], a[3]);
                *(u32x2*)(sp + (j0 + j) * CH) = o;
                a[0] = a[0] * sd + bflo(w[j].x); a[1] = a[1] * sd + bfhi(w[j].x); a[2] = a[2] * sd + bflo(w[j].y); a[3] = a[3] * sd + bfhi(w[j].y);
            }
        }
        float* o = p.out + OUT_RETP + ((size_t)((l * 2 + b) * 4 + h) * 256 + d4) * 512 + e;
#pragma unroll
        for (int j = 0; j < 4; ++j) o[(size_t)j * 512] = a[j];
    }
}

__device__ __forceinline__ void phase_sret(int wv, const Params& p, int l, LAS unsigned char* lds) {
    int wv_ = wv; asm volatile("" : "+s"(wv_)); int tid = wv_ * 64 + lane_id(); asm volatile("" : "+v"(tid));
    const int lane = tid & 63, w = __builtin_amdgcn_readfirstlane(tid >> 6);
    unsigned char* ws = p.ws;
    LAS float* attL = (LAS float*)lds;
    LAS float* red = (LAS float*)(lds + 8192);
    for (int unit = blockIdx.x, GG = gdim(); unit < 256; unit += GG) {
        const int es = unit & 7, h = (unit >> 3) & 3, bs = unit >> 5;
        const float lg = lgdec(h);
        const bf16_t* q = (const bf16_t*)(ws + WS_Q) + (size_t)(NPT + bs * 32) * 1024 + h * 256;
        const bf16_t* k = (const bf16_t*)(ws + WS_KS) + (size_t)(bs * 32) * 1024 + h * 256;
        const bf16_t* kT = (const bf16_t*)(ws + WS_KTS) + (size_t)(h * 256) * 256 + bs * 32;
        const bf16_t* vT = (const bf16_t*)(ws + WS_VTS) + (size_t)(h * 512 + es * 64) * 256 + bs * 32;
        if (w == 0) {
            f32x16 accq;
#pragma unroll
            for (int r = 0; r < 16; ++r) accq[r] = 0.f;
            const bf16_t* qa = q + (size_t)(lane & 31) * 1024 + (lane >> 5) * 8; const bf16_t* kb = k + (size_t)(lane & 31) * 1024 + (lane >> 5) * 8;
#pragma unroll
            for (int sk = 0; sk < 16; ++sk) { const bf16x8 af = *(const bf16x8*)(qa + 16 * sk), bfr = *(const bf16x8*)(kb + 16 * sk); accq = __builtin_amdgcn_mfma_f32_32x32x16_bf16(af, bfr, accq, 0, 0, 0); }
            const int m = lane & 31;
#pragma unroll
            for (int r = 0; r < 16; ++r) { const int n = (r & 3) + 8 * (r >> 2) + 4 * (lane >> 5); attL[n * 33 + m] = (m <= n) ? accq[r] * __expf(lg * (float)(n - m)) : 0.f; }
        }
        const int e = es * 64 + lane;
        const float* S0 = p.in[3] + ((size_t)((l * 8 + bs) * 4 + h) * 256 + w * 32) * 512 + e;
        float s0[32];
#pragma unroll
        for (int dd = 0; dd < 32; ++dd) s0[dd] = S0[(size_t)dd * 512];
        float v[32];
        { const u32x4* vp = (const u32x4*)(vT + (size_t)lane * 256);
#pragma unroll
          for (int c = 0; c < 4; ++c) { f32x4 a, b2; unpack8(vp[c], a, b2); v[8 * c] = a[0]; v[8 * c + 1] = a[1]; v[8 * c + 2] = a[2]; v[8 * c + 3] = a[3]; v[8 * c + 4] = b2[0]; v[8 * c + 5] = b2[1]; v[8 * c + 6] = b2[2]; v[8 * c + 7] = b2[3]; } }
        {
            float* So = p.out + OUT_RETS + ((size_t)((l * 8 + bs) * 4 + h) * 256 + w * 32) * 512 + e;
            const float sd = __expf(lg * 32.0f);
#pragma unroll 4
            for (int dd = 0; dd < 32; ++dd) {
                const u32x4* kr = (const u32x4*)(kT + (size_t)(w * 32 + dd) * 256); float a = s0[dd] * sd;
#pragma unroll
                for (int c4 = 0; c4 < 4; ++c4) { f32x4 k0, k1; unpack8(kr[c4], k0, k1);
                    a += (k0[0] * v[8 * c4] + k0[1] * v[8 * c4 + 1]) + (k0[2] * v[8 * c4 + 2] + k0[3] * v[8 * c4 + 3]) + (k1[0] * v[8 * c4 + 4] + k1[1] * v[8 * c4 + 5]) + (k1[2] * v[8 * c4 + 6] + k1[3] * v[8 * c4 + 7]); }
                So[(size_t)dd * 512] = a;
            }
        }
#pragma unroll 2
        for (int n = 0; n < 32; ++n) {
            const u32x4* qr = (const u32x4*)(q + (size_t)n * 1024 + w * 32); float a = 0.f;
#pragma unroll
            for (int c4 = 0; c4 < 4; ++c4) { f32x4 k0, k1; unpack8(qr[c4], k0, k1);
                a += (k0[0] * s0[8 * c4] + k0[1] * s0[8 * c4 + 1]) + (k0[2] * s0[8 * c4 + 2] + k0[3] * s0[8 * c4 + 3]) + (k1[0] * s0[8 * c4 + 4] + k1[1] * s0[8 * c4 + 5]) + (k1[2] * s0[8 * c4 + 6] + k1[3] * s0[8 * c4 + 7]); }
            red[(w * 32 + n) * 64 + lane] = a * __expf(lg * (float)(n + 1));
        }
        __syncthreads();
        bf16_t* O = (bf16_t*)(ws + WS_OS) + (size_t)(bs * 32) * 2048 + h * 512 + e;
        fx_t* st = (fx_t*)(ws + WS_STATS) + (size_t)(bs * 32) * 8 + h * 2;
#pragma unroll
        for (int r = 0; r < 4; ++r) {
            const int n = w * 4 + r; float a = 0.f;
#pragma unroll
            for (int ww = 0; ww < 8; ++ww) a += red[(ww * 32 + n) * 64 + lane];
#pragma unroll
            for (int m = 0; m < 32; ++m) a += attL[n * 33 + m] * v[m];
            O[(size_t)n * 2048] = (bf16_t)(cvt_pk_bf16(a, 0.f) & 0xffffu);
            const float s = wave_sum(a), qq = wave_sum(a * a);
            if (lane == 0) { fx_add(st + (size_t)n * 8, s); fx_add(st + (size_t)n * 8 + 1, qq); }
        }
        __syncthreads();
    }
}

__device__ __forceinline__ void phase_conv(int wv, const Params& p, int l, LAS unsigned char* lds) {
    int wv_ = wv; asm volatile("" : "+s"(wv_)); int tid = wv_ * 64 + lane_id(); asm volatile("" : "+v"(tid));
    const int lane = tid & 63, wave = tid >> 6;
    unsigned char* ws = p.ws;
    LAS float* red = (LAS float*)lds;
    const int c0 = tid * 2;
    const float* cw = p.in[6] + (size_t)l * 31 * 1024 + c0;
    float w0[31], w1[31];
#pragma unroll
    for (int j = 0; j < 31; ++j) { const f32x2 t = *(const f32x2*)(cw + (size_t)j * 1024); w0[j] = t.x; w1[j] = t.y; }
    const f32x2 cb = *(const f32x2*)(p.in[7] + l * 1024 + c0), lg = *(const f32x2*)(p.in[8] + l * 1024 + c0), lb = *(const f32x2*)(p.in[9] + l * 1024 + c0);
    const int GG = gdim();
    { unsigned z = 0u; asm volatile("" : "+v"(z)); unsigned* sa = (unsigned*)(ws + WS_SSQA); for (int i = blockIdx.x * 512 + tid; i < NTOK * 2; i += GG * 512) sa[i] = z; }
    for (int tok = blockIdx.x; tok < 256; tok += GG) {
        const int sb = tok >> 5, t = tok & 31;
        const bf16_t* gl = (const bf16_t*)(ws + WS_GLU) + (size_t)(NPT + sb * 32) * 1024 + c0;
        const float* cst = p.in[2] + (size_t)(l * 8 + sb) * 30 * 1024 + c0;
        unsigned xg[31]; f32x2 xs[31];
#pragma unroll
        for (int j = 0; j < 31; ++j) { const int tt = t + j - 30; const int tg = tt < 0 ? 0 : tt, tsx = tt + 30 > 29 ? 29 : tt + 30;
            xg[j] = *(const unsigned*)(gl + (size_t)tg * 1024); xs[j] = *(const f32x2*)(cst + (size_t)tsx * 1024); }
        float a0 = cb.x, a1 = cb.y;
#pragma unroll
        for (int j = 0; j < 31; ++j) { const bool fromg = (t + j - 30) >= 0; const float x0 = fromg ? bflo(xg[j]) : xs[j].x, x1 = fromg ? bfhi(xg[j]) : xs[j].y; a0 += x0 * w0[j]; a1 += x1 * w1[j]; }
        if (t >= 2) *(f32x2*)(p.out + OUT_CONVS + ((size_t)(l * 8 + sb) * 30 + (t - 2)) * 1024 + c0) = (f32x2){bflo(xg[30]), bfhi(xg[30])};
        { const float s = wave_sum(a0 + a1), q = wave_sum(a0 * a0 + a1 * a1); if (lane == 0) { red[wave] = s; red[128 + wave] = q; } }
        __syncthreads();
        { float s = 0.f, q = 0.f;
#pragma unroll
          for (int ww = 0; ww < 8; ++ww) { s += red[ww]; q += red[128 + ww]; }
          const float mu = s * (1.0f / 1024.0f); const float var = fmaxf(q * (1.0f / 1024.0f) - mu * mu, 0.f); const float rstd = __builtin_amdgcn_rsqf(var + LN_EPS);
          float y0 = (a0 - mu) * rstd * lg.x + lb.x, y1 = (a1 - mu) * rstd * lg.y + lb.y; y0 *= sigm(y0); y1 *= sigm(y1);
          *(unsigned*)((bf16_t*)(ws + WS_YC) + (size_t)(NPT + tok) * 1024 + c0) = cvt_pk_bf16(y0, y1); }
        __syncthreads();
    }
    for (int unit = blockIdx.x; unit < NPT / 16; unit += GG) {
        const int g0 = unit * 16, t0 = g0 & (SEQ - 1), pb = g0 >> 13;
        const bool lastt = (t0 == SEQ - 16);
        const bf16_t* gl = (const bf16_t*)(ws + WS_GLU) + (size_t)g0 * 1024 + c0;
        float* cso = p.out + OUT_CONVP + (size_t)(l * 2 + pb) * 30 * 1024 + c0;
        unsigned xin[46];
#pragma unroll
        for (int r = 0; r < 46; ++r) { const int tt = t0 - 30 + r; const long off = tt >= 0 ? (long)(r - 30) : 0l; xin[r] = *(const unsigned*)(gl + off * 1024); if (tt < 0) xin[r] = 0u; }
        float a0[16], a1[16];
#pragma unroll
        for (int t = 0; t < 16; ++t) { a0[t] = cb.x; a1[t] = cb.y; }
#pragma unroll
        for (int r = 0; r < 46; ++r) {
            const float x0 = bflo(xin[r]), x1 = bfhi(xin[r]);
            if (r >= 16 && lastt) *(f32x2*)(cso + (size_t)(r - 16) * 1024) = (f32x2){x0, x1};
#pragma unroll
            for (int t = 0; t < 16; ++t) { const int j = r - t; if (j >= 0 && j <= 30) { a0[t] += x0 * w0[j]; a1[t] += x1 * w1[j]; } }
        }
#pragma unroll
        for (int t = 0; t < 16; ++t) { const float s = wave_sum(a0[t] + a1[t]), q = wave_sum(a0[t] * a0[t] + a1[t] * a1[t]); if (lane == 0) { red[t * 8 + wave] = s; red[128 + t * 8 + wave] = q; } }
        __syncthreads();
        bf16_t* yo = (bf16_t*)(ws + WS_YC) + (size_t)g0 * 1024 + c0;
#pragma unroll
        for (int t = 0; t < 16; ++t) { float s = 0.f, q = 0.f;
#pragma unroll
            for (int ww = 0; ww < 8; ++ww) { s += red[t * 8 + ww]; q += red[128 + t * 8 + ww]; }
            const float mu = s * (1.0f / 1024.0f); const float var = fmaxf(q * (1.0f / 1024.0f) - mu * mu, 0.f);
            const float rstd = __builtin_amdgcn_rsqf(var + LN_EPS);
            float y0 = (a0[t] - mu) * rstd * lg.x + lb.x, y1 = (a1[t] - mu) * rstd * lg.y + lb.y;
            y0 *= sigm(y0); y1 *= sigm(y1);
            *(unsigned*)(yo + (size_t)t * 1024) = cvt_pk_bf16(y0, y1); }
        __syncthreads();
    }
}

__device__ __forceinline__ void phase_rms2(int wv, const Params& p, int l) {
    int wv_ = wv; asm volatile("" : "+s"(wv_)); int tid = wv_ * 64 + lane_id(); asm volatile("" : "+v"(tid));
    const int lane = tid & 63, gw = blockIdx.x * 8 + (tid >> 6), NGW = gdim() * 8;
    const float* g2 = p.in[14] + l * 1024;
    for (int m = gw; m < NTOK; m += NGW) rms_row(p.out + (size_t)m * 1024, g2, (bf16_t*)(p.ws + WS_H) + (size_t)m * 1024, nullptr, lane);
}
__device__ __forceinline__ void phase_final(int wv, const Params& p) {
    int wv_ = wv; asm volatile("" : "+s"(wv_)); int tid = wv_ * 64 + lane_id(); asm volatile("" : "+v"(tid));
    const int lane = tid & 63, gw = blockIdx.x * 8 + (tid >> 6), NGW = gdim() * 8;
    const f32x4* gr = (const f32x4*)p.in[17] + lane; const fx_t* ssq = (const fx_t*)(p.ws + WS_SSQA);
    for (int m = gw; m < NTOK; m += NGW) {
        f32x4* yr = (f32x4*)(p.out + (size_t)m * 1024) + lane; const u32x2* xr = (const u32x2*)((const bf16_t*)(p.ws + WS_H) + (size_t)m * 1024) + lane; const float r = rstd_of(fx_get(ssq[m]));
#pragma unroll
        for (int j = 0; j < 4; ++j) { const u32x2 w = xr[64 * j]; const f32x4 xv = {bflo(w.x), bfhi(w.x), bflo(w.y), bfhi(w.y)}; yr[64 * j] = xv * r * gr[64 * j]; }
    }
}

struct SPre { fx_t f0, f1, f2; unsigned u0, u1, u2, u3; f32x2 g0, g1; };
#define SG_BAR() do { asm volatile("s_waitcnt lgkmcnt(0)" ::: "memory"); __builtin_amdgcn_s_barrier(); asm volatile("" ::: "memory"); } while (0)
template <bool PAIR, class EpiS>
__device__ __forceinline__ void sgemm_phase(int wv, LAS unsigned char* lds, const bf16_t* A, const bf16_t* Wt, int K, int nUnits, const EpiS& epi) {
    int wv_ = wv; asm volatile("" : "+s"(wv_)); int tid = wv_ * 64 + lane_id(); asm volatile("" : "+v"(tid));
    const int lane = tid & 63, w = __builtin_amdgcn_readfirstlane(tid >> 6);
    LAS float* red = (LAS float*)lds;
    const int kw = K >> 3, GG = gdim();
    const size_t loff = (size_t)(lane & 31) * K + w * kw + (lane >> 5) * 8;
    const int row = tid >> 4, jq = tid & 15;
    int unit = blockIdx.x;
    if (unit >= nUnits) return;
#define SG_PTRS(u_) const int rb_ = (u_) & 7, cp_ = (u_) >> 3, n0_ = PAIR ? ((cp_ >> 2) * 256 + (cp_ & 3) * 32) : cp_ * 32; \
        const bf16_t* ap = A + (size_t)(rb_ * 32) * K + loff; const bf16_t* bp0 = Wt + (size_t)n0_ * K + loff; const bf16_t* bp1 = bp0 + (size_t)128 * K;
#define SG_REDUCE(u_, pr_) do { \
        _Pragma("unroll") for (int r = 0; r < 16; ++r) { const int i = (r & 3) + 8 * (r >> 2) + 4 * (lane >> 5); \
            red[(w * 32 + i) * 64 + (lane & 31)] = acc0[r]; if (PAIR) red[(w * 32 + i) * 64 + 32 + (lane & 31)] = acc1[r]; } \
        SG_BAR(); \
        const int rbq = (u_) & 7, cpq = (u_) >> 3, n0q = PAIR ? ((cpq >> 2) * 256 + (cpq & 3) * 32) : cpq * 32; \
        float x1[2] = {0.f, 0.f}, x2[2] = {0.f, 0.f}; \
        _Pragma("unroll") for (int ww = 0; ww < 8; ++ww) { const f32x2 p0 = *(const LAS f32x2*)(red + (ww * 32 + row) * 64 + 2 * jq); x1[0] += p0.x; x1[1] += p0.y; \
            if (PAIR) { const f32x2 p1 = *(const LAS f32x2*)(red + (ww * 32 + row) * 64 + 32 + 2 * jq); x2[0] += p1.x; x2[1] += p1.y; } } \
        epi(rbq * 32 + row, n0q + 2 * jq, x1, x2, pr_); \
        SG_BAR(); } while (0)
    if (K == 1024) {
        bf16x8 ra[8], rb0[8], rb1[8];
        { SG_PTRS(unit)
#pragma unroll
          for (int s = 0; s < 8; ++s) { ra[s] = *(const bf16x8*)(ap + 16 * s); rb0[s] = *(const bf16x8*)(bp0 + 16 * s); if (PAIR) rb1[s] = *(const bf16x8*)(bp1 + 16 * s); } }
#pragma unroll 1
        for (;;) {
            f32x16 acc0, acc1;
#pragma unroll
            for (int r = 0; r < 16; ++r) { acc0[r] = 0.f; acc1[r] = 0.f; }
#pragma unroll
            for (int s = 0; s < 8; ++s) { acc0 = __builtin_amdgcn_mfma_f32_32x32x16_bf16(ra[s], rb0[s], acc0, 0, 0, 0); if (PAIR) acc1 = __builtin_amdgcn_mfma_f32_32x32x16_bf16(ra[s], rb1[s], acc1, 0, 0, 0); }
            const int cur = unit; unit += GG; const bool has = unit < nUnits;
            SPre pr; { const int rbc = cur & 7, cpc = cur >> 3, n0c = PAIR ? ((cpc >> 2) * 256 + (cpc & 3) * 32) : cpc * 32; pr = epi.pre(rbc * 32 + row, n0c + 2 * jq); }
            if (has) { SG_PTRS(unit)
#pragma unroll
                for (int s = 0; s < 8; ++s) { ra[s] = *(const bf16x8*)(ap + 16 * s); rb0[s] = *(const bf16x8*)(bp0 + 16 * s); if (PAIR) rb1[s] = *(const bf16x8*)(bp1 + 16 * s); } }
            SG_REDUCE(cur, pr);
            if (!has) break;
        }
    } else {
#pragma unroll 1
        for (; unit < nUnits; unit += GG) {
            SG_PTRS(unit)
            const SPre pr = epi.pre(rb_ * 32 + row, n0_ + 2 * jq);
            f32x16 acc0, acc1;
#pragma unroll
            for (int r = 0; r < 16; ++r) { acc0[r] = 0.f; acc1[r] = 0.f; }
#pragma unroll 8
            for (int ks = 0; ks < kw; ks += 16) {
                const bf16x8 a = *(const bf16x8*)(ap + ks), b0 = *(const bf16x8*)(bp0 + ks);
                acc0 = __builtin_amdgcn_mfma_f32_32x32x16_bf16(a, b0, acc0, 0, 0, 0);
                if (PAIR) { const bf16x8 b1 = *(const bf16x8*)(bp1 + ks); acc1 = __builtin_amdgcn_mfma_f32_32x32x16_bf16(a, b1, acc1, 0, 0, 0); }
            }
            SG_REDUCE(unit, pr);
        }
    }
    asm volatile("s_waitcnt vmcnt(0) lgkmcnt(0)" ::: "memory");
    __syncthreads();
#undef SG_PTRS
#undef SG_REDUCE
}
#define SEPI_ARGS int rl, int n, const float (&x1)[2], const float (&x2)[2]
struct SEpiB1 {
    unsigned char* ws;
    __device__ __forceinline__ SPre pre(int rl, int n) const {
        SPre p_{}; p_.f0 = ((const fx_t*)(ws + WS_SSQA))[NPT + rl];
        const f32x2* tab = (const f32x2*)(ws + WS_TAB); const int d = n & 127, pos = PAST + (rl & 31);
        p_.g0 = tab[(size_t)pos * 128 + d]; p_.g1 = tab[(size_t)pos * 128 + d + 1];
        return p_;
    }
    __device__ __forceinline__ void operator()(int rl, int n, const float (&y1)[2], const float (&y2)[2], const SPre& pr) const {
        const float rs_ = rstd_of(fx_get(pr.f0));
        const float x1[2] = {y1[0] * rs_, y1[1] * rs_}, x2[2] = {y2[0] * rs_, y2[1] * rs_};
        if (n < 2048) {
            const int head = (n >> 8) & 3, d = n & 255;
            const f32x2 c0 = pr.g0, c1 = pr.g1;
            float o1[2], o2[2];
            o1[0] = x1[0] * c0.x - x2[0] * c0.y; o2[0] = x2[0] * c0.x + x1[0] * c0.y;
            o1[1] = x1[1] * c1.x - x2[1] * c1.y; o2[1] = x2[1] * c1.x + x1[1] * c1.y;
            if (n < 1024) {
                bf16_t* q = (bf16_t*)(ws + WS_Q) + (size_t)(NPT + rl) * 1024 + head * 256 + d;
                *(unsigned*)q = cvt_pk_bf16(o1[0], o1[1]); *(unsigned*)(q + 128) = cvt_pk_bf16(o2[0], o2[1]);
            } else {
                bf16_t* k = (bf16_t*)(ws + WS_KS) + (size_t)rl * 1024 + head * 256 + d;
                *(unsigned*)k = cvt_pk_bf16(o1[0] * 0.0625f, o1[1] * 0.0625f); *(unsigned*)(k + 128) = cvt_pk_bf16(o2[0] * 0.0625f, o2[1] * 0.0625f);
                const float dec = 0.0625f * __expf(lgdec(head) * (float)(DSEQ - 1 - (rl & 31)));
                bf16_t* kt = (bf16_t*)(ws + WS_KTS) + (size_t)(head * 256 + d) * 256 + rl;
                const unsigned wa = cvt_pk_bf16(o1[0] * dec, o1[1] * dec), wb = cvt_pk_bf16(o2[0] * dec, o2[1] * dec);
                kt[0] = (bf16_t)(wa & 0xffffu); kt[256] = (bf16_t)(wa >> 16); kt[128 * 256] = (bf16_t)(wb & 0xffffu); kt[129 * 256] = (bf16_t)(wb >> 16);
            }
        } else {
            bf16_t* vt = (bf16_t*)(ws + WS_VTS) + (size_t)(n - 2048) * 256 + rl;
            const unsigned wa = cvt_pk_bf16(x1[0], x1[1]), wb = cvt_pk_bf16(x2[0], x2[1]);
            vt[0] = (bf16_t)(wa & 0xffffu); vt[256] = (bf16_t)(wa >> 16); vt[128 * 256] = (bf16_t)(wb & 0xffffu); vt[129 * 256] = (bf16_t)(wb >> 16);
        }
    }
};
struct SEpiB2 {
    unsigned char* ws; const float* gn_g;
    __device__ __forceinline__ SPre pre(int rl, int n) const {
        SPre p_{}; p_.f0 = ((const fx_t*)(ws + WS_SSQA))[NPT + rl];
        const int col = (n - 2048) & 2047, head = col >> 9;
        const fx_t* sp2 = (const fx_t*)(ws + WS_STATS) + (size_t)rl * 8 + head * 2; p_.f1 = sp2[0]; p_.f2 = sp2[1];
        const bf16_t* o = (const bf16_t*)(ws + WS_OS) + (size_t)rl * 2048 + col; p_.u0 = *(const unsigned*)o; p_.u1 = *(const unsigned*)(o + 128);
        p_.g0 = *(const f32x2*)(gn_g + col); p_.g1 = *(const f32x2*)(gn_g + col + 128);
        return p_;
    }
    __device__ __forceinline__ void operator()(int rl, int n, const float (&y1)[2], const float (&y2)[2], const SPre& pr) const {
        const float rs_ = rstd_of(fx_get(pr.f0));
        const float x1[2] = {y1[0] * rs_, y1[1] * rs_}, x2[2] = {y2[0] * rs_, y2[1] * rs_};
        if (n < 2048) {
            bf16_t* o = (bf16_t*)(ws + WS_GLU) + (size_t)(NPT + rl) * 1024 + (n >> 8) * 128 + (n & 127);
            *(unsigned*)o = cvt_pk_bf16(x1[0] * sigm(x2[0]), x1[1] * sigm(x2[1]));
        } else if (n < 4096) {
            const int col = n - 2048, head = col >> 9;
            const f32x2 sq = {fx_get(pr.f1), fx_get(pr.f2)};
            const float mu = sq.x * (1.0f / 512.0f); const float var = fmaxf(sq.y * (1.0f / 512.0f) - mu * mu, 0.f); const float rstd = __builtin_amdgcn_rsqf(var + LN_EPS);
            bf16_t* o = (bf16_t*)(ws + WS_OS) + (size_t)rl * 2048 + col;
            const unsigned oa = pr.u0, ob = pr.u1;
            const f32x2 ga = pr.g0, gb = pr.g1;
            *(unsigned*)o = cvt_pk_bf16(x1[0] * sigm(x1[0]) * ((bflo(oa) - mu) * rstd * ga.x), x1[1] * sigm(x1[1]) * ((bfhi(oa) - mu) * rstd * ga.y));
            *(unsigned*)(o + 128) = cvt_pk_bf16(x2[0] * sigm(x2[0]) * ((bflo(ob) - mu) * rstd * gb.x), x2[1] * sigm(x2[1]) * ((bfhi(ob) - mu) * rstd * gb.y));
        } else {
            bf16_t* o = (bf16_t*)(ws + (n < 5120 ? WS_GC : WS_GR)) + (size_t)(NPT + rl) * 1024 + ((n - 4096) & 1023);
            *(unsigned*)o = cvt_pk_bf16(sigm(x1[0]), sigm(x1[1])); *(unsigned*)(o + 128) = cvt_pk_bf16(sigm(x2[0]), sigm(x2[1]));
        }
    }
};
template <int MODE, bool PAIR> struct SEpiEW {
    unsigned char* ws; float* x; fx_t* ssq;
    __device__ __forceinline__ SPre pre(int rl, int n) const {
        SPre p_{}; const size_t row = (size_t)(NPT + rl);
        if (MODE == 0) { const bf16_t* g = (const bf16_t*)(ws + WS_GC) + row * 1024 + n; p_.u0 = *(const unsigned*)g; if (PAIR) p_.u1 = *(const unsigned*)(g + 128); }
        else if (MODE == 1) { const bf16_t* g = (const bf16_t*)(ws + WS_GR) + row * 1024 + n; const bf16_t* t = (const bf16_t*)(ws + WS_T) + row * 1024 + n;
            p_.u0 = *(const unsigned*)g; p_.u2 = *(const unsigned*)t; if (PAIR) { p_.u1 = *(const unsigned*)(g + 128); p_.u3 = *(const unsigned*)(t + 128); } }
        else if (MODE == 2) { const bf16_t* xb = (const bf16_t*)(ws + WS_H) + row * 1024 + n; p_.u0 = *(const unsigned*)xb; if (PAIR) p_.u1 = *(const unsigned*)(xb + 128); }
        else p_.f0 = ssq[row];
        return p_;
    }
    __device__ __forceinline__ void operator()(SEPI_ARGS, const SPre& pr) const {
        const size_t row = (size_t)(NPT + rl);
        if (MODE == 0) {
            bf16_t* t = (bf16_t*)(ws + WS_T) + row * 1024 + n;
            const unsigned ga = pr.u0, gb = pr.u1;
            *(unsigned*)t = cvt_pk_bf16(x1[0] * bflo(ga), x1[1] * bfhi(ga)); if (PAIR) *(unsigned*)(t + 128) = cvt_pk_bf16(x2[0] * bflo(gb), x2[1] * bfhi(gb));
        } else if (MODE == 1) {
            bf16_t* t = (bf16_t*)(ws + WS_T) + row * 1024 + n;
            const unsigned ga = pr.u0, gb = pr.u1, ta = pr.u2, tb = pr.u3;
            *(unsigned*)t = cvt_pk_bf16(bflo(ta) + x1[0] * bflo(ga), bfhi(ta) + x1[1] * bfhi(ga)); if (PAIR) *(unsigned*)(t + 128) = cvt_pk_bf16(bflo(tb) + x2[0] * bflo(gb), bfhi(tb) + x2[1] * bfhi(gb));
        } else if (MODE == 2) {
            bf16_t* xb = (bf16_t*)(ws + WS_H) + row * 1024 + n; const unsigned xa = pr.u0, xc = PAIR ? pr.u1 : 0u;
            f32x2 a = {bflo(xa) + x1[0], bfhi(xa) + x1[1]}, b = {bflo(xc) + x2[0], bfhi(xc) + x2[1]};
            *(unsigned*)xb = cvt_pk_bf16(a.x, a.y); if (PAIR) *(unsigned*)(xb + 128) = cvt_pk_bf16(b.x, b.y);
            float q = a.x * a.x + a.y * a.y; if (PAIR) q += b.x * b.x + b.y * b.y;
            q += shx<1>(q); q += shx<2>(q); q += shx<4>(q); q += shx<8>(q);
            if ((lane_id() & 15) == 0) fx_add(ssq + row, q);
        } else {
            bf16_t* u = (bf16_t*)(ws + WS_U) + row * 4096 + n;
            const float r3 = rstd_of(fx_get(pr.f0));
            const float a0 = fmaxf(x1[0], 0.f) * r3, a1 = fmaxf(x1[1], 0.f) * r3, b0 = fmaxf(x2[0], 0.f) * r3, b1 = fmaxf(x2[1], 0.f) * r3;
            *(unsigned*)u = cvt_pk_bf16(a0 * a0, a1 * a1); if (PAIR) *(unsigned*)(u + 128) = cvt_pk_bf16(b0 * b0, b1 * b1);
        }
    }
};

#define XB_TMO      128
#define XB_XCNT(j)  (256  + 64 * (j))
#define XB_XSUB(j)  (1280 + 64 * (j))
#define XB_XGEN(j)  (2304 + 64 * (j))
#define XB_TOP      3328
#define XB_TOPGEN   3392
#define XCD_BAR_WORDS 3456
#define XB_SPIN_CAP (1u << 18)

__device__ __forceinline__ unsigned xb_ld(unsigned* p)              { return __hip_atomic_load(p, __ATOMIC_RELAXED, __HIP_MEMORY_SCOPE_AGENT); }
__device__ __forceinline__ unsigned xb_add(unsigned* p, unsigned v) { return __hip_atomic_fetch_add(p, v, __ATOMIC_RELAXED, __HIP_MEMORY_SCOPE_AGENT); }
__device__ __forceinline__ unsigned xb_xcc_id() { return (unsigned)__builtin_amdgcn_s_getreg((3 << 11) | 20) & 0xFu; }
#define XB_SPIN(cond, bar) do { unsigned _sp = 0; while (cond) { __builtin_amdgcn_s_sleep(1); \
    if ((++_sp & 255u) == 0u) { if (xb_ld(&(bar)[XB_TMO])) break; if (_sp > XB_SPIN_CAP) { atomicAdd(&(bar)[XB_TMO], 1u); break; } } } } while (0)

struct XcdBarrier {
    unsigned* bar; unsigned x;
    volatile LAS unsigned* st;
};

__device__ __forceinline__ XcdBarrier xcd_barrier_post(unsigned* bar, volatile LAS unsigned* st, int wv) {
    XcdBarrier b; b.bar = bar; b.x = xb_xcc_id(); b.st = st;
    if (wv == 0 && lane_id() == 0) (void)xb_add(&bar[XB_XCNT(b.x)], 1u);
    return b;
}
__device__ __forceinline__ void xcd_barrier_complete(unsigned* bar, unsigned x, unsigned& nloc, unsigned& nx) {
    const unsigned G = gridDim.x * gridDim.y * gridDim.z;
    unsigned sum, cnt, mine, sp = 0u;
    for (;;) {
        sum = 0u; cnt = 0u; mine = 0u;
#pragma unroll
        for (unsigned j = 0; j < 16; ++j) { const unsigned c = xb_ld(&bar[XB_XCNT(j)]); sum += c; cnt += (c > 0u) ? 1u : 0u; mine = (j == x) ? c : mine; }
        if (sum == G) break;
        __builtin_amdgcn_s_sleep(1);
        if ((++sp & 255u) == 0u) { if (xb_ld(&bar[XB_TMO])) break; if (sp > XB_SPIN_CAP) { atomicAdd(&bar[XB_TMO], 1u); break; } }
    }
    nloc = mine > 0u ? mine : 1u; nx = cnt > 0u ? cnt : 1u;
}

__device__ __forceinline__ void xcd_barrier(const XcdBarrier& b, int wv) {
    asm volatile("s_waitcnt vmcnt(0)" ::: "memory");
    __syncthreads();
    if (wv == 0 && lane_id() == 0) {
        unsigned* bar = b.bar;
        __builtin_amdgcn_s_waitcnt(0);
        unsigned nloc = b.st[0], nx = b.st[1];
        if (nloc == 0u) { xcd_barrier_complete(bar, b.x, nloc, nx); b.st[0] = nloc; b.st[1] = nx; }
        const unsigned old = xb_add(&bar[XB_XSUB(b.x)], 1u);
        const unsigned gen = old / nloc;
        if (old + 1u == (gen + 1u) * nloc) {
            __builtin_amdgcn_fence(__ATOMIC_RELEASE, "agent");
            asm volatile("s_waitcnt vmcnt(0)" ::: "memory");
            const unsigned og = xb_add(&bar[XB_TOP], 1u);
            const unsigned tg = og / nx;
            if (og + 1u == (tg + 1u) * nx) xb_add(&bar[XB_TOPGEN], 1u);
            else XB_SPIN(xb_ld(&bar[XB_TOPGEN]) == tg, bar);
            __builtin_amdgcn_fence(__ATOMIC_ACQUIRE, "agent");
            xb_add(&bar[XB_XGEN(b.x)], 1u);
            asm volatile("s_waitcnt vmcnt(0)" ::: "memory");
        } else {
            XB_SPIN(xb_ld(&bar[XB_XGEN(b.x)]) == gen, bar);
            __builtin_amdgcn_fence(__ATOMIC_ACQUIRE, "agent");
            asm volatile("s_waitcnt vmcnt(0)" ::: "memory");
        }
    }
    __syncthreads();
}


constexpr int LDS_BYTES = 131072 + 4096;
#define LCV ({ int c_ = (int)blockIdx.x; asm volatile("" : "+s"(c_)); c_; })
__global__ void __launch_bounds__(512, 2) fwd_megakernel(Params p) {
    extern __shared__ __attribute__((aligned(16))) unsigned char lds_raw[];
    LAS unsigned char* lds = (LAS unsigned char*)lds_raw;
    cg::grid_group grid = cg::this_grid();
    const int G = gridDim.x, c = blockIdx.x;
    unsigned char* ws = p.ws;
    int wv = __builtin_amdgcn_readfirstlane((int)(threadIdx.x >> 6)); asm volatile("" : "+s"(wv));
    volatile LAS unsigned* stw = (volatile LAS unsigned*)(lds + 131072);
    if (wv == 0) stw[lane_id()] = 0u;
    __syncthreads();
    XcdBarrier xbar = xcd_barrier_post((unsigned*)(ws + WS_BAR), stw, wv);
    if (p.ws == nullptr) grid.sync();
#define GSYNC() xcd_barrier(xbar, wv)
#pragma unroll 1
    for (int l = 0; l < 2; ++l) {
        phase0(wv, p, l, lds, 0);
        GSYNC();
        {
            SchedB1 S{G, LCV, (const char*)(ws + WS_H), (const char*)(ws + WS_WIN)}; EpiB1 E{ws};
            pg8::gemm_phase(wv, lds, pg8::Gemm{1024, 16, 1024, 1024}, S, E);
            sgemm_phase<true>(wv, lds, (const bf16_t*)(ws + WS_H) + (size_t)NPT * 1024, (const bf16_t*)(ws + WS_WIN), 1024, 8 * 64, SEpiB1{ws});
        }
        GSYNC();
        {
            { SchedAtt S{G, LCV, ws}; EpiAtt E{ws}; pg8::gemm_phase(wv, lds, pg8::Gemm{256, 4, 1024, 1024}, S, E); }
            { SchedU S{G, LCV, ws}; EpiU E{ws}; pg8::gemm_phase(wv, lds, pg8::Gemm{256, 4, SEQ, SEQ}, S, E); }
            phase_sret(wv, p, l, lds);
            GSYNC();
            phase_scan(wv, p, l);
            GSYNC();
            { SchedE S{G, LCV, ws}; EpiE E{ws}; pg8::gemm_phase(wv, lds, pg8::Gemm{512, 4, 1024, SEQ}, S, E); }
            {
                const int t_ = wv * 64 + lane_id(), row_ = t_ >> 1, which_ = t_ & 1, idx_ = (int)blockIdx.x, h_ = idx_ & 3, j_ = (idx_ >> 2) & 31, b_ = idx_ >> 7;
                if (idx_ < 256) {
                    const float* sl_ = (const float*)(ws + WS_SLOTS) + (size_t)idx_ * 4096 + row_ * 16 + which_;
                    float a_ = 0.f;
#pragma unroll
                    for (int k_ = 0; k_ < 8; ++k_) a_ += sl_[k_ * 2];
                    ((float*)(ws + WS_STATF))[(size_t)(b_ * SEQ + j_ * CH + row_) * 8 + h_ * 2 + which_] = a_;
                }
            }
            GSYNC();
        }
        {
            SchedN S{G, LCV, 24, 0, (const char*)(ws + WS_H), (const char*)(ws + WS_WIN) + (size_t)16 * TILEB, TILEB, ws, TILEB};
            EpiB2 E{ws, p.in[11] + l * 2048};
            pg8::gemm_phase(wv, lds, pg8::Gemm{1024, 16, 1024, 1024}, S, E);
            sgemm_phase<true>(wv, lds, (const bf16_t*)(ws + WS_H) + (size_t)NPT * 1024, (const bf16_t*)(ws + WS_WIN) + (size_t)4096 * 1024, 1024, 8 * 96, SEpiB2{ws, p.in[11] + l * 2048});
        }
        GSYNC();
        phase0(wv, p, l, lds, 1);
        phase_conv(wv, p, l, lds);
        GSYNC();
        { SchedN S{G, LCV, 4, 0, (const char*)(ws + WS_YC), (const char*)(ws + WS_WC), TILEB, ws, TILEB}; EpiEW<0> E{ws, p.out, nullptr}; pg8::gemm_phase(wv, lds, pg8::Gemm{1024, 16, 1024, 1024}, S, E); }
        sgemm_phase<false>(wv, lds, (const bf16_t*)(ws + WS_YC) + (size_t)NPT * 1024, (const bf16_t*)(ws + WS_WC), 1024, 8 * 32, SEpiEW<0, false>{ws, p.out, nullptr});
        { SchedN S{G, LCV, 4, 1, nullptr, (const char*)(ws + WS_WR), 2 * TILEB, ws, 0}; EpiEW<1> E{ws, p.out, nullptr}; pg8::gemm_phase(wv, lds, pg8::Gemm{2048, 32, 2048, 2048}, S, E); }
        sgemm_phase<false>(wv, lds, (const bf16_t*)(ws + WS_OS), (const bf16_t*)(ws + WS_WR), 2048, 8 * 32, SEpiEW<1, false>{ws, p.out, nullptr});
        GSYNC();
        { SchedN S{G, LCV, 4, 0, (const char*)(ws + WS_T), (const char*)(ws + WS_WO), TILEB, ws, TILEB}; EpiEW<2> E{ws, p.out, (fx_t*)(ws + WS_SSQB)}; pg8::gemm_phase(wv, lds, pg8::Gemm{1024, 16, 1024, 1024}, S, E); }
        sgemm_phase<false>(wv, lds, (const bf16_t*)(ws + WS_T) + (size_t)NPT * 1024, (const bf16_t*)(ws + WS_WO), 1024, 8 * 32, SEpiEW<2, false>{ws, p.out, (fx_t*)(ws + WS_SSQB)});
        GSYNC();
        { SchedN S{G, LCV, 16, 0, (const char*)(ws + WS_H), (const char*)(ws + WS_WM1), TILEB, ws, TILEB}; EpiEW<3> E{ws, p.out, (fx_t*)(ws + WS_SSQB)}; pg8::gemm_phase(wv, lds, pg8::Gemm{1024, 16, 1024, 1024}, S, E); }
        sgemm_phase<true>(wv, lds, (const bf16_t*)(ws + WS_H) + (size_t)NPT * 1024, (const bf16_t*)(ws + WS_WM1), 1024, 8 * 64, SEpiEW<3, true>{ws, p.out, (fx_t*)(ws + WS_SSQB)});
        GSYNC();
        { SchedN S{G, LCV, 4, 0, (const char*)(ws + WS_U), (const char*)(ws + WS_WM2), 4 * TILEB, ws, 4 * TILEB}; EpiEW<2> E{ws, p.out, (fx_t*)(ws + WS_SSQA)}; pg8::gemm_phase(wv, lds, pg8::Gemm{4096, 64, 4096, 4096}, S, E); }
        sgemm_phase<false>(wv, lds, (const bf16_t*)(ws + WS_U) + (size_t)NPT * 4096, (const bf16_t*)(ws + WS_WM2), 4096, 8 * 32, SEpiEW<2, false>{ws, p.out, (fx_t*)(ws + WS_SSQA)});
        GSYNC();
    }
    phase_final(wv, p);
}

extern "C" void kernel_launch(void* const* d_in, const int* in_sizes, int n_in, void* d_out, int out_size, void* d_ws, size_t ws_size, hipStream_t stream) {
    static int grid = 0;
    if (grid == 0) {
        if (n_in != 18 || ws_size < WS_END) { fprintf(stderr, "kernel_launch: unexpected n_in %d / ws_size %zu (need %zu)\n", n_in, ws_size, (size_t)WS_END); grid = -1; return; }
        int dev = 0, cus = 0, per_cu = 0;
        hipGetDevice(&dev); hipDeviceGetAttribute(&cus, hipDeviceAttributeMultiprocessorCount, dev);
        hipFuncSetAttribute((const void*)fwd_megakernel, hipFuncAttributeMaxDynamicSharedMemorySize, LDS_BYTES);
        hipOccupancyMaxActiveBlocksPerMultiprocessor(&per_cu, (const void*)fwd_megakernel, 512, LDS_BYTES);
        (void)hipGetLastError();
        if (per_cu < 1) per_cu = 1;
        grid = cus;
        fprintf(stderr, "kernel_launch: cus %d per_cu %d grid %d\n", cus, per_cu, grid);
    }
    if (grid < 0) return;
    if (hipMemsetAsync((char*)d_ws + WS_BAR, 0, 16384, stream) != hipSuccess) { fprintf(stderr, "memset failed\n"); return; }
    Params p{};
    for (int i = 0; i < 18; ++i) p.in[i] = (const float*)d_in[i];
    p.out = (float*)d_out; p.ws = (unsigned char*)d_ws;
    void* args[] = {&p};
    hipError_t e = hipLaunchCooperativeKernel((const void*)fwd_megakernel, dim3(grid), dim3(512), args, LDS_BYTES, stream);
    if (e != hipSuccess) fprintf(stderr, "cooperative launch failed: %s (grid %d)\n", hipGetErrorString(e), grid);
}
```

```cpp
#include <hip/hip_runtime.h>
#include <hip/hip_cooperative_groups.h>
#include <cstdio>
#include <cstdint>
namespace cg = cooperative_groups;

#define LAS __attribute__((address_space(3)))
typedef unsigned short bf16_t;
typedef short bf16x8 __attribute__((ext_vector_type(8)));
typedef float f32x4 __attribute__((ext_vector_type(4)));
typedef float f32x2 __attribute__((ext_vector_type(2)));
typedef float f32x16 __attribute__((ext_vector_type(16)));
typedef unsigned u32x4 __attribute__((ext_vector_type(4)));
typedef unsigned u32x2 __attribute__((ext_vector_type(2)));

constexpr int DM = 1024, SEQ = 8192, NPT = 16384, NTOK = 16640, DSEQ = 32, PAST = 4096;
constexpr int DFF = 4096, RV = 2048, CH = 256;
constexpr float RMS_EPS = 1e-6f, LN_EPS = 1e-5f;
constexpr size_t MiB = 1u << 20;
constexpr size_t TILEB = 256 * 1024 * 2;
constexpr size_t WS_STATF = 313 * MiB + MiB / 2;
constexpr size_t WS_SLOTS = 314 * MiB;
constexpr size_t WS_STATS = 313 * MiB;
constexpr size_t WS_BAR = 640 * 1024;
constexpr size_t WS_SSQA = 318 * MiB, WS_SSQB = 319 * MiB;
constexpr size_t WS_TAB = 1 * MiB;
constexpr size_t WS_WIN = 9 * MiB;
constexpr size_t WS_WC = 29 * MiB, WS_WR = 31 * MiB, WS_WO = 35 * MiB, WS_WM1 = 37 * MiB, WS_WM2 = 45 * MiB;
constexpr size_t WS_H = 53 * MiB;
constexpr size_t WS_Q = WS_H + 32 * MiB + MiB / 2;
constexpr size_t WS_KB0 = 118 * MiB, WS_KTB0 = 134 * MiB, WS_KB1 = 150 * MiB, WS_KTB1 = 166 * MiB, WS_KS = 182 * MiB, WS_KTS = WS_KS + MiB / 2;
constexpr size_t WS_VTB0 = 183 * MiB, WS_VTB1 = 215 * MiB, WS_VTS = 247 * MiB;
constexpr size_t WS_ATT = 248 * MiB;
constexpr size_t WS_S = 280 * MiB;
constexpr size_t WS_OS = 312 * MiB;
constexpr size_t WS_END = 320 * MiB;
constexpr size_t WS_GLU = WS_Q, WS_T = WS_Q, WS_U = WS_Q, WS_GC = WS_VTB0, WS_GR = WS_VTB0 + 32 * MiB + MiB / 2, WS_YC = WS_ATT;
constexpr size_t WS_OB0 = WS_KB0, WS_OB1 = WS_KB1;
static_assert(WS_Q == 85 * MiB + MiB / 2 && WS_Q + 32 * MiB + MiB / 2 == WS_KB0, "map");
static_assert(WS_U + (size_t)NTOK * DFF * 2 <= WS_END, "map");
constexpr size_t OUT_CONVP = 17039360, OUT_RETP = 17162240, OUT_CONVS = 19259392, OUT_RETS = 19750912;

struct Params { const float* in[18]; float* out; unsigned char* ws; };

typedef __bf16 bf16x2_t __attribute__((ext_vector_type(2)));
__device__ __forceinline__ unsigned cvt_pk_bf16(float lo, float hi) { const f32x2 v = {lo, hi}; return __builtin_bit_cast(unsigned, __builtin_convertvector(v, bf16x2_t)); }
__device__ __forceinline__ float bflo(unsigned w) { return __uint_as_float(w << 16); }
__device__ __forceinline__ float bfhi(unsigned w) { return __uint_as_float(w & 0xffff0000u); }
__device__ __forceinline__ float bf2f(bf16_t v) { return __uint_as_float((unsigned)v << 16); }
__device__ __forceinline__ float lgdec(int h) { return h == 0 ? -0.0317486983145803f : (h == 1 ? -0.015748356968139168f : (h == 2 ? -0.007843177461025893f : -0.003913899321136329f)); }
typedef unsigned long long fx_t;
constexpr float FX_SCALE = 16777216.0f, FX_INV = 1.0f / 16777216.0f;
__device__ __forceinline__ fx_t fx_of(float v) { return (fx_t)(long long)(v * FX_SCALE); }
__device__ __forceinline__ void fx_add(fx_t* p, float v) { atomicAdd(p, fx_of(v)); }
__device__ __forceinline__ float fx_get(fx_t v) { return (float)(long long)v * FX_INV; }
__device__ __forceinline__ float rstd_of(float ssq) { return __builtin_amdgcn_rsqf(ssq * (1.0f / 1024.0f) + RMS_EPS); }
__device__ __forceinline__ float sigm(float x) { return __builtin_amdgcn_rcpf(1.0f + __expf(-x)); }
__device__ __forceinline__ u32x4 pack8(const f32x4 a, const f32x4 b) { u32x4 w; w.x = cvt_pk_bf16(a[0], a[1]); w.y = cvt_pk_bf16(a[2], a[3]); w.z = cvt_pk_bf16(b[0], b[1]); w.w = cvt_pk_bf16(b[2], b[3]); return w; }
__device__ __forceinline__ void unpack8(const u32x4 w, f32x4& a, f32x4& b) { a = (f32x4){bflo(w.x), bfhi(w.x), bflo(w.y), bfhi(w.y)}; b = (f32x4){bflo(w.z), bfhi(w.z), bflo(w.w), bfhi(w.w)}; }
__device__ __forceinline__ int lane_id() { return (int)__builtin_amdgcn_mbcnt_hi(~0u, __builtin_amdgcn_mbcnt_lo(~0u, 0u)); }
__device__ __forceinline__ int gdim() { int g = (int)gridDim.x; asm volatile("" : "+s"(g)); return g; }
template <int K> __device__ __forceinline__ float shx(float v) {
    if constexpr (K < 32) return __builtin_bit_cast(float, __builtin_amdgcn_ds_swizzle(__builtin_bit_cast(int, v), (K << 10) | 0x1f));
    else { int l = lane_id(); asm volatile("" : "+v"(l)); return __builtin_bit_cast(float, __builtin_amdgcn_ds_bpermute((l ^ 32) << 2, __builtin_bit_cast(int, v))); }
}
__device__ __forceinline__ float wave_sum(float v) { v += shx<1>(v); v += shx<2>(v); v += shx<4>(v); v += shx<8>(v); v += shx<16>(v); v += shx<32>(v); return v; }

namespace pg8 {
constexpr int BM = 256, BK = 64, HALF = 128, HTB = HALF * BK * 2, STAGE_BYTES = 8 * HTB;
__host__ __device__ __forceinline__ int lds_byte(int r, int c) { const int st = (r >> 4) * 2 + (c >> 5), rr = r & 15, cc = c & 31, ob = rr * 64 + cc * 2; return st * 1024 + (ob ^ (((ob >> 9) & 1) << 5)); }
__host__ __device__ __forceinline__ void stage_rc(int b, int& R, int& C) { const int st = b / 1024, sb = b % 1024, swz = sb ^ (((sb >> 9) & 1) << 5); R = (st >> 1) * 16 + swz / 64; C = (st & 1) * 32 + (swz % 64) / 2; }
__host__ __device__ __forceinline__ int perm32(int rho) { const int n = rho >> 4, i = rho & 15; return 8 * (i >> 2) + 4 * n + (i & 3); }

struct Unit { const char* a; const char* b; long a2d, b2d; int kind, pm, pn, aux; };
struct Gemm { int K, nt1, lda, ldb; };

__device__ __forceinline__ void xcd_remap(int& wgid, int nwg) { const int q = nwg / 8, r = nwg % 8, xcd = wgid % 8, off = wgid / 8; wgid = (xcd < r ? xcd * (q + 1) : r * (q + 1) + (xcd - r) * q) + off; }
__device__ __forceinline__ void grp_decode(int wgid, int nM, int nN, int& pm, int& pn) { const int nig = 8 * nN, gid = wgid / nig, fm = gid * 8, gsz = (nM - fm) < 8 ? (nM - fm) : 8; pm = fm + ((wgid % nig) % gsz); pn = (wgid % nig) / gsz; }

template <class Epi, class Sched>
__device__ __forceinline__ void gemm_phase(int wv, LAS unsigned char* lds, const Gemm g, const Sched& S, const Epi& E) {
    int wv_ = wv; asm volatile("" : "+s"(wv_)); int tid = wv_ * 64 + lane_id(); asm volatile("" : "+v"(tid));
    const int wid = __builtin_amdgcn_readfirstlane(tid >> 6), lane = tid & 63, wr = wid >> 2, wc = wid & 3, fr = lane & 15, fq = lane >> 4;
    const int nt = g.K / BK, nt1 = g.nt1;
    unsigned voffA[2], voffB[2];
#pragma unroll
    for (int i = 0; i < 2; ++i) { int R, C; stage_rc(tid * 16 + i * 8192, R, C); const int Rb = (R & ~31) + perm32(R & 31);
        voffA[i] = (unsigned)(R * g.lda + C) * 2u; voffB[i] = (unsigned)(Rb * g.ldb + C) * 2u; }
    const size_t kstep = (size_t)(BK * 2);
    const size_t hstepA = (size_t)HALF * g.lda * 2, hstepB = (size_t)HALF * g.ldb * 2;
    const unsigned ldsw = (unsigned)wid * 1024u;
    const int aoff = lds_byte(wr * 64 + fr, fq * 8), boff = lds_byte(wc * 32 + fr, fq * 8);
#define PG8_SA(b, h) (((b) * 2 + (h)) * HTB)
#define PG8_SB(b, h) ((4 + (b) * 2 + (h)) * HTB)
#define PG8_STAGE(bufoff, gbase, voff) do { _Pragma("unroll") for (int _i = 0; _i < 2; ++_i) \
        __builtin_amdgcn_global_load_lds((const unsigned*)((const char*)(gbase) + (voff)[_i]), (LAS unsigned*)(lds + (bufoff) + ldsw + _i * 8192), 16, 0, 0); } while (0)
#define PG8_LDA(dst, b, h) do { _Pragma("unroll") for (int m = 0; m < 4; ++m) _Pragma("unroll") for (int k = 0; k < 2; ++k) dst[m][k] = *(const LAS bf16x8*)(lds + PG8_SA(b, h) + aoff + m * 2048 + k * 1024); } while (0)
#define PG8_LDB(dst, b, h) do { _Pragma("unroll") for (int n = 0; n < 2; ++n) _Pragma("unroll") for (int k = 0; k < 2; ++k) dst[n][k] = *(const LAS bf16x8*)(lds + PG8_SB(b, h) + boff + n * 2048 + k * 1024); } while (0)
#define PG8_MMA(ai, bj, At, Bt) do { __builtin_amdgcn_s_setprio(1); _Pragma("unroll") for (int m = 0; m < 4; ++m) _Pragma("unroll") for (int n = 0; n < 2; ++n) _Pragma("unroll") for (int k = 0; k < 2; ++k) \
        acc[ai][bj][m][n] = __builtin_amdgcn_mfma_f32_16x16x32_bf16(Bt[n][k], At[m][k], acc[ai][bj][m][n], 0, 0, 0); __builtin_amdgcn_s_setprio(0); } while (0)
#define PG8_WAIT_V(n) asm volatile("s_waitcnt vmcnt(" #n ")" ::: "memory")
#define PG8_WAIT_L(n) asm volatile("s_waitcnt lgkmcnt(" #n ")" ::: "memory")
#define PG8_BAR __builtin_amdgcn_s_barrier()
#define PG8_SCHED __builtin_amdgcn_sched_barrier(0)
#define PG8_TPA(u, t) ((u).a + (size_t)(t) * kstep + (((t) >= nt1) ? (u).a2d : 0l))
#define PG8_TPB(u, t) ((u).b + (size_t)(t) * kstep + (((t) >= nt1) ? (u).b2d : 0l))
    Unit cur, nxt; int ui = 0;
    if (!S.next(0, cur)) return;
    {
        const char* cA = cur.a; const char* cB = cur.b;
        PG8_STAGE(PG8_SB(0, 0), cB, voffB); PG8_STAGE(PG8_SB(0, 1), cB + hstepB, voffB); PG8_STAGE(PG8_SA(0, 0), cA, voffA); PG8_STAGE(PG8_SA(0, 1), cA + hstepA, voffA);
        if (wr == 1) PG8_BAR;
        PG8_WAIT_V(2); PG8_BAR;
        PG8_STAGE(PG8_SB(1, 0), cB + kstep, voffB); PG8_STAGE(PG8_SA(1, 0), cA + kstep, voffA); PG8_STAGE(PG8_SB(1, 1), cB + hstepB + kstep, voffB);
        PG8_WAIT_V(6); PG8_BAR;
    }
    f32x4 acc[2][2][4][2];
#pragma unroll
    for (int a = 0; a < 2; ++a)
#pragma unroll
        for (int b = 0; b < 2; ++b)
#pragma unroll
            for (int m = 0; m < 4; ++m)
#pragma unroll
                for (int n = 0; n < 2; ++n) acc[a][b][m][n] = (f32x4){0.f, 0.f, 0.f, 0.f};
    bf16x8 At[4][2], B0[2][2], B1[2][2];
#pragma unroll 1
    for (;;) {
        const bool has_next = S.next(ui + 1, nxt);
        if (!has_next) nxt = cur;
#pragma unroll 1
        for (int t = 0; t < nt; t += 2) {
            const bool last = (t == nt - 2);
            const char* a1 = PG8_TPA(cur, t + 1);
            const char* a2 = last ? PG8_TPA(nxt, 0) : PG8_TPA(cur, t + 2); const char* b2 = last ? PG8_TPB(nxt, 0) : PG8_TPB(cur, t + 2);
            const char* a3 = a2 + kstep; const char* b3 = b2 + kstep;
            PG8_LDB(B0, 0, 0); PG8_LDB(B1, 0, 1); PG8_SCHED; PG8_LDA(At, 0, 0); PG8_STAGE(PG8_SA(1, 1), a1 + hstepA, voffA);
            PG8_WAIT_V(8); PG8_WAIT_L(0); PG8_BAR; PG8_MMA(0, 0, At, B0); PG8_MMA(0, 1, At, B1); PG8_BAR; PG8_SCHED;
            PG8_LDA(At, 0, 1); PG8_STAGE(PG8_SB(0, 0), b2, voffB); PG8_STAGE(PG8_SB(0, 1), b2 + hstepB, voffB); PG8_STAGE(PG8_SA(0, 0), a2, voffA);
            PG8_WAIT_V(8); PG8_WAIT_L(0); PG8_BAR; PG8_MMA(1, 0, At, B0); PG8_MMA(1, 1, At, B1); PG8_BAR; PG8_SCHED;
            PG8_LDB(B0, 1, 0); PG8_LDB(B1, 1, 1); PG8_SCHED; PG8_LDA(At, 1, 0); PG8_STAGE(PG8_SA(0, 1), a2 + hstepA, voffA);
            PG8_WAIT_V(8); PG8_WAIT_L(0); PG8_BAR; PG8_MMA(0, 0, At, B0); PG8_MMA(0, 1, At, B1); PG8_BAR; PG8_SCHED;
            PG8_LDA(At, 1, 1); PG8_STAGE(PG8_SB(1, 0), b3, voffB); PG8_STAGE(PG8_SB(1, 1), b3 + hstepB, voffB); PG8_STAGE(PG8_SA(1, 0), a3, voffA);
            PG8_WAIT_V(8); PG8_WAIT_L(0); PG8_BAR; PG8_MMA(1, 0, At, B0); PG8_MMA(1, 1, At, B1); PG8_BAR; PG8_SCHED;
        }
        if (wr == 0) PG8_BAR;
        { int fr2 = fr, fq2 = fq; asm volatile("" : "+v"(fr2), "+v"(fq2)); E(acc, cur, wr, wc, fr2, fq2); }
        if (!has_next) break;
#pragma unroll
        for (int a = 0; a < 2; ++a)
#pragma unroll
            for (int b = 0; b < 2; ++b)
#pragma unroll
                for (int m = 0; m < 4; ++m)
#pragma unroll
                    for (int n = 0; n < 2; ++n) acc[a][b][m][n] = (f32x4){0.f, 0.f, 0.f, 0.f};
        cur = nxt; ++ui;
        if (wr == 1) PG8_BAR;
    }
    PG8_WAIT_V(0);
    PG8_BAR;
    asm volatile("s_waitcnt vmcnt(0) lgkmcnt(0)" ::: "memory");
    __syncthreads();
#undef PG8_SA
#undef PG8_SB
#undef PG8_STAGE
#undef PG8_LDA
#undef PG8_LDB
#undef PG8_MMA
#undef PG8_WAIT_V
#undef PG8_WAIT_L
#undef PG8_BAR
#undef PG8_SCHED
#undef PG8_TPA
#undef PG8_TPB
}
}
using pg8::Unit;

__device__ __forceinline__ bf16_t* k_tile(unsigned char* ws, int pm) { return (bf16_t*)(ws + (pm < 32 ? WS_KB0 + (size_t)pm * TILEB : (pm < 64 ? WS_KB1 + (size_t)(pm - 32) * TILEB : WS_KS))); }
__device__ __forceinline__ bf16_t* o_tile(unsigned char* ws, int pm) { return (bf16_t*)(ws + (pm < 32 ? WS_OB0 + (size_t)pm * 2 * TILEB : (pm < 64 ? WS_OB1 + (size_t)(pm - 32) * 2 * TILEB : WS_OS))); }

__device__ __forceinline__ bf16_t* s_head(unsigned char* ws, int b, int h) {
    const size_t off = b == 0 ? WS_S + (size_t)h * 8 * MiB : (h == 0 ? WS_TAB : (h == 1 ? WS_WC : (h == 2 ? WS_WM1 : WS_WM2)));
    return (bf16_t*)(ws + off);
}
struct SchedB1 {
    int G, c; const char* H; const char* W;
    __device__ __forceinline__ bool next(int i, Unit& u) const {
        const long L = (long)i * G + c; if (L >= 1024) return false;
        int wgid = (int)L; pg8::xcd_remap(wgid, 1024);
        { const int x = wgid >> 7, w = wgid & 127; wgid = w < 64 ? x * 64 + w : 512 + x * 64 + (w - 64); }
        u.a2d = 0; u.b2d = 0; u.aux = 0;
        if (wgid < 512) { pg8::grp_decode(wgid, 64, 8, u.pm, u.pn); u.kind = 0; u.a = H + (size_t)u.pm * TILEB; u.b = W + (size_t)u.pn * TILEB; }
        else { pg8::grp_decode(wgid - 512, 8, 64, u.pm, u.pn); u.pm += 4; u.kind = 1; u.a = W + (size_t)(4 + u.pm) * TILEB; u.b = H + (size_t)u.pn * TILEB; }
        return true;
    }
};
struct SchedN {
    int G, c, nN, amode; const char* A; const char* B; size_t bTile; unsigned char* ws; size_t aTile;
    __device__ __forceinline__ bool next(int i, Unit& u) const {
        const int nwg = 64 * nN; const long L = (long)i * G + c; if (L >= nwg) return false;
        int wgid = (int)L; pg8::xcd_remap(wgid, nwg); pg8::grp_decode(wgid, 64, nN, u.pm, u.pn);
        u.a2d = 0; u.b2d = 0; u.aux = 0; u.kind = 0;
        u.a = amode ? (const char*)o_tile(ws, u.pm) : A + (size_t)u.pm * aTile; u.b = B + (size_t)u.pn * bTile;
        return true;
    }
};
struct SchedAtt {
    int G, c; unsigned char* ws;
    __device__ __forceinline__ bool next(int i, Unit& u) const {
        const int L = i * G + c; if (L >= 256) return false;
        const int h = L & 3, j = (L >> 2) & 31, b = L >> 7;
        u.a2d = 0; u.b2d = 0; u.kind = 0; u.pm = j; u.pn = b; u.aux = h;
        u.a = (const char*)(ws + WS_Q) + ((size_t)(b * SEQ + j * CH) * 1024 + h * 256) * 2;
        u.b = (const char*)(ws + (b ? WS_KB1 : WS_KB0)) + ((size_t)(j * CH) * 1024 + h * 256) * 2;
        return true;
    }
};
struct SchedU {
    int G, c; unsigned char* ws;
    __device__ __forceinline__ bool next(int i, Unit& u) const {
        const int L = i * G + c; if (L >= 512) return false;
        const int pmt = L & 1, h = (L >> 1) & 3, j = (L >> 3) & 31, b = L >> 8;
        u.a2d = 0; u.b2d = 0; u.kind = b; u.pm = j; u.pn = 0; u.aux = h * 2 + pmt;
        u.a = (const char*)(ws + (b ? WS_VTB1 : WS_VTB0)) + ((size_t)(h * 512 + pmt * 256) * SEQ + j * CH) * 2;
        u.b = (const char*)(ws + (b ? WS_KTB1 : WS_KTB0)) + ((size_t)(h * 256) * SEQ + j * CH) * 2;
        return true;
    }
};
struct SchedE {
    int G, c; unsigned char* ws;
    __device__ __forceinline__ bool next(int i, Unit& u) const {
        const int L = i * G + c; if (L >= 512) return false;
        const int idx = L & 255, pnt = L >> 8, h = idx & 3, j = (idx >> 2) & 31, b = idx >> 7;
        u.kind = b; u.pm = j; u.pn = pnt; u.aux = h;
        const char* a1 = (const char*)(ws + WS_ATT) + ((size_t)(b * SEQ + j * CH) * 1024 + h * 256) * 2;
        const char* a2 = (const char*)(ws + WS_Q) + ((size_t)(b * SEQ + j * CH) * 1024 + h * 256) * 2;
        const char* b1 = (const char*)(ws + (b ? WS_VTB1 : WS_VTB0)) + ((size_t)(h * 512 + pnt * 256) * SEQ + j * CH) * 2;
        const char* b2 = (const char*)(s_head(ws, b, h) + (size_t)(pnt * 256) * SEQ + j * CH);
        u.a = a1; u.b = b1; u.a2d = (long)(a2 - a1) - 4 * 128; u.b2d = (long)(b2 - b1) - 4 * 128;
        return true;
    }
};

#define EPI_FENCE asm volatile("" ::: "memory")
#define EPI_ARGS const f32x4 (&acc)[2][2][4][2], const Unit& u, int wr, int wc, int fr, int fq
struct EpiB1 {
    unsigned char* ws;
    __device__ __forceinline__ void operator()(EPI_ARGS) const {
        const f32x2* tab = (const f32x2*)(ws + WS_TAB); const fx_t* ssq = (const fx_t*)(ws + WS_SSQA);
        if (u.kind == 0) {
            const int head = u.pn & 3; const bool isk = u.pn >= 4;
            bf16_t* dst = isk ? k_tile(ws, u.pm) : (bf16_t*)(ws + WS_Q) + (size_t)u.pm * 256 * 1024;
            const float sc = isk ? 0.0625f : 1.0f;
            const __amdgpu_buffer_rsrc_t ktr = __builtin_amdgcn_make_buffer_rsrc((void*)(ws + (u.pm < 32 ? WS_KTB0 : WS_KTB1)), (short)0, (int)(16 * MiB), 0x00020000);
            const int d0 = wc * 32 + fq * 8;
#pragma unroll
            for (int aih = 0; aih < 2; ++aih) {
                const int ai = aih, mb = 0;
                f32x4 tb[4][4]; float rsq[4];
#pragma unroll
                for (int m = mb; m < mb + 4; ++m) {
                    const int row = ai * 128 + wr * 64 + m * 16 + fr;
                    const int pos = u.pm < 64 ? ((u.pm & 31) * 256 + row) : (PAST + (row & 31));
                    const f32x4* tp = (const f32x4*)(tab + (size_t)pos * 128 + d0);
                    tb[m][0] = tp[0]; tb[m][1] = tp[1]; tb[m][2] = tp[2]; tb[m][3] = tp[3];
                    rsq[m] = fx_get(ssq[(size_t)u.pm * 256 + row]);
                }
                EPI_FENCE;
#pragma unroll
                for (int m = mb; m < mb + 4; ++m) {
                    const int row = ai * 128 + wr * 64 + m * 16 + fr;
                    const f32x4 c01 = tb[m][0], c23 = tb[m][1], c45 = tb[m][2], c67 = tb[m][3];
                    const f32x4 cs0 = (f32x4){c01[0], c01[2], c23[0], c23[2]}, sn0 = (f32x4){c01[1], c01[3], c23[1], c23[3]};
                    const f32x4 cs1 = (f32x4){c45[0], c45[2], c67[0], c67[2]}, sn1 = (f32x4){c45[1], c45[3], c67[1], c67[3]};
                    const f32x4 x1a = acc[ai][0][m][0], x1b = acc[ai][0][m][1], x2a = acc[ai][1][m][0], x2b = acc[ai][1][m][1];
                    const float scr_ = sc * rstd_of(rsq[m]);
                    const f32x4 o1a = (x1a * cs0 - x2a * sn0) * scr_, o1b = (x1b * cs1 - x2b * sn1) * scr_;
                    const f32x4 o2a = (x2a * cs0 + x1a * sn0) * scr_, o2b = (x2b * cs1 + x1b * sn1) * scr_;
                    bf16_t* rp = dst + (size_t)row * 1024 + head * 256 + d0;
                    *(u32x4*)rp = pack8(o1a, o1b); *(u32x4*)(rp + 128) = pack8(o2a, o2b);
                    if (isk) {
                        const float dk = __expf(lgdec(head) * (float)(CH - 1 - (row & (CH - 1))));
                        const unsigned voff = (unsigned)((d0 * SEQ + row) * 2);
                        const unsigned sbase = (unsigned)(((head * 256) * SEQ + (u.pm & 31) * 256) * 2);
                        const u32x4 t1 = pack8(o1a * dk, o1b * dk);
#pragma unroll
                        for (int jj = 0; jj < 4; ++jj) {
                            __builtin_amdgcn_raw_buffer_store_b16((short)(t1[jj] & 0xffffu), ktr, voff, sbase + (unsigned)(2 * jj) * SEQ * 2u, 0);
                            __builtin_amdgcn_raw_buffer_store_b16((short)(t1[jj] >> 16), ktr, voff, sbase + (unsigned)(2 * jj + 1) * SEQ * 2u, 0); }
                        const u32x4 t2 = pack8(o2a * dk, o2b * dk);
#pragma unroll
                        for (int jj = 0; jj < 4; ++jj) {
                            __builtin_amdgcn_raw_buffer_store_b16((short)(t2[jj] & 0xffffu), ktr, voff, sbase + (unsigned)(128 + 2 * jj) * SEQ * 2u, 0);
                            __builtin_amdgcn_raw_buffer_store_b16((short)(t2[jj] >> 16), ktr, voff, sbase + (unsigned)(129 + 2 * jj) * SEQ * 2u, 0); }
                    }
                }
                EPI_FENCE;
            }
        } else {
            bf16_t* dst; int ld;
            if (u.pn < 32) { dst = (bf16_t*)(ws + WS_VTB0) + (size_t)u.pn * 256; ld = SEQ; }
            else if (u.pn < 64) { dst = (bf16_t*)(ws + WS_VTB1) + (size_t)(u.pn - 32) * 256; ld = SEQ; }
            else { dst = (bf16_t*)(ws + WS_VTS); ld = 256; }
            f32x4 rsv[2][2];
#pragma unroll
            for (int bj = 0; bj < 2; ++bj) { const fx_t* sp8 = ssq + (size_t)u.pn * 256 + bj * 128 + wc * 32 + fq * 8;
#pragma unroll
                for (int n = 0; n < 2; ++n) rsv[bj][n] = (f32x4){rstd_of(fx_get(sp8[4 * n])), rstd_of(fx_get(sp8[4 * n + 1])), rstd_of(fx_get(sp8[4 * n + 2])), rstd_of(fx_get(sp8[4 * n + 3]))}; }
#pragma unroll
            for (int ai = 0; ai < 2; ++ai)
#pragma unroll
                for (int m = 0; m < 4; ++m) {
                    const int e = (u.pm - 4) * 256 + ai * 128 + wr * 64 + m * 16 + fr;
                    bf16_t* rp = dst + (size_t)e * ld + wc * 32 + fq * 8;
#pragma unroll
                    for (int bj = 0; bj < 2; ++bj) *(u32x4*)(rp + bj * 128) = pack8(acc[ai][bj][m][0] * rsv[bj][0], acc[ai][bj][m][1] * rsv[bj][1]);
                    EPI_FENCE;
                }
        }
    }
};
struct EpiAtt {
    unsigned char* ws;
    __device__ __forceinline__ void operator()(EPI_ARGS) const {
        const int h = u.aux; const float lg = lgdec(h);
        bf16_t* dst = (bf16_t*)(ws + WS_ATT) + (size_t)(u.pn * SEQ + u.pm * CH) * 1024 + h * 256;
        float cf[2][8];
#pragma unroll
        for (int bj = 0; bj < 2; ++bj)
#pragma unroll
            for (int j = 0; j < 8; ++j) cf[bj][j] = __expf(-lg * (float)(bj * 128 + wc * 32 + fq * 8 + j + 1));
#pragma unroll
        for (int ai = 0; ai < 2; ++ai)
#pragma unroll
            for (int m = 0; m < 4; ++m) {
                const int n = ai * 128 + wr * 64 + m * 16 + fr;
#pragma unroll
                for (int bj = 0; bj < 2; ++bj) {
                    const int m0 = bj * 128 + wc * 32 + fq * 8;
                    float o[8];
#pragma unroll
                    for (int j = 0; j < 8; ++j) o[j] = __uint_as_float(__float_as_uint(acc[ai][bj][m][j >> 2][j & 3] * cf[bj][j]) & ~(unsigned)((n - m0 - j) >> 31));
                    *(u32x4*)(dst + (size_t)n * 1024 + m0) = pack8((f32x4){o[0], o[1], o[2], o[3]}, (f32x4){o[4], o[5], o[6], o[7]});
                }
                EPI_FENCE;
            }
    }
};
struct EpiU {
    unsigned char* ws;
    __device__ __forceinline__ void operator()(EPI_ARGS) const {
        bf16_t* dst = s_head(ws, u.kind, u.aux >> 1) + (size_t)((u.aux & 1) * 256) * SEQ + u.pm * CH;
#pragma unroll
        for (int ai = 0; ai < 2; ++ai)
#pragma unroll
            for (int m = 0; m < 4; ++m) {
                bf16_t* rp = dst + (size_t)(ai * 128 + wr * 64 + m * 16 + fr) * SEQ + wc * 32 + fq * 8;
#pragma unroll
                for (int bj = 0; bj < 2; ++bj) *(u32x4*)(rp + bj * 128) = pack8(acc[ai][bj][m][0], acc[ai][bj][m][1]);
                    EPI_FENCE;
            }
    }
};
struct EpiE {
    unsigned char* ws;
    __device__ __forceinline__ void operator()(EPI_ARGS) const {
        const int h = u.aux, b = u.kind; const float lg = lgdec(h);
        bf16_t* dst = (bf16_t*)(ws + (b ? WS_OB1 : WS_OB0)) + (size_t)(u.pm * CH) * 2048 + h * 512 + u.pn * 256;
        float* sl = (float*)(ws + WS_SLOTS) + (size_t)blockIdx.x * 4096 + (u.pn * 4 + wc) * 2;
#pragma unroll
        for (int ai = 0; ai < 2; ++ai)
#pragma unroll
            for (int m = 0; m < 4; ++m) {
                const int n = ai * 128 + wr * 64 + m * 16 + fr; const float rs = __expf(lg * (float)(n + 1));
                float s = 0.f, q = 0.f;
#pragma unroll
                for (int bj = 0; bj < 2; ++bj) {
                    const f32x4 v0 = acc[ai][bj][m][0] * rs, v1 = acc[ai][bj][m][1] * rs;
                    s += (v0[0] + v0[1]) + (v0[2] + v0[3]) + (v1[0] + v1[1]) + (v1[2] + v1[3]);
                    q += (v0[0] * v0[0] + v0[1] * v0[1]) + (v0[2] * v0[2] + v0[3] * v0[3]) + (v1[0] * v1[0] + v1[1] * v1[1]) + (v1[2] * v1[2] + v1[3] * v1[3]);
                    *(u32x4*)(dst + (size_t)n * 2048 + bj * 128 + wc * 32 + fq * 8) = pack8(v0, v1);
                }
                s += shx<16>(s); s += shx<32>(s); q += shx<16>(q); q += shx<32>(q);
                if (fq == 0) *(f32x2*)(sl + (size_t)n * 16) = (f32x2){s, q};
                EPI_FENCE;
            }
    }
};
struct EpiB2 {
    unsigned char* ws; const float* gn_g;
    __device__ __forceinline__ void operator()(EPI_ARGS) const {
        const fx_t* ssq = (const fx_t*)(ws + WS_SSQA) + (size_t)u.pm * 256;
        float rsr[2][4];
#pragma unroll
        for (int ai = 0; ai < 2; ++ai)
#pragma unroll
            for (int m = 0; m < 4; ++m) rsr[ai][m] = fx_get(ssq[ai * 128 + wr * 64 + m * 16 + fr]);
#pragma unroll
        for (int ai = 0; ai < 2; ++ai)
#pragma unroll
            for (int m = 0; m < 4; ++m) rsr[ai][m] = rstd_of(rsr[ai][m]);
        if (u.pn < 8) {
            bf16_t* dst = (bf16_t*)(ws + WS_GLU) + (size_t)u.pm * 256 * 1024 + u.pn * 128 + wc * 32 + fq * 8;
#pragma unroll
            for (int ai = 0; ai < 2; ++ai)
#pragma unroll
                for (int m = 0; m < 4; ++m) {
                    const int row = ai * 128 + wr * 64 + m * 16 + fr;
                    const float rs = rsr[ai][m];
                    f32x4 a0 = acc[ai][0][m][0] * rs, a1 = acc[ai][0][m][1] * rs; const f32x4 b0 = acc[ai][1][m][0] * rs, b1 = acc[ai][1][m][1] * rs;
#pragma unroll
                    for (int j = 0; j < 4; ++j) { a0[j] *= sigm(b0[j]); a1[j] *= sigm(b1[j]); }
                    *(u32x4*)(dst + (size_t)row * 1024) = pack8(a0, a1);
                    EPI_FENCE;
                }
        } else if (u.pn < 16) {
            const int t = u.pn - 8, head = t >> 1;
            bf16_t* ob = o_tile(ws, u.pm) + t * 256 + wc * 32 + fq * 8;
            const float* st = (const float*)(ws + WS_STATF) + (size_t)u.pm * 256 * 8 + head * 2;
            f32x4 gg[2][2];
#pragma unroll
            for (int bj = 0; bj < 2; ++bj) { const f32x4* gp = (const f32x4*)(gn_g + t * 256 + bj * 128 + wc * 32 + fq * 8); gg[bj][0] = gp[0]; gg[bj][1] = gp[1]; }
#pragma unroll
            for (int aih = 0; aih < 4; ++aih) {
                const int ai = aih >> 1, mb = (aih & 1) * 2;
                f32x2 sqv[4]; u32x4 ov[4][2];
#pragma unroll
                for (int m = mb; m < mb + 2; ++m) {
                    const int row = ai * 128 + wr * 64 + m * 16 + fr;
                    sqv[m] = *(const f32x2*)(st + (size_t)row * 8);
#pragma unroll
                    for (int bj = 0; bj < 2; ++bj) ov[m][bj] = *(const u32x4*)(ob + (size_t)row * 2048 + bj * 128);
                }
                EPI_FENCE;
#pragma unroll
                for (int m = mb; m < mb + 2; ++m) {
                    const int row = ai * 128 + wr * 64 + m * 16 + fr;
                    const f32x2 sq = sqv[m]; const float rsn = rsr[ai][m];
                    const float mu = sq.x * (1.0f / 512.0f); const float var = fmaxf(sq.y * (1.0f / 512.0f) - mu * mu, 0.f); const float rstd = __builtin_amdgcn_rsqf(var + LN_EPS);
#pragma unroll
                    for (int bj = 0; bj < 2; ++bj) {
                        bf16_t* rp = ob + (size_t)row * 2048 + bj * 128;
                        f32x4 o0, o1; unpack8(ov[m][bj], o0, o1);
                        f32x4 g0 = acc[ai][bj][m][0] * rsn, g1 = acc[ai][bj][m][1] * rsn;
#pragma unroll
                        for (int j = 0; j < 4; ++j) { g0[j] = g0[j] * sigm(g0[j]) * ((o0[j] - mu) * rstd * gg[bj][0][j]); g1[j] = g1[j] * sigm(g1[j]) * ((o1[j] - mu) * rstd * gg[bj][1][j]); }
                        *(u32x4*)rp = pack8(g0, g1);
                    }
                }
                EPI_FENCE;
            }
        } else {
            const int t = (u.pn - 16) & 3;
            bf16_t* dst = (bf16_t*)(ws + (u.pn < 20 ? WS_GC : WS_GR)) + (size_t)u.pm * 256 * 1024 + t * 256 + wc * 32 + fq * 8;
#pragma unroll
            for (int ai = 0; ai < 2; ++ai)
#pragma unroll
                for (int m = 0; m < 4; ++m) {
                    const int row = ai * 128 + wr * 64 + m * 16 + fr; const float rs = rsr[ai][m];
#pragma unroll
                    for (int bj = 0; bj < 2; ++bj) {
                        f32x4 a0 = acc[ai][bj][m][0] * rs, a1 = acc[ai][bj][m][1] * rs;
#pragma unroll
                        for (int j = 0; j < 4; ++j) { a0[j] = sigm(a0[j]); a1[j] = sigm(a1[j]); }
                        *(u32x4*)(dst + (size_t)row * 1024 + bj * 128) = pack8(a0, a1);
                    }
                    EPI_FENCE;
                }
        }
    }
};
template <int MODE> struct EpiEW {
    unsigned char* ws; float* x; fx_t* ssq;
    __device__ __forceinline__ void operator()(EPI_ARGS) const {
        const int c0 = u.pn * 256 + wc * 32 + fq * 8;
#pragma unroll
        for (int ai = 0; ai < 2; ++ai) {
            u32x4 gv[4][2], tv[4][2]; float sqs[4] = {0.f, 0.f, 0.f, 0.f}, rs3[4];
            if (MODE == 3) {
#pragma unroll
                for (int m = 0; m < 4; ++m) rs3[m] = rstd_of(fx_get(ssq[(size_t)u.pm * 256 + ai * 128 + wr * 64 + m * 16 + fr]));
            }
            if (MODE != 3) {
#pragma unroll
                for (int m = 0; m < 4; ++m) {
                    const size_t row = (size_t)u.pm * 256 + ai * 128 + wr * 64 + m * 16 + fr;
#pragma unroll
                    for (int bj = 0; bj < 2; ++bj) {
                        if (MODE == 0) gv[m][bj] = *(const u32x4*)((const bf16_t*)(ws + WS_GC) + row * 1024 + c0 + bj * 128);
                        if (MODE == 1) { gv[m][bj] = *(const u32x4*)((const bf16_t*)(ws + WS_GR) + row * 1024 + c0 + bj * 128); tv[m][bj] = *(const u32x4*)((const bf16_t*)(ws + WS_T) + row * 1024 + c0 + bj * 128); }
                        if (MODE == 2) tv[m][bj] = *(const u32x4*)((const bf16_t*)(ws + WS_H) + row * 1024 + c0 + bj * 128);
                    }
                }
                EPI_FENCE;
            }
#pragma unroll
            for (int m = 0; m < 4; ++m) {
                const size_t row = (size_t)u.pm * 256 + ai * 128 + wr * 64 + m * 16 + fr;
#pragma unroll
                for (int bj = 0; bj < 2; ++bj) {
                    f32x4 a0 = acc[ai][bj][m][0], a1 = acc[ai][bj][m][1];
                    if (MODE == 0) {
                        f32x4 g0, g1; unpack8(gv[m][bj], g0, g1);
                        *(u32x4*)((bf16_t*)(ws + WS_T) + row * 1024 + c0 + bj * 128) = pack8(a0 * g0, a1 * g1);
                    } else if (MODE == 1) {
                        f32x4 g0, g1, t0, t1; unpack8(gv[m][bj], g0, g1); unpack8(tv[m][bj], t0, t1);
                        *(u32x4*)((bf16_t*)(ws + WS_T) + row * 1024 + c0 + bj * 128) = pack8(t0 + a0 * g0, t1 + a1 * g1);
                    } else if (MODE == 2) {
                        f32x4 x0, x1; unpack8(tv[m][bj], x0, x1);
                        a0 = x0 + a0; a1 = x1 + a1;
                        *(u32x4*)((bf16_t*)(ws + WS_H) + row * 1024 + c0 + bj * 128) = pack8(a0, a1);
                        sqs[m] += (a0[0] * a0[0] + a0[1] * a0[1]) + (a0[2] * a0[2] + a0[3] * a0[3]) + (a1[0] * a1[0] + a1[1] * a1[1]) + (a1[2] * a1[2] + a1[3] * a1[3]);
                    } else {
#pragma unroll
                        for (int j = 0; j < 4; ++j) { const float r0 = fmaxf(a0[j], 0.f) * rs3[m], r1 = fmaxf(a1[j], 0.f) * rs3[m]; a0[j] = r0 * r0; a1[j] = r1 * r1; }
                        *(u32x4*)((bf16_t*)(ws + WS_U) + row * 4096 + c0 + bj * 128) = pack8(a0, a1);
                    }
                }
                if (MODE == 2) { float q = sqs[m]; q += shx<16>(q); q += shx<32>(q); if (fq == 0) fx_add(ssq + row, q); }
            }
            EPI_FENCE;
        }
    }
};

__device__ __forceinline__ void transpose_item(const float* W, int K, int N, bf16_t* WT, int k0, int n0, int drow0, LAS float* scr, int lane, const float* gk = nullptr) {
    float tv[32];
#pragma unroll
    for (int i = 0; i < 32; ++i) { const int kk = 2 * i + (lane >> 5); tv[i] = W[(size_t)(k0 + kk) * N + n0 + (lane & 31)]; }
#pragma unroll
    for (int i = 0; i < 32; ++i) { const int kk = 2 * i + (lane >> 5); scr[kk * 33 + (lane & 31)] = gk ? tv[i] * gk[k0 + kk] : tv[i]; }
    asm volatile("s_waitcnt lgkmcnt(0)" ::: "memory");
    const int c = lane & 7;
#pragma unroll
    for (int j = 0; j < 4; ++j) { const int n = (lane >> 3) + 8 * j; const LAS float* s = scr + (8 * c) * 33 + n;
        u32x4 o; o.x = cvt_pk_bf16(s[0 * 33], s[1 * 33]); o.y = cvt_pk_bf16(s[2 * 33], s[3 * 33]); o.z = cvt_pk_bf16(s[4 * 33], s[5 * 33]); o.w = cvt_pk_bf16(s[6 * 33], s[7 * 33]);
        *(u32x4*)(WT + (size_t)(drow0 + n) * K + k0 + 8 * c) = o; }
    asm volatile("s_waitcnt lgkmcnt(0)" ::: "memory");
}
struct TItem { const float* W; const float* gk; bf16_t* WT; int K, N, k0, n0, drow0; };
__device__ __forceinline__ void titem_load(const TItem& t, int lane, float (&tv)[32], f32x4& g0, f32x4& g1) {
#pragma unroll
    for (int i = 0; i < 32; ++i) { const int kk = 2 * i + (lane >> 5); tv[i] = t.W[(size_t)(t.k0 + kk) * t.N + t.n0 + (lane & 31)]; }
    g0 = (f32x4){1.f, 1.f, 1.f, 1.f}; g1 = g0;
    if (t.gk) { const f32x4* gp = (const f32x4*)(t.gk + t.k0 + 8 * (lane & 7)); g0 = gp[0]; g1 = gp[1]; }
}
__device__ __forceinline__ void titem_store(const TItem& t, int lane, const float (&tv)[32], const f32x4 g0, const f32x4 g1, LAS float* scr) {
#pragma unroll
    for (int i = 0; i < 32; ++i) { const int kk = 2 * i + (lane >> 5); scr[kk * 33 + (lane & 31)] = tv[i]; }
    asm volatile("s_waitcnt lgkmcnt(0)" ::: "memory");
    const int c = lane & 7;
#pragma unroll
    for (int j = 0; j < 4; ++j) { const int n = (lane >> 3) + 8 * j; const LAS float* sp = scr + (8 * c) * 33 + n;
        u32x4 o; o.x = cvt_pk_bf16(sp[0 * 33] * g0[0], sp[1 * 33] * g0[1]); o.y = cvt_pk_bf16(sp[2 * 33] * g0[2], sp[3 * 33] * g0[3]);
        o.z = cvt_pk_bf16(sp[4 * 33] * g1[0], sp[5 * 33] * g1[1]); o.w = cvt_pk_bf16(sp[6 * 33] * g1[2], sp[7 * 33] * g1[3]);
        *(u32x4*)(t.WT + (size_t)(t.drow0 + n) * t.K + t.k0 + 8 * c) = o; }
    asm volatile("s_waitcnt lgkmcnt(0)" ::: "memory");
}
__device__ __forceinline__ int win_drow(int n0) {
    if (n0 < 2048) { const int bj = n0 >> 10, jj = n0 & 1023; return 4096 + 256 * (jj >> 7) + 128 * bj + (jj & 127); }
    if (n0 < 6144) return n0 - 2048;
    return n0;
}
__device__ __forceinline__ void rms_row(const float* xrow, const float* g, bf16_t* orow, float* copy, int lane) {
    const f32x4* xr = (const f32x4*)xrow + lane; const f32x4* gr = (const f32x4*)g + lane;
    f32x4 v[4]; float s = 0.f;
#pragma unroll
    for (int j = 0; j < 4; ++j) { v[j] = xr[64 * j]; s += (v[j][0] * v[j][0] + v[j][1] * v[j][1]) + (v[j][2] * v[j][2] + v[j][3] * v[j][3]); }
    const float r = 1.0f / sqrtf(wave_sum(s) * (1.0f / 1024.0f) + RMS_EPS);
    u32x2* o8 = (u32x2*)orow + lane;
#pragma unroll
    for (int j = 0; j < 4; ++j) { const f32x4 gg = gr[64 * j]; if (copy) ((f32x4*)copy + lane)[64 * j] = v[j];
        u32x2 w; w.x = cvt_pk_bf16(v[j][0] * r * gg[0], v[j][1] * r * gg[1]); w.y = cvt_pk_bf16(v[j][2] * r * gg[2], v[j][3] * r * gg[3]); o8[64 * j] = w; }
}

__device__ __forceinline__ void phase0(int wv, const Params& p, int l, LAS unsigned char* lds, int part) {
    int wv_ = wv; asm volatile("" : "+s"(wv_)); int tid = wv_ * 64 + lane_id(); asm volatile("" : "+v"(tid));
    const int lane = tid & 63, wave = tid >> 6, G = gdim();
    const int gw = blockIdx.x * 8 + wave, NGW = G * 8;
    unsigned char* ws = p.ws;
    LAS float* scr = (LAS float*)(lds + wave * 16384);
    const float* w_in = p.in[5] + (size_t)l * 1024 * 10240; const float* w_c = p.in[10] + (size_t)l * 1024 * 1024; const float* w_r = p.in[12] + (size_t)l * 2048 * 1024;
    const float* w_o = p.in[13] + (size_t)l * 1024 * 1024; const float* w_1 = p.in[15] + (size_t)l * 1024 * 4096; const float* w_2 = p.in[16] + (size_t)l * 4096 * 1024;
    constexpr int I_IN = 16 * 320, I_C = 16 * 32, I_R = 32 * 32, I_O = 16 * 32, I_1 = 16 * 128, I_2 = 64 * 32, NIT = I_IN + I_C + I_R + I_O + I_1 + I_2;
#define TI_DECODE(it_, T_) do { int r = (it_); \
        if (r < I_IN) { const int kb = r / 320, nb = r % 320; T_ = TItem{w_in, p.in[4] + l * 1024, (bf16_t*)(ws + WS_WIN), 1024, 10240, kb * 64, nb * 32, win_drow(nb * 32)}; break; } r -= I_IN; \
        if (r < I_C) { const int kb = r / 32, nb = r % 32; T_ = TItem{w_c, nullptr, (bf16_t*)(ws + WS_WC), 1024, 1024, kb * 64, nb * 32, nb * 32}; break; } r -= I_C; \
        if (r < I_R) { const int kb = r / 32, nb = r % 32; T_ = TItem{w_r, nullptr, (bf16_t*)(ws + WS_WR), 2048, 1024, kb * 64, nb * 32, nb * 32}; break; } r -= I_R; \
        if (r < I_O) { const int kb = r / 32, nb = r % 32; T_ = TItem{w_o, nullptr, (bf16_t*)(ws + WS_WO), 1024, 1024, kb * 64, nb * 32, nb * 32}; break; } r -= I_O; \
        if (r < I_1) { const int kb = r / 128, nb = r % 128; T_ = TItem{w_1, p.in[14] + l * 1024, (bf16_t*)(ws + WS_WM1), 1024, 4096, kb * 64, nb * 32, nb * 32}; break; } r -= I_1; \
        { const int kb = r / 32, nb = r % 32; T_ = TItem{w_2, nullptr, (bf16_t*)(ws + WS_WM2), 4096, 1024, kb * 64, nb * 32, nb * 32}; } } while (0)
    const int it_first = part == 0 ? 0 : I_IN, it_last = part == 0 ? I_IN : NIT;
    if (it_first + gw < it_last) {
        int it = it_first + gw; TItem cur; TI_DECODE(it, cur);
        float tv[32]; f32x4 g0, g1; titem_load(cur, lane, tv, g0, g1);
#pragma unroll 1
        for (;;) {
            const int nit = it + NGW; const bool has = nit < it_last;
            TItem nx = cur; float tn[32]; f32x4 h0 = g0, h1 = g1;
            if (has) { TI_DECODE(nit, nx); titem_load(nx, lane, tn, h0, h1); }
            titem_store(cur, lane, tv, g0, g1, scr);
            if (!has) break;
            cur = nx; it = nit; g0 = h0; g1 = h1;
#pragma unroll
            for (int i = 0; i < 32; ++i) tv[i] = tn[i];
        }
    }
#undef TI_DECODE
    if (part != 0) { asm volatile("s_waitcnt vmcnt(0) lgkmcnt(0)" ::: "memory"); __syncthreads(); return; }
    if (l == 0) {
        for (int m = gw; m < NTOK; m += NGW) {
            const float* src = m < NPT ? p.in[0] + (size_t)m * 1024 : p.in[1] + (size_t)(m - NPT) * 1024;
            const f32x4* xr = (const f32x4*)src + lane; f32x4 v[4]; float sq = 0.f;
#pragma unroll
            for (int j = 0; j < 4; ++j) { v[j] = xr[64 * j]; sq += (v[j][0] * v[j][0] + v[j][1] * v[j][1]) + (v[j][2] * v[j][2] + v[j][3] * v[j][3]); }
            sq = wave_sum(sq);
            u32x2* o8 = (u32x2*)((bf16_t*)(ws + WS_H) + (size_t)m * 1024) + lane;
#pragma unroll
            for (int j = 0; j < 4; ++j) { u32x2 wv; wv.x = cvt_pk_bf16(v[j][0], v[j][1]); wv.y = cvt_pk_bf16(v[j][2], v[j][3]); o8[64 * j] = wv; }
            if (lane == 0) ((fx_t*)(ws + WS_SSQA))[m] = fx_of(sq);
        }
    }
    { unsigned z = 0u; asm volatile("" : "+v"(z)); unsigned* sb = (unsigned*)(ws + WS_SSQB); for (int i = blockIdx.x * 512 + tid; i < NTOK * 2; i += G * 512) sb[i] = z; }
    { unsigned z = 0u; asm volatile("" : "+v"(z)); unsigned* st = (unsigned*)(ws + WS_STATS); for (int i = blockIdx.x * 512 + tid; i < 256 * 16; i += G * 512) st[i] = z; }
    {
        f32x2* tab = (f32x2*)(ws + WS_TAB);
        for (int i = blockIdx.x * 512 + tid; i < 8192 * 128; i += G * 512) {
            const int pos = i >> 7, k = i & 127;
            const float inv = powf(10000.0f, -(float)(2 * k) / 256.0f); const float ang = (float)pos * inv;
            float sn, cs; sincosf(ang, &sn, &cs); tab[i] = (f32x2){cs, sn};
        }
    }
}

__device__ __forceinline__ void phase_scan(int wv, const Params& p, int l) {
    int wv_ = wv; asm volatile("" : "+s"(wv_)); int tid = wv_ * 64 + lane_id(); asm volatile("" : "+v"(tid));
    const int gt = blockIdx.x * 512 + tid;
    if (gt >= 2048 * 64) return;
    const int row = gt >> 6, d4 = (gt & 63) * 4, h = row >> 9, e = row & 511;
    const float sd = __expf(lgdec(h) * (float)CH);
#pragma unroll 1
    for (int b = 0; b < 2; ++b) {
        bf16_t* sp = s_head(p.ws, b, h) + (size_t)e * SEQ + d4;
        float a[4] = {0.f, 0.f, 0.f, 0.f};
#pragma unroll 1
        for (int j0 = 0; j0 < 32; j0 += 16) {
            u32x2 w[16];
#pragma unroll
            for (int j = 0; j < 16; ++j) w[j] = *(const u32x2*)(sp + (j0 + j) * CH);
#pragma unroll
            for (int j = 0; j < 16; ++j) {
                u32x2 o; o.x = cvt_pk_bf16(a[0], a[1]); o.y = cvt_pk_bf16(a[2], a[3]);
                *(u32x2*)(sp + (j0 + j) * CH) = o;
                a[0] = a[0] * sd + bflo(w[j].x); a[1] = a[1] * sd + bfhi(w[j].x); a[2] = a[2] * sd + bflo(w[j].y); a[3] = a[3] * sd + bfhi(w[j].y);
            }
        }
        float* o = p.out + OUT_RETP + ((size_t)((l * 2 + b) * 4 + h) * 256 + d4) * 512 + e;
#pragma unroll
        for (int j = 0; j < 4; ++j) o[(size_t)j * 512] = a[j];
    }
}

__device__ __forceinline__ void phase_sret(int wv, const Params& p, int l, LAS unsigned char* lds) {
    int wv_ = wv; asm volatile("" : "+s"(wv_)); int tid = wv_ * 64 + lane_id(); asm volatile("" : "+v"(tid));
    const int lane = tid & 63, w = __builtin_amdgcn_readfirstlane(tid >> 6);
    unsigned char* ws = p.ws;
    LAS float* attL = (LAS float*)lds;
    LAS float* red = (LAS float*)(lds + 8192);
    for (int unit = blockIdx.x, GG = gdim(); unit < 256; unit += GG) {
        const int es = unit & 7, h = (unit >> 3) & 3, bs = unit >> 5;
        const float lg = lgdec(h);
        const bf16_t* q = (const bf16_t*)(ws + WS_Q) + (size_t)(NPT + bs * 32) * 1024 + h * 256;
        const bf16_t* k = (const bf16_t*)(ws + WS_KS) + (size_t)(bs * 32) * 1024 + h * 256;
        const bf16_t* kT = (const bf16_t*)(ws + WS_KTS) + (size_t)(h * 256) * 256 + bs * 32;
        const bf16_t* vT = (const bf16_t*)(ws + WS_VTS) + (size_t)(h * 512 + es * 64) * 256 + bs * 32;
        if (w == 0) {
            f32x16 accq;
#pragma unroll
            for (int r = 0; r < 16; ++r) accq[r] = 0.f;
            const bf16_t* qa = q + (size_t)(lane & 31) * 1024 + (lane >> 5) * 8; const bf16_t* kb = k + (size_t)(lane & 31) * 1024 + (lane >> 5) * 8;
#pragma unroll
            for (int sk = 0; sk < 16; ++sk) { const bf16x8 af = *(const bf16x8*)(qa + 16 * sk), bfr = *(const bf16x8*)(kb + 16 * sk); accq = __builtin_amdgcn_mfma_f32_32x32x16_bf16(af, bfr, accq, 0, 0, 0); }
            const int m = lane & 31;
#pragma unroll
            for (int r = 0; r < 16; ++r) { const int n = (r & 3) + 8 * (r >> 2) + 4 * (lane >> 5); attL[n * 33 + m] = (m <= n) ? accq[r] * __expf(lg * (float)(n - m)) : 0.f; }
        }
        const int e = es * 64 + lane;
        const float* S0 = p.in[3] + ((size_t)((l * 8 + bs) * 4 + h) * 256 + w * 32) * 512 + e;
        float s0[32];
#pragma unroll
        for (int dd = 0; dd < 32; ++dd) s0[dd] = S0[(size_t)dd * 512];
        float v[32];
        { const u32x4* vp = (const u32x4*)(vT + (size_t)lane * 256);
#pragma unroll
          for (int c = 0; c < 4; ++c) { f32x4 a, b2; unpack8(vp[c], a, b2); v[8 * c] = a[0]; v[8 * c + 1] = a[1]; v[8 * c + 2] = a[2]; v[8 * c + 3] = a[3]; v[8 * c + 4] = b2[0]; v[8 * c + 5] = b2[1]; v[8 * c + 6] = b2[2]; v[8 * c + 7] = b2[3]; } }
        {
            float* So = p.out + OUT_RETS + ((size_t)((l * 8 + bs) * 4 + h) * 256 + w * 32) * 512 + e;
            const float sd = __expf(lg * 32.0f);
#pragma unroll 4
            for (int dd = 0; dd < 32; ++dd) {
                const u32x4* kr = (const u32x4*)(kT + (size_t)(w * 32 + dd) * 256); float a = s0[dd] * sd;
#pragma unroll
                for (int c4 = 0; c4 < 4; ++c4) { f32x4 k0, k1; unpack8(kr[c4], k0, k1);
                    a += (k0[0] * v[8 * c4] + k0[1] * v[8 * c4 + 1]) + (k0[2] * v[8 * c4 + 2] + k0[3] * v[8 * c4 + 3]) + (k1[0] * v[8 * c4 + 4] + k1[1] * v[8 * c4 + 5]) + (k1[2] * v[8 * c4 + 6] + k1[3] * v[8 * c4 + 7]); }
                So[(size_t)dd * 512] = a;
            }
        }
#pragma unroll 2
        for (int n = 0; n < 32; ++n) {
            const u32x4* qr = (const u32x4*)(q + (size_t)n * 1024 + w * 32); float a = 0.f;
#pragma unroll
            for (int c4 = 0; c4 < 4; ++c4) { f32x4 k0, k1; unpack8(qr[c4], k0, k1);
                a += (k0[0] * s0[8 * c4] + k0[1] * s0[8 * c4 + 1]) + (k0[2] * s0[8 * c4 + 2] + k0[3] * s0[8 * c4 + 3]) + (k1[0] * s0[8 * c4 + 4] + k1[1] * s0[8 * c4 + 5]) + (k1[2] * s0[8 * c4 + 6] + k1[3] * s0[8 * c4 + 7]); }
            red[(w * 32 + n) * 64 + lane] = a * __expf(lg * (float)(n + 1));
        }
        __syncthreads();
        bf16_t* O = (bf16_t*)(ws + WS_OS) + (size_t)(bs * 32) * 2048 + h * 512 + e;
        fx_t* st = (fx_t*)(ws + WS_STATS) + (size_t)(bs * 32) * 8 + h * 2;
#pragma unroll
        for (int r = 0; r < 4; ++r) {
            const int n = w * 4 + r; float a = 0.f;
#pragma unroll
            for (int ww = 0; ww < 8; ++ww) a += red[(ww * 32 + n) * 64 + lane];
#pragma unroll
            for (int m = 0; m < 32; ++m) a += attL[n * 33 + m] * v[m];
            O[(size_t)n * 2048] = (bf16_t)(cvt_pk_bf16(a, 0.f) & 0xffffu);
            const float s = wave_sum(a), qq = wave_sum(a * a);
            if (lane == 0) { fx_add(st + (size_t)n * 8, s); fx_add(st + (size_t)n * 8 + 1, qq); }
        }
        __syncthreads();
    }
}

__device__ __forceinline__ void phase_conv(int wv, const Params& p, int l, LAS unsigned char* lds) {
    int wv_ = wv; asm volatile("" : "+s"(wv_)); int tid = wv_ * 64 + lane_id(); asm volatile("" : "+v"(tid));
    const int lane = tid & 63, wave = tid >> 6;
    unsigned char* ws = p.ws;
    LAS float* red = (LAS float*)lds;
    const int c0 = tid * 2;
    const float* cw = p.in[6] + (size_t)l * 31 * 1024 + c0;
    float w0[31], w1[31];
#pragma unroll
    for (int j = 0; j < 31; ++j) { const f32x2 t = *(const f32x2*)(cw + (size_t)j * 1024); w0[j] = t.x; w1[j] = t.y; }
    const f32x2 cb = *(const f32x2*)(p.in[7] + l * 1024 + c0), lg = *(const f32x2*)(p.in[8] + l * 1024 + c0), lb = *(const f32x2*)(p.in[9] + l * 1024 + c0);
    const int GG = gdim();
    { unsigned z = 0u; asm volatile("" : "+v"(z)); unsigned* sa = (unsigned*)(ws + WS_SSQA); for (int i = blockIdx.x * 512 + tid; i < NTOK * 2; i += GG * 512) sa[i] = z; }
    for (int tok = blockIdx.x; tok < 256; tok += GG) {
        const int sb = tok >> 5, t = tok & 31;
        const bf16_t* gl = (const bf16_t*)(ws + WS_GLU) + (size_t)(NPT + sb * 32) * 1024 + c0;
        const float* cst = p.in[2] + (size_t)(l * 8 + sb) * 30 * 1024 + c0;
        unsigned xg[31]; f32x2 xs[31];
#pragma unroll
        for (int j = 0; j < 31; ++j) { const int tt = t + j - 30; const int tg = tt < 0 ? 0 : tt, tsx = tt + 30 > 29 ? 29 : tt + 30;
            xg[j] = *(const unsigned*)(gl + (size_t)tg * 1024); xs[j] = *(const f32x2*)(cst + (size_t)tsx * 1024); }
        float a0 = cb.x, a1 = cb.y;
#pragma unroll
        for (int j = 0; j < 31; ++j) { const bool fromg = (t + j - 30) >= 0; const float x0 = fromg ? bflo(xg[j]) : xs[j].x, x1 = fromg ? bfhi(xg[j]) : xs[j].y; a0 += x0 * w0[j]; a1 += x1 * w1[j]; }
        if (t >= 2) *(f32x2*)(p.out + OUT_CONVS + ((size_t)(l * 8 + sb) * 30 + (t - 2)) * 1024 + c0) = (f32x2){bflo(xg[30]), bfhi(xg[30])};
        { const float s = wave_sum(a0 + a1), q = wave_sum(a0 * a0 + a1 * a1); if (lane == 0) { red[wave] = s; red[128 + wave] = q; } }
        __syncthreads();
        { float s = 0.f, q = 0.f;
#pragma unroll
          for (int ww = 0; ww < 8; ++ww) { s += red[ww]; q += red[128 + ww]; }
          const float mu = s * (1.0f / 1024.0f); const float var = fmaxf(q * (1.0f / 1024.0f) - mu * mu, 0.f); const float rstd = __builtin_amdgcn_rsqf(var + LN_EPS);
          float y0 = (a0 - mu) * rstd * lg.x + lb.x, y1 = (a1 - mu) * rstd * lg.y + lb.y; y0 *= sigm(y0); y1 *= sigm(y1);
          *(unsigned*)((bf16_t*)(ws + WS_YC) + (size_t)(NPT + tok) * 1024 + c0) = cvt_pk_bf16(y0, y1); }
        __syncthreads();
    }
    for (int unit = blockIdx.x; unit < NPT / 16; unit += GG) {
        const int g0 = unit * 16, t0 = g0 & (SEQ - 1), pb = g0 >> 13;
        const bool lastt = (t0 == SEQ - 16);
        const bf16_t* gl = (const bf16_t*)(ws + WS_GLU) + (size_t)g0 * 1024 + c0;
        float* cso = p.out + OUT_CONVP + (size_t)(l * 2 + pb) * 30 * 1024 + c0;
        unsigned xin[46];
#pragma unroll
        for (int r = 0; r < 46; ++r) { const int tt = t0 - 30 + r; const long off = tt >= 0 ? (long)(r - 30) : 0l; xin[r] = *(const unsigned*)(gl + off * 1024); if (tt < 0) xin[r] = 0u; }
        float a0[16], a1[16];
#pragma unroll
        for (int t = 0; t < 16; ++t) { a0[t] = cb.x; a1[t] = cb.y; }
#pragma unroll
        for (int r = 0; r < 46; ++r) {
            const float x0 = bflo(xin[r]), x1 = bfhi(xin[r]);
            if (r >= 16 && lastt) *(f32x2*)(cso + (size_t)(r - 16) * 1024) = (f32x2){x0, x1};
#pragma unroll
            for (int t = 0; t < 16; ++t) { const int j = r - t; if (j >= 0 && j <= 30) { a0[t] += x0 * w0[j]; a1[t] += x1 * w1[j]; } }
        }
#pragma unroll
        for (int t = 0; t < 16; ++t) { const float s = wave_sum(a0[t] + a1[t]), q = wave_sum(a0[t] * a0[t] + a1[t] * a1[t]); if (lane == 0) { red[t * 8 + wave] = s; red[128 + t * 8 + wave] = q; } }
        __syncthreads();
        bf16_t* yo = (bf16_t*)(ws + WS_YC) + (size_t)g0 * 1024 + c0;
#pragma unroll
        for (int t = 0; t < 16; ++t) { float s = 0.f, q = 0.f;
#pragma unroll
            for (int ww = 0; ww < 8; ++ww) { s += red[t * 8 + ww]; q += red[128 + t * 8 + ww]; }
            const float mu = s * (1.0f / 1024.0f); const float var = fmaxf(q * (1.0f / 1024.0f) - mu * mu, 0.f);
            const float rstd = __builtin_amdgcn_rsqf(var + LN_EPS);
            float y0 = (a0[t] - mu) * rstd * lg.x + lb.x, y1 = (a1[t] - mu) * rstd * lg.y + lb.y;
            y0 *= sigm(y0); y1 *= sigm(y1);
            *(unsigned*)(yo + (size_t)t * 1024) = cvt_pk_bf16(y0, y1); }
        __syncthreads();
    }
}

__device__ __forceinline__ void phase_rms2(int wv, const Params& p, int l) {
    int wv_ = wv; asm volatile("" : "+s"(wv_)); int tid = wv_ * 64 + lane_id(); asm volatile("" : "+v"(tid));
    const int lane = tid & 63, gw = blockIdx.x * 8 + (tid >> 6), NGW = gdim() * 8;
    const float* g2 = p.in[14] + l * 1024;
    for (int m = gw; m < NTOK; m += NGW) rms_row(p.out + (size_t)m * 1024, g2, (bf16_t*)(p.ws + WS_H) + (size_t)m * 1024, nullptr, lane);
}
__device__ __forceinline__ void phase_final(int wv, const Params& p) {
    int wv_ = wv; asm volatile("" : "+s"(wv_)); int tid = wv_ * 64 + lane_id(); asm volatile("" : "+v"(tid));
    const int lane = tid & 63, gw = blockIdx.x * 8 + (tid >> 6), NGW = gdim() * 8;
    const f32x4* gr = (const f32x4*)p.in[17] + lane; const fx_t* ssq = (const fx_t*)(p.ws + WS_SSQA);
    for (int m = gw; m < NTOK; m += NGW) {
        f32x4* yr = (f32x4*)(p.out + (size_t)m * 1024) + lane; const u32x2* xr = (const u32x2*)((const bf16_t*)(p.ws + WS_H) + (size_t)m * 1024) + lane; const float r = rstd_of(fx_get(ssq[m]));
#pragma unroll
        for (int j = 0; j < 4; ++j) { const u32x2 w = xr[64 * j]; const f32x4 xv = {bflo(w.x), bfhi(w.x), bflo(w.y), bfhi(w.y)}; yr[64 * j] = xv * r * gr[64 * j]; }
    }
}

struct SPre { fx_t f0, f1, f2; unsigned u0, u1, u2, u3; f32x2 g0, g1; };
#define SG_BAR() do { asm volatile("s_waitcnt lgkmcnt(0)" ::: "memory"); __builtin_amdgcn_s_barrier(); asm volatile("" ::: "memory"); } while (0)
template <bool PAIR, class EpiS>
__device__ __forceinline__ void sgemm_phase(int wv, LAS unsigned char* lds, const bf16_t* A, const bf16_t* Wt, int K, int nUnits, const EpiS& epi) {
    int wv_ = wv; asm volatile("" : "+s"(wv_)); int tid = wv_ * 64 + lane_id(); asm volatile("" : "+v"(tid));
    const int lane = tid & 63, w = __builtin_amdgcn_readfirstlane(tid >> 6);
    LAS float* red = (LAS float*)lds;
    const int kw = K >> 3, GG = gdim();
    const size_t loff = (size_t)(lane & 15) * K + w * kw + (lane >> 4) * 8;
    const size_t r16 = (size_t)16 * K;
    const int row = tid >> 4, jq = tid & 15;
    int unit = blockIdx.x;
    if (unit >= nUnits) return;
#define SG_PTRS(u_) const int rb_ = (u_) & 7, cp_ = (u_) >> 3, n0_ = PAIR ? ((cp_ >> 2) * 256 + (cp_ & 3) * 32) : cp_ * 32; \
        const bf16_t* ap = A + (size_t)(rb_ * 32) * K + loff; const bf16_t* bp0 = Wt + (size_t)n0_ * K + loff; const bf16_t* bp1 = bp0 + (size_t)128 * K;
#define SG_LOAD(fa_, fb0_, fb1_, s_, ks_) do { fa_[s_][0] = *(const bf16x8*)(ap + (ks_)); fa_[s_][1] = *(const bf16x8*)(ap + r16 + (ks_)); \
        fb0_[s_][0] = *(const bf16x8*)(bp0 + (ks_)); fb0_[s_][1] = *(const bf16x8*)(bp0 + r16 + (ks_)); \
        if (PAIR) { fb1_[s_][0] = *(const bf16x8*)(bp1 + (ks_)); fb1_[s_][1] = *(const bf16x8*)(bp1 + r16 + (ks_)); } } while (0)
#define SG_MMA(fa_, fb0_, fb1_, s_) do { _Pragma("unroll") for (int a_ = 0; a_ < 2; ++a_) _Pragma("unroll") for (int c_ = 0; c_ < 2; ++c_) { \
        acc[a_][0][c_] = __builtin_amdgcn_mfma_f32_16x16x32_bf16(fa_[s_][a_], fb0_[s_][c_], acc[a_][0][c_], 0, 0, 0); \
        if (PAIR) acc[a_][1][c_] = __builtin_amdgcn_mfma_f32_16x16x32_bf16(fa_[s_][a_], fb1_[s_][c_], acc[a_][1][c_], 0, 0, 0); } } while (0)
#define SG_ZERO() do { _Pragma("unroll") for (int a_ = 0; a_ < 2; ++a_) _Pragma("unroll") for (int g_ = 0; g_ < 2; ++g_) _Pragma("unroll") for (int c_ = 0; c_ < 2; ++c_) acc[a_][g_][c_] = (f32x4){0.f, 0.f, 0.f, 0.f}; } while (0)
#define SG_REDUCE(u_, pr_) do { \
        _Pragma("unroll") for (int a_ = 0; a_ < 2; ++a_) _Pragma("unroll") for (int g_ = 0; g_ < (PAIR ? 2 : 1); ++g_) _Pragma("unroll") for (int c_ = 0; c_ < 2; ++c_) _Pragma("unroll") for (int r = 0; r < 4; ++r) \
            red[(w * 32 + a_ * 16 + (lane >> 4) * 4 + r) * 64 + g_ * 32 + c_ * 16 + (lane & 15)] = acc[a_][g_][c_][r]; \
        SG_BAR(); \
        const int rbq = (u_) & 7, cpq = (u_) >> 3, n0q = PAIR ? ((cpq >> 2) * 256 + (cpq & 3) * 32) : cpq * 32; \
        float x1[2] = {0.f, 0.f}, x2[2] = {0.f, 0.f}; \
        _Pragma("unroll") for (int ww = 0; ww < 8; ++ww) { const f32x2 p0 = *(const LAS f32x2*)(red + (ww * 32 + row) * 64 + 2 * jq); x1[0] += p0.x; x1[1] += p0.y; \
            if (PAIR) { const f32x2 p1 = *(const LAS f32x2*)(red + (ww * 32 + row) * 64 + 32 + 2 * jq); x2[0] += p1.x; x2[1] += p1.y; } } \
        epi(rbq * 32 + row, n0q + 2 * jq, x1, x2, pr_); \
        SG_BAR(); } while (0)
    f32x4 acc[2][2][2];
    if (K == 1024) {
        bf16x8 fa[4][2], fb0[4][2], fb1[4][2];
        { SG_PTRS(unit)
#pragma unroll
          for (int s = 0; s < 4; ++s) SG_LOAD(fa, fb0, fb1, s, 32 * s); }
#pragma unroll 1
        for (;;) {
            SG_ZERO();
#pragma unroll
            for (int s = 0; s < 4; ++s) SG_MMA(fa, fb0, fb1, s);
            const int cur = unit; unit += GG; const bool has = unit < nUnits;
            SPre pr; { const int rbc = cur & 7, cpc = cur >> 3, n0c = PAIR ? ((cpc >> 2) * 256 + (cpc & 3) * 32) : cpc * 32; pr = epi.pre(rbc * 32 + row, n0c + 2 * jq); }
            if (has) { SG_PTRS(unit)
#pragma unroll
                for (int s = 0; s < 4; ++s) SG_LOAD(fa, fb0, fb1, s, 32 * s); }
            SG_REDUCE(cur, pr);
            if (!has) break;
        }
    } else {
#pragma unroll 1
        for (; unit < nUnits; unit += GG) {
            SG_PTRS(unit)
            const SPre pr = epi.pre(rb_ * 32 + row, n0_ + 2 * jq);
            SG_ZERO();
#pragma unroll 1
            for (int ks = 0; ks < kw; ks += 128) {
                bf16x8 fa[4][2], fb0[4][2], fb1[4][2];
#pragma unroll
                for (int s = 0; s < 4; ++s) SG_LOAD(fa, fb0, fb1, s, ks + 32 * s);
#pragma unroll
                for (int s = 0; s < 4; ++s) SG_MMA(fa, fb0, fb1, s);
            }
            SG_REDUCE(unit, pr);
        }
    }
    asm volatile("s_waitcnt vmcnt(0) lgkmcnt(0)" ::: "memory");
    __syncthreads();
#undef SG_PTRS
#undef SG_LOAD
#undef SG_MMA
#undef SG_ZERO
#undef SG_REDUCE
}
#define SEPI_ARGS int rl, int n, const float (&x1)[2], const float (&x2)[2]
struct SEpiB1 {
    unsigned char* ws;
    __device__ __forceinline__ SPre pre(int rl, int n) const {
        SPre p_{}; p_.f0 = ((const fx_t*)(ws + WS_SSQA))[NPT + rl];
        const f32x2* tab = (const f32x2*)(ws + WS_TAB); const int d = n & 127, pos = PAST + (rl & 31);
        p_.g0 = tab[(size_t)pos * 128 + d]; p_.g1 = tab[(size_t)pos * 128 + d + 1];
        return p_;
    }
    __device__ __forceinline__ void operator()(int rl, int n, const float (&y1)[2], const float (&y2)[2], const SPre& pr) const {
        const float rs_ = rstd_of(fx_get(pr.f0));
        const float x1[2] = {y1[0] * rs_, y1[1] * rs_}, x2[2] = {y2[0] * rs_, y2[1] * rs_};
        if (n < 2048) {
            const int head = (n >> 8) & 3, d = n & 255;
            const f32x2 c0 = pr.g0, c1 = pr.g1;
            float o1[2], o2[2];
            o1[0] = x1[0] * c0.x - x2[0] * c0.y; o2[0] = x2[0] * c0.x + x1[0] * c0.y;
            o1[1] = x1[1] * c1.x - x2[1] * c1.y; o2[1] = x2[1] * c1.x + x1[1] * c1.y;
            if (n < 1024) {
                bf16_t* q = (bf16_t*)(ws + WS_Q) + (size_t)(NPT + rl) * 1024 + head * 256 + d;
                *(unsigned*)q = cvt_pk_bf16(o1[0], o1[1]); *(unsigned*)(q + 128) = cvt_pk_bf16(o2[0], o2[1]);
            } else {
                bf16_t* k = (bf16_t*)(ws + WS_KS) + (size_t)rl * 1024 + head * 256 + d;
                *(unsigned*)k = cvt_pk_bf16(o1[0] * 0.0625f, o1[1] * 0.0625f); *(unsigned*)(k + 128) = cvt_pk_bf16(o2[0] * 0.0625f, o2[1] * 0.0625f);
                const float dec = 0.0625f * __expf(lgdec(head) * (float)(DSEQ - 1 - (rl & 31)));
                bf16_t* kt = (bf16_t*)(ws + WS_KTS) + (size_t)(head * 256 + d) * 256 + rl;
                const unsigned wa = cvt_pk_bf16(o1[0] * dec, o1[1] * dec), wb = cvt_pk_bf16(o2[0] * dec, o2[1] * dec);
                kt[0] = (bf16_t)(wa & 0xffffu); kt[256] = (bf16_t)(wa >> 16); kt[128 * 256] = (bf16_t)(wb & 0xffffu); kt[129 * 256] = (bf16_t)(wb >> 16);
            }
        } else {
            bf16_t* vt = (bf16_t*)(ws + WS_VTS) + (size_t)(n - 2048) * 256 + rl;
            const unsigned wa = cvt_pk_bf16(x1[0], x1[1]), wb = cvt_pk_bf16(x2[0], x2[1]);
            vt[0] = (bf16_t)(wa & 0xffffu); vt[256] = (bf16_t)(wa >> 16); vt[128 * 256] = (bf16_t)(wb & 0xffffu); vt[129 * 256] = (bf16_t)(wb >> 16);
        }
    }
};
struct SEpiB2 {
    unsigned char* ws; const float* gn_g;
    __device__ __forceinline__ SPre pre(int rl, int n) const {
        SPre p_{}; p_.f0 = ((const fx_t*)(ws + WS_SSQA))[NPT + rl];
        const int col = (n - 2048) & 2047, head = col >> 9;
        const fx_t* sp2 = (const fx_t*)(ws + WS_STATS) + (size_t)rl * 8 + head * 2; p_.f1 = sp2[0]; p_.f2 = sp2[1];
        const bf16_t* o = (const bf16_t*)(ws + WS_OS) + (size_t)rl * 2048 + col; p_.u0 = *(const unsigned*)o; p_.u1 = *(const unsigned*)(o + 128);
        p_.g0 = *(const f32x2*)(gn_g + col); p_.g1 = *(const f32x2*)(gn_g + col + 128);
        return p_;
    }
    __device__ __forceinline__ void operator()(int rl, int n, const float (&y1)[2], const float (&y2)[2], const SPre& pr) const {
        const float rs_ = rstd_of(fx_get(pr.f0));
        const float x1[2] = {y1[0] * rs_, y1[1] * rs_}, x2[2] = {y2[0] * rs_, y2[1] * rs_};
        if (n < 2048) {
            bf16_t* o = (bf16_t*)(ws + WS_GLU) + (size_t)(NPT + rl) * 1024 + (n >> 8) * 128 + (n & 127);
            *(unsigned*)o = cvt_pk_bf16(x1[0] * sigm(x2[0]), x1[1] * sigm(x2[1]));
        } else if (n < 4096) {
            const int col = n - 2048, head = col >> 9;
            const f32x2 sq = {fx_get(pr.f1), fx_get(pr.f2)};
            const float mu = sq.x * (1.0f / 512.0f); const float var = fmaxf(sq.y * (1.0f / 512.0f) - mu * mu, 0.f); const float rstd = __builtin_amdgcn_rsqf(var + LN_EPS);
            bf16_t* o = (bf16_t*)(ws + WS_OS) + (size_t)rl * 2048 + col;
            const unsigned oa = pr.u0, ob = pr.u1;
            const f32x2 ga = pr.g0, gb = pr.g1;
            *(unsigned*)o = cvt_pk_bf16(x1[0] * sigm(x1[0]) * ((bflo(oa) - mu) * rstd * ga.x), x1[1] * sigm(x1[1]) * ((bfhi(oa) - mu) * rstd * ga.y));
            *(unsigned*)(o + 128) = cvt_pk_bf16(x2[0] * sigm(x2[0]) * ((bflo(ob) - mu) * rstd * gb.x), x2[1] * sigm(x2[1]) * ((bfhi(ob) - mu) * rstd * gb.y));
        } else {
            bf16_t* o = (bf16_t*)(ws + (n < 5120 ? WS_GC : WS_GR)) + (size_t)(NPT + rl) * 1024 + ((n - 4096) & 1023);
            *(unsigned*)o = cvt_pk_bf16(sigm(x1[0]), sigm(x1[1])); *(unsigned*)(o + 128) = cvt_pk_bf16(sigm(x2[0]), sigm(x2[1]));
        }
    }
};
template <int MODE, bool PAIR> struct SEpiEW {
    unsigned char* ws; float* x; fx_t* ssq;
    __device__ __forceinline__ SPre pre(int rl, int n) const {
        SPre p_{}; const size_t row = (size_t)(NPT + rl);
        if (MODE == 0) { const bf16_t* g = (const bf16_t*)(ws + WS_GC) + row * 1024 + n; p_.u0 = *(const unsigned*)g; if (PAIR) p_.u1 = *(const unsigned*)(g + 128); }
        else if (MODE == 1) { const bf16_t* g = (const bf16_t*)(ws + WS_GR) + row * 1024 + n; const bf16_t* t = (const bf16_t*)(ws + WS_T) + row * 1024 + n;
            p_.u0 = *(const unsigned*)g; p_.u2 = *(const unsigned*)t; if (PAIR) { p_.u1 = *(const unsigned*)(g + 128); p_.u3 = *(const unsigned*)(t + 128); } }
        else if (MODE == 2) { const bf16_t* xb = (const bf16_t*)(ws + WS_H) + row * 1024 + n; p_.u0 = *(const unsigned*)xb; if (PAIR) p_.u1 = *(const unsigned*)(xb + 128); }
        else p_.f0 = ssq[row];
        return p_;
    }
    __device__ __forceinline__ void operator()(SEPI_ARGS, const SPre& pr) const {
        const size_t row = (size_t)(NPT + rl);
        if (MODE == 0) {
            bf16_t* t = (bf16_t*)(ws + WS_T) + row * 1024 + n;
            const unsigned ga = pr.u0, gb = pr.u1;
            *(unsigned*)t = cvt_pk_bf16(x1[0] * bflo(ga), x1[1] * bfhi(ga)); if (PAIR) *(unsigned*)(t + 128) = cvt_pk_bf16(x2[0] * bflo(gb), x2[1] * bfhi(gb));
        } else if (MODE == 1) {
            bf16_t* t = (bf16_t*)(ws + WS_T) + row * 1024 + n;
            const unsigned ga = pr.u0, gb = pr.u1, ta = pr.u2, tb = pr.u3;
            *(unsigned*)t = cvt_pk_bf16(bflo(ta) + x1[0] * bflo(ga), bfhi(ta) + x1[1] * bfhi(ga)); if (PAIR) *(unsigned*)(t + 128) = cvt_pk_bf16(bflo(tb) + x2[0] * bflo(gb), bfhi(tb) + x2[1] * bfhi(gb));
        } else if (MODE == 2) {
            bf16_t* xb = (bf16_t*)(ws + WS_H) + row * 1024 + n; const unsigned xa = pr.u0, xc = PAIR ? pr.u1 : 0u;
            f32x2 a = {bflo(xa) + x1[0], bfhi(xa) + x1[1]}, b = {bflo(xc) + x2[0], bfhi(xc) + x2[1]};
            *(unsigned*)xb = cvt_pk_bf16(a.x, a.y); if (PAIR) *(unsigned*)(xb + 128) = cvt_pk_bf16(b.x, b.y);
            float q = a.x * a.x + a.y * a.y; if (PAIR) q += b.x * b.x + b.y * b.y;
            q += shx<1>(q); q += shx<2>(q); q += shx<4>(q); q += shx<8>(q);
            if ((lane_id() & 15) == 0) fx_add(ssq + row, q);
        } else {
            bf16_t* u = (bf16_t*)(ws + WS_U) + row * 4096 + n;
            const float r3 = rstd_of(fx_get(pr.f0));
            const float a0 = fmaxf(x1[0], 0.f) * r3, a1 = fmaxf(x1[1], 0.f) * r3, b0 = fmaxf(x2[0], 0.f) * r3, b1 = fmaxf(x2[1], 0.f) * r3;
            *(unsigned*)u = cvt_pk_bf16(a0 * a0, a1 * a1); if (PAIR) *(unsigned*)(u + 128) = cvt_pk_bf16(b0 * b0, b1 * b1);
        }
    }
};

#define XB_TMO      128
#define XB_XCNT(j)  (256  + 64 * (j))
#define XB_XSUB(j)  (1280 + 64 * (j))
#define XB_XGEN(j)  (2304 + 64 * (j))
#define XB_TOP      3328
#define XB_TOPGEN   3392
#define XCD_BAR_WORDS 3456
#define XB_SPIN_CAP (1u << 18)

__device__ __forceinline__ unsigned xb_ld(unsigned* p)              { return __hip_atomic_load(p, __ATOMIC_RELAXED, __HIP_MEMORY_SCOPE_AGENT); }
__device__ __forceinline__ unsigned xb_add(unsigned* p, unsigned v) { return __hip_atomic_fetch_add(p, v, __ATOMIC_RELAXED, __HIP_MEMORY_SCOPE_AGENT); }
__device__ __forceinline__ unsigned xb_xcc_id() { return (unsigned)__builtin_amdgcn_s_getreg((3 << 11) | 20) & 0xFu; }
#define XB_SPIN(cond, bar) do { unsigned _sp = 0; while (cond) { __builtin_amdgcn_s_sleep(1); \
    if ((++_sp & 255u) == 0u) { if (xb_ld(&(bar)[XB_TMO])) break; if (_sp > XB_SPIN_CAP) { atomicAdd(&(bar)[XB_TMO], 1u); break; } } } } while (0)

struct XcdBarrier {
    unsigned* bar; unsigned x;
    volatile LAS unsigned* st;
};

__device__ __forceinline__ XcdBarrier xcd_barrier_post(unsigned* bar, volatile LAS unsigned* st, int wv) {
    XcdBarrier b; b.bar = bar; b.x = xb_xcc_id(); b.st = st;
    if (wv == 0 && lane_id() == 0) (void)xb_add(&bar[XB_XCNT(b.x)], 1u);
    return b;
}
__device__ __forceinline__ void xcd_barrier_complete(unsigned* bar, unsigned x, unsigned& nloc, unsigned& nx) {
    const unsigned G = gridDim.x * gridDim.y * gridDim.z;
    unsigned sum, cnt, mine, sp = 0u;
    for (;;) {
        sum = 0u; cnt = 0u; mine = 0u;
#pragma unroll
        for (unsigned j = 0; j < 16; ++j) { const unsigned c = xb_ld(&bar[XB_XCNT(j)]); sum += c; cnt += (c > 0u) ? 1u : 0u; mine = (j == x) ? c : mine; }
        if (sum == G) break;
        __builtin_amdgcn_s_sleep(1);
        if ((++sp & 255u) == 0u) { if (xb_ld(&bar[XB_TMO])) break; if (sp > XB_SPIN_CAP) { atomicAdd(&bar[XB_TMO], 1u); break; } }
    }
    nloc = mine > 0u ? mine : 1u; nx = cnt > 0u ? cnt : 1u;
}

__device__ __forceinline__ void xcd_barrier(const XcdBarrier& b, int wv) {
    asm volatile("s_waitcnt vmcnt(0)" ::: "memory");
    __syncthreads();
    if (wv == 0 && lane_id() == 0) {
        unsigned* bar = b.bar;
        __builtin_amdgcn_s_waitcnt(0);
        unsigned nloc = b.st[0], nx = b.st[1];
        if (nloc == 0u) { xcd_barrier_complete(bar, b.x, nloc, nx); b.st[0] = nloc; b.st[1] = nx; }
        const unsigned old = xb_add(&bar[XB_XSUB(b.x)], 1u);
        const unsigned gen = old / nloc;
        if (old + 1u == (gen + 1u) * nloc) {
            __builtin_amdgcn_fence(__ATOMIC_RELEASE, "agent");
            asm volatile("s_waitcnt vmcnt(0)" ::: "memory");
            const unsigned og = xb_add(&bar[XB_TOP], 1u);
            const unsigned tg = og / nx;
            if (og + 1u == (tg + 1u) * nx) xb_add(&bar[XB_TOPGEN], 1u);
            else XB_SPIN(xb_ld(&bar[XB_TOPGEN]) == tg, bar);
            __builtin_amdgcn_fence(__ATOMIC_ACQUIRE, "agent");
            xb_add(&bar[XB_XGEN(b.x)], 1u);
            asm volatile("s_waitcnt vmcnt(0)" ::: "memory");
        } else {
            XB_SPIN(xb_ld(&bar[XB_XGEN(b.x)]) == gen, bar);
            __builtin_amdgcn_fence(__ATOMIC_ACQUIRE, "agent");
            asm volatile("s_waitcnt vmcnt(0)" ::: "memory");
        }
    }
    __syncthreads();
}


constexpr int LDS_BYTES = 131072 + 4096;
#define LCV ({ int c_ = (int)blockIdx.x; asm volatile("" : "+s"(c_)); c_; })
__global__ void __launch_bounds__(512, 2) fwd_megakernel(Params p) {
    extern __shared__ __attribute__((aligned(16))) unsigned char lds_raw[];
    LAS unsigned char* lds = (LAS unsigned char*)lds_raw;
    cg::grid_group grid = cg::this_grid();
    const int G = gridDim.x, c = blockIdx.x;
    unsigned char* ws = p.ws;
    int wv = __builtin_amdgcn_readfirstlane((int)(threadIdx.x >> 6)); asm volatile("" : "+s"(wv));
    volatile LAS unsigned* stw = (volatile LAS unsigned*)(lds + 131072);
    if (wv == 0) stw[lane_id()] = 0u;
    __syncthreads();
    XcdBarrier xbar = xcd_barrier_post((unsigned*)(ws + WS_BAR), stw, wv);
    if (p.ws == nullptr) grid.sync();
#define GSYNC() xcd_barrier(xbar, wv)
#pragma unroll 1
    for (int l = 0; l < 2; ++l) {
        phase0(wv, p, l, lds, 0);
        GSYNC();
        {
            SchedB1 S{G, LCV, (const char*)(ws + WS_H), (const char*)(ws + WS_WIN)}; EpiB1 E{ws};
            pg8::gemm_phase(wv, lds, pg8::Gemm{1024, 16, 1024, 1024}, S, E);
            sgemm_phase<true>(wv, lds, (const bf16_t*)(ws + WS_H) + (size_t)NPT * 1024, (const bf16_t*)(ws + WS_WIN), 1024, 8 * 64, SEpiB1{ws});
        }
        GSYNC();
        {
            { SchedAtt S{G, LCV, ws}; EpiAtt E{ws}; pg8::gemm_phase(wv, lds, pg8::Gemm{256, 4, 1024, 1024}, S, E); }
            { SchedU S{G, LCV, ws}; EpiU E{ws}; pg8::gemm_phase(wv, lds, pg8::Gemm{256, 4, SEQ, SEQ}, S, E); }
            phase_sret(wv, p, l, lds);
            GSYNC();
            phase_scan(wv, p, l);
            GSYNC();
            { SchedE S{G, LCV, ws}; EpiE E{ws}; pg8::gemm_phase(wv, lds, pg8::Gemm{512, 4, 1024, SEQ}, S, E); }
            {
                const int t_ = wv * 64 + lane_id(), row_ = t_ >> 1, which_ = t_ & 1, idx_ = (int)blockIdx.x, h_ = idx_ & 3, j_ = (idx_ >> 2) & 31, b_ = idx_ >> 7;
                if (idx_ < 256) {
                    const float* sl_ = (const float*)(ws + WS_SLOTS) + (size_t)idx_ * 4096 + row_ * 16 + which_;
                    float a_ = 0.f;
#pragma unroll
                    for (int k_ = 0; k_ < 8; ++k_) a_ += sl_[k_ * 2];
                    ((float*)(ws + WS_STATF))[(size_t)(b_ * SEQ + j_ * CH + row_) * 8 + h_ * 2 + which_] = a_;
                }
            }
            GSYNC();
        }
        {
            SchedN S{G, LCV, 24, 0, (const char*)(ws + WS_H), (const char*)(ws + WS_WIN) + (size_t)16 * TILEB, TILEB, ws, TILEB};
            EpiB2 E{ws, p.in[11] + l * 2048};
            pg8::gemm_phase(wv, lds, pg8::Gemm{1024, 16, 1024, 1024}, S, E);
            sgemm_phase<true>(wv, lds, (const bf16_t*)(ws + WS_H) + (size_t)NPT * 1024, (const bf16_t*)(ws + WS_WIN) + (size_t)4096 * 1024, 1024, 8 * 96, SEpiB2{ws, p.in[11] + l * 2048});
        }
        GSYNC();
        phase0(wv, p, l, lds, 1);
        phase_conv(wv, p, l, lds);
        GSYNC();
        { SchedN S{G, LCV, 4, 0, (const char*)(ws + WS_YC), (const char*)(ws + WS_WC), TILEB, ws, TILEB}; EpiEW<0> E{ws, p.out, nullptr}; pg8::gemm_phase(wv, lds, pg8::Gemm{1024, 16, 1024, 1024}, S, E); }
        sgemm_phase<false>(wv, lds, (const bf16_t*)(ws + WS_YC) + (size_t)NPT * 1024, (const bf16_t*)(ws + WS_WC), 1024, 8 * 32, SEpiEW<0, false>{ws, p.out, nullptr});
        { SchedN S{G, LCV, 4, 1, nullptr, (const char*)(ws + WS_WR), 2 * TILEB, ws, 0}; EpiEW<1> E{ws, p.out, nullptr}; pg8::gemm_phase(wv, lds, pg8::Gemm{2048, 32, 2048, 2048}, S, E); }
        sgemm_phase<false>(wv, lds, (const bf16_t*)(ws + WS_OS), (const bf16_t*)(ws + WS_WR), 2048, 8 * 32, SEpiEW<1, false>{ws, p.out, nullptr});
        GSYNC();
        { SchedN S{G, LCV, 4, 0, (const char*)(ws + WS_T), (const char*)(ws + WS_WO), TILEB, ws, TILEB}; EpiEW<2> E{ws, p.out, (fx_t*)(ws + WS_SSQB)}; pg8::gemm_phase(wv, lds, pg8::Gemm{1024, 16, 1024, 1024}, S, E); }
        sgemm_phase<false>(wv, lds, (const bf16_t*)(ws + WS_T) + (size_t)NPT * 1024, (const bf16_t*)(ws + WS_WO), 1024, 8 * 32, SEpiEW<2, false>{ws, p.out, (fx_t*)(ws + WS_SSQB)});
        GSYNC();
        { SchedN S{G, LCV, 16, 0, (const char*)(ws + WS_H), (const char*)(ws + WS_WM1), TILEB, ws, TILEB}; EpiEW<3> E{ws, p.out, (fx_t*)(ws + WS_SSQB)}; pg8::gemm_phase(wv, lds, pg8::Gemm{1024, 16, 1024, 1024}, S, E); }
        sgemm_phase<true>(wv, lds, (const bf16_t*)(ws + WS_H) + (size_t)NPT * 1024, (const bf16_t*)(ws + WS_WM1), 1024, 8 * 64, SEpiEW<3, true>{ws, p.out, (fx_t*)(ws + WS_SSQB)});
        GSYNC();
        { SchedN S{G, LCV, 4, 0, (const char*)(ws + WS_U), (const char*)(ws + WS_WM2), 4 * TILEB, ws, 4 * TILEB}; EpiEW<2> E{ws, p.out, (fx_t*)(ws + WS_SSQA)}; pg8::gemm_phase(wv, lds, pg8::Gemm{4096, 64, 4096, 4096}, S, E); }
        sgemm_phase<false>(wv, lds, (const bf16_t*)(ws + WS_U) + (size_t)NPT * 4096, (const bf16_t*)(ws + WS_WM2), 4096, 8 * 32, SEpiEW<2, false>{ws, p.out, (fx_t*)(ws + WS_SSQA)});
        GSYNC();
    }
    phase_final(wv, p);
}

extern "C" void kernel_launch(void* const* d_in, const int* in_sizes, int n_in, void* d_out, int out_size, void* d_ws, size_t ws_size, hipStream_t stream) {
    static int grid = 0;
    if (grid == 0) {
        if (n_in != 18 || ws_size < WS_END) { fprintf(stderr, "kernel_launch: unexpected n_in %d / ws_size %zu (need %zu)\n", n_in, ws_size, (size_t)WS_END); grid = -1; return; }
        int dev = 0, cus = 0, per_cu = 0;
        hipGetDevice(&dev); hipDeviceGetAttribute(&cus, hipDeviceAttributeMultiprocessorCount, dev);
        hipFuncSetAttribute((const void*)fwd_megakernel, hipFuncAttributeMaxDynamicSharedMemorySize, LDS_BYTES);
        hipOccupancyMaxActiveBlocksPerMultiprocessor(&per_cu, (const void*)fwd_megakernel, 512, LDS_BYTES);
        (void)hipGetLastError();
        if (per_cu < 1) per_cu = 1;
        grid = cus;
        fprintf(stderr, "kernel_launch: cus %d per_cu %d grid %d\n", cus, per_cu, grid);
    }
    if (grid < 0) return;
    if (hipMemsetAsync((char*)d_ws + WS_BAR, 0, 16384, stream) != hipSuccess) { fprintf(stderr, "memset failed\n"); return; }
    Params p{};
    for (int i = 0; i < 18; ++i) p.in[i] = (const float*)d_in[i];
    p.out = (float*)d_out; p.ws = (unsigned char*)d_ws;
    void* args[] = {&p};
    hipError_t e = hipLaunchCooperativeKernel((const void*)fwd_megakernel, dim3(grid), dim3(512), args, LDS_BYTES, stream);
    if (e != hipSuccess) fprintf(stderr, "cooperative launch failed: %s (grid %d)\n", hipGetErrorString(e), grid);
}
```

```cpp
#include <hip/hip_runtime.h>
#include <hip/hip_cooperative_groups.h>
#include <cstdio>
#include <cstdint>
namespace cg = cooperative_groups;

#define LAS __attribute__((address_space(3)))
typedef unsigned short bf16_t;
typedef short bf16x8 __attribute__((ext_vector_type(8)));
typedef float f32x4 __attribute__((ext_vector_type(4)));
typedef float f32x2 __attribute__((ext_vector_type(2)));
typedef float f32x16 __attribute__((ext_vector_type(16)));
typedef unsigned u32x4 __attribute__((ext_vector_type(4)));
typedef unsigned u32x2 __attribute__((ext_vector_type(2)));

constexpr int DM = 1024, SEQ = 8192, NPT = 16384, NTOK = 16640, DSEQ = 32, PAST = 4096;
constexpr int DFF = 4096, RV = 2048, CH = 256;
constexpr float RMS_EPS = 1e-6f, LN_EPS = 1e-5f;
constexpr size_t MiB = 1u << 20;
constexpr size_t TILEB = 256 * 1024 * 2;
constexpr size_t WS_STATF = 313 * MiB + MiB / 2;
constexpr size_t WS_SLOTS = 314 * MiB;
constexpr size_t WS_STATS = 313 * MiB;
constexpr size_t WS_BAR = 640 * 1024;
constexpr size_t WS_SSQA = 318 * MiB, WS_SSQB = 319 * MiB;
constexpr size_t WS_TAB = 1 * MiB;
constexpr size_t WS_WIN = 9 * MiB;
constexpr size_t WS_WC = 29 * MiB, WS_WR = 31 * MiB, WS_WO = 35 * MiB, WS_WM1 = 37 * MiB, WS_WM2 = 45 * MiB;
constexpr size_t WS_H = 53 * MiB;
constexpr size_t WS_Q = WS_H + 32 * MiB + MiB / 2;
constexpr size_t WS_KB0 = 118 * MiB, WS_KTB0 = 134 * MiB, WS_KB1 = 150 * MiB, WS_KTB1 = 166 * MiB, WS_KS = 182 * MiB, WS_KTS = WS_KS + MiB / 2;
constexpr size_t WS_VTB0 = 183 * MiB, WS_VTB1 = 215 * MiB, WS_VTS = 247 * MiB;
constexpr size_t WS_ATT = 248 * MiB;
constexpr size_t WS_S = 280 * MiB;
constexpr size_t WS_OS = 312 * MiB;
constexpr size_t WS_END = 320 * MiB;
constexpr size_t WS_GLU = WS_Q, WS_T = WS_Q, WS_U = WS_Q, WS_GC = WS_VTB0, WS_GR = WS_VTB0 + 32 * MiB + MiB / 2, WS_YC = WS_ATT;
constexpr size_t WS_OB0 = WS_KB0, WS_OB1 = WS_KB1;
static_assert(WS_Q == 85 * MiB + MiB / 2 && WS_Q + 32 * MiB + MiB / 2 == WS_KB0, "map");
static_assert(WS_U + (size_t)NTOK * DFF * 2 <= WS_END, "map");
constexpr size_t OUT_CONVP = 17039360, OUT_RETP = 17162240, OUT_CONVS = 19259392, OUT_RETS = 19750912;

struct Params { const float* in[18]; float* out; unsigned char* ws; };

typedef __bf16 bf16x2_t __attribute__((ext_vector_type(2)));
__device__ __forceinline__ unsigned cvt_pk_bf16(float lo, float hi) { const f32x2 v = {lo, hi}; return __builtin_bit_cast(unsigned, __builtin_convertvector(v, bf16x2_t)); }
__device__ __forceinline__ float bflo(unsigned w) { return __uint_as_float(w << 16); }
__device__ __forceinline__ float bfhi(unsigned w) { return __uint_as_float(w & 0xffff0000u); }
__device__ __forceinline__ float bf2f(bf16_t v) { return __uint_as_float((unsigned)v << 16); }
__device__ __forceinline__ float lgdec(int h) { return h == 0 ? -0.0317486983145803f : (h == 1 ? -0.015748356968139168f : (h == 2 ? -0.007843177461025893f : -0.003913899321136329f)); }
typedef unsigned long long fx_t;
constexpr float FX_SCALE = 16777216.0f, FX_INV = 1.0f / 16777216.0f;
__device__ __forceinline__ fx_t fx_of(float v) { return (fx_t)(long long)(v * FX_SCALE); }
__device__ __forceinline__ void fx_add(fx_t* p, float v) { atomicAdd(p, fx_of(v)); }
__device__ __forceinline__ float fx_get(fx_t v) { return (float)(long long)v * FX_INV; }
__device__ __forceinline__ float rstd_of(float ssq) { return __builtin_amdgcn_rsqf(ssq * (1.0f / 1024.0f) + RMS_EPS); }
__device__ __forceinline__ float sigm(float x) { return __builtin_amdgcn_rcpf(1.0f + __expf(-x)); }
__device__ __forceinline__ u32x4 pack8(const f32x4 a, const f32x4 b) { u32x4 w; w.x = cvt_pk_bf16(a[0], a[1]); w.y = cvt_pk_bf16(a[2], a[3]); w.z = cvt_pk_bf16(b[0], b[1]); w.w = cvt_pk_bf16(b[2], b[3]); return w; }
__device__ __forceinline__ void unpack8(const u32x4 w, f32x4& a, f32x4& b) { a = (f32x4){bflo(w.x), bfhi(w.x), bflo(w.y), bfhi(w.y)}; b = (f32x4){bflo(w.z), bfhi(w.z), bflo(w.w), bfhi(w.w)}; }
__device__ __forceinline__ int lane_id() { return (int)__builtin_amdgcn_mbcnt_hi(~0u, __builtin_amdgcn_mbcnt_lo(~0u, 0u)); }
__device__ __forceinline__ int gdim() { int g = (int)gridDim.x; asm volatile("" : "+s"(g)); return g; }
template <int K> __device__ __forceinline__ float shx(float v) {
    if constexpr (K < 32) return __builtin_bit_cast(float, __builtin_amdgcn_ds_swizzle(__builtin_bit_cast(int, v), (K << 10) | 0x1f));
    else { int l = lane_id(); asm volatile("" : "+v"(l)); return __builtin_bit_cast(float, __builtin_amdgcn_ds_bpermute((l ^ 32) << 2, __builtin_bit_cast(int, v))); }
}
template <int CTRL> __device__ __forceinline__ float dpp_f(float v) { return __builtin_bit_cast(float, __builtin_amdgcn_update_dpp(0, __builtin_bit_cast(int, v), CTRL, 0xf, 0xf, true)); }
__device__ __forceinline__ float wave_sum(float v) {
    v += dpp_f<0xB1>(v);
    v += dpp_f<0x4E>(v);
    v += dpp_f<0x141>(v);
    v += dpp_f<0x140>(v);
    const int iv = __builtin_bit_cast(int, v);
    return (__builtin_bit_cast(float, __builtin_amdgcn_readlane(iv, 0)) + __builtin_bit_cast(float, __builtin_amdgcn_readlane(iv, 16))) +
           (__builtin_bit_cast(float, __builtin_amdgcn_readlane(iv, 32)) + __builtin_bit_cast(float, __builtin_amdgcn_readlane(iv, 48)));
}

namespace pg8 {
constexpr int BM = 256, BK = 64, HALF = 128, HTB = HALF * BK * 2, STAGE_BYTES = 8 * HTB;
__host__ __device__ __forceinline__ int lds_byte(int r, int c) { const int st = (r >> 4) * 2 + (c >> 5), rr = r & 15, cc = c & 31, ob = rr * 64 + cc * 2; return st * 1024 + (ob ^ (((ob >> 9) & 1) << 5)); }
__host__ __device__ __forceinline__ void stage_rc(int b, int& R, int& C) { const int st = b / 1024, sb = b % 1024, swz = sb ^ (((sb >> 9) & 1) << 5); R = (st >> 1) * 16 + swz / 64; C = (st & 1) * 32 + (swz % 64) / 2; }
__host__ __device__ __forceinline__ int perm32(int rho) { const int n = rho >> 4, i = rho & 15; return 8 * (i >> 2) + 4 * n + (i & 3); }

struct Unit { const char* a; const char* b; long a2d, b2d; int kind, pm, pn, aux; };
struct Gemm { int K, nt1, lda, ldb; };

__device__ __forceinline__ void xcd_remap(int& wgid, int nwg) { const int q = nwg / 8, r = nwg % 8, xcd = wgid % 8, off = wgid / 8; wgid = (xcd < r ? xcd * (q + 1) : r * (q + 1) + (xcd - r) * q) + off; }
__device__ __forceinline__ void grp_decode(int wgid, int nM, int nN, int& pm, int& pn) { const int nig = 8 * nN, gid = wgid / nig, fm = gid * 8, gsz = (nM - fm) < 8 ? (nM - fm) : 8; pm = fm + ((wgid % nig) % gsz); pn = (wgid % nig) / gsz; }

template <class Epi, class Sched>
__device__ __forceinline__ void gemm_phase(int wv, LAS unsigned char* lds, const Gemm g, const Sched& S, const Epi& E) {
    int wv_ = wv; asm volatile("" : "+s"(wv_)); int tid = wv_ * 64 + lane_id(); asm volatile("" : "+v"(tid));
    const int wid = __builtin_amdgcn_readfirstlane(tid >> 6), lane = tid & 63, wr = wid >> 2, wc = wid & 3, fr = lane & 15, fq = lane >> 4;
    const int nt = g.K / BK, nt1 = g.nt1;
    unsigned voffA[2], voffB[2];
#pragma unroll
    for (int i = 0; i < 2; ++i) { int R, C; stage_rc(tid * 16 + i * 8192, R, C); const int Rb = (R & ~31) + perm32(R & 31);
        voffA[i] = (unsigned)(R * g.lda + C) * 2u; voffB[i] = (unsigned)(Rb * g.ldb + C) * 2u; }
    const size_t kstep = (size_t)(BK * 2);
    const size_t hstepA = (size_t)HALF * g.lda * 2, hstepB = (size_t)HALF * g.ldb * 2;
    const unsigned ldsw = (unsigned)wid * 1024u;
    const int aoff = lds_byte(wr * 64 + fr, fq * 8), boff = lds_byte(wc * 32 + fr, fq * 8);
#define PG8_SA(b, h) (((b) * 2 + (h)) * HTB)
#define PG8_SB(b, h) ((4 + (b) * 2 + (h)) * HTB)
#define PG8_STAGE(bufoff, gbase, voff) do { _Pragma("unroll") for (int _i = 0; _i < 2; ++_i) \
        __builtin_amdgcn_global_load_lds((const unsigned*)((const char*)(gbase) + (voff)[_i]), (LAS unsigned*)(lds + (bufoff) + ldsw + _i * 8192), 16, 0, 0); } while (0)
#define PG8_LDA(dst, b, h) do { _Pragma("unroll") for (int m = 0; m < 4; ++m) _Pragma("unroll") for (int k = 0; k < 2; ++k) dst[m][k] = *(const LAS bf16x8*)(lds + PG8_SA(b, h) + aoff + m * 2048 + k * 1024); } while (0)
#define PG8_LDB(dst, b, h) do { _Pragma("unroll") for (int n = 0; n < 2; ++n) _Pragma("unroll") for (int k = 0; k < 2; ++k) dst[n][k] = *(const LAS bf16x8*)(lds + PG8_SB(b, h) + boff + n * 2048 + k * 1024); } while (0)
#define PG8_MMA(ai, bj, At, Bt) do { __builtin_amdgcn_s_setprio(1); _Pragma("unroll") for (int m = 0; m < 4; ++m) _Pragma("unroll") for (int n = 0; n < 2; ++n) _Pragma("unroll") for (int k = 0; k < 2; ++k) \
        acc[ai][bj][m][n] = __builtin_amdgcn_mfma_f32_16x16x32_bf16(Bt[n][k], At[m][k], acc[ai][bj][m][n], 0, 0, 0); __builtin_amdgcn_s_setprio(0); } while (0)
#define PG8_WAIT_V(n) asm volatile("s_waitcnt vmcnt(" #n ")" ::: "memory")
#define PG8_WAIT_L(n) asm volatile("s_waitcnt lgkmcnt(" #n ")" ::: "memory")
#define PG8_BAR __builtin_amdgcn_s_barrier()
#define PG8_SCHED __builtin_amdgcn_sched_barrier(0)
#define PG8_TPA(u, t) ((u).a + (size_t)(t) * kstep + (((t) >= nt1) ? (u).a2d : 0l))
#define PG8_TPB(u, t) ((u).b + (size_t)(t) * kstep + (((t) >= nt1) ? (u).b2d : 0l))
    Unit cur, nxt; int ui = 0;
    if (!S.next(0, cur)) return;
    {
        const char* cA = cur.a; const char* cB = cur.b;
        PG8_STAGE(PG8_SB(0, 0), cB, voffB); PG8_STAGE(PG8_SB(0, 1), cB + hstepB, voffB); PG8_STAGE(PG8_SA(0, 0), cA, voffA); PG8_STAGE(PG8_SA(0, 1), cA + hstepA, voffA);
        if (wr == 1) PG8_BAR;
        PG8_WAIT_V(2); PG8_BAR;
        PG8_STAGE(PG8_SB(1, 0), cB + kstep, voffB); PG8_STAGE(PG8_SA(1, 0), cA + kstep, voffA); PG8_STAGE(PG8_SB(1, 1), cB + hstepB + kstep, voffB);
        PG8_WAIT_V(6); PG8_BAR;
    }
    f32x4 acc[2][2][4][2];
#pragma unroll
    for (int a = 0; a < 2; ++a)
#pragma unroll
        for (int b = 0; b < 2; ++b)
#pragma unroll
            for (int m = 0; m < 4; ++m)
#pragma unroll
                for (int n = 0; n < 2; ++n) acc[a][b][m][n] = (f32x4){0.f, 0.f, 0.f, 0.f};
    bf16x8 At[4][2], B0[2][2], B1[2][2];
#pragma unroll 1
    for (;;) {
        const bool has_next = S.next(ui + 1, nxt);
        if (!has_next) nxt = cur;
#pragma unroll 1
        for (int t = 0; t < nt; t += 2) {
            const bool last = (t == nt - 2);
            const char* a1 = PG8_TPA(cur, t + 1);
            const char* a2 = last ? PG8_TPA(nxt, 0) : PG8_TPA(cur, t + 2); const char* b2 = last ? PG8_TPB(nxt, 0) : PG8_TPB(cur, t + 2);
            const char* a3 = a2 + kstep; const char* b3 = b2 + kstep;
            PG8_LDB(B0, 0, 0); PG8_LDB(B1, 0, 1); PG8_SCHED; PG8_LDA(At, 0, 0); PG8_STAGE(PG8_SA(1, 1), a1 + hstepA, voffA);
            PG8_WAIT_V(8); PG8_WAIT_L(0); PG8_BAR; PG8_MMA(0, 0, At, B0); PG8_MMA(0, 1, At, B1); PG8_BAR; PG8_SCHED;
            PG8_LDA(At, 0, 1); PG8_STAGE(PG8_SB(0, 0), b2, voffB); PG8_STAGE(PG8_SB(0, 1), b2 + hstepB, voffB); PG8_STAGE(PG8_SA(0, 0), a2, voffA);
            PG8_WAIT_V(8); PG8_WAIT_L(0); PG8_BAR; PG8_MMA(1, 0, At, B0); PG8_MMA(1, 1, At, B1); PG8_BAR; PG8_SCHED;
            PG8_LDB(B0, 1, 0); PG8_LDB(B1, 1, 1); PG8_SCHED; PG8_LDA(At, 1, 0); PG8_STAGE(PG8_SA(0, 1), a2 + hstepA, voffA);
            PG8_WAIT_V(8); PG8_WAIT_L(0); PG8_BAR; PG8_MMA(0, 0, At, B0); PG8_MMA(0, 1, At, B1); PG8_BAR; PG8_SCHED;
            PG8_LDA(At, 1, 1); PG8_STAGE(PG8_SB(1, 0), b3, voffB); PG8_STAGE(PG8_SB(1, 1), b3 + hstepB, voffB); PG8_STAGE(PG8_SA(1, 0), a3, voffA);
            PG8_WAIT_V(8); PG8_WAIT_L(0); PG8_BAR; PG8_MMA(1, 0, At, B0); PG8_MMA(1, 1, At, B1); PG8_BAR; PG8_SCHED;
        }
        if (wr == 0) PG8_BAR;
        { int fr2 = fr, fq2 = fq; asm volatile("" : "+v"(fr2), "+v"(fq2)); E(acc, cur, wr, wc, fr2, fq2); }
        if (!has_next) break;
#pragma unroll
        for (int a = 0; a < 2; ++a)
#pragma unroll
            for (int b = 0; b < 2; ++b)
#pragma unroll
                for (int m = 0; m < 4; ++m)
#pragma unroll
                    for (int n = 0; n < 2; ++n) acc[a][b][m][n] = (f32x4){0.f, 0.f, 0.f, 0.f};
        cur = nxt; ++ui;
        if (wr == 1) PG8_BAR;
    }
    PG8_WAIT_V(0);
    PG8_BAR;
    asm volatile("s_waitcnt vmcnt(0) lgkmcnt(0)" ::: "memory");
    __syncthreads();
#undef PG8_SA
#undef PG8_SB
#undef PG8_STAGE
#undef PG8_LDA
#undef PG8_LDB
#undef PG8_MMA
#undef PG8_WAIT_V
#undef PG8_WAIT_L
#undef PG8_BAR
#undef PG8_SCHED
#undef PG8_TPA
#undef PG8_TPB
}
}
using pg8::Unit;

__device__ __forceinline__ bf16_t* k_tile(unsigned char* ws, int pm) { return (bf16_t*)(ws + (pm < 32 ? WS_KB0 + (size_t)pm * TILEB : (pm < 64 ? WS_KB1 + (size_t)(pm - 32) * TILEB : WS_KS))); }
__device__ __forceinline__ bf16_t* o_tile(unsigned char* ws, int pm) { return (bf16_t*)(ws + (pm < 32 ? WS_OB0 + (size_t)pm * 2 * TILEB : (pm < 64 ? WS_OB1 + (size_t)(pm - 32) * 2 * TILEB : WS_OS))); }

__device__ __forceinline__ bf16_t* s_head(unsigned char* ws, int b, int h) {
    const size_t off = b == 0 ? WS_S + (size_t)h * 8 * MiB : (h == 0 ? WS_TAB : (h == 1 ? WS_WC : (h == 2 ? WS_WM1 : WS_WM2)));
    return (bf16_t*)(ws + off);
}
struct SchedB1 {
    int G, c; const char* H; const char* W;
    __device__ __forceinline__ bool next(int i, Unit& u) const {
        const long L = (long)i * G + c; if (L >= 1024) return false;
        int wgid = (int)L; pg8::xcd_remap(wgid, 1024);
        { const int x = wgid >> 7, w = wgid & 127; wgid = w < 64 ? x * 64 + w : 512 + x * 64 + (w - 64); }
        u.a2d = 0; u.b2d = 0; u.aux = 0;
        if (wgid < 512) { pg8::grp_decode(wgid, 64, 8, u.pm, u.pn); u.kind = 0; u.a = H + (size_t)u.pm * TILEB; u.b = W + (size_t)u.pn * TILEB; }
        else { pg8::grp_decode(wgid - 512, 8, 64, u.pm, u.pn); u.pm += 4; u.kind = 1; u.a = W + (size_t)(4 + u.pm) * TILEB; u.b = H + (size_t)u.pn * TILEB; }
        return true;
    }
};
struct SchedN {
    int G, c, nN, amode; const char* A; const char* B; size_t bTile; unsigned char* ws; size_t aTile;
    __device__ __forceinline__ bool next(int i, Unit& u) const {
        const int nwg = 64 * nN; const long L = (long)i * G + c; if (L >= nwg) return false;
        int wgid = (int)L; pg8::xcd_remap(wgid, nwg); pg8::grp_decode(wgid, 64, nN, u.pm, u.pn);
        u.a2d = 0; u.b2d = 0; u.aux = 0; u.kind = 0;
        u.a = amode ? (const char*)o_tile(ws, u.pm) : A + (size_t)u.pm * aTile; u.b = B + (size_t)u.pn * bTile;
        return true;
    }
};
struct SchedAtt {
    int G, c; unsigned char* ws;
    __device__ __forceinline__ bool next(int i, Unit& u) const {
        const int L = i * G + c; if (L >= 256) return false;
        const int h = L & 3, j = (L >> 2) & 31, b = L >> 7;
        u.a2d = 0; u.b2d = 0; u.kind = 0; u.pm = j; u.pn = b; u.aux = h;
        u.a = (const char*)(ws + WS_Q) + ((size_t)(b * SEQ + j * CH) * 1024 + h * 256) * 2;
        u.b = (const char*)(ws + (b ? WS_KB1 : WS_KB0)) + ((size_t)(j * CH) * 1024 + h * 256) * 2;
        return true;
    }
};
struct SchedU {
    int G, c; unsigned char* ws;
    __device__ __forceinline__ bool next(int i, Unit& u) const {
        const int L = i * G + c; if (L >= 512) return false;
        const int pmt = L & 1, h = (L >> 1) & 3, j = (L >> 3) & 31, b = L >> 8;
        u.a2d = 0; u.b2d = 0; u.kind = b; u.pm = j; u.pn = 0; u.aux = h * 2 + pmt;
        u.a = (const char*)(ws + (b ? WS_VTB1 : WS_VTB0)) + ((size_t)(h * 512 + pmt * 256) * SEQ + j * CH) * 2;
        u.b = (const char*)(ws + (b ? WS_KTB1 : WS_KTB0)) + ((size_t)(h * 256) * SEQ + j * CH) * 2;
        return true;
    }
};
struct SchedE {
    int G, c; unsigned char* ws;
    __device__ __forceinline__ bool next(int i, Unit& u) const {
        const int L = i * G + c; if (L >= 512) return false;
        const int idx = L & 255, pnt = L >> 8, h = idx & 3, j = (idx >> 2) & 31, b = idx >> 7;
        u.kind = b; u.pm = j; u.pn = pnt; u.aux = h;
        const char* a1 = (const char*)(ws + WS_ATT) + ((size_t)(b * SEQ + j * CH) * 1024 + h * 256) * 2;
        const char* a2 = (const char*)(ws + WS_Q) + ((size_t)(b * SEQ + j * CH) * 1024 + h * 256) * 2;
        const char* b1 = (const char*)(ws + (b ? WS_VTB1 : WS_VTB0)) + ((size_t)(h * 512 + pnt * 256) * SEQ + j * CH) * 2;
        const char* b2 = (const char*)(s_head(ws, b, h) + (size_t)(pnt * 256) * SEQ + j * CH);
        u.a = a1; u.b = b1; u.a2d = (long)(a2 - a1) - 4 * 128; u.b2d = (long)(b2 - b1) - 4 * 128;
        return true;
    }
};

#define EPI_FENCE asm volatile("" ::: "memory")
#define EPI_ARGS const f32x4 (&acc)[2][2][4][2], const Unit& u, int wr, int wc, int fr, int fq
struct EpiB1 {
    unsigned char* ws;
    __device__ __forceinline__ void operator()(EPI_ARGS) const {
        const f32x2* tab = (const f32x2*)(ws + WS_TAB); const fx_t* ssq = (const fx_t*)(ws + WS_SSQA);
        if (u.kind == 0) {
            const int head = u.pn & 3; const bool isk = u.pn >= 4;
            bf16_t* dst = isk ? k_tile(ws, u.pm) : (bf16_t*)(ws + WS_Q) + (size_t)u.pm * 256 * 1024;
            const float sc = isk ? 0.0625f : 1.0f;
            const __amdgpu_buffer_rsrc_t ktr = __builtin_amdgcn_make_buffer_rsrc((void*)(ws + (u.pm < 32 ? WS_KTB0 : WS_KTB1)), (short)0, (int)(16 * MiB), 0x00020000);
            const int d0 = wc * 32 + fq * 8;
#pragma unroll
            for (int aih = 0; aih < 2; ++aih) {
                const int ai = aih, mb = 0;
                f32x4 tb[4][4]; float rsq[4];
#pragma unroll
                for (int m = mb; m < mb + 4; ++m) {
                    const int row = ai * 128 + wr * 64 + m * 16 + fr;
                    const int pos = u.pm < 64 ? ((u.pm & 31) * 256 + row) : (PAST + (row & 31));
                    const f32x4* tp = (const f32x4*)(tab + (size_t)pos * 128 + d0);
                    tb[m][0] = tp[0]; tb[m][1] = tp[1]; tb[m][2] = tp[2]; tb[m][3] = tp[3];
                    rsq[m] = fx_get(ssq[(size_t)u.pm * 256 + row]);
                }
                EPI_FENCE;
#pragma unroll
                for (int m = mb; m < mb + 4; ++m) {
                    const int row = ai * 128 + wr * 64 + m * 16 + fr;
                    const f32x4 c01 = tb[m][0], c23 = tb[m][1], c45 = tb[m][2], c67 = tb[m][3];
                    const f32x4 cs0 = (f32x4){c01[0], c01[2], c23[0], c23[2]}, sn0 = (f32x4){c01[1], c01[3], c23[1], c23[3]};
                    const f32x4 cs1 = (f32x4){c45[0], c45[2], c67[0], c67[2]}, sn1 = (f32x4){c45[1], c45[3], c67[1], c67[3]};
                    const f32x4 x1a = acc[ai][0][m][0], x1b = acc[ai][0][m][1], x2a = acc[ai][1][m][0], x2b = acc[ai][1][m][1];
                    const float scr_ = sc * rstd_of(rsq[m]);
                    const f32x4 o1a = (x1a * cs0 - x2a * sn0) * scr_, o1b = (x1b * cs1 - x2b * sn1) * scr_;
                    const f32x4 o2a = (x2a * cs0 + x1a * sn0) * scr_, o2b = (x2b * cs1 + x1b * sn1) * scr_;
                    bf16_t* rp = dst + (size_t)row * 1024 + head * 256 + d0;
                    *(u32x4*)rp = pack8(o1a, o1b); *(u32x4*)(rp + 128) = pack8(o2a, o2b);
                    if (isk) {
                        const float dk = __expf(lgdec(head) * (float)(CH - 1 - (row & (CH - 1))));
                        const unsigned voff = (unsigned)((d0 * SEQ + row) * 2);
                        const unsigned sbase = (unsigned)(((head * 256) * SEQ + (u.pm & 31) * 256) * 2);
                        const u32x4 t1 = pack8(o1a * dk, o1b * dk);
#pragma unroll
                        for (int jj = 0; jj < 4; ++jj) {
                            __builtin_amdgcn_raw_buffer_store_b16((short)(t1[jj] & 0xffffu), ktr, voff, sbase + (unsigned)(2 * jj) * SEQ * 2u, 0);
                            __builtin_amdgcn_raw_buffer_store_b16((short)(t1[jj] >> 16), ktr, voff, sbase + (unsigned)(2 * jj + 1) * SEQ * 2u, 0); }
                        const u32x4 t2 = pack8(o2a * dk, o2b * dk);
#pragma unroll
                        for (int jj = 0; jj < 4; ++jj) {
                            __builtin_amdgcn_raw_buffer_store_b16((short)(t2[jj] & 0xffffu), ktr, voff, sbase + (unsigned)(128 + 2 * jj) * SEQ * 2u, 0);
                            __builtin_amdgcn_raw_buffer_store_b16((short)(t2[jj] >> 16), ktr, voff, sbase + (unsigned)(129 + 2 * jj) * SEQ * 2u, 0); }
                    }
                }
                EPI_FENCE;
            }
        } else {
            bf16_t* dst; int ld;
            if (u.pn < 32) { dst = (bf16_t*)(ws + WS_VTB0) + (size_t)u.pn * 256; ld = SEQ; }
            else if (u.pn < 64) { dst = (bf16_t*)(ws + WS_VTB1) + (size_t)(u.pn - 32) * 256; ld = SEQ; }
            else { dst = (bf16_t*)(ws + WS_VTS); ld = 256; }
            f32x4 rsv[2][2];
#pragma unroll
            for (int bj = 0; bj < 2; ++bj) { const fx_t* sp8 = ssq + (size_t)u.pn * 256 + bj * 128 + wc * 32 + fq * 8;
#pragma unroll
                for (int n = 0; n < 2; ++n) rsv[bj][n] = (f32x4){rstd_of(fx_get(sp8[4 * n])), rstd_of(fx_get(sp8[4 * n + 1])), rstd_of(fx_get(sp8[4 * n + 2])), rstd_of(fx_get(sp8[4 * n + 3]))}; }
#pragma unroll
            for (int ai = 0; ai < 2; ++ai)
#pragma unroll
                for (int m = 0; m < 4; ++m) {
                    const int e = (u.pm - 4) * 256 + ai * 128 + wr * 64 + m * 16 + fr;
                    bf16_t* rp = dst + (size_t)e * ld + wc * 32 + fq * 8;
#pragma unroll
                    for (int bj = 0; bj < 2; ++bj) *(u32x4*)(rp + bj * 128) = pack8(acc[ai][bj][m][0] * rsv[bj][0], acc[ai][bj][m][1] * rsv[bj][1]);
                    EPI_FENCE;
                }
        }
    }
};
struct EpiAtt {
    unsigned char* ws;
    __device__ __forceinline__ void operator()(EPI_ARGS) const {
        const int h = u.aux; const float lg = lgdec(h);
        bf16_t* dst = (bf16_t*)(ws + WS_ATT) + (size_t)(u.pn * SEQ + u.pm * CH) * 1024 + h * 256;
        float cf[2][8];
#pragma unroll
        for (int bj = 0; bj < 2; ++bj)
#pragma unroll
            for (int j = 0; j < 8; ++j) cf[bj][j] = __expf(-lg * (float)(bj * 128 + wc * 32 + fq * 8 + j + 1));
#pragma unroll
        for (int ai = 0; ai < 2; ++ai)
#pragma unroll
            for (int m = 0; m < 4; ++m) {
                const int n = ai * 128 + wr * 64 + m * 16 + fr;
#pragma unroll
                for (int bj = 0; bj < 2; ++bj) {
                    const int m0 = bj * 128 + wc * 32 + fq * 8;
                    float o[8];
#pragma unroll
                    for (int j = 0; j < 8; ++j) o[j] = __uint_as_float(__float_as_uint(acc[ai][bj][m][j >> 2][j & 3] * cf[bj][j]) & ~(unsigned)((n - m0 - j) >> 31));
                    *(u32x4*)(dst + (size_t)n * 1024 + m0) = pack8((f32x4){o[0], o[1], o[2], o[3]}, (f32x4){o[4], o[5], o[6], o[7]});
                }
                EPI_FENCE;
            }
    }
};
struct EpiU {
    unsigned char* ws;
    __device__ __forceinline__ void operator()(EPI_ARGS) const {
        bf16_t* dst = s_head(ws, u.kind, u.aux >> 1) + (size_t)((u.aux & 1) * 256) * SEQ + u.pm * CH;
#pragma unroll
        for (int ai = 0; ai < 2; ++ai)
#pragma unroll
            for (int m = 0; m < 4; ++m) {
                bf16_t* rp = dst + (size_t)(ai * 128 + wr * 64 + m * 16 + fr) * SEQ + wc * 32 + fq * 8;
#pragma unroll
                for (int bj = 0; bj < 2; ++bj) *(u32x4*)(rp + bj * 128) = pack8(acc[ai][bj][m][0], acc[ai][bj][m][1]);
                    EPI_FENCE;
            }
    }
};
struct EpiE {
    unsigned char* ws;
    __device__ __forceinline__ void operator()(EPI_ARGS) const {
        const int h = u.aux, b = u.kind; const float lg = lgdec(h);
        bf16_t* dst = (bf16_t*)(ws + (b ? WS_OB1 : WS_OB0)) + (size_t)(u.pm * CH) * 2048 + h * 512 + u.pn * 256;
        float* sl = (float*)(ws + WS_SLOTS) + (size_t)blockIdx.x * 4096 + (u.pn * 4 + wc) * 2;
#pragma unroll
        for (int ai = 0; ai < 2; ++ai)
#pragma unroll
            for (int m = 0; m < 4; ++m) {
                const int n = ai * 128 + wr * 64 + m * 16 + fr; const float rs = __expf(lg * (float)(n + 1));
                float s = 0.f, q = 0.f;
#pragma unroll
                for (int bj = 0; bj < 2; ++bj) {
                    const f32x4 v0 = acc[ai][bj][m][0] * rs, v1 = acc[ai][bj][m][1] * rs;
                    s += (v0[0] + v0[1]) + (v0[2] + v0[3]) + (v1[0] + v1[1]) + (v1[2] + v1[3]);
                    q += (v0[0] * v0[0] + v0[1] * v0[1]) + (v0[2] * v0[2] + v0[3] * v0[3]) + (v1[0] * v1[0] + v1[1] * v1[1]) + (v1[2] * v1[2] + v1[3] * v1[3]);
                    *(u32x4*)(dst + (size_t)n * 2048 + bj * 128 + wc * 32 + fq * 8) = pack8(v0, v1);
                }
                s += shx<16>(s); s += shx<32>(s); q += shx<16>(q); q += shx<32>(q);
                if (fq == 0) *(f32x2*)(sl + (size_t)n * 16) = (f32x2){s, q};
                EPI_FENCE;
            }
    }
};
struct EpiB2 {
    unsigned char* ws; const float* gn_g;
    __device__ __forceinline__ void operator()(EPI_ARGS) const {
        const fx_t* ssq = (const fx_t*)(ws + WS_SSQA) + (size_t)u.pm * 256;
        float rsr[2][4];
#pragma unroll
        for (int ai = 0; ai < 2; ++ai)
#pragma unroll
            for (int m = 0; m < 4; ++m) rsr[ai][m] = fx_get(ssq[ai * 128 + wr * 64 + m * 16 + fr]);
#pragma unroll
        for (int ai = 0; ai < 2; ++ai)
#pragma unroll
            for (int m = 0; m < 4; ++m) rsr[ai][m] = rstd_of(rsr[ai][m]);
        if (u.pn < 8) {
            bf16_t* dst = (bf16_t*)(ws + WS_GLU) + (size_t)u.pm * 256 * 1024 + u.pn * 128 + wc * 32 + fq * 8;
#pragma unroll
            for (int ai = 0; ai < 2; ++ai)
#pragma unroll
                for (int m = 0; m < 4; ++m) {
                    const int row = ai * 128 + wr * 64 + m * 16 + fr;
                    const float rs = rsr[ai][m];
                    f32x4 a0 = acc[ai][0][m][0] * rs, a1 = acc[ai][0][m][1] * rs; const f32x4 b0 = acc[ai][1][m][0] * rs, b1 = acc[ai][1][m][1] * rs;
#pragma unroll
                    for (int j = 0; j < 4; ++j) { a0[j] *= sigm(b0[j]); a1[j] *= sigm(b1[j]); }
                    *(u32x4*)(dst + (size_t)row * 1024) = pack8(a0, a1);
                    EPI_FENCE;
                }
        } else if (u.pn < 16) {
            const int t = u.pn - 8, head = t >> 1;
            bf16_t* ob = o_tile(ws, u.pm) + t * 256 + wc * 32 + fq * 8;
            const float* st = (const float*)(ws + WS_STATF) + (size_t)u.pm * 256 * 8 + head * 2;
            f32x4 gg[2][2];
#pragma unroll
            for (int bj = 0; bj < 2; ++bj) { const f32x4* gp = (const f32x4*)(gn_g + t * 256 + bj * 128 + wc * 32 + fq * 8); gg[bj][0] = gp[0]; gg[bj][1] = gp[1]; }
#pragma unroll
            for (int aih = 0; aih < 4; ++aih) {
                const int ai = aih >> 1, mb = (aih & 1) * 2;
                f32x2 sqv[4]; u32x4 ov[4][2];
#pragma unroll
                for (int m = mb; m < mb + 2; ++m) {
                    const int row = ai * 128 + wr * 64 + m * 16 + fr;
                    sqv[m] = *(const f32x2*)(st + (size_t)row * 8);
#pragma unroll
                    for (int bj = 0; bj < 2; ++bj) ov[m][bj] = *(const u32x4*)(ob + (size_t)row * 2048 + bj * 128);
                }
                EPI_FENCE;
#pragma unroll
                for (int m = mb; m < mb + 2; ++m) {
                    const int row = ai * 128 + wr * 64 + m * 16 + fr;
                    const f32x2 sq = sqv[m]; const float rsn = rsr[ai][m];
                    const float mu = sq.x * (1.0f / 512.0f); const float var = fmaxf(sq.y * (1.0f / 512.0f) - mu * mu, 0.f); const float rstd = __builtin_amdgcn_rsqf(var + LN_EPS);
#pragma unroll
                    for (int bj = 0; bj < 2; ++bj) {
                        bf16_t* rp = ob + (size_t)row * 2048 + bj * 128;
                        f32x4 o0, o1; unpack8(ov[m][bj], o0, o1);
                        f32x4 g0 = acc[ai][bj][m][0] * rsn, g1 = acc[ai][bj][m][1] * rsn;
#pragma unroll
                        for (int j = 0; j < 4; ++j) { g0[j] = g0[j] * sigm(g0[j]) * ((o0[j] - mu) * rstd * gg[bj][0][j]); g1[j] = g1[j] * sigm(g1[j]) * ((o1[j] - mu) * rstd * gg[bj][1][j]); }
                        *(u32x4*)rp = pack8(g0, g1);
                    }
                }
                EPI_FENCE;
            }
        } else {
            const int t = (u.pn - 16) & 3;
            bf16_t* dst = (bf16_t*)(ws + (u.pn < 20 ? WS_GC : WS_GR)) + (size_t)u.pm * 256 * 1024 + t * 256 + wc * 32 + fq * 8;
#pragma unroll
            for (int ai = 0; ai < 2; ++ai)
#pragma unroll
                for (int m = 0; m < 4; ++m) {
                    const int row = ai * 128 + wr * 64 + m * 16 + fr; const float rs = rsr[ai][m];
#pragma unroll
                    for (int bj = 0; bj < 2; ++bj) {
                        f32x4 a0 = acc[ai][bj][m][0] * rs, a1 = acc[ai][bj][m][1] * rs;
#pragma unroll
                        for (int j = 0; j < 4; ++j) { a0[j] = sigm(a0[j]); a1[j] = sigm(a1[j]); }
                        *(u32x4*)(dst + (size_t)row * 1024 + bj * 128) = pack8(a0, a1);
                    }
                    EPI_FENCE;
                }
        }
    }
};
template <int MODE> struct EpiEW {
    unsigned char* ws; float* x; fx_t* ssq;
    __device__ __forceinline__ void operator()(EPI_ARGS) const {
        const int c0 = u.pn * 256 + wc * 32 + fq * 8;
#pragma unroll
        for (int ai = 0; ai < 2; ++ai) {
            u32x4 gv[4][2], tv[4][2]; float sqs[4] = {0.f, 0.f, 0.f, 0.f}, rs3[4];
            if (MODE == 3) {
#pragma unroll
                for (int m = 0; m < 4; ++m) rs3[m] = rstd_of(fx_get(ssq[(size_t)u.pm * 256 + ai * 128 + wr * 64 + m * 16 + fr]));
            }
            if (MODE != 3) {
#pragma unroll
                for (int m = 0; m < 4; ++m) {
                    const size_t row = (size_t)u.pm * 256 + ai * 128 + wr * 64 + m * 16 + fr;
#pragma unroll
                    for (int bj = 0; bj < 2; ++bj) {
                        if (MODE == 0) gv[m][bj] = *(const u32x4*)((const bf16_t*)(ws + WS_GC) + row * 1024 + c0 + bj * 128);
                        if (MODE == 1) { gv[m][bj] = *(const u32x4*)((const bf16_t*)(ws + WS_GR) + row * 1024 + c0 + bj * 128); tv[m][bj] = *(const u32x4*)((const bf16_t*)(ws + WS_T) + row * 1024 + c0 + bj * 128); }
                        if (MODE == 2) tv[m][bj] = *(const u32x4*)((const bf16_t*)(ws + WS_H) + row * 1024 + c0 + bj * 128);
                    }
                }
                EPI_FENCE;
            }
#pragma unroll
            for (int m = 0; m < 4; ++m) {
                const size_t row = (size_t)u.pm * 256 + ai * 128 + wr * 64 + m * 16 + fr;
#pragma unroll
                for (int bj = 0; bj < 2; ++bj) {
                    f32x4 a0 = acc[ai][bj][m][0], a1 = acc[ai][bj][m][1];
                    if (MODE == 0) {
                        f32x4 g0, g1; unpack8(gv[m][bj], g0, g1);
                        *(u32x4*)((bf16_t*)(ws + WS_T) + row * 1024 + c0 + bj * 128) = pack8(a0 * g0, a1 * g1);
                    } else if (MODE == 1) {
                        f32x4 g0, g1, t0, t1; unpack8(gv[m][bj], g0, g1); unpack8(tv[m][bj], t0, t1);
                        *(u32x4*)((bf16_t*)(ws + WS_T) + row * 1024 + c0 + bj * 128) = pack8(t0 + a0 * g0, t1 + a1 * g1);
                    } else if (MODE == 2) {
                        f32x4 x0, x1; unpack8(tv[m][bj], x0, x1);
                        a0 = x0 + a0; a1 = x1 + a1;
                        *(u32x4*)((bf16_t*)(ws + WS_H) + row * 1024 + c0 + bj * 128) = pack8(a0, a1);
                        sqs[m] += (a0[0] * a0[0] + a0[1] * a0[1]) + (a0[2] * a0[2] + a0[3] * a0[3]) + (a1[0] * a1[0] + a1[1] * a1[1]) + (a1[2] * a1[2] + a1[3] * a1[3]);
                    } else {
#pragma unroll
                        for (int j = 0; j < 4; ++j) { const float r0 = fmaxf(a0[j], 0.f) * rs3[m], r1 = fmaxf(a1[j], 0.f) * rs3[m]; a0[j] = r0 * r0; a1[j] = r1 * r1; }
                        *(u32x4*)((bf16_t*)(ws + WS_U) + row * 4096 + c0 + bj * 128) = pack8(a0, a1);
                    }
                }
                if (MODE == 2) { float q = sqs[m]; q += shx<16>(q); q += shx<32>(q); if (fq == 0) fx_add(ssq + row, q); }
            }
            EPI_FENCE;
        }
    }
};

__device__ __forceinline__ void transpose_item(const float* W, int K, int N, bf16_t* WT, int k0, int n0, int drow0, LAS float* scr, int lane, const float* gk = nullptr) {
    float tv[32];
#pragma unroll
    for (int i = 0; i < 32; ++i) { const int kk = 2 * i + (lane >> 5); tv[i] = W[(size_t)(k0 + kk) * N + n0 + (lane & 31)]; }
#pragma unroll
    for (int i = 0; i < 32; ++i) { const int kk = 2 * i + (lane >> 5); scr[kk * 33 + (lane & 31)] = gk ? tv[i] * gk[k0 + kk] : tv[i]; }
    asm volatile("s_waitcnt lgkmcnt(0)" ::: "memory");
    const int c = lane & 7;
#pragma unroll
    for (int j = 0; j < 4; ++j) { const int n = (lane >> 3) + 8 * j; const LAS float* s = scr + (8 * c) * 33 + n;
        u32x4 o; o.x = cvt_pk_bf16(s[0 * 33], s[1 * 33]); o.y = cvt_pk_bf16(s[2 * 33], s[3 * 33]); o.z = cvt_pk_bf16(s[4 * 33], s[5 * 33]); o.w = cvt_pk_bf16(s[6 * 33], s[7 * 33]);
        *(u32x4*)(WT + (size_t)(drow0 + n) * K + k0 + 8 * c) = o; }
    asm volatile("s_waitcnt lgkmcnt(0)" ::: "memory");
}
struct TItem { const float* W; const float* gk; bf16_t* WT; int K, N, k0, n0, drow0; };
__device__ __forceinline__ void titem_load(const TItem& t, int lane, float (&tv)[32], f32x4& g0, f32x4& g1) {
#pragma unroll
    for (int i = 0; i < 32; ++i) { const int kk = 2 * i + (lane >> 5); tv[i] = t.W[(size_t)(t.k0 + kk) * t.N + t.n0 + (lane & 31)]; }
    g0 = (f32x4){1.f, 1.f, 1.f, 1.f}; g1 = g0;
    if (t.gk) { const f32x4* gp = (const f32x4*)(t.gk + t.k0 + 8 * (lane & 7)); g0 = gp[0]; g1 = gp[1]; }
}
__device__ __forceinline__ void titem_store(const TItem& t, int lane, const float (&tv)[32], const f32x4 g0, const f32x4 g1, LAS float* scr) {
#pragma unroll
    for (int i = 0; i < 32; ++i) { const int kk = 2 * i + (lane >> 5); scr[kk * 33 + (lane & 31)] = tv[i]; }
    asm volatile("s_waitcnt lgkmcnt(0)" ::: "memory");
    const int c = lane & 7;
#pragma unroll
    for (int j = 0; j < 4; ++j) { const int n = (lane >> 3) + 8 * j; const LAS float* sp = scr + (8 * c) * 33 + n;
        u32x4 o; o.x = cvt_pk_bf16(sp[0 * 33] * g0[0], sp[1 * 33] * g0[1]); o.y = cvt_pk_bf16(sp[2 * 33] * g0[2], sp[3 * 33] * g0[3]);
        o.z = cvt_pk_bf16(sp[4 * 33] * g1[0], sp[5 * 33] * g1[1]); o.w = cvt_pk_bf16(sp[6 * 33] * g1[2], sp[7 * 33] * g1[3]);
        *(u32x4*)(t.WT + (size_t)(t.drow0 + n) * t.K + t.k0 + 8 * c) = o; }
    asm volatile("s_waitcnt lgkmcnt(0)" ::: "memory");
}
__device__ __forceinline__ int win_drow(int n0) {
    if (n0 < 2048) { const int bj = n0 >> 10, jj = n0 & 1023; return 4096 + 256 * (jj >> 7) + 128 * bj + (jj & 127); }
    if (n0 < 6144) return n0 - 2048;
    return n0;
}
__device__ __forceinline__ void rms_row(const float* xrow, const float* g, bf16_t* orow, float* copy, int lane) {
    const f32x4* xr = (const f32x4*)xrow + lane; const f32x4* gr = (const f32x4*)g + lane;
    f32x4 v[4]; float s = 0.f;
#pragma unroll
    for (int j = 0; j < 4; ++j) { v[j] = xr[64 * j]; s += (v[j][0] * v[j][0] + v[j][1] * v[j][1]) + (v[j][2] * v[j][2] + v[j][3] * v[j][3]); }
    const float r = 1.0f / sqrtf(wave_sum(s) * (1.0f / 1024.0f) + RMS_EPS);
    u32x2* o8 = (u32x2*)orow + lane;
#pragma unroll
    for (int j = 0; j < 4; ++j) { const f32x4 gg = gr[64 * j]; if (copy) ((f32x4*)copy + lane)[64 * j] = v[j];
        u32x2 w; w.x = cvt_pk_bf16(v[j][0] * r * gg[0], v[j][1] * r * gg[1]); w.y = cvt_pk_bf16(v[j][2] * r * gg[2], v[j][3] * r * gg[3]); o8[64 * j] = w; }
}

__device__ __forceinline__ void phase0(int wv, const Params& p, int l, LAS unsigned char* lds, int part) {
    int wv_ = wv; asm volatile("" : "+s"(wv_)); int tid = wv_ * 64 + lane_id(); asm volatile("" : "+v"(tid));
    const int lane = tid & 63, wave = tid >> 6, G = gdim();
    const int gw = blockIdx.x * 8 + wave, NGW = G * 8;
    unsigned char* ws = p.ws;
    LAS float* scr = (LAS float*)(lds + wave * 16384);
    const float* w_in = p.in[5] + (size_t)l * 1024 * 10240; const float* w_c = p.in[10] + (size_t)l * 1024 * 1024; const float* w_r = p.in[12] + (size_t)l * 2048 * 1024;
    const float* w_o = p.in[13] + (size_t)l * 1024 * 1024; const float* w_1 = p.in[15] + (size_t)l * 1024 * 4096; const float* w_2 = p.in[16] + (size_t)l * 4096 * 1024;
    constexpr int I_IN = 16 * 320, I_C = 16 * 32, I_R = 32 * 32, I_O = 16 * 32, I_1 = 16 * 128, I_2 = 64 * 32, NIT = I_IN + I_C + I_R + I_O + I_1 + I_2;
#define TI_DECODE(it_, T_) do { int r = (it_); \
        if (r < I_IN) { const int kb = r / 320, nb = r % 320; T_ = TItem{w_in, p.in[4] + l * 1024, (bf16_t*)(ws + WS_WIN), 1024, 10240, kb * 64, nb * 32, win_drow(nb * 32)}; break; } r -= I_IN; \
        if (r < I_C) { const int kb = r / 32, nb = r % 32; T_ = TItem{w_c, nullptr, (bf16_t*)(ws + WS_WC), 1024, 1024, kb * 64, nb * 32, nb * 32}; break; } r -= I_C; \
        if (r < I_R) { const int kb = r / 32, nb = r % 32; T_ = TItem{w_r, nullptr, (bf16_t*)(ws + WS_WR), 2048, 1024, kb * 64, nb * 32, nb * 32}; break; } r -= I_R; \
        if (r < I_O) { const int kb = r / 32, nb = r % 32; T_ = TItem{w_o, nullptr, (bf16_t*)(ws + WS_WO), 1024, 1024, kb * 64, nb * 32, nb * 32}; break; } r -= I_O; \
        if (r < I_1) { const int kb = r / 128, nb = r % 128; T_ = TItem{w_1, p.in[14] + l * 1024, (bf16_t*)(ws + WS_WM1), 1024, 4096, kb * 64, nb * 32, nb * 32}; break; } r -= I_1; \
        { const int kb = r / 32, nb = r % 32; T_ = TItem{w_2, nullptr, (bf16_t*)(ws + WS_WM2), 4096, 1024, kb * 64, nb * 32, nb * 32}; } } while (0)
    const int it_first = part == 0 ? 0 : I_IN, it_last = part == 0 ? I_IN : NIT;
    if (it_first + gw < it_last) {
        int it = it_first + gw; TItem cur; TI_DECODE(it, cur);
        float tv[32]; f32x4 g0, g1; titem_load(cur, lane, tv, g0, g1);
#pragma unroll 1
        for (;;) {
            const int nit = it + NGW; const bool has = nit < it_last;
            TItem nx = cur; float tn[32]; f32x4 h0 = g0, h1 = g1;
            if (has) { TI_DECODE(nit, nx); titem_load(nx, lane, tn, h0, h1); }
            titem_store(cur, lane, tv, g0, g1, scr);
            if (!has) break;
            cur = nx; it = nit; g0 = h0; g1 = h1;
#pragma unroll
            for (int i = 0; i < 32; ++i) tv[i] = tn[i];
        }
    }
#undef TI_DECODE
    if (part != 0) { asm volatile("s_waitcnt vmcnt(0) lgkmcnt(0)" ::: "memory"); __syncthreads(); return; }
    if (l == 0) {
        for (int m = gw; m < NTOK; m += NGW) {
            const float* src = m < NPT ? p.in[0] + (size_t)m * 1024 : p.in[1] + (size_t)(m - NPT) * 1024;
            const f32x4* xr = (const f32x4*)src + lane; f32x4 v[4]; float sq = 0.f;
#pragma unroll
            for (int j = 0; j < 4; ++j) { v[j] = xr[64 * j]; sq += (v[j][0] * v[j][0] + v[j][1] * v[j][1]) + (v[j][2] * v[j][2] + v[j][3] * v[j][3]); }
            sq = wave_sum(sq);
            u32x2* o8 = (u32x2*)((bf16_t*)(ws + WS_H) + (size_t)m * 1024) + lane;
#pragma unroll
            for (int j = 0; j < 4; ++j) { u32x2 wv; wv.x = cvt_pk_bf16(v[j][0], v[j][1]); wv.y = cvt_pk_bf16(v[j][2], v[j][3]); o8[64 * j] = wv; }
            if (lane == 0) ((fx_t*)(ws + WS_SSQA))[m] = fx_of(sq);
        }
    }
    { unsigned z = 0u; asm volatile("" : "+v"(z)); unsigned* sb = (unsigned*)(ws + WS_SSQB); for (int i = blockIdx.x * 512 + tid; i < NTOK * 2; i += G * 512) sb[i] = z; }
    { unsigned z = 0u; asm volatile("" : "+v"(z)); unsigned* st = (unsigned*)(ws + WS_STATS); for (int i = blockIdx.x * 512 + tid; i < 256 * 16; i += G * 512) st[i] = z; }
    {
        f32x2* tab = (f32x2*)(ws + WS_TAB);
        for (int i = blockIdx.x * 512 + tid; i < 8192 * 128; i += G * 512) {
            const int pos = i >> 7, k = i & 127;
            const float inv = powf(10000.0f, -(float)(2 * k) / 256.0f); const float ang = (float)pos * inv;
            float sn, cs; sincosf(ang, &sn, &cs); tab[i] = (f32x2){cs, sn};
        }
    }
}

__device__ __forceinline__ void phase_scan(int wv, const Params& p, int l) {
    int wv_ = wv; asm volatile("" : "+s"(wv_)); int tid = wv_ * 64 + lane_id(); asm volatile("" : "+v"(tid));
    const int gt = blockIdx.x * 512 + tid;
    if (gt >= 2048 * 64) return;
    const int row = gt >> 6, d4 = (gt & 63) * 4, h = row >> 9, e = row & 511;
    const float sd = __expf(lgdec(h) * (float)CH);
#pragma unroll 1
    for (int b = 0; b < 2; ++b) {
        bf16_t* sp = s_head(p.ws, b, h) + (size_t)e * SEQ + d4;
        float a[4] = {0.f, 0.f, 0.f, 0.f};
#pragma unroll 1
        for (int j0 = 0; j0 < 32; j0 += 16) {
            u32x2 w[16];
#pragma unroll
            for (int j = 0; j < 16; ++j) w[j] = *(const u32x2*)(sp + (j0 + j) * CH);
#pragma unroll
            for (int j = 0; j < 16; ++j) {
                u32x2 o; o.x = cvt_pk_bf16(a[0], a[1]); o.y = cvt_pk_bf16(a[2], a[3]);
                *(u32x2*)(sp + (j0 + j) * CH) = o;
                a[0] = a[0] * sd + bflo(w[j].x); a[1] = a[1] * sd + bfhi(w[j].x); a[2] = a[2] * sd + bflo(w[j].y); a[3] = a[3] * sd + bfhi(w[j].y);
            }
        }
        float* o = p.out + OUT_RETP + ((size_t)((l * 2 + b) * 4 + h) * 256 + d4) * 512 + e;
#pragma unroll
        for (int j = 0; j < 4; ++j) o[(size_t)j * 512] = a[j];
    }
}

__device__ __forceinline__ void phase_sret(int wv, const Params& p, int l, LAS unsigned char* lds) {
    int wv_ = wv; asm volatile("" : "+s"(wv_)); int tid = wv_ * 64 + lane_id(); asm volatile("" : "+v"(tid));
    const int lane = tid & 63, w = __builtin_amdgcn_readfirstlane(tid >> 6);
    unsigned char* ws = p.ws;
    LAS float* attL = (LAS float*)lds;
    LAS float* red = (LAS float*)(lds + 8192);
    for (int unit = blockIdx.x, GG = gdim(); unit < 256; unit += GG) {
        const int es = unit & 7, h = (unit >> 3) & 3, bs = unit >> 5;
        const float lg = lgdec(h);
        const bf16_t* q = (const bf16_t*)(ws + WS_Q) + (size_t)(NPT + bs * 32) * 1024 + h * 256;
        const bf16_t* k = (const bf16_t*)(ws + WS_KS) + (size_t)(bs * 32) * 1024 + h * 256;
        const bf16_t* kT = (const bf16_t*)(ws + WS_KTS) + (size_t)(h * 256) * 256 + bs * 32;
        const bf16_t* vT = (const bf16_t*)(ws + WS_VTS) + (size_t)(h * 512 + es * 64) * 256 + bs * 32;
        if (w == 0) {
            f32x16 accq;
#pragma unroll
            for (int r = 0; r < 16; ++r) accq[r] = 0.f;
            const bf16_t* qa = q + (size_t)(lane & 31) * 1024 + (lane >> 5) * 8; const bf16_t* kb = k + (size_t)(lane & 31) * 1024 + (lane >> 5) * 8;
#pragma unroll
            for (int sk = 0; sk < 16; ++sk) { const bf16x8 af = *(const bf16x8*)(qa + 16 * sk), bfr = *(const bf16x8*)(kb + 16 * sk); accq = __builtin_amdgcn_mfma_f32_32x32x16_bf16(af, bfr, accq, 0, 0, 0); }
            const int m = lane & 31;
#pragma unroll
            for (int r = 0; r < 16; ++r) { const int n = (r & 3) + 8 * (r >> 2) + 4 * (lane >> 5); attL[n * 33 + m] = (m <= n) ? accq[r] * __expf(lg * (float)(n - m)) : 0.f; }
        }
        const int e = es * 64 + lane;
        const float* S0 = p.in[3] + ((size_t)((l * 8 + bs) * 4 + h) * 256 + w * 32) * 512 + e;
        float s0[32];
#pragma unroll
        for (int dd = 0; dd < 32; ++dd) s0[dd] = S0[(size_t)dd * 512];
        float v[32];
        { const u32x4* vp = (const u32x4*)(vT + (size_t)lane * 256);
#pragma unroll
          for (int c = 0; c < 4; ++c) { f32x4 a, b2; unpack8(vp[c], a, b2); v[8 * c] = a[0]; v[8 * c + 1] = a[1]; v[8 * c + 2] = a[2]; v[8 * c + 3] = a[3]; v[8 * c + 4] = b2[0]; v[8 * c + 5] = b2[1]; v[8 * c + 6] = b2[2]; v[8 * c + 7] = b2[3]; } }
        {
            float* So = p.out + OUT_RETS + ((size_t)((l * 8 + bs) * 4 + h) * 256 + w * 32) * 512 + e;
            const float sd = __expf(lg * 32.0f);
#pragma unroll 4
            for (int dd = 0; dd < 32; ++dd) {
                const u32x4* kr = (const u32x4*)(kT + (size_t)(w * 32 + dd) * 256); float a = s0[dd] * sd;
#pragma unroll
                for (int c4 = 0; c4 < 4; ++c4) { f32x4 k0, k1; unpack8(kr[c4], k0, k1);
                    a += (k0[0] * v[8 * c4] + k0[1] * v[8 * c4 + 1]) + (k0[2] * v[8 * c4 + 2] + k0[3] * v[8 * c4 + 3]) + (k1[0] * v[8 * c4 + 4] + k1[1] * v[8 * c4 + 5]) + (k1[2] * v[8 * c4 + 6] + k1[3] * v[8 * c4 + 7]); }
                So[(size_t)dd * 512] = a;
            }
        }
#pragma unroll 2
        for (int n = 0; n < 32; ++n) {
            const u32x4* qr = (const u32x4*)(q + (size_t)n * 1024 + w * 32); float a = 0.f;
#pragma unroll
            for (int c4 = 0; c4 < 4; ++c4) { f32x4 k0, k1; unpack8(qr[c4], k0, k1);
                a += (k0[0] * s0[8 * c4] + k0[1] * s0[8 * c4 + 1]) + (k0[2] * s0[8 * c4 + 2] + k0[3] * s0[8 * c4 + 3]) + (k1[0] * s0[8 * c4 + 4] + k1[1] * s0[8 * c4 + 5]) + (k1[2] * s0[8 * c4 + 6] + k1[3] * s0[8 * c4 + 7]); }
            red[(w * 32 + n) * 64 + lane] = a * __expf(lg * (float)(n + 1));
        }
        __syncthreads();
        bf16_t* O = (bf16_t*)(ws + WS_OS) + (size_t)(bs * 32) * 2048 + h * 512 + e;
        fx_t* st = (fx_t*)(ws + WS_STATS) + (size_t)(bs * 32) * 8 + h * 2;
#pragma unroll
        for (int r = 0; r < 4; ++r) {
            const int n = w * 4 + r; float a = 0.f;
#pragma unroll
            for (int ww = 0; ww < 8; ++ww) a += red[(ww * 32 + n) * 64 + lane];
#pragma unroll
            for (int m = 0; m < 32; ++m) a += attL[n * 33 + m] * v[m];
            O[(size_t)n * 2048] = (bf16_t)(cvt_pk_bf16(a, 0.f) & 0xffffu);
            const float s = wave_sum(a), qq = wave_sum(a * a);
            if (lane == 0) { fx_add(st + (size_t)n * 8, s); fx_add(st + (size_t)n * 8 + 1, qq); }
        }
        __syncthreads();
    }
}

__device__ __forceinline__ void phase_conv(int wv, const Params& p, int l, LAS unsigned char* lds) {
    int wv_ = wv; asm volatile("" : "+s"(wv_)); int tid = wv_ * 64 + lane_id(); asm volatile("" : "+v"(tid));
    const int lane = tid & 63, wave = tid >> 6;
    unsigned char* ws = p.ws;
    LAS float* red = (LAS float*)lds;
    const int c0 = tid * 2;
    const float* cw = p.in[6] + (size_t)l * 31 * 1024 + c0;
    float w0[31], w1[31];
#pragma unroll
    for (int j = 0; j < 31; ++j) { const f32x2 t = *(const f32x2*)(cw + (size_t)j * 1024); w0[j] = t.x; w1[j] = t.y; }
    const f32x2 cb = *(const f32x2*)(p.in[7] + l * 1024 + c0), lg = *(const f32x2*)(p.in[8] + l * 1024 + c0), lb = *(const f32x2*)(p.in[9] + l * 1024 + c0);
    const int GG = gdim();
    { unsigned z = 0u; asm volatile("" : "+v"(z)); unsigned* sa = (unsigned*)(ws + WS_SSQA); for (int i = blockIdx.x * 512 + tid; i < NTOK * 2; i += GG * 512) sa[i] = z; }
    for (int tok = blockIdx.x; tok < 256; tok += GG) {
        const int sb = tok >> 5, t = tok & 31;
        const bf16_t* gl = (const bf16_t*)(ws + WS_GLU) + (size_t)(NPT + sb * 32) * 1024 + c0;
        const float* cst = p.in[2] + (size_t)(l * 8 + sb) * 30 * 1024 + c0;
        unsigned xg[31]; f32x2 xs[31];
#pragma unroll
        for (int j = 0; j < 31; ++j) { const int tt = t + j - 30; const int tg = tt < 0 ? 0 : tt, tsx = tt + 30 > 29 ? 29 : tt + 30;
            xg[j] = *(const unsigned*)(gl + (size_t)tg * 1024); xs[j] = *(const f32x2*)(cst + (size_t)tsx * 1024); }
        float a0 = cb.x, a1 = cb.y;
#pragma unroll
        for (int j = 0; j < 31; ++j) { const bool fromg = (t + j - 30) >= 0; const float x0 = fromg ? bflo(xg[j]) : xs[j].x, x1 = fromg ? bfhi(xg[j]) : xs[j].y; a0 += x0 * w0[j]; a1 += x1 * w1[j]; }
        if (t >= 2) *(f32x2*)(p.out + OUT_CONVS + ((size_t)(l * 8 + sb) * 30 + (t - 2)) * 1024 + c0) = (f32x2){bflo(xg[30]), bfhi(xg[30])};
        { const float s = wave_sum(a0 + a1), q = wave_sum(a0 * a0 + a1 * a1); if (lane == 0) { red[wave] = s; red[128 + wave] = q; } }
        __syncthreads();
        { float s = 0.f, q = 0.f;
#pragma unroll
          for (int ww = 0; ww < 8; ++ww) { s += red[ww]; q += red[128 + ww]; }
          const float mu = s * (1.0f / 1024.0f); const float var = fmaxf(q * (1.0f / 1024.0f) - mu * mu, 0.f); const float rstd = __builtin_amdgcn_rsqf(var + LN_EPS);
          float y0 = (a0 - mu) * rstd * lg.x + lb.x, y1 = (a1 - mu) * rstd * lg.y + lb.y; y0 *= sigm(y0); y1 *= sigm(y1);
          *(unsigned*)((bf16_t*)(ws + WS_YC) + (size_t)(NPT + tok) * 1024 + c0) = cvt_pk_bf16(y0, y1); }
        __syncthreads();
    }
    for (int unit = blockIdx.x; unit < NPT / 16; unit += GG) {
        const int g0 = unit * 16, t0 = g0 & (SEQ - 1), pb = g0 >> 13;
        const bool lastt = (t0 == SEQ - 16);
        const bf16_t* gl = (const bf16_t*)(ws + WS_GLU) + (size_t)g0 * 1024 + c0;
        float* cso = p.out + OUT_CONVP + (size_t)(l * 2 + pb) * 30 * 1024 + c0;
        unsigned xin[46];
#pragma unroll
        for (int r = 0; r < 46; ++r) { const int tt = t0 - 30 + r; const long off = tt >= 0 ? (long)(r - 30) : 0l; xin[r] = *(const unsigned*)(gl + off * 1024); if (tt < 0) xin[r] = 0u; }
        f32x2 xv[46];
#pragma unroll
        for (int r = 0; r < 46; ++r) { xv[r] = (f32x2){bflo(xin[r]), bfhi(xin[r])}; if (r >= 16 && lastt) *(f32x2*)(cso + (size_t)(r - 16) * 1024) = xv[r]; }
        float a0[16], a1[16];
#pragma unroll
        for (int tq = 0; tq < 16; tq += 4) {
            f32x2 v0 = cb, v1 = cb, v2 = cb, v3 = cb;
#pragma unroll
            for (int j = 0; j < 31; ++j) {
                const f32x2 wv = {w0[j], w1[j]};
                asm volatile("v_pk_fma_f32 %0, %4, %8, %0\n\tv_pk_fma_f32 %1, %5, %8, %1\n\tv_pk_fma_f32 %2, %6, %8, %2\n\tv_pk_fma_f32 %3, %7, %8, %3"
                             : "+v"(v0), "+v"(v1), "+v"(v2), "+v"(v3) : "v"(xv[tq + j]), "v"(xv[tq + 1 + j]), "v"(xv[tq + 2 + j]), "v"(xv[tq + 3 + j]), "v"(wv));
            }
            a0[tq] = v0.x; a1[tq] = v0.y; a0[tq + 1] = v1.x; a1[tq + 1] = v1.y; a0[tq + 2] = v2.x; a1[tq + 2] = v2.y; a0[tq + 3] = v3.x; a1[tq + 3] = v3.y;
        }
#pragma unroll
        for (int t = 0; t < 16; ++t) { const float s = wave_sum(a0[t] + a1[t]), q = wave_sum(a0[t] * a0[t] + a1[t] * a1[t]); if (lane == 0) { red[t * 8 + wave] = s; red[128 + t * 8 + wave] = q; } }
        asm volatile("s_waitcnt lgkmcnt(0)" ::: "memory"); __builtin_amdgcn_s_barrier(); asm volatile("" ::: "memory");
        bf16_t* yo = (bf16_t*)(ws + WS_YC) + (size_t)g0 * 1024 + c0;
#pragma unroll
        for (int t = 0; t < 16; ++t) { float s = 0.f, q = 0.f;
#pragma unroll
            for (int ww = 0; ww < 8; ++ww) { s += red[t * 8 + ww]; q += red[128 + t * 8 + ww]; }
            const float mu = s * (1.0f / 1024.0f); const float var = fmaxf(q * (1.0f / 1024.0f) - mu * mu, 0.f);
            const float rstd = __builtin_amdgcn_rsqf(var + LN_EPS);
            float y0 = (a0[t] - mu) * rstd * lg.x + lb.x, y1 = (a1[t] - mu) * rstd * lg.y + lb.y;
            y0 *= sigm(y0); y1 *= sigm(y1);
            *(unsigned*)(yo + (size_t)t * 1024) = cvt_pk_bf16(y0, y1); }
        asm volatile("s_waitcnt lgkmcnt(0)" ::: "memory"); __builtin_amdgcn_s_barrier(); asm volatile("" ::: "memory");
    }
    asm volatile("s_waitcnt vmcnt(0) lgkmcnt(0)" ::: "memory");
    __syncthreads();
}

__device__ __forceinline__ void phase_rms2(int wv, const Params& p, int l) {
    int wv_ = wv; asm volatile("" : "+s"(wv_)); int tid = wv_ * 64 + lane_id(); asm volatile("" : "+v"(tid));
    const int lane = tid & 63, gw = blockIdx.x * 8 + (tid >> 6), NGW = gdim() * 8;
    const float* g2 = p.in[14] + l * 1024;
    for (int m = gw; m < NTOK; m += NGW) rms_row(p.out + (size_t)m * 1024, g2, (bf16_t*)(p.ws + WS_H) + (size_t)m * 1024, nullptr, lane);
}
__device__ __forceinline__ void phase_final(int wv, const Params& p) {
    int wv_ = wv; asm volatile("" : "+s"(wv_)); int tid = wv_ * 64 + lane_id(); asm volatile("" : "+v"(tid));
    const int lane = tid & 63, gw = blockIdx.x * 8 + (tid >> 6), NGW = gdim() * 8;
    const f32x4* gr = (const f32x4*)p.in[17] + lane; const fx_t* ssq = (const fx_t*)(p.ws + WS_SSQA);
    for (int m = gw; m < NTOK; m += NGW) {
        f32x4* yr = (f32x4*)(p.out + (size_t)m * 1024) + lane; const u32x2* xr = (const u32x2*)((const bf16_t*)(p.ws + WS_H) + (size_t)m * 1024) + lane; const float r = rstd_of(fx_get(ssq[m]));
#pragma unroll
        for (int j = 0; j < 4; ++j) { const u32x2 w = xr[64 * j]; const f32x4 xv = {bflo(w.x), bfhi(w.x), bflo(w.y), bfhi(w.y)}; yr[64 * j] = xv * r * gr[64 * j]; }
    }
}

struct SPre { fx_t f0, f1, f2; unsigned u0, u1, u2, u3; f32x2 g0, g1; };
#define SG_BAR() do { asm volatile("s_waitcnt lgkmcnt(0)" ::: "memory"); __builtin_amdgcn_s_barrier(); asm volatile("" ::: "memory"); } while (0)
template <bool PAIR, class EpiS>
__device__ __forceinline__ void sgemm_phase(int wv, LAS unsigned char* lds, const bf16_t* A, const bf16_t* Wt, int K, int nUnits, const EpiS& epi) {
    int wv_ = wv; asm volatile("" : "+s"(wv_)); int tid = wv_ * 64 + lane_id(); asm volatile("" : "+v"(tid));
    const int lane = tid & 63, w = __builtin_amdgcn_readfirstlane(tid >> 6);
    LAS float* red = (LAS float*)lds;
    const int kw = K >> 3, GG = gdim();
    const size_t loff = (size_t)(lane & 15) * K + w * kw + (lane >> 4) * 8;
    const size_t r16 = (size_t)16 * K;
    const int row = tid >> 4, jq = tid & 15;
    int unit = blockIdx.x;
    if (unit >= nUnits) return;
#define SG_PTRS(u_) const int rb_ = (u_) & 7, cp_ = (u_) >> 3, n0_ = PAIR ? ((cp_ >> 2) * 256 + (cp_ & 3) * 32) : cp_ * 32; \
        const bf16_t* ap = A + (size_t)(rb_ * 32) * K + loff; const bf16_t* bp0 = Wt + (size_t)n0_ * K + loff; const bf16_t* bp1 = bp0 + (size_t)128 * K;
#define SG_LOAD(fa_, fb0_, fb1_, s_, ks_) do { fa_[s_][0] = *(const bf16x8*)(ap + (ks_)); fa_[s_][1] = *(const bf16x8*)(ap + r16 + (ks_)); \
        fb0_[s_][0] = *(const bf16x8*)(bp0 + (ks_)); fb0_[s_][1] = *(const bf16x8*)(bp0 + r16 + (ks_)); \
        if (PAIR) { fb1_[s_][0] = *(const bf16x8*)(bp1 + (ks_)); fb1_[s_][1] = *(const bf16x8*)(bp1 + r16 + (ks_)); } } while (0)
#define SG_MMA(fa_, fb0_, fb1_, s_) do { _Pragma("unroll") for (int a_ = 0; a_ < 2; ++a_) _Pragma("unroll") for (int c_ = 0; c_ < 2; ++c_) { \
        acc[a_][0][c_] = __builtin_amdgcn_mfma_f32_16x16x32_bf16(fa_[s_][a_], fb0_[s_][c_], acc[a_][0][c_], 0, 0, 0); \
        if (PAIR) acc[a_][1][c_] = __builtin_amdgcn_mfma_f32_16x16x32_bf16(fa_[s_][a_], fb1_[s_][c_], acc[a_][1][c_], 0, 0, 0); } } while (0)
#define SG_ZERO() do { _Pragma("unroll") for (int a_ = 0; a_ < 2; ++a_) _Pragma("unroll") for (int g_ = 0; g_ < 2; ++g_) _Pragma("unroll") for (int c_ = 0; c_ < 2; ++c_) acc[a_][g_][c_] = (f32x4){0.f, 0.f, 0.f, 0.f}; } while (0)
#define SG_REDUCE(u_, pr_) do { \
        _Pragma("unroll") for (int a_ = 0; a_ < 2; ++a_) _Pragma("unroll") for (int g_ = 0; g_ < (PAIR ? 2 : 1); ++g_) _Pragma("unroll") for (int c_ = 0; c_ < 2; ++c_) _Pragma("unroll") for (int r = 0; r < 4; ++r) \
            red[(w * 32 + a_ * 16 + (lane >> 4) * 4 + r) * 64 + g_ * 32 + c_ * 16 + (lane & 15)] = acc[a_][g_][c_][r]; \
        SG_BAR(); \
        const int rbq = (u_) & 7, cpq = (u_) >> 3, n0q = PAIR ? ((cpq >> 2) * 256 + (cpq & 3) * 32) : cpq * 32; \
        float x1[2] = {0.f, 0.f}, x2[2] = {0.f, 0.f}; \
        _Pragma("unroll") for (int ww = 0; ww < 8; ++ww) { const f32x2 p0 = *(const LAS f32x2*)(red + (ww * 32 + row) * 64 + 2 * jq); x1[0] += p0.x; x1[1] += p0.y; \
            if (PAIR) { const f32x2 p1 = *(const LAS f32x2*)(red + (ww * 32 + row) * 64 + 32 + 2 * jq); x2[0] += p1.x; x2[1] += p1.y; } } \
        epi(rbq * 32 + row, n0q + 2 * jq, x1, x2, pr_); \
        SG_BAR(); } while (0)
    f32x4 acc[2][2][2];
    if (K == 1024) {
        bf16x8 fa[4][2], fb0[4][2], fb1[4][2];
        { SG_PTRS(unit)
#pragma unroll
          for (int s = 0; s < 4; ++s) SG_LOAD(fa, fb0, fb1, s, 32 * s); }
#pragma unroll 1
        for (;;) {
            SG_ZERO();
#pragma unroll
            for (int s = 0; s < 4; ++s) SG_MMA(fa, fb0, fb1, s);
            const int cur = unit; unit += GG; const bool has = unit < nUnits;
            SPre pr; { const int rbc = cur & 7, cpc = cur >> 3, n0c = PAIR ? ((cpc >> 2) * 256 + (cpc & 3) * 32) : cpc * 32; pr = epi.pre(rbc * 32 + row, n0c + 2 * jq); }
            if (has) { SG_PTRS(unit)
#pragma unroll
                for (int s = 0; s < 4; ++s) SG_LOAD(fa, fb0, fb1, s, 32 * s); }
            SG_REDUCE(cur, pr);
            if (!has) break;
        }
    } else {
#pragma unroll 1
        for (; unit < nUnits; unit += GG) {
            SG_PTRS(unit)
            const SPre pr = epi.pre(rb_ * 32 + row, n0_ + 2 * jq);
            SG_ZERO();
#pragma unroll 1
            for (int ks = 0; ks < kw; ks += 128) {
                bf16x8 fa[4][2], fb0[4][2], fb1[4][2];
#pragma unroll
                for (int s = 0; s < 4; ++s) SG_LOAD(fa, fb0, fb1, s, ks + 32 * s);
#pragma unroll
                for (int s = 0; s < 4; ++s) SG_MMA(fa, fb0, fb1, s);
            }
            SG_REDUCE(unit, pr);
        }
    }
    asm volatile("s_waitcnt vmcnt(0) lgkmcnt(0)" ::: "memory");
    __syncthreads();
#undef SG_PTRS
#undef SG_LOAD
#undef SG_MMA
#undef SG_ZERO
#undef SG_REDUCE
}
#define SEPI_ARGS int rl, int n, const float (&x1)[2], const float (&x2)[2]
struct SEpiB1 {
    unsigned char* ws;
    __device__ __forceinline__ SPre pre(int rl, int n) const {
        SPre p_{}; p_.f0 = ((const fx_t*)(ws + WS_SSQA))[NPT + rl];
        const f32x2* tab = (const f32x2*)(ws + WS_TAB); const int d = n & 127, pos = PAST + (rl & 31);
        p_.g0 = tab[(size_t)pos * 128 + d]; p_.g1 = tab[(size_t)pos * 128 + d + 1];
        return p_;
    }
    __device__ __forceinline__ void operator()(int rl, int n, const float (&y1)[2], const float (&y2)[2], const SPre& pr) const {
        const float rs_ = rstd_of(fx_get(pr.f0));
        const float x1[2] = {y1[0] * rs_, y1[1] * rs_}, x2[2] = {y2[0] * rs_, y2[1] * rs_};
        if (n < 2048) {
            const int head = (n >> 8) & 3, d = n & 255;
            const f32x2 c0 = pr.g0, c1 = pr.g1;
            float o1[2], o2[2];
            o1[0] = x1[0] * c0.x - x2[0] * c0.y; o2[0] = x2[0] * c0.x + x1[0] * c0.y;
            o1[1] = x1[1] * c1.x - x2[1] * c1.y; o2[1] = x2[1] * c1.x + x1[1] * c1.y;
            if (n < 1024) {
                bf16_t* q = (bf16_t*)(ws + WS_Q) + (size_t)(NPT + rl) * 1024 + head * 256 + d;
                *(unsigned*)q = cvt_pk_bf16(o1[0], o1[1]); *(unsigned*)(q + 128) = cvt_pk_bf16(o2[0], o2[1]);
            } else {
                bf16_t* k = (bf16_t*)(ws + WS_KS) + (size_t)rl * 1024 + head * 256 + d;
                *(unsigned*)k = cvt_pk_bf16(o1[0] * 0.0625f, o1[1] * 0.0625f); *(unsigned*)(k + 128) = cvt_pk_bf16(o2[0] * 0.0625f, o2[1] * 0.0625f);
                const float dec = 0.0625f * __expf(lgdec(head) * (float)(DSEQ - 1 - (rl & 31)));
                bf16_t* kt = (bf16_t*)(ws + WS_KTS) + (size_t)(head * 256 + d) * 256 + rl;
                const unsigned wa = cvt_pk_bf16(o1[0] * dec, o1[1] * dec), wb = cvt_pk_bf16(o2[0] * dec, o2[1] * dec);
                kt[0] = (bf16_t)(wa & 0xffffu); kt[256] = (bf16_t)(wa >> 16); kt[128 * 256] = (bf16_t)(wb & 0xffffu); kt[129 * 256] = (bf16_t)(wb >> 16);
            }
        } else {
            bf16_t* vt = (bf16_t*)(ws + WS_VTS) + (size_t)(n - 2048) * 256 + rl;
            const unsigned wa = cvt_pk_bf16(x1[0], x1[1]), wb = cvt_pk_bf16(x2[0], x2[1]);
            vt[0] = (bf16_t)(wa & 0xffffu); vt[256] = (bf16_t)(wa >> 16); vt[128 * 256] = (bf16_t)(wb & 0xffffu); vt[129 * 256] = (bf16_t)(wb >> 16);
        }
    }
};
struct SEpiB2 {
    unsigned char* ws; const float* gn_g;
    __device__ __forceinline__ SPre pre(int rl, int n) const {
        SPre p_{}; p_.f0 = ((const fx_t*)(ws + WS_SSQA))[NPT + rl];
        const int col = (n - 2048) & 2047, head = col >> 9;
        const fx_t* sp2 = (const fx_t*)(ws + WS_STATS) + (size_t)rl * 8 + head * 2; p_.f1 = sp2[0]; p_.f2 = sp2[1];
        const bf16_t* o = (const bf16_t*)(ws + WS_OS) + (size_t)rl * 2048 + col; p_.u0 = *(const unsigned*)o; p_.u1 = *(const unsigned*)(o + 128);
        p_.g0 = *(const f32x2*)(gn_g + col); p_.g1 = *(const f32x2*)(gn_g + col + 128);
        return p_;
    }
    __device__ __forceinline__ void operator()(int rl, int n, const float (&y1)[2], const float (&y2)[2], const SPre& pr) const {
        const float rs_ = rstd_of(fx_get(pr.f0));
        const float x1[2] = {y1[0] * rs_, y1[1] * rs_}, x2[2] = {y2[0] * rs_, y2[1] * rs_};
        if (n < 2048) {
            bf16_t* o = (bf16_t*)(ws + WS_GLU) + (size_t)(NPT + rl) * 1024 + (n >> 8) * 128 + (n & 127);
            *(unsigned*)o = cvt_pk_bf16(x1[0] * sigm(x2[0]), x1[1] * sigm(x2[1]));
        } else if (n < 4096) {
            const int col = n - 2048, head = col >> 9;
            const f32x2 sq = {fx_get(pr.f1), fx_get(pr.f2)};
            const float mu = sq.x * (1.0f / 512.0f); const float var = fmaxf(sq.y * (1.0f / 512.0f) - mu * mu, 0.f); const float rstd = __builtin_amdgcn_rsqf(var + LN_EPS);
            bf16_t* o = (bf16_t*)(ws + WS_OS) + (size_t)rl * 2048 + col;
            const unsigned oa = pr.u0, ob = pr.u1;
            const f32x2 ga = pr.g0, gb = pr.g1;
            *(unsigned*)o = cvt_pk_bf16(x1[0] * sigm(x1[0]) * ((bflo(oa) - mu) * rstd * ga.x), x1[1] * sigm(x1[1]) * ((bfhi(oa) - mu) * rstd * ga.y));
            *(unsigned*)(o + 128) = cvt_pk_bf16(x2[0] * sigm(x2[0]) * ((bflo(ob) - mu) * rstd * gb.x), x2[1] * sigm(x2[1]) * ((bfhi(ob) - mu) * rstd * gb.y));
        } else {
            bf16_t* o = (bf16_t*)(ws + (n < 5120 ? WS_GC : WS_GR)) + (size_t)(NPT + rl) * 1024 + ((n - 4096) & 1023);
            *(unsigned*)o = cvt_pk_bf16(sigm(x1[0]), sigm(x1[1])); *(unsigned*)(o + 128) = cvt_pk_bf16(sigm(x2[0]), sigm(x2[1]));
        }
    }
};
template <int MODE, bool PAIR> struct SEpiEW {
    unsigned char* ws; float* x; fx_t* ssq;
    __device__ __forceinline__ SPre pre(int rl, int n) const {
        SPre p_{}; const size_t row = (size_t)(NPT + rl);
        if (MODE == 0) { const bf16_t* g = (const bf16_t*)(ws + WS_GC) + row * 1024 + n; p_.u0 = *(const unsigned*)g; if (PAIR) p_.u1 = *(const unsigned*)(g + 128); }
        else if (MODE == 1) { const bf16_t* g = (const bf16_t*)(ws + WS_GR) + row * 1024 + n; const bf16_t* t = (const bf16_t*)(ws + WS_T) + row * 1024 + n;
            p_.u0 = *(const unsigned*)g; p_.u2 = *(const unsigned*)t; if (PAIR) { p_.u1 = *(const unsigned*)(g + 128); p_.u3 = *(const unsigned*)(t + 128); } }
        else if (MODE == 2) { const bf16_t* xb = (const bf16_t*)(ws + WS_H) + row * 1024 + n; p_.u0 = *(const unsigned*)xb; if (PAIR) p_.u1 = *(const unsigned*)(xb + 128); }
        else p_.f0 = ssq[row];
        return p_;
    }
    __device__ __forceinline__ void operator()(SEPI_ARGS, const SPre& pr) const {
        const size_t row = (size_t)(NPT + rl);
        if (MODE == 0) {
            bf16_t* t = (bf16_t*)(ws + WS_T) + row * 1024 + n;
            const unsigned ga = pr.u0, gb = pr.u1;
            *(unsigned*)t = cvt_pk_bf16(x1[0] * bflo(ga), x1[1] * bfhi(ga)); if (PAIR) *(unsigned*)(t + 128) = cvt_pk_bf16(x2[0] * bflo(gb), x2[1] * bfhi(gb));
        } else if (MODE == 1) {
            bf16_t* t = (bf16_t*)(ws + WS_T) + row * 1024 + n;
            const unsigned ga = pr.u0, gb = pr.u1, ta = pr.u2, tb = pr.u3;
            *(unsigned*)t = cvt_pk_bf16(bflo(ta) + x1[0] * bflo(ga), bfhi(ta) + x1[1] * bfhi(ga)); if (PAIR) *(unsigned*)(t + 128) = cvt_pk_bf16(bflo(tb) + x2[0] * bflo(gb), bfhi(tb) + x2[1] * bfhi(gb));
        } else if (MODE == 2) {
            bf16_t* xb = (bf16_t*)(ws + WS_H) + row * 1024 + n; const unsigned xa = pr.u0, xc = PAIR ? pr.u1 : 0u;
            f32x2 a = {bflo(xa) + x1[0], bfhi(xa) + x1[1]}, b = {bflo(xc) + x2[0], bfhi(xc) + x2[1]};
            *(unsigned*)xb = cvt_pk_bf16(a.x, a.y); if (PAIR) *(unsigned*)(xb + 128) = cvt_pk_bf16(b.x, b.y);
            float q = a.x * a.x + a.y * a.y; if (PAIR) q += b.x * b.x + b.y * b.y;
            q += shx<1>(q); q += shx<2>(q); q += shx<4>(q); q += shx<8>(q);
            if ((lane_id() & 15) == 0) fx_add(ssq + row, q);
        } else {
            bf16_t* u = (bf16_t*)(ws + WS_U) + row * 4096 + n;
            const float r3 = rstd_of(fx_get(pr.f0));
            const float a0 = fmaxf(x1[0], 0.f) * r3, a1 = fmaxf(x1[1], 0.f) * r3, b0 = fmaxf(x2[0], 0.f) * r3, b1 = fmaxf(x2[1], 0.f) * r3;
            *(unsigned*)u = cvt_pk_bf16(a0 * a0, a1 * a1); if (PAIR) *(unsigned*)(u + 128) = cvt_pk_bf16(b0 * b0, b1 * b1);
        }
    }
};

#define XB_TMO      128
#define XB_XCNT(j)  (256  + 64 * (j))
#define XB_XSUB(j)  (1280 + 64 * (j))
#define XB_XGEN(j)  (2304 + 64 * (j))
#define XB_TOP      3328
#define XB_TOPGEN   3392
#define XCD_BAR_WORDS 3456
#define XB_SPIN_CAP (1u << 18)

__device__ __forceinline__ unsigned xb_ld(unsigned* p)              { return __hip_atomic_load(p, __ATOMIC_RELAXED, __HIP_MEMORY_SCOPE_AGENT); }
__device__ __forceinline__ unsigned xb_add(unsigned* p, unsigned v) { return __hip_atomic_fetch_add(p, v, __ATOMIC_RELAXED, __HIP_MEMORY_SCOPE_AGENT); }
__device__ __forceinline__ unsigned xb_xcc_id() { return (unsigned)__builtin_amdgcn_s_getreg((3 << 11) | 20) & 0xFu; }
#define XB_SPIN(cond, bar) do { unsigned _sp = 0; while (cond) { __builtin_amdgcn_s_sleep(1); \
    if ((++_sp & 255u) == 0u) { if (xb_ld(&(bar)[XB_TMO])) break; if (_sp > XB_SPIN_CAP) { atomicAdd(&(bar)[XB_TMO], 1u); break; } } } } while (0)

struct XcdBarrier {
    unsigned* bar; unsigned x;
    volatile LAS unsigned* st;
};

__device__ __forceinline__ XcdBarrier xcd_barrier_post(unsigned* bar, volatile LAS unsigned* st, int wv) {
    XcdBarrier b; b.bar = bar; b.x = xb_xcc_id(); b.st = st;
    if (wv == 0 && lane_id() == 0) (void)xb_add(&bar[XB_XCNT(b.x)], 1u);
    return b;
}
__device__ __forceinline__ void xcd_barrier_complete(unsigned* bar, unsigned x, unsigned& nloc, unsigned& nx) {
    const unsigned G = gridDim.x * gridDim.y * gridDim.z;
    unsigned sum, cnt, mine, sp = 0u;
    for (;;) {
        sum = 0u; cnt = 0u; mine = 0u;
#pragma unroll
        for (unsigned j = 0; j < 16; ++j) { const unsigned c = xb_ld(&bar[XB_XCNT(j)]); sum += c; cnt += (c > 0u) ? 1u : 0u; mine = (j == x) ? c : mine; }
        if (sum == G) break;
        __builtin_amdgcn_s_sleep(1);
        if ((++sp & 255u) == 0u) { if (xb_ld(&bar[XB_TMO])) break; if (sp > XB_SPIN_CAP) { atomicAdd(&bar[XB_TMO], 1u); break; } }
    }
    nloc = mine > 0u ? mine : 1u; nx = cnt > 0u ? cnt : 1u;
}

__device__ __forceinline__ void xcd_barrier(const XcdBarrier& b, int wv) {
    asm volatile("s_waitcnt vmcnt(0)" ::: "memory");
    __syncthreads();
    if (wv == 0 && lane_id() == 0) {
        unsigned* bar = b.bar;
        __builtin_amdgcn_s_waitcnt(0);
        unsigned nloc = b.st[0], nx = b.st[1];
        if (nloc == 0u) { xcd_barrier_complete(bar, b.x, nloc, nx); b.st[0] = nloc; b.st[1] = nx; }
        const unsigned old = xb_add(&bar[XB_XSUB(b.x)], 1u);
        const unsigned gen = old / nloc;
        if (old + 1u == (gen + 1u) * nloc) {
            __builtin_amdgcn_fence(__ATOMIC_RELEASE, "agent");
            asm volatile("s_waitcnt vmcnt(0)" ::: "memory");
            const unsigned og = xb_add(&bar[XB_TOP], 1u);
            const unsigned tg = og / nx;
            if (og + 1u == (tg + 1u) * nx) xb_add(&bar[XB_TOPGEN], 1u);
            else XB_SPIN(xb_ld(&bar[XB_TOPGEN]) == tg, bar);
            __builtin_amdgcn_fence(__ATOMIC_ACQUIRE, "agent");
            xb_add(&bar[XB_XGEN(b.x)], 1u);
            asm volatile("s_waitcnt vmcnt(0)" ::: "memory");
        } else {
            XB_SPIN(xb_ld(&bar[XB_XGEN(b.x)]) == gen, bar);
            __builtin_amdgcn_fence(__ATOMIC_ACQUIRE, "agent");
            asm volatile("s_waitcnt vmcnt(0)" ::: "memory");
        }
    }
    __syncthreads();
}


constexpr int LDS_BYTES = 131072 + 4096;
#define LCV ({ int c_ = (int)blockIdx.x; asm volatile("" : "+s"(c_)); c_; })
__global__ void __launch_bounds__(512, 2) fwd_megakernel(Params p) {
    extern __shared__ __attribute__((aligned(16))) unsigned char lds_raw[];
    LAS unsigned char* lds = (LAS unsigned char*)lds_raw;
    cg::grid_group grid = cg::this_grid();
    const int G = gridDim.x, c = blockIdx.x;
    unsigned char* ws = p.ws;
    int wv = __builtin_amdgcn_readfirstlane((int)(threadIdx.x >> 6)); asm volatile("" : "+s"(wv));
    volatile LAS unsigned* stw = (volatile LAS unsigned*)(lds + 131072);
    if (wv == 0) stw[lane_id()] = 0u;
    __syncthreads();
    XcdBarrier xbar = xcd_barrier_post((unsigned*)(ws + WS_BAR), stw, wv);
    if (p.ws == nullptr) grid.sync();
#define GSYNC() xcd_barrier(xbar, wv)
#pragma unroll 1
    for (int l = 0; l < 2; ++l) {
        phase0(wv, p, l, lds, 0);
        GSYNC();
        {
            SchedB1 S{G, LCV, (const char*)(ws + WS_H), (const char*)(ws + WS_WIN)}; EpiB1 E{ws};
            pg8::gemm_phase(wv, lds, pg8::Gemm{1024, 16, 1024, 1024}, S, E);
            sgemm_phase<true>(wv, lds, (const bf16_t*)(ws + WS_H) + (size_t)NPT * 1024, (const bf16_t*)(ws + WS_WIN), 1024, 8 * 64, SEpiB1{ws});
        }
        GSYNC();
        {
            { SchedAtt S{G, LCV, ws}; EpiAtt E{ws}; pg8::gemm_phase(wv, lds, pg8::Gemm{256, 4, 1024, 1024}, S, E); }
            { SchedU S{G, LCV, ws}; EpiU E{ws}; pg8::gemm_phase(wv, lds, pg8::Gemm{256, 4, SEQ, SEQ}, S, E); }
            phase_sret(wv, p, l, lds);
            GSYNC();
            phase_scan(wv, p, l);
            GSYNC();
            { SchedE S{G, LCV, ws}; EpiE E{ws}; pg8::gemm_phase(wv, lds, pg8::Gemm{512, 4, 1024, SEQ}, S, E); }
            {
                const int t_ = wv * 64 + lane_id(), row_ = t_ >> 1, which_ = t_ & 1, idx_ = (int)blockIdx.x, h_ = idx_ & 3, j_ = (idx_ >> 2) & 31, b_ = idx_ >> 7;
                if (idx_ < 256) {
                    const float* sl_ = (const float*)(ws + WS_SLOTS) + (size_t)idx_ * 4096 + row_ * 16 + which_;
                    float a_ = 0.f;
#pragma unroll
                    for (int k_ = 0; k_ < 8; ++k_) a_ += sl_[k_ * 2];
                    ((float*)(ws + WS_STATF))[(size_t)(b_ * SEQ + j_ * CH + row_) * 8 + h_ * 2 + which_] = a_;
                }
            }
            GSYNC();
        }
        {
            SchedN S{G, LCV, 24, 0, (const char*)(ws + WS_H), (const char*)(ws + WS_WIN) + (size_t)16 * TILEB, TILEB, ws, TILEB};
            EpiB2 E{ws, p.in[11] + l * 2048};
            pg8::gemm_phase(wv, lds, pg8::Gemm{1024, 16, 1024, 1024}, S, E);
            sgemm_phase<true>(wv, lds, (const bf16_t*)(ws + WS_H) + (size_t)NPT * 1024, (const bf16_t*)(ws + WS_WIN) + (size_t)4096 * 1024, 1024, 8 * 96, SEpiB2{ws, p.in[11] + l * 2048});
        }
        GSYNC();
        phase0(wv, p, l, lds, 1);
        phase_conv(wv, p, l, lds);
        GSYNC();
        { SchedN S{G, LCV, 4, 0, (const char*)(ws + WS_YC), (const char*)(ws + WS_WC), TILEB, ws, TILEB}; EpiEW<0> E{ws, p.out, nullptr}; pg8::gemm_phase(wv, lds, pg8::Gemm{1024, 16, 1024, 1024}, S, E); }
        sgemm_phase<false>(wv, lds, (const bf16_t*)(ws + WS_YC) + (size_t)NPT * 1024, (const bf16_t*)(ws + WS_WC), 1024, 8 * 32, SEpiEW<0, false>{ws, p.out, nullptr});
        { SchedN S{G, LCV, 4, 1, nullptr, (const char*)(ws + WS_WR), 2 * TILEB, ws, 0}; EpiEW<1> E{ws, p.out, nullptr}; pg8::gemm_phase(wv, lds, pg8::Gemm{2048, 32, 2048, 2048}, S, E); }
        sgemm_phase<false>(wv, lds, (const bf16_t*)(ws + WS_OS), (const bf16_t*)(ws + WS_WR), 2048, 8 * 32, SEpiEW<1, false>{ws, p.out, nullptr});
        GSYNC();
        { SchedN S{G, LCV, 4, 0, (const char*)(ws + WS_T), (const char*)(ws + WS_WO), TILEB, ws, TILEB}; EpiEW<2> E{ws, p.out, (fx_t*)(ws + WS_SSQB)}; pg8::gemm_phase(wv, lds, pg8::Gemm{1024, 16, 1024, 1024}, S, E); }
        sgemm_phase<false>(wv, lds, (const bf16_t*)(ws + WS_T) + (size_t)NPT * 1024, (const bf16_t*)(ws + WS_WO), 1024, 8 * 32, SEpiEW<2, false>{ws, p.out, (fx_t*)(ws + WS_SSQB)});
        GSYNC();
        { SchedN S{G, LCV, 16, 0, (const char*)(ws + WS_H), (const char*)(ws + WS_WM1), TILEB, ws, TILEB}; EpiEW<3> E{ws, p.out, (fx_t*)(ws + WS_SSQB)}; pg8::gemm_phase(wv, lds, pg8::Gemm{1024, 16, 1024, 1024}, S, E); }
        sgemm_phase<true>(wv, lds, (const bf16_t*)(ws + WS_H) + (size_t)NPT * 1024, (const bf16_t*)(ws + WS_WM1), 1024, 8 * 64, SEpiEW<3, true>{ws, p.out, (fx_t*)(ws + WS_SSQB)});
        GSYNC();
        { SchedN S{G, LCV, 4, 0, (const char*)(ws + WS_U), (const char*)(ws + WS_WM2), 4 * TILEB, ws, 4 * TILEB}; EpiEW<2> E{ws, p.out, (fx_t*)(ws + WS_SSQA)}; pg8::gemm_phase(wv, lds, pg8::Gemm{4096, 64, 4096, 4096}, S, E); }
        sgemm_phase<false>(wv, lds, (const bf16_t*)(ws + WS_U) + (size_t)NPT * 4096, (const bf16_t*)(ws + WS_WM2), 4096, 8 * 32, SEpiEW<2, false>{ws, p.out, (fx_t*)(ws + WS_SSQA)});
        GSYNC();
    }
    phase_final(wv, p);
}

extern "C" void kernel_launch(void* const* d_in, const int* in_sizes, int n_in, void* d_out, int out_size, void* d_ws, size_t ws_size, hipStream_t stream) {
    static int grid = 0;
    if (grid == 0) {
        if (n_in != 18 || ws_size < WS_END) { fprintf(stderr, "kernel_launch: unexpected n_in %d / ws_size %zu (need %zu)\n", n_in, ws_size, (size_t)WS_END); grid = -1; return; }
        int dev = 0, cus = 0, per_cu = 0;
        hipGetDevice(&dev); hipDeviceGetAttribute(&cus, hipDeviceAttributeMultiprocessorCount, dev);
        hipFuncSetAttribute((const void*)fwd_megakernel, hipFuncAttributeMaxDynamicSharedMemorySize, LDS_BYTES);
        hipOccupancyMaxActiveBlocksPerMultiprocessor(&per_cu, (const void*)fwd_megakernel, 512, LDS_BYTES);
        (void)hipGetLastError();
        if (per_cu < 1) per_cu = 1;
        grid = cus;
        fprintf(stderr, "kernel_launch: cus %d per_cu %d grid %d\n", cus, per_cu, grid);
    }
    if (grid < 0) return;
    if (hipMemsetAsync((char*)d_ws + WS_BAR, 0, 16384, stream) != hipSuccess) { fprintf(stderr, "memset failed\n"); return; }
    Params p{};
    for (int i = 0; i < 18; ++i) p.in[i] = (const float*)d_in[i];
    p.out = (float*)d_out; p.ws = (unsigned char*)d_ws;
    void* args[] = {&p};
    hipError_t e = hipLaunchCooperativeKernel((const void*)fwd_megakernel, dim3(grid), dim3(512), args, LDS_BYTES, stream);
    if (e != hipSuccess) fprintf(stderr, "cooperative launch failed: %s (grid %d)\n", hipGetErrorString(e), grid);
}
```

```cpp
#include <hip/hip_runtime.h>
#include <hip/hip_cooperative_groups.h>
#include <cstdio>
#include <cstdint>
namespace cg = cooperative_groups;

#define LAS __attribute__((address_space(3)))
typedef unsigned short bf16_t;
typedef short bf16x8 __attribute__((ext_vector_type(8)));
typedef float f32x4 __attribute__((ext_vector_type(4)));
typedef float f32x2 __attribute__((ext_vector_type(2)));
typedef float f32x16 __attribute__((ext_vector_type(16)));
typedef unsigned u32x4 __attribute__((ext_vector_type(4)));
typedef unsigned u32x2 __attribute__((ext_vector_type(2)));

constexpr int DM = 1024, SEQ = 8192, NPT = 16384, NTOK = 16640, DSEQ = 32, PAST = 4096;
constexpr int DFF = 4096, RV = 2048, CH = 256;
constexpr float RMS_EPS = 1e-6f, LN_EPS = 1e-5f;
constexpr size_t MiB = 1u << 20;
constexpr size_t TILEB = 256 * 1024 * 2;
constexpr size_t WS_STATF = 313 * MiB + MiB / 2;
constexpr size_t WS_SLOTS = 314 * MiB;
constexpr size_t WS_STATS = 313 * MiB;
constexpr size_t WS_BAR = 640 * 1024;
constexpr size_t WS_SSQA = 318 * MiB, WS_SSQB = 319 * MiB;
constexpr size_t WS_TAB = 1 * MiB;
constexpr size_t WS_WIN = 9 * MiB;
constexpr size_t WS_WC = 29 * MiB, WS_WR = 31 * MiB, WS_WO = 35 * MiB, WS_WM1 = 37 * MiB, WS_WM2 = 45 * MiB;
constexpr size_t WS_H = 53 * MiB;
constexpr size_t WS_Q = WS_H + 32 * MiB + MiB / 2;
constexpr size_t WS_KB0 = 118 * MiB, WS_KTB0 = 134 * MiB, WS_KB1 = 150 * MiB, WS_KTB1 = 166 * MiB, WS_KS = 182 * MiB, WS_KTS = WS_KS + MiB / 2;
constexpr size_t WS_VTB0 = 183 * MiB, WS_VTB1 = 215 * MiB, WS_VTS = 247 * MiB;
constexpr size_t WS_ATT = 248 * MiB;
constexpr size_t WS_S = 280 * MiB;
constexpr size_t WS_OS = 312 * MiB;
constexpr size_t WS_END = 320 * MiB;
constexpr size_t WS_GLU = WS_Q, WS_T = WS_Q, WS_U = WS_Q, WS_GC = WS_VTB0, WS_GR = WS_VTB0 + 32 * MiB + MiB / 2, WS_YC = WS_ATT;
constexpr size_t WS_OB0 = WS_KB0, WS_OB1 = WS_KB1;
static_assert(WS_Q == 85 * MiB + MiB / 2 && WS_Q + 32 * MiB + MiB / 2 == WS_KB0, "map");
static_assert(WS_U + (size_t)NTOK * DFF * 2 <= WS_END, "map");
constexpr size_t OUT_CONVP = 17039360, OUT_RETP = 17162240, OUT_CONVS = 19259392, OUT_RETS = 19750912;

struct Params { const float* in[18]; float* out; unsigned char* ws; };

typedef __bf16 bf16x2_t __attribute__((ext_vector_type(2)));
__device__ __forceinline__ unsigned cvt_pk_bf16(float lo, float hi) { const f32x2 v = {lo, hi}; return __builtin_bit_cast(unsigned, __builtin_convertvector(v, bf16x2_t)); }
__device__ __forceinline__ float bflo(unsigned w) { return __uint_as_float(w << 16); }
__device__ __forceinline__ float bfhi(unsigned w) { return __uint_as_float(w & 0xffff0000u); }
__device__ __forceinline__ float bf2f(bf16_t v) { return __uint_as_float((unsigned)v << 16); }
__device__ __forceinline__ float lgdec(int h) { return h == 0 ? -0.0317486983145803f : (h == 1 ? -0.015748356968139168f : (h == 2 ? -0.007843177461025893f : -0.003913899321136329f)); }
typedef unsigned long long fx_t;
constexpr float FX_SCALE = 16777216.0f, FX_INV = 1.0f / 16777216.0f;
__device__ __forceinline__ fx_t fx_of(float v) { return (fx_t)(long long)(v * FX_SCALE); }
__device__ __forceinline__ void fx_add(fx_t* p, float v) { atomicAdd(p, fx_of(v)); }
__device__ __forceinline__ float fx_get(fx_t v) { return (float)(long long)v * FX_INV; }
__device__ __forceinline__ float rstd_of(float ssq) { return __builtin_amdgcn_rsqf(ssq * (1.0f / 1024.0f) + RMS_EPS); }
__device__ __forceinline__ float sigm(float x) { return __builtin_amdgcn_rcpf(1.0f + __expf(-x)); }
__device__ __forceinline__ u32x4 pack8(const f32x4 a, const f32x4 b) { u32x4 w; w.x = cvt_pk_bf16(a[0], a[1]); w.y = cvt_pk_bf16(a[2], a[3]); w.z = cvt_pk_bf16(b[0], b[1]); w.w = cvt_pk_bf16(b[2], b[3]); return w; }
__device__ __forceinline__ void unpack8(const u32x4 w, f32x4& a, f32x4& b) { a = (f32x4){bflo(w.x), bfhi(w.x), bflo(w.y), bfhi(w.y)}; b = (f32x4){bflo(w.z), bfhi(w.z), bflo(w.w), bfhi(w.w)}; }
__device__ __forceinline__ int lane_id() { return (int)__builtin_amdgcn_mbcnt_hi(~0u, __builtin_amdgcn_mbcnt_lo(~0u, 0u)); }
__device__ __forceinline__ int gdim() { int g = (int)gridDim.x; asm volatile("" : "+s"(g)); return g; }
template <int K> __device__ __forceinline__ float shx(float v) {
    if constexpr (K < 32) return __builtin_bit_cast(float, __builtin_amdgcn_ds_swizzle(__builtin_bit_cast(int, v), (K << 10) | 0x1f));
    else { int l = lane_id(); asm volatile("" : "+v"(l)); return __builtin_bit_cast(float, __builtin_amdgcn_ds_bpermute((l ^ 32) << 2, __builtin_bit_cast(int, v))); }
}
template <int CTRL> __device__ __forceinline__ float dpp_f(float v) { return __builtin_bit_cast(float, __builtin_amdgcn_update_dpp(0, __builtin_bit_cast(int, v), CTRL, 0xf, 0xf, true)); }
__device__ __forceinline__ float wave_sum(float v) {
    v += dpp_f<0xB1>(v);
    v += dpp_f<0x4E>(v);
    v += dpp_f<0x141>(v);
    v += dpp_f<0x140>(v);
    const int iv = __builtin_bit_cast(int, v);
    return (__builtin_bit_cast(float, __builtin_amdgcn_readlane(iv, 0)) + __builtin_bit_cast(float, __builtin_amdgcn_readlane(iv, 16))) +
           (__builtin_bit_cast(float, __builtin_amdgcn_readlane(iv, 32)) + __builtin_bit_cast(float, __builtin_amdgcn_readlane(iv, 48)));
}

namespace pg8 {
constexpr int BM = 256, BK = 64, HALF = 128, HTB = HALF * BK * 2, STAGE_BYTES = 8 * HTB;
__host__ __device__ __forceinline__ int lds_byte(int r, int c) { const int st = (r >> 4) * 2 + (c >> 5), rr = r & 15, cc = c & 31, ob = rr * 64 + cc * 2; return st * 1024 + (ob ^ (((ob >> 9) & 1) << 5)); }
__host__ __device__ __forceinline__ void stage_rc(int b, int& R, int& C) { const int st = b / 1024, sb = b % 1024, swz = sb ^ (((sb >> 9) & 1) << 5); R = (st >> 1) * 16 + swz / 64; C = (st & 1) * 32 + (swz % 64) / 2; }
__host__ __device__ __forceinline__ int perm32(int rho) { const int n = rho >> 4, i = rho & 15; return 8 * (i >> 2) + 4 * n + (i & 3); }

struct Unit { const char* a; const char* b; long a2d, b2d; int kind, pm, pn, aux; };
struct Gemm { int K, nt1, lda, ldb; };

__device__ __forceinline__ void xcd_remap(int& wgid, int nwg) { const int q = nwg / 8, r = nwg % 8, xcd = wgid % 8, off = wgid / 8; wgid = (xcd < r ? xcd * (q + 1) : r * (q + 1) + (xcd - r) * q) + off; }
__device__ __forceinline__ void grp_decode(int wgid, int nM, int nN, int& pm, int& pn) { const int nig = 8 * nN, gid = wgid / nig, fm = gid * 8, gsz = (nM - fm) < 8 ? (nM - fm) : 8; pm = fm + ((wgid % nig) % gsz); pn = (wgid % nig) / gsz; }

template <class Epi, class Sched>
__device__ __forceinline__ void gemm_phase(int wv, LAS unsigned char* lds, const Gemm g, const Sched& S, const Epi& E) {
    int wv_ = wv; asm volatile("" : "+s"(wv_)); int tid = wv_ * 64 + lane_id(); asm volatile("" : "+v"(tid));
    const int wid = __builtin_amdgcn_readfirstlane(tid >> 6), lane = tid & 63, wr = wid >> 2, wc = wid & 3, fr = lane & 15, fq = lane >> 4;
    const int nt = g.K / BK, nt1 = g.nt1;
    unsigned voffA[2], voffB[2];
#pragma unroll
    for (int i = 0; i < 2; ++i) { int R, C; stage_rc(tid * 16 + i * 8192, R, C); const int Rb = (R & ~31) + perm32(R & 31);
        voffA[i] = (unsigned)(R * g.lda + C) * 2u; voffB[i] = (unsigned)(Rb * g.ldb + C) * 2u; }
    const size_t kstep = (size_t)(BK * 2);
    const size_t hstepA = (size_t)HALF * g.lda * 2, hstepB = (size_t)HALF * g.ldb * 2;
    const unsigned ldsw = (unsigned)wid * 1024u;
    const int aoff = lds_byte(wr * 64 + fr, fq * 8), boff = lds_byte(wc * 32 + fr, fq * 8);
#define PG8_SA(b, h) (((b) * 2 + (h)) * HTB)
#define PG8_SB(b, h) ((4 + (b) * 2 + (h)) * HTB)
#define PG8_STAGE(bufoff, gbase, voff) do { _Pragma("unroll") for (int _i = 0; _i < 2; ++_i) \
        __builtin_amdgcn_global_load_lds((const unsigned*)((const char*)(gbase) + (voff)[_i]), (LAS unsigned*)(lds + (bufoff) + ldsw + _i * 8192), 16, 0, 0); } while (0)
#define PG8_LDA(dst, b, h) do { _Pragma("unroll") for (int m = 0; m < 4; ++m) _Pragma("unroll") for (int k = 0; k < 2; ++k) dst[m][k] = *(const LAS bf16x8*)(lds + PG8_SA(b, h) + aoff + m * 2048 + k * 1024); } while (0)
#define PG8_LDB(dst, b, h) do { _Pragma("unroll") for (int n = 0; n < 2; ++n) _Pragma("unroll") for (int k = 0; k < 2; ++k) dst[n][k] = *(const LAS bf16x8*)(lds + PG8_SB(b, h) + boff + n * 2048 + k * 1024); } while (0)
#define PG8_MMA(ai, bj, At, Bt) do { __builtin_amdgcn_s_setprio(1); _Pragma("unroll") for (int m = 0; m < 4; ++m) _Pragma("unroll") for (int n = 0; n < 2; ++n) _Pragma("unroll") for (int k = 0; k < 2; ++k) \
        acc[ai][bj][m][n] = __builtin_amdgcn_mfma_f32_16x16x32_bf16(Bt[n][k], At[m][k], acc[ai][bj][m][n], 0, 0, 0); __builtin_amdgcn_s_setprio(0); } while (0)
#define PG8_WAIT_V(n) asm volatile("s_waitcnt vmcnt(" #n ")" ::: "memory")
#define PG8_WAIT_L(n) asm volatile("s_waitcnt lgkmcnt(" #n ")" ::: "memory")
#define PG8_BAR __builtin_amdgcn_s_barrier()
#define PG8_SCHED __builtin_amdgcn_sched_barrier(0)
#define PG8_TPA(u, t) ((u).a + (size_t)(t) * kstep + (((t) >= nt1) ? (u).a2d : 0l))
#define PG8_TPB(u, t) ((u).b + (size_t)(t) * kstep + (((t) >= nt1) ? (u).b2d : 0l))
    Unit cur, nxt; int ui = 0;
    if (!S.next(0, cur)) return;
    {
        const char* cA = cur.a; const char* cB = cur.b;
        PG8_STAGE(PG8_SB(0, 0), cB, voffB); PG8_STAGE(PG8_SB(0, 1), cB + hstepB, voffB); PG8_STAGE(PG8_SA(0, 0), cA, voffA); PG8_STAGE(PG8_SA(0, 1), cA + hstepA, voffA);
        if (wr == 1) PG8_BAR;
        PG8_WAIT_V(2); PG8_BAR;
        PG8_STAGE(PG8_SB(1, 0), cB + kstep, voffB); PG8_STAGE(PG8_SA(1, 0), cA + kstep, voffA); PG8_STAGE(PG8_SB(1, 1), cB + hstepB + kstep, voffB);
        PG8_WAIT_V(6); PG8_BAR;
    }
    f32x4 acc[2][2][4][2];
#pragma unroll
    for (int a = 0; a < 2; ++a)
#pragma unroll
        for (int b = 0; b < 2; ++b)
#pragma unroll
            for (int m = 0; m < 4; ++m)
#pragma unroll
                for (int n = 0; n < 2; ++n) acc[a][b][m][n] = (f32x4){0.f, 0.f, 0.f, 0.f};
    bf16x8 At[4][2], B0[2][2], B1[2][2];
#pragma unroll 1
    for (;;) {
        const bool has_next = S.next(ui + 1, nxt);
        if (!has_next) nxt = cur;
#pragma unroll 1
        for (int t = 0; t < nt; t += 2) {
            const bool last = (t == nt - 2);
            const char* a1 = PG8_TPA(cur, t + 1);
            const char* a2 = last ? PG8_TPA(nxt, 0) : PG8_TPA(cur, t + 2); const char* b2 = last ? PG8_TPB(nxt, 0) : PG8_TPB(cur, t + 2);
            const char* a3 = a2 + kstep; const char* b3 = b2 + kstep;
            PG8_LDB(B0, 0, 0); PG8_LDB(B1, 0, 1); PG8_SCHED; PG8_LDA(At, 0, 0); PG8_STAGE(PG8_SA(1, 1), a1 + hstepA, voffA);
            PG8_WAIT_V(8); PG8_WAIT_L(0); PG8_BAR; PG8_MMA(0, 0, At, B0); PG8_MMA(0, 1, At, B1); PG8_BAR; PG8_SCHED;
            PG8_LDA(At, 0, 1); PG8_STAGE(PG8_SB(0, 0), b2, voffB); PG8_STAGE(PG8_SB(0, 1), b2 + hstepB, voffB); PG8_STAGE(PG8_SA(0, 0), a2, voffA);
            PG8_WAIT_V(8); PG8_WAIT_L(0); PG8_BAR; PG8_MMA(1, 0, At, B0); PG8_MMA(1, 1, At, B1); PG8_BAR; PG8_SCHED;
            PG8_LDB(B0, 1, 0); PG8_LDB(B1, 1, 1); PG8_SCHED; PG8_LDA(At, 1, 0); PG8_STAGE(PG8_SA(0, 1), a2 + hstepA, voffA);
            PG8_WAIT_V(8); PG8_WAIT_L(0); PG8_BAR; PG8_MMA(0, 0, At, B0); PG8_MMA(0, 1, At, B1); PG8_BAR; PG8_SCHED;
            PG8_LDA(At, 1, 1); PG8_STAGE(PG8_SB(1, 0), b3, voffB); PG8_STAGE(PG8_SB(1, 1), b3 + hstepB, voffB); PG8_STAGE(PG8_SA(1, 0), a3, voffA);
            PG8_WAIT_V(8); PG8_WAIT_L(0); PG8_BAR; PG8_MMA(1, 0, At, B0); PG8_MMA(1, 1, At, B1); PG8_BAR; PG8_SCHED;
        }
        if (wr == 0) PG8_BAR;
        { int fr2 = fr, fq2 = fq; asm volatile("" : "+v"(fr2), "+v"(fq2)); E(acc, cur, wr, wc, fr2, fq2); }
        if (!has_next) break;
#pragma unroll
        for (int a = 0; a < 2; ++a)
#pragma unroll
            for (int b = 0; b < 2; ++b)
#pragma unroll
                for (int m = 0; m < 4; ++m)
#pragma unroll
                    for (int n = 0; n < 2; ++n) acc[a][b][m][n] = (f32x4){0.f, 0.f, 0.f, 0.f};
        cur = nxt; ++ui;
        if (wr == 1) PG8_BAR;
    }
    PG8_WAIT_V(0);
    PG8_BAR;
    asm volatile("s_waitcnt vmcnt(0) lgkmcnt(0)" ::: "memory");
    __syncthreads();
#undef PG8_SA
#undef PG8_SB
#undef PG8_STAGE
#undef PG8_LDA
#undef PG8_LDB
#undef PG8_MMA
#undef PG8_WAIT_V
#undef PG8_WAIT_L
#undef PG8_BAR
#undef PG8_SCHED
#undef PG8_TPA
#undef PG8_TPB
}
}
using pg8::Unit;

__device__ __forceinline__ bf16_t* k_tile(unsigned char* ws, int pm) { return (bf16_t*)(ws + (pm < 32 ? WS_KB0 + (size_t)pm * TILEB : (pm < 64 ? WS_KB1 + (size_t)(pm - 32) * TILEB : WS_KS))); }
__device__ __forceinline__ bf16_t* o_tile(unsigned char* ws, int pm) { return (bf16_t*)(ws + (pm < 32 ? WS_OB0 + (size_t)pm * 2 * TILEB : (pm < 64 ? WS_OB1 + (size_t)(pm - 32) * 2 * TILEB : WS_OS))); }

__device__ __forceinline__ bf16_t* s_head(unsigned char* ws, int b, int h) {
    const size_t off = b == 0 ? WS_S + (size_t)h * 8 * MiB : (h == 0 ? WS_TAB : (h == 1 ? WS_WC : (h == 2 ? WS_WM1 : WS_WM2)));
    return (bf16_t*)(ws + off);
}
struct SchedB1 {
    int G, c; const char* H; const char* W;
    __device__ __forceinline__ bool next(int i, Unit& u) const {
        const long L = (long)i * G + c; if (L >= 1024) return false;
        int wgid = (int)L; pg8::xcd_remap(wgid, 1024);
        { const int x = wgid >> 7, w = wgid & 127; wgid = w < 64 ? x * 64 + w : 512 + x * 64 + (w - 64); }
        u.a2d = 0; u.b2d = 0; u.aux = 0;
        if (wgid < 512) { pg8::grp_decode(wgid, 64, 8, u.pm, u.pn); u.kind = 0; u.a = H + (size_t)u.pm * TILEB; u.b = W + (size_t)u.pn * TILEB; }
        else { pg8::grp_decode(wgid - 512, 8, 64, u.pm, u.pn); u.pm += 4; u.kind = 1; u.a = W + (size_t)(4 + u.pm) * TILEB; u.b = H + (size_t)u.pn * TILEB; }
        return true;
    }
};
struct SchedN {
    int G, c, nN, amode; const char* A; const char* B; size_t bTile; unsigned char* ws; size_t aTile;
    __device__ __forceinline__ bool next(int i, Unit& u) const {
        const int nwg = 64 * nN; const long L = (long)i * G + c; if (L >= nwg) return false;
        int wgid = (int)L; pg8::xcd_remap(wgid, nwg); pg8::grp_decode(wgid, 64, nN, u.pm, u.pn);
        u.a2d = 0; u.b2d = 0; u.aux = 0; u.kind = 0;
        u.a = amode ? (const char*)o_tile(ws, u.pm) : A + (size_t)u.pm * aTile; u.b = B + (size_t)u.pn * bTile;
        return true;
    }
};
struct SchedAtt {
    int G, c; unsigned char* ws;
    __device__ __forceinline__ bool next(int i, Unit& u) const {
        const int L = i * G + c; if (L >= 256) return false;
        const int h = L & 3, j = (L >> 2) & 31, b = L >> 7;
        u.a2d = 0; u.b2d = 0; u.kind = 0; u.pm = j; u.pn = b; u.aux = h;
        u.a = (const char*)(ws + WS_Q) + ((size_t)(b * SEQ + j * CH) * 1024 + h * 256) * 2;
        u.b = (const char*)(ws + (b ? WS_KB1 : WS_KB0)) + ((size_t)(j * CH) * 1024 + h * 256) * 2;
        return true;
    }
};
struct SchedU {
    int G, c; unsigned char* ws;
    __device__ __forceinline__ bool next(int i, Unit& u) const {
        const int L = i * G + c; if (L >= 512) return false;
        const int pmt = L & 1, h = (L >> 1) & 3, j = (L >> 3) & 31, b = L >> 8;
        u.a2d = 0; u.b2d = 0; u.kind = b; u.pm = j; u.pn = 0; u.aux = h * 2 + pmt;
        u.a = (const char*)(ws + (b ? WS_VTB1 : WS_VTB0)) + ((size_t)(h * 512 + pmt * 256) * SEQ + j * CH) * 2;
        u.b = (const char*)(ws + (b ? WS_KTB1 : WS_KTB0)) + ((size_t)(h * 256) * SEQ + j * CH) * 2;
        return true;
    }
};
struct SchedE {
    int G, c; unsigned char* ws;
    __device__ __forceinline__ bool next(int i, Unit& u) const {
        const int L = i * G + c; if (L >= 512) return false;
        const int idx = L & 255, pnt = L >> 8, h = idx & 3, j = (idx >> 2) & 31, b = idx >> 7;
        u.kind = b; u.pm = j; u.pn = pnt; u.aux = h;
        const char* a1 = (const char*)(ws + WS_ATT) + ((size_t)(b * SEQ + j * CH) * 1024 + h * 256) * 2;
        const char* a2 = (const char*)(ws + WS_Q) + ((size_t)(b * SEQ + j * CH) * 1024 + h * 256) * 2;
        const char* b1 = (const char*)(ws + (b ? WS_VTB1 : WS_VTB0)) + ((size_t)(h * 512 + pnt * 256) * SEQ + j * CH) * 2;
        const char* b2 = (const char*)(s_head(ws, b, h) + (size_t)(pnt * 256) * SEQ + j * CH);
        u.a = a1; u.b = b1; u.a2d = (long)(a2 - a1) - 4 * 128; u.b2d = (long)(b2 - b1) - 4 * 128;
        return true;
    }
};

#define EPI_FENCE asm volatile("" ::: "memory")
#define EPI_ARGS const f32x4 (&acc)[2][2][4][2], const Unit& u, int wr, int wc, int fr, int fq
struct EpiB1 {
    unsigned char* ws;
    __device__ __forceinline__ void operator()(EPI_ARGS) const {
        const f32x2* tab = (const f32x2*)(ws + WS_TAB); const fx_t* ssq = (const fx_t*)(ws + WS_SSQA);
        if (u.kind == 0) {
            const int head = u.pn & 3; const bool isk = u.pn >= 4;
            bf16_t* dst = isk ? k_tile(ws, u.pm) : (bf16_t*)(ws + WS_Q) + (size_t)u.pm * 256 * 1024;
            const float sc = isk ? 0.0625f : 1.0f;
            const __amdgpu_buffer_rsrc_t ktr = __builtin_amdgcn_make_buffer_rsrc((void*)(ws + (u.pm < 32 ? WS_KTB0 : WS_KTB1)), (short)0, (int)(16 * MiB), 0x00020000);
            const int d0 = wc * 32 + fq * 8;
#pragma unroll
            for (int aih = 0; aih < 2; ++aih) {
                const int ai = aih, mb = 0;
                f32x4 tb[4][4]; float rsq[4];
#pragma unroll
                for (int m = mb; m < mb + 4; ++m) {
                    const int row = ai * 128 + wr * 64 + m * 16 + fr;
                    const int pos = u.pm < 64 ? ((u.pm & 31) * 256 + row) : (PAST + (row & 31));
                    const f32x4* tp = (const f32x4*)(tab + (size_t)pos * 128 + d0);
                    tb[m][0] = tp[0]; tb[m][1] = tp[1]; tb[m][2] = tp[2]; tb[m][3] = tp[3];
                    rsq[m] = fx_get(ssq[(size_t)u.pm * 256 + row]);
                }
                EPI_FENCE;
#pragma unroll
                for (int m = mb; m < mb + 4; ++m) {
                    const int row = ai * 128 + wr * 64 + m * 16 + fr;
                    const f32x4 c01 = tb[m][0], c23 = tb[m][1], c45 = tb[m][2], c67 = tb[m][3];
                    const f32x4 cs0 = (f32x4){c01[0], c01[2], c23[0], c23[2]}, sn0 = (f32x4){c01[1], c01[3], c23[1], c23[3]};
                    const f32x4 cs1 = (f32x4){c45[0], c45[2], c67[0], c67[2]}, sn1 = (f32x4){c45[1], c45[3], c67[1], c67[3]};
                    const f32x4 x1a = acc[ai][0][m][0], x1b = acc[ai][0][m][1], x2a = acc[ai][1][m][0], x2b = acc[ai][1][m][1];
                    const float scr_ = sc * rstd_of(rsq[m]);
                    const f32x4 o1a = (x1a * cs0 - x2a * sn0) * scr_, o1b = (x1b * cs1 - x2b * sn1) * scr_;
                    const f32x4 o2a = (x2a * cs0 + x1a * sn0) * scr_, o2b = (x2b * cs1 + x1b * sn1) * scr_;
                    bf16_t* rp = dst + (size_t)row * 1024 + head * 256 + d0;
                    *(u32x4*)rp = pack8(o1a, o1b); *(u32x4*)(rp + 128) = pack8(o2a, o2b);
                    if (isk) {
                        const float dk = __expf(lgdec(head) * (float)(CH - 1 - (row & (CH - 1))));
                        const unsigned voff = (unsigned)((d0 * SEQ + row) * 2);
                        const unsigned sbase = (unsigned)(((head * 256) * SEQ + (u.pm & 31) * 256) * 2);
                        const u32x4 t1 = pack8(o1a * dk, o1b * dk);
#pragma unroll
                        for (int jj = 0; jj < 4; ++jj) {
                            __builtin_amdgcn_raw_buffer_store_b16((short)(t1[jj] & 0xffffu), ktr, voff, sbase + (unsigned)(2 * jj) * SEQ * 2u, 0);
                            __builtin_amdgcn_raw_buffer_store_b16((short)(t1[jj] >> 16), ktr, voff, sbase + (unsigned)(2 * jj + 1) * SEQ * 2u, 0); }
                        const u32x4 t2 = pack8(o2a * dk, o2b * dk);
#pragma unroll
                        for (int jj = 0; jj < 4; ++jj) {
                            __builtin_amdgcn_raw_buffer_store_b16((short)(t2[jj] & 0xffffu), ktr, voff, sbase + (unsigned)(128 + 2 * jj) * SEQ * 2u, 0);
                            __builtin_amdgcn_raw_buffer_store_b16((short)(t2[jj] >> 16), ktr, voff, sbase + (unsigned)(129 + 2 * jj) * SEQ * 2u, 0); }
                    }
                }
                EPI_FENCE;
            }
        } else {
            bf16_t* dst; int ld;
            if (u.pn < 32) { dst = (bf16_t*)(ws + WS_VTB0) + (size_t)u.pn * 256; ld = SEQ; }
            else if (u.pn < 64) { dst = (bf16_t*)(ws + WS_VTB1) + (size_t)(u.pn - 32) * 256; ld = SEQ; }
            else { dst = (bf16_t*)(ws + WS_VTS); ld = 256; }
            f32x4 rsv[2][2];
#pragma unroll
            for (int bj = 0; bj < 2; ++bj) { const fx_t* sp8 = ssq + (size_t)u.pn * 256 + bj * 128 + wc * 32 + fq * 8;
#pragma unroll
                for (int n = 0; n < 2; ++n) rsv[bj][n] = (f32x4){rstd_of(fx_get(sp8[4 * n])), rstd_of(fx_get(sp8[4 * n + 1])), rstd_of(fx_get(sp8[4 * n + 2])), rstd_of(fx_get(sp8[4 * n + 3]))}; }
#pragma unroll
            for (int ai = 0; ai < 2; ++ai)
#pragma unroll
                for (int m = 0; m < 4; ++m) {
                    const int e = (u.pm - 4) * 256 + ai * 128 + wr * 64 + m * 16 + fr;
                    bf16_t* rp = dst + (size_t)e * ld + wc * 32 + fq * 8;
#pragma unroll
                    for (int bj = 0; bj < 2; ++bj) *(u32x4*)(rp + bj * 128) = pack8(acc[ai][bj][m][0] * rsv[bj][0], acc[ai][bj][m][1] * rsv[bj][1]);
                    EPI_FENCE;
                }
        }
    }
};
struct EpiAtt {
    unsigned char* ws;
    __device__ __forceinline__ void operator()(EPI_ARGS) const {
        const int h = u.aux; const float lg = lgdec(h);
        bf16_t* dst = (bf16_t*)(ws + WS_ATT) + (size_t)(u.pn * SEQ + u.pm * CH) * 1024 + h * 256;
        float cf[2][8];
#pragma unroll
        for (int bj = 0; bj < 2; ++bj)
#pragma unroll
            for (int j = 0; j < 8; ++j) cf[bj][j] = __expf(-lg * (float)(bj * 128 + wc * 32 + fq * 8 + j + 1));
#pragma unroll
        for (int ai = 0; ai < 2; ++ai)
#pragma unroll
            for (int m = 0; m < 4; ++m) {
                const int n = ai * 128 + wr * 64 + m * 16 + fr;
#pragma unroll
                for (int bj = 0; bj < 2; ++bj) {
                    const int m0 = bj * 128 + wc * 32 + fq * 8;
                    float o[8];
#pragma unroll
                    for (int j = 0; j < 8; ++j) o[j] = __uint_as_float(__float_as_uint(acc[ai][bj][m][j >> 2][j & 3] * cf[bj][j]) & ~(unsigned)((n - m0 - j) >> 31));
                    *(u32x4*)(dst + (size_t)n * 1024 + m0) = pack8((f32x4){o[0], o[1], o[2], o[3]}, (f32x4){o[4], o[5], o[6], o[7]});
                }
                EPI_FENCE;
            }
    }
};
struct EpiU {
    unsigned char* ws;
    __device__ __forceinline__ void operator()(EPI_ARGS) const {
        bf16_t* dst = s_head(ws, u.kind, u.aux >> 1) + (size_t)((u.aux & 1) * 256) * SEQ + u.pm * CH;
#pragma unroll
        for (int ai = 0; ai < 2; ++ai)
#pragma unroll
            for (int m = 0; m < 4; ++m) {
                bf16_t* rp = dst + (size_t)(ai * 128 + wr * 64 + m * 16 + fr) * SEQ + wc * 32 + fq * 8;
#pragma unroll
                for (int bj = 0; bj < 2; ++bj) *(u32x4*)(rp + bj * 128) = pack8(acc[ai][bj][m][0], acc[ai][bj][m][1]);
                    EPI_FENCE;
            }
    }
};
struct EpiE {
    unsigned char* ws;
    __device__ __forceinline__ void operator()(EPI_ARGS) const {
        const int h = u.aux, b = u.kind; const float lg = lgdec(h);
        bf16_t* dst = (bf16_t*)(ws + (b ? WS_OB1 : WS_OB0)) + (size_t)(u.pm * CH) * 2048 + h * 512 + u.pn * 256;
        float* sl = (float*)(ws + WS_SLOTS) + (size_t)blockIdx.x * 4096 + (u.pn * 4 + wc) * 2;
#pragma unroll
        for (int ai = 0; ai < 2; ++ai)
#pragma unroll
            for (int m = 0; m < 4; ++m) {
                const int n = ai * 128 + wr * 64 + m * 16 + fr; const float rs = __expf(lg * (float)(n + 1));
                float s = 0.f, q = 0.f;
#pragma unroll
                for (int bj = 0; bj < 2; ++bj) {
                    const f32x4 v0 = acc[ai][bj][m][0] * rs, v1 = acc[ai][bj][m][1] * rs;
                    s += (v0[0] + v0[1]) + (v0[2] + v0[3]) + (v1[0] + v1[1]) + (v1[2] + v1[3]);
                    q += (v0[0] * v0[0] + v0[1] * v0[1]) + (v0[2] * v0[2] + v0[3] * v0[3]) + (v1[0] * v1[0] + v1[1] * v1[1]) + (v1[2] * v1[2] + v1[3] * v1[3]);
                    *(u32x4*)(dst + (size_t)n * 2048 + bj * 128 + wc * 32 + fq * 8) = pack8(v0, v1);
                }
                s += shx<16>(s); s += shx<32>(s); q += shx<16>(q); q += shx<32>(q);
                if (fq == 0) *(f32x2*)(sl + (size_t)n * 16) = (f32x2){s, q};
                EPI_FENCE;
            }
    }
};
struct EpiB2 {
    unsigned char* ws; const float* gn_g;
    __device__ __forceinline__ void operator()(EPI_ARGS) const {
        const fx_t* ssq = (const fx_t*)(ws + WS_SSQA) + (size_t)u.pm * 256;
        float rsr[2][4];
#pragma unroll
        for (int ai = 0; ai < 2; ++ai)
#pragma unroll
            for (int m = 0; m < 4; ++m) rsr[ai][m] = fx_get(ssq[ai * 128 + wr * 64 + m * 16 + fr]);
#pragma unroll
        for (int ai = 0; ai < 2; ++ai)
#pragma unroll
            for (int m = 0; m < 4; ++m) rsr[ai][m] = rstd_of(rsr[ai][m]);
        if (u.pn < 8) {
            bf16_t* dst = (bf16_t*)(ws + WS_GLU) + (size_t)u.pm * 256 * 1024 + u.pn * 128 + wc * 32 + fq * 8;
#pragma unroll
            for (int ai = 0; ai < 2; ++ai)
#pragma unroll
                for (int m = 0; m < 4; ++m) {
                    const int row = ai * 128 + wr * 64 + m * 16 + fr;
                    const float rs = rsr[ai][m];
                    f32x4 a0 = acc[ai][0][m][0] * rs, a1 = acc[ai][0][m][1] * rs; const f32x4 b0 = acc[ai][1][m][0] * rs, b1 = acc[ai][1][m][1] * rs;
#pragma unroll
                    for (int j = 0; j < 4; ++j) { a0[j] *= sigm(b0[j]); a1[j] *= sigm(b1[j]); }
                    *(u32x4*)(dst + (size_t)row * 1024) = pack8(a0, a1);
                    EPI_FENCE;
                }
        } else if (u.pn < 16) {
            const int t = u.pn - 8, head = t >> 1;
            bf16_t* ob = o_tile(ws, u.pm) + t * 256 + wc * 32 + fq * 8;
            const float* st = (const float*)(ws + WS_STATF) + (size_t)u.pm * 256 * 8 + head * 2;
            f32x4 gg[2][2];
#pragma unroll
            for (int bj = 0; bj < 2; ++bj) { const f32x4* gp = (const f32x4*)(gn_g + t * 256 + bj * 128 + wc * 32 + fq * 8); gg[bj][0] = gp[0]; gg[bj][1] = gp[1]; }
#pragma unroll
            for (int aih = 0; aih < 4; ++aih) {
                const int ai = aih >> 1, mb = (aih & 1) * 2;
                f32x2 sqv[4]; u32x4 ov[4][2];
#pragma unroll
                for (int m = mb; m < mb + 2; ++m) {
                    const int row = ai * 128 + wr * 64 + m * 16 + fr;
                    sqv[m] = *(const f32x2*)(st + (size_t)row * 8);
#pragma unroll
                    for (int bj = 0; bj < 2; ++bj) ov[m][bj] = *(const u32x4*)(ob + (size_t)row * 2048 + bj * 128);
                }
                EPI_FENCE;
#pragma unroll
                for (int m = mb; m < mb + 2; ++m) {
                    const int row = ai * 128 + wr * 64 + m * 16 + fr;
                    const f32x2 sq = sqv[m]; const float rsn = rsr[ai][m];
                    const float mu = sq.x * (1.0f / 512.0f); const float var = fmaxf(sq.y * (1.0f / 512.0f) - mu * mu, 0.f); const float rstd = __builtin_amdgcn_rsqf(var + LN_EPS);
#pragma unroll
                    for (int bj = 0; bj < 2; ++bj) {
                        bf16_t* rp = ob + (size_t)row * 2048 + bj * 128;
                        f32x4 o0, o1; unpack8(ov[m][bj], o0, o1);
                        f32x4 g0 = acc[ai][bj][m][0] * rsn, g1 = acc[ai][bj][m][1] * rsn;
#pragma unroll
                        for (int j = 0; j < 4; ++j) { g0[j] = g0[j] * sigm(g0[j]) * ((o0[j] - mu) * rstd * gg[bj][0][j]); g1[j] = g1[j] * sigm(g1[j]) * ((o1[j] - mu) * rstd * gg[bj][1][j]); }
                        *(u32x4*)rp = pack8(g0, g1);
                    }
                }
                EPI_FENCE;
            }
        } else {
            const int t = (u.pn - 16) & 3;
            bf16_t* dst = (bf16_t*)(ws + (u.pn < 20 ? WS_GC : WS_GR)) + (size_t)u.pm * 256 * 1024 + t * 256 + wc * 32 + fq * 8;
#pragma unroll
            for (int ai = 0; ai < 2; ++ai)
#pragma unroll
                for (int m = 0; m < 4; ++m) {
                    const int row = ai * 128 + wr * 64 + m * 16 + fr; const float rs = rsr[ai][m];
#pragma unroll
                    for (int bj = 0; bj < 2; ++bj) {
                        f32x4 a0 = acc[ai][bj][m][0] * rs, a1 = acc[ai][bj][m][1] * rs;
#pragma unroll
                        for (int j = 0; j < 4; ++j) { a0[j] = sigm(a0[j]); a1[j] = sigm(a1[j]); }
                        *(u32x4*)(dst + (size_t)row * 1024 + bj * 128) = pack8(a0, a1);
                    }
                    EPI_FENCE;
                }
        }
    }
};
template <int MODE> struct EpiEW {
    unsigned char* ws; float* x; fx_t* ssq;
    __device__ __forceinline__ void operator()(EPI_ARGS) const {
        const int c0 = u.pn * 256 + wc * 32 + fq * 8;
#pragma unroll
        for (int ai = 0; ai < 2; ++ai) {
            u32x4 gv[4][2], tv[4][2]; float sqs[4] = {0.f, 0.f, 0.f, 0.f}, rs3[4];
            if (MODE == 3) {
#pragma unroll
                for (int m = 0; m < 4; ++m) rs3[m] = rstd_of(fx_get(ssq[(size_t)u.pm * 256 + ai * 128 + wr * 64 + m * 16 + fr]));
            }
            if (MODE != 3) {
#pragma unroll
                for (int m = 0; m < 4; ++m) {
                    const size_t row = (size_t)u.pm * 256 + ai * 128 + wr * 64 + m * 16 + fr;
#pragma unroll
                    for (int bj = 0; bj < 2; ++bj) {
                        if (MODE == 0) gv[m][bj] = *(const u32x4*)((const bf16_t*)(ws + WS_GC) + row * 1024 + c0 + bj * 128);
                        if (MODE == 1) { gv[m][bj] = *(const u32x4*)((const bf16_t*)(ws + WS_GR) + row * 1024 + c0 + bj * 128); tv[m][bj] = *(const u32x4*)((const bf16_t*)(ws + WS_T) + row * 1024 + c0 + bj * 128); }
                        if (MODE == 2) tv[m][bj] = *(const u32x4*)((const bf16_t*)(ws + WS_H) + row * 1024 + c0 + bj * 128);
                    }
                }
                EPI_FENCE;
            }
#pragma unroll
            for (int m = 0; m < 4; ++m) {
                const size_t row = (size_t)u.pm * 256 + ai * 128 + wr * 64 + m * 16 + fr;
#pragma unroll
                for (int bj = 0; bj < 2; ++bj) {
                    f32x4 a0 = acc[ai][bj][m][0], a1 = acc[ai][bj][m][1];
                    if (MODE == 0) {
                        f32x4 g0, g1; unpack8(gv[m][bj], g0, g1);
                        *(u32x4*)((bf16_t*)(ws + WS_T) + row * 1024 + c0 + bj * 128) = pack8(a0 * g0, a1 * g1);
                    } else if (MODE == 1) {
                        f32x4 g0, g1, t0, t1; unpack8(gv[m][bj], g0, g1); unpack8(tv[m][bj], t0, t1);
                        *(u32x4*)((bf16_t*)(ws + WS_T) + row * 1024 + c0 + bj * 128) = pack8(t0 + a0 * g0, t1 + a1 * g1);
                    } else if (MODE == 2) {
                        f32x4 x0, x1; unpack8(tv[m][bj], x0, x1);
                        a0 = x0 + a0; a1 = x1 + a1;
                        *(u32x4*)((bf16_t*)(ws + WS_H) + row * 1024 + c0 + bj * 128) = pack8(a0, a1);
                        sqs[m] += (a0[0] * a0[0] + a0[1] * a0[1]) + (a0[2] * a0[2] + a0[3] * a0[3]) + (a1[0] * a1[0] + a1[1] * a1[1]) + (a1[2] * a1[2] + a1[3] * a1[3]);
                    } else {
#pragma unroll
                        for (int j = 0; j < 4; ++j) { const float r0 = fmaxf(a0[j], 0.f) * rs3[m], r1 = fmaxf(a1[j], 0.f) * rs3[m]; a0[j] = r0 * r0; a1[j] = r1 * r1; }
                        *(u32x4*)((bf16_t*)(ws + WS_U) + row * 4096 + c0 + bj * 128) = pack8(a0, a1);
                    }
                }
                if (MODE == 2) { float q = sqs[m]; q += shx<16>(q); q += shx<32>(q); if (fq == 0) fx_add(ssq + row, q); }
            }
            EPI_FENCE;
        }
    }
};

__device__ __forceinline__ void transpose_item(const float* W, int K, int N, bf16_t* WT, int k0, int n0, int drow0, LAS float* scr, int lane, const float* gk = nullptr) {
    float tv[32];
#pragma unroll
    for (int i = 0; i < 32; ++i) { const int kk = 2 * i + (lane >> 5); tv[i] = W[(size_t)(k0 + kk) * N + n0 + (lane & 31)]; }
#pragma unroll
    for (int i = 0; i < 32; ++i) { const int kk = 2 * i + (lane >> 5); scr[kk * 33 + (lane & 31)] = gk ? tv[i] * gk[k0 + kk] : tv[i]; }
    asm volatile("s_waitcnt lgkmcnt(0)" ::: "memory");
    const int c = lane & 7;
#pragma unroll
    for (int j = 0; j < 4; ++j) { const int n = (lane >> 3) + 8 * j; const LAS float* s = scr + (8 * c) * 33 + n;
        u32x4 o; o.x = cvt_pk_bf16(s[0 * 33], s[1 * 33]); o.y = cvt_pk_bf16(s[2 * 33], s[3 * 33]); o.z = cvt_pk_bf16(s[4 * 33], s[5 * 33]); o.w = cvt_pk_bf16(s[6 * 33], s[7 * 33]);
        *(u32x4*)(WT + (size_t)(drow0 + n) * K + k0 + 8 * c) = o; }
    asm volatile("s_waitcnt lgkmcnt(0)" ::: "memory");
}
struct TItem { const float* W; const float* gk; bf16_t* WT; int K, N, k0, n0, drow0; };
__device__ __forceinline__ void titem_load(const TItem& t, int lane, float (&tv)[32], f32x4& g0, f32x4& g1) {
#pragma unroll
    for (int i = 0; i < 32; ++i) { const int kk = 2 * i + (lane >> 5); tv[i] = t.W[(size_t)(t.k0 + kk) * t.N + t.n0 + (lane & 31)]; }
    g0 = (f32x4){1.f, 1.f, 1.f, 1.f}; g1 = g0;
    if (t.gk) { const f32x4* gp = (const f32x4*)(t.gk + t.k0 + 8 * (lane & 7)); g0 = gp[0]; g1 = gp[1]; }
}
__device__ __forceinline__ void titem_store(const TItem& t, int lane, const float (&tv)[32], const f32x4 g0, const f32x4 g1, LAS float* scr) {
#pragma unroll
    for (int i = 0; i < 32; ++i) { const int kk = 2 * i + (lane >> 5); scr[kk * 33 + (lane & 31)] = tv[i]; }
    asm volatile("s_waitcnt lgkmcnt(0)" ::: "memory");
    const int c = lane & 7;
#pragma unroll
    for (int j = 0; j < 4; ++j) { const int n = (lane >> 3) + 8 * j; const LAS float* sp = scr + (8 * c) * 33 + n;
        u32x4 o; o.x = cvt_pk_bf16(sp[0 * 33] * g0[0], sp[1 * 33] * g0[1]); o.y = cvt_pk_bf16(sp[2 * 33] * g0[2], sp[3 * 33] * g0[3]);
        o.z = cvt_pk_bf16(sp[4 * 33] * g1[0], sp[5 * 33] * g1[1]); o.w = cvt_pk_bf16(sp[6 * 33] * g1[2], sp[7 * 33] * g1[3]);
        *(u32x4*)(t.WT + (size_t)(t.drow0 + n) * t.K + t.k0 + 8 * c) = o; }
    asm volatile("s_waitcnt lgkmcnt(0)" ::: "memory");
}
__device__ __forceinline__ int win_drow(int n0) {
    if (n0 < 2048) { const int bj = n0 >> 10, jj = n0 & 1023; return 4096 + 256 * (jj >> 7) + 128 * bj + (jj & 127); }
    if (n0 < 6144) return n0 - 2048;
    return n0;
}
__device__ __forceinline__ void rms_row(const float* xrow, const float* g, bf16_t* orow, float* copy, int lane) {
    const f32x4* xr = (const f32x4*)xrow + lane; const f32x4* gr = (const f32x4*)g + lane;
    f32x4 v[4]; float s = 0.f;
#pragma unroll
    for (int j = 0; j < 4; ++j) { v[j] = xr[64 * j]; s += (v[j][0] * v[j][0] + v[j][1] * v[j][1]) + (v[j][2] * v[j][2] + v[j][3] * v[j][3]); }
    const float r = 1.0f / sqrtf(wave_sum(s) * (1.0f / 1024.0f) + RMS_EPS);
    u32x2* o8 = (u32x2*)orow + lane;
#pragma unroll
    for (int j = 0; j < 4; ++j) { const f32x4 gg = gr[64 * j]; if (copy) ((f32x4*)copy + lane)[64 * j] = v[j];
        u32x2 w; w.x = cvt_pk_bf16(v[j][0] * r * gg[0], v[j][1] * r * gg[1]); w.y = cvt_pk_bf16(v[j][2] * r * gg[2], v[j][3] * r * gg[3]); o8[64 * j] = w; }
}

__device__ __forceinline__ void phase0(int wv, const Params& p, int l, LAS unsigned char* lds, int part) {
    int wv_ = wv; asm volatile("" : "+s"(wv_)); int tid = wv_ * 64 + lane_id(); asm volatile("" : "+v"(tid));
    const int lane = tid & 63, wave = tid >> 6, G = gdim();
    const int gw = blockIdx.x * 8 + wave, NGW = G * 8;
    unsigned char* ws = p.ws;
    LAS float* scr = (LAS float*)(lds + wave * 16384);
    const float* w_in = p.in[5] + (size_t)l * 1024 * 10240; const float* w_c = p.in[10] + (size_t)l * 1024 * 1024; const float* w_r = p.in[12] + (size_t)l * 2048 * 1024;
    const float* w_o = p.in[13] + (size_t)l * 1024 * 1024; const float* w_1 = p.in[15] + (size_t)l * 1024 * 4096; const float* w_2 = p.in[16] + (size_t)l * 4096 * 1024;
    constexpr int I_IN = 16 * 320, I_C = 16 * 32, I_R = 32 * 32, I_O = 16 * 32, I_1 = 16 * 128, I_2 = 64 * 32, NIT = I_IN + I_C + I_R + I_O + I_1 + I_2;
#define TI_DECODE(it_, T_) do { int r = (it_); \
        if (r < I_IN) { const int kb = r / 320, nb = r % 320; T_ = TItem{w_in, p.in[4] + l * 1024, (bf16_t*)(ws + WS_WIN), 1024, 10240, kb * 64, nb * 32, win_drow(nb * 32)}; break; } r -= I_IN; \
        if (r < I_C) { const int kb = r / 32, nb = r % 32; T_ = TItem{w_c, nullptr, (bf16_t*)(ws + WS_WC), 1024, 1024, kb * 64, nb * 32, nb * 32}; break; } r -= I_C; \
        if (r < I_R) { const int kb = r / 32, nb = r % 32; T_ = TItem{w_r, nullptr, (bf16_t*)(ws + WS_WR), 2048, 1024, kb * 64, nb * 32, nb * 32}; break; } r -= I_R; \
        if (r < I_O) { const int kb = r / 32, nb = r % 32; T_ = TItem{w_o, nullptr, (bf16_t*)(ws + WS_WO), 1024, 1024, kb * 64, nb * 32, nb * 32}; break; } r -= I_O; \
        if (r < I_1) { const int kb = r / 128, nb = r % 128; T_ = TItem{w_1, p.in[14] + l * 1024, (bf16_t*)(ws + WS_WM1), 1024, 4096, kb * 64, nb * 32, nb * 32}; break; } r -= I_1; \
        { const int kb = r / 32, nb = r % 32; T_ = TItem{w_2, nullptr, (bf16_t*)(ws + WS_WM2), 4096, 1024, kb * 64, nb * 32, nb * 32}; } } while (0)
    const int it_first = part == 0 ? 0 : I_IN, it_last = part == 0 ? I_IN : NIT;
    if (it_first + gw < it_last) {
        int it = it_first + gw; TItem cur; TI_DECODE(it, cur);
        float tv[32]; f32x4 g0, g1; titem_load(cur, lane, tv, g0, g1);
#pragma unroll 1
        for (;;) {
            const int nit = it + NGW; const bool has = nit < it_last;
            TItem nx = cur; float tn[32]; f32x4 h0 = g0, h1 = g1;
            if (has) { TI_DECODE(nit, nx); titem_load(nx, lane, tn, h0, h1); }
            titem_store(cur, lane, tv, g0, g1, scr);
            if (!has) break;
            cur = nx; it = nit; g0 = h0; g1 = h1;
#pragma unroll
            for (int i = 0; i < 32; ++i) tv[i] = tn[i];
        }
    }
#undef TI_DECODE
    if (part != 0) { asm volatile("s_waitcnt vmcnt(0) lgkmcnt(0)" ::: "memory"); __syncthreads(); return; }
    if (l == 0) {
        for (int m = gw; m < NTOK; m += NGW) {
            const float* src = m < NPT ? p.in[0] + (size_t)m * 1024 : p.in[1] + (size_t)(m - NPT) * 1024;
            const f32x4* xr = (const f32x4*)src + lane; f32x4 v[4]; float sq = 0.f;
#pragma unroll
            for (int j = 0; j < 4; ++j) { v[j] = xr[64 * j]; sq += (v[j][0] * v[j][0] + v[j][1] * v[j][1]) + (v[j][2] * v[j][2] + v[j][3] * v[j][3]); }
            sq = wave_sum(sq);
            u32x2* o8 = (u32x2*)((bf16_t*)(ws + WS_H) + (size_t)m * 1024) + lane;
#pragma unroll
            for (int j = 0; j < 4; ++j) { u32x2 wv; wv.x = cvt_pk_bf16(v[j][0], v[j][1]); wv.y = cvt_pk_bf16(v[j][2], v[j][3]); o8[64 * j] = wv; }
            if (lane == 0) ((fx_t*)(ws + WS_SSQA))[m] = fx_of(sq);
        }
    }
    { unsigned z = 0u; asm volatile("" : "+v"(z)); unsigned* sb = (unsigned*)(ws + WS_SSQB); for (int i = blockIdx.x * 512 + tid; i < NTOK * 2; i += G * 512) sb[i] = z; }
    { unsigned z = 0u; asm volatile("" : "+v"(z)); unsigned* st = (unsigned*)(ws + WS_STATS); for (int i = blockIdx.x * 512 + tid; i < 256 * 16; i += G * 512) st[i] = z; }
    {
        f32x2* tab = (f32x2*)(ws + WS_TAB);
        for (int i = blockIdx.x * 512 + tid; i < 8192 * 128; i += G * 512) {
            const int pos = i >> 7, k = i & 127;
            const float inv = powf(10000.0f, -(float)(2 * k) / 256.0f); const float ang = (float)pos * inv;
            float sn, cs; sincosf(ang, &sn, &cs); tab[i] = (f32x2){cs, sn};
        }
    }
}

__device__ __forceinline__ void phase_scan(int wv, const Params& p, int l) {
    int wv_ = wv; asm volatile("" : "+s"(wv_)); int tid = wv_ * 64 + lane_id(); asm volatile("" : "+v"(tid));
    const int gt = blockIdx.x * 512 + tid;
    if (gt >= 2048 * 64) return;
    const int row = gt >> 6, d4 = (gt & 63) * 4, h = row >> 9, e = row & 511;
    const float sd = __expf(lgdec(h) * (float)CH);
#pragma unroll 1
    for (int b = 0; b < 2; ++b) {
        bf16_t* sp = s_head(p.ws, b, h) + (size_t)e * SEQ + d4;
        float a[4] = {0.f, 0.f, 0.f, 0.f};
#pragma unroll 1
        for (int j0 = 0; j0 < 32; j0 += 16) {
            u32x2 w[16];
#pragma unroll
            for (int j = 0; j < 16; ++j) w[j] = *(const u32x2*)(sp + (j0 + j) * CH);
#pragma unroll
            for (int j = 0; j < 16; ++j) {
                u32x2 o; o.x = cvt_pk_bf16(a[0], a[1]); o.y = cvt_pk_bf16(a[2], a[3]);
                *(u32x2*)(sp + (j0 + j) * CH) = o;
                a[0] = a[0] * sd + bflo(w[j].x); a[1] = a[1] * sd + bfhi(w[j].x); a[2] = a[2] * sd + bflo(w[j].y); a[3] = a[3] * sd + bfhi(w[j].y);
            }
        }
        float* o = p.out + OUT_RETP + ((size_t)((l * 2 + b) * 4 + h) * 256 + d4) * 512 + e;
#pragma unroll
        for (int j = 0; j < 4; ++j) o[(size_t)j * 512] = a[j];
    }
}

__device__ __forceinline__ void phase_sret(int wv, const Params& p, int l, LAS unsigned char* lds) {
    int wv_ = wv; asm volatile("" : "+s"(wv_)); int tid = wv_ * 64 + lane_id(); asm volatile("" : "+v"(tid));
    const int lane = tid & 63, w = __builtin_amdgcn_readfirstlane(tid >> 6);
    unsigned char* ws = p.ws;
    LAS float* attL = (LAS float*)lds;
    LAS float* red = (LAS float*)(lds + 8192);
    for (int unit = blockIdx.x, GG = gdim(); unit < 256; unit += GG) {
        const int es = unit & 7, h = (unit >> 3) & 3, bs = unit >> 5;
        const float lg = lgdec(h);
        const bf16_t* q = (const bf16_t*)(ws + WS_Q) + (size_t)(NPT + bs * 32) * 1024 + h * 256;
        const bf16_t* k = (const bf16_t*)(ws + WS_KS) + (size_t)(bs * 32) * 1024 + h * 256;
        const bf16_t* kT = (const bf16_t*)(ws + WS_KTS) + (size_t)(h * 256) * 256 + bs * 32;
        const bf16_t* vT = (const bf16_t*)(ws + WS_VTS) + (size_t)(h * 512 + es * 64) * 256 + bs * 32;
        if (w == 0) {
            f32x16 accq;
#pragma unroll
            for (int r = 0; r < 16; ++r) accq[r] = 0.f;
            const bf16_t* qa = q + (size_t)(lane & 31) * 1024 + (lane >> 5) * 8; const bf16_t* kb = k + (size_t)(lane & 31) * 1024 + (lane >> 5) * 8;
#pragma unroll
            for (int sk = 0; sk < 16; ++sk) { const bf16x8 af = *(const bf16x8*)(qa + 16 * sk), bfr = *(const bf16x8*)(kb + 16 * sk); accq = __builtin_amdgcn_mfma_f32_32x32x16_bf16(af, bfr, accq, 0, 0, 0); }
            const int m = lane & 31;
#pragma unroll
            for (int r = 0; r < 16; ++r) { const int n = (r & 3) + 8 * (r >> 2) + 4 * (lane >> 5); attL[n * 33 + m] = (m <= n) ? accq[r] * __expf(lg * (float)(n - m)) : 0.f; }
        }
        const int e = es * 64 + lane;
        const float* S0 = p.in[3] + ((size_t)((l * 8 + bs) * 4 + h) * 256 + w * 32) * 512 + e;
        float s0[32];
#pragma unroll
        for (int dd = 0; dd < 32; ++dd) s0[dd] = S0[(size_t)dd * 512];
        float v[32];
        { const u32x4* vp = (const u32x4*)(vT + (size_t)lane * 256);
#pragma unroll
          for (int c = 0; c < 4; ++c) { f32x4 a, b2; unpack8(vp[c], a, b2); v[8 * c] = a[0]; v[8 * c + 1] = a[1]; v[8 * c + 2] = a[2]; v[8 * c + 3] = a[3]; v[8 * c + 4] = b2[0]; v[8 * c + 5] = b2[1]; v[8 * c + 6] = b2[2]; v[8 * c + 7] = b2[3]; } }
        {
            float* So = p.out + OUT_RETS + ((size_t)((l * 8 + bs) * 4 + h) * 256 + w * 32) * 512 + e;
            const float sd = __expf(lg * 32.0f);
#pragma unroll 4
            for (int dd = 0; dd < 32; ++dd) {
                const u32x4* kr = (const u32x4*)(kT + (size_t)(w * 32 + dd) * 256); float a = s0[dd] * sd;
#pragma unroll
                for (int c4 = 0; c4 < 4; ++c4) { f32x4 k0, k1; unpack8(kr[c4], k0, k1);
                    a += (k0[0] * v[8 * c4] + k0[1] * v[8 * c4 + 1]) + (k0[2] * v[8 * c4 + 2] + k0[3] * v[8 * c4 + 3]) + (k1[0] * v[8 * c4 + 4] + k1[1] * v[8 * c4 + 5]) + (k1[2] * v[8 * c4 + 6] + k1[3] * v[8 * c4 + 7]); }
                So[(size_t)dd * 512] = a;
            }
        }
#pragma unroll 2
        for (int n = 0; n < 32; ++n) {
            const u32x4* qr = (const u32x4*)(q + (size_t)n * 1024 + w * 32); float a = 0.f;
#pragma unroll
            for (int c4 = 0; c4 < 4; ++c4) { f32x4 k0, k1; unpack8(qr[c4], k0, k1);
                a += (k0[0] * s0[8 * c4] + k0[1] * s0[8 * c4 + 1]) + (k0[2] * s0[8 * c4 + 2] + k0[3] * s0[8 * c4 + 3]) + (k1[0] * s0[8 * c4 + 4] + k1[1] * s0[8 * c4 + 5]) + (k1[2] * s0[8 * c4 + 6] + k1[3] * s0[8 * c4 + 7]); }
            red[(w * 32 + n) * 64 + lane] = a * __expf(lg * (float)(n + 1));
        }
        __syncthreads();
        bf16_t* O = (bf16_t*)(ws + WS_OS) + (size_t)(bs * 32) * 2048 + h * 512 + e;
        fx_t* st = (fx_t*)(ws + WS_STATS) + (size_t)(bs * 32) * 8 + h * 2;
#pragma unroll
        for (int r = 0; r < 4; ++r) {
            const int n = w * 4 + r; float a = 0.f;
#pragma unroll
            for (int ww = 0; ww < 8; ++ww) a += red[(ww * 32 + n) * 64 + lane];
#pragma unroll
            for (int m = 0; m < 32; ++m) a += attL[n * 33 + m] * v[m];
            O[(size_t)n * 2048] = (bf16_t)(cvt_pk_bf16(a, 0.f) & 0xffffu);
            const float s = wave_sum(a), qq = wave_sum(a * a);
            if (lane == 0) { fx_add(st + (size_t)n * 8, s); fx_add(st + (size_t)n * 8 + 1, qq); }
        }
        __syncthreads();
    }
}

__device__ __forceinline__ void phase_conv(int wv, const Params& p, int l, LAS unsigned char* lds) {
    int wv_ = wv; asm volatile("" : "+s"(wv_)); int tid = wv_ * 64 + lane_id(); asm volatile("" : "+v"(tid));
    const int lane = tid & 63, wave = tid >> 6;
    unsigned char* ws = p.ws;
    LAS float* red = (LAS float*)lds;
    const int c0 = tid * 2;
    const float* cw = p.in[6] + (size_t)l * 31 * 1024 + c0;
    float w0[31], w1[31];
#pragma unroll
    for (int j = 0; j < 31; ++j) { const f32x2 t = *(const f32x2*)(cw + (size_t)j * 1024); w0[j] = t.x; w1[j] = t.y; }
    const f32x2 cb = *(const f32x2*)(p.in[7] + l * 1024 + c0), lg = *(const f32x2*)(p.in[8] + l * 1024 + c0), lb = *(const f32x2*)(p.in[9] + l * 1024 + c0);
    const int GG = gdim();
    { unsigned z = 0u; asm volatile("" : "+v"(z)); unsigned* sa = (unsigned*)(ws + WS_SSQA); for (int i = blockIdx.x * 512 + tid; i < NTOK * 2; i += GG * 512) sa[i] = z; }
    for (int tok = blockIdx.x; tok < 256; tok += GG) {
        const int sb = tok >> 5, t = tok & 31;
        const bf16_t* gl = (const bf16_t*)(ws + WS_GLU) + (size_t)(NPT + sb * 32) * 1024 + c0;
        const float* cst = p.in[2] + (size_t)(l * 8 + sb) * 30 * 1024 + c0;
        unsigned xg[31]; f32x2 xs[31];
#pragma unroll
        for (int j = 0; j < 31; ++j) { const int tt = t + j - 30; const int tg = tt < 0 ? 0 : tt, tsx = tt + 30 > 29 ? 29 : tt + 30;
            xg[j] = *(const unsigned*)(gl + (size_t)tg * 1024); xs[j] = *(const f32x2*)(cst + (size_t)tsx * 1024); }
        float a0 = cb.x, a1 = cb.y;
#pragma unroll
        for (int j = 0; j < 31; ++j) { const bool fromg = (t + j - 30) >= 0; const float x0 = fromg ? bflo(xg[j]) : xs[j].x, x1 = fromg ? bfhi(xg[j]) : xs[j].y; a0 += x0 * w0[j]; a1 += x1 * w1[j]; }
        if (t >= 2) *(f32x2*)(p.out + OUT_CONVS + ((size_t)(l * 8 + sb) * 30 + (t - 2)) * 1024 + c0) = (f32x2){bflo(xg[30]), bfhi(xg[30])};
        { const float s = wave_sum(a0 + a1), q = wave_sum(a0 * a0 + a1 * a1); if (lane == 0) { red[wave] = s; red[128 + wave] = q; } }
        __syncthreads();
        { float s = 0.f, q = 0.f;
#pragma unroll
          for (int ww = 0; ww < 8; ++ww) { s += red[ww]; q += red[128 + ww]; }
          const float mu = s * (1.0f / 1024.0f); const float var = fmaxf(q * (1.0f / 1024.0f) - mu * mu, 0.f); const float rstd = __builtin_amdgcn_rsqf(var + LN_EPS);
          float y0 = (a0 - mu) * rstd * lg.x + lb.x, y1 = (a1 - mu) * rstd * lg.y + lb.y; y0 *= sigm(y0); y1 *= sigm(y1);
          *(unsigned*)((bf16_t*)(ws + WS_YC) + (size_t)(NPT + tok) * 1024 + c0) = cvt_pk_bf16(y0, y1); }
        __syncthreads();
    }
    for (int unit = blockIdx.x; unit < NPT / 16; unit += GG) {
        const int g0 = unit * 16, t0 = g0 & (SEQ - 1), pb = g0 >> 13;
        const bool lastt = (t0 == SEQ - 16);
        const bf16_t* gl = (const bf16_t*)(ws + WS_GLU) + (size_t)g0 * 1024 + c0;
        float* cso = p.out + OUT_CONVP + (size_t)(l * 2 + pb) * 30 * 1024 + c0;
        unsigned xin[46];
#pragma unroll
        for (int r = 0; r < 46; ++r) { const int tt = t0 - 30 + r; const long off = tt >= 0 ? (long)(r - 30) : 0l; xin[r] = *(const unsigned*)(gl + off * 1024); if (tt < 0) xin[r] = 0u; }
        f32x2 xv[46];
#pragma unroll
        for (int r = 0; r < 46; ++r) { xv[r] = (f32x2){bflo(xin[r]), bfhi(xin[r])}; if (r >= 16 && lastt) *(f32x2*)(cso + (size_t)(r - 16) * 1024) = xv[r]; }
        float a0[16], a1[16];
#pragma unroll
        for (int tq = 0; tq < 16; tq += 4) {
            f32x2 v0 = cb, v1 = cb, v2 = cb, v3 = cb;
#pragma unroll
            for (int j = 0; j < 31; ++j) {
                const f32x2 wv = {w0[j], w1[j]};
                asm volatile("v_pk_fma_f32 %0, %4, %8, %0\n\tv_pk_fma_f32 %1, %5, %8, %1\n\tv_pk_fma_f32 %2, %6, %8, %2\n\tv_pk_fma_f32 %3, %7, %8, %3"
                             : "+v"(v0), "+v"(v1), "+v"(v2), "+v"(v3) : "v"(xv[tq + j]), "v"(xv[tq + 1 + j]), "v"(xv[tq + 2 + j]), "v"(xv[tq + 3 + j]), "v"(wv));
            }
            a0[tq] = v0.x; a1[tq] = v0.y; a0[tq + 1] = v1.x; a1[tq + 1] = v1.y; a0[tq + 2] = v2.x; a1[tq + 2] = v2.y; a0[tq + 3] = v3.x; a1[tq + 3] = v3.y;
        }
#pragma unroll
        for (int t = 0; t < 16; ++t) { const float s = wave_sum(a0[t] + a1[t]), q = wave_sum(a0[t] * a0[t] + a1[t] * a1[t]); if (lane == 0) { red[t * 8 + wave] = s; red[128 + t * 8 + wave] = q; } }
        asm volatile("s_waitcnt lgkmcnt(0)" ::: "memory"); __builtin_amdgcn_s_barrier(); asm volatile("" ::: "memory");
        bf16_t* yo = (bf16_t*)(ws + WS_YC) + (size_t)g0 * 1024 + c0;
#pragma unroll
        for (int t = 0; t < 16; ++t) { float s = 0.f, q = 0.f;
#pragma unroll
            for (int ww = 0; ww < 8; ++ww) { s += red[t * 8 + ww]; q += red[128 + t * 8 + ww]; }
            const float mu = s * (1.0f / 1024.0f); const float var = fmaxf(q * (1.0f / 1024.0f) - mu * mu, 0.f);
            const float rstd = __builtin_amdgcn_rsqf(var + LN_EPS);
            float y0 = (a0[t] - mu) * rstd * lg.x + lb.x, y1 = (a1[t] - mu) * rstd * lg.y + lb.y;
            y0 *= sigm(y0); y1 *= sigm(y1);
            *(unsigned*)(yo + (size_t)t * 1024) = cvt_pk_bf16(y0, y1); }
        asm volatile("s_waitcnt lgkmcnt(0)" ::: "memory"); __builtin_amdgcn_s_barrier(); asm volatile("" ::: "memory");
    }
    asm volatile("s_waitcnt vmcnt(0) lgkmcnt(0)" ::: "memory");
    __syncthreads();
}

__device__ __forceinline__ void phase_rms2(int wv, const Params& p, int l) {
    int wv_ = wv; asm volatile("" : "+s"(wv_)); int tid = wv_ * 64 + lane_id(); asm volatile("" : "+v"(tid));
    const int lane = tid & 63, gw = blockIdx.x * 8 + (tid >> 6), NGW = gdim() * 8;
    const float* g2 = p.in[14] + l * 1024;
    for (int m = gw; m < NTOK; m += NGW) rms_row(p.out + (size_t)m * 1024, g2, (bf16_t*)(p.ws + WS_H) + (size_t)m * 1024, nullptr, lane);
}
__device__ __forceinline__ void phase_final(int wv, const Params& p) {
    int wv_ = wv; asm volatile("" : "+s"(wv_)); int tid = wv_ * 64 + lane_id(); asm volatile("" : "+v"(tid));
    const int lane = tid & 63, gw = blockIdx.x * 8 + (tid >> 6), NGW = gdim() * 8;
    const f32x4* gr = (const f32x4*)p.in[17] + lane; const fx_t* ssq = (const fx_t*)(p.ws + WS_SSQA);
    for (int m = gw; m < NTOK; m += NGW) {
        f32x4* yr = (f32x4*)(p.out + (size_t)m * 1024) + lane; const u32x2* xr = (const u32x2*)((const bf16_t*)(p.ws + WS_H) + (size_t)m * 1024) + lane; const float r = rstd_of(fx_get(ssq[m]));
#pragma unroll
        for (int j = 0; j < 4; ++j) { const u32x2 w = xr[64 * j]; const f32x4 xv = {bflo(w.x), bfhi(w.x), bflo(w.y), bfhi(w.y)}; yr[64 * j] = xv * r * gr[64 * j]; }
    }
}

struct SPre { fx_t f0, f1, f2; unsigned u0, u1, u2, u3; f32x2 g0, g1; };
#define SG_BAR() do { asm volatile("s_waitcnt lgkmcnt(0)" ::: "memory"); __builtin_amdgcn_s_barrier(); asm volatile("" ::: "memory"); } while (0)
template <bool PAIR, class EpiS>
__device__ __forceinline__ void sgemm_phase(int wv, LAS unsigned char* lds, const bf16_t* A, const bf16_t* Wt, int K, int nUnits, const EpiS& epi) {
    int wv_ = wv; asm volatile("" : "+s"(wv_)); int tid = wv_ * 64 + lane_id(); asm volatile("" : "+v"(tid));
    const int lane = tid & 63, w = __builtin_amdgcn_readfirstlane(tid >> 6);
    LAS float* red = (LAS float*)lds;
    const int kw = K >> 3, GG = gdim();
    const size_t loff = (size_t)(lane & 15) * K + w * kw + (lane >> 4) * 8;
    const size_t r16 = (size_t)16 * K;
    const int row = tid >> 4, jq = tid & 15;
    int unit = blockIdx.x;
    if (unit >= nUnits) return;
#define SG_PTRS(u_) const int rb_ = (u_) & 7, cp_ = (u_) >> 3, n0_ = PAIR ? ((cp_ >> 2) * 256 + (cp_ & 3) * 32) : cp_ * 32; \
        const bf16_t* ap = A + (size_t)(rb_ * 32) * K + loff; const bf16_t* bp0 = Wt + (size_t)n0_ * K + loff; const bf16_t* bp1 = bp0 + (size_t)128 * K;
#define SG_LOAD(fa_, fb0_, fb1_, s_, ks_) do { fa_[s_][0] = *(const bf16x8*)(ap + (ks_)); fa_[s_][1] = *(const bf16x8*)(ap + r16 + (ks_)); \
        fb0_[s_][0] = *(const bf16x8*)(bp0 + (ks_)); fb0_[s_][1] = *(const bf16x8*)(bp0 + r16 + (ks_)); \
        if (PAIR) { fb1_[s_][0] = *(const bf16x8*)(bp1 + (ks_)); fb1_[s_][1] = *(const bf16x8*)(bp1 + r16 + (ks_)); } } while (0)
#define SG_MMA(fa_, fb0_, fb1_, s_) do { _Pragma("unroll") for (int a_ = 0; a_ < 2; ++a_) _Pragma("unroll") for (int c_ = 0; c_ < 2; ++c_) { \
        acc[a_][0][c_] = __builtin_amdgcn_mfma_f32_16x16x32_bf16(fa_[s_][a_], fb0_[s_][c_], acc[a_][0][c_], 0, 0, 0); \
        if (PAIR) acc[a_][1][c_] = __builtin_amdgcn_mfma_f32_16x16x32_bf16(fa_[s_][a_], fb1_[s_][c_], acc[a_][1][c_], 0, 0, 0); } } while (0)
#define SG_ZERO() do { _Pragma("unroll") for (int a_ = 0; a_ < 2; ++a_) _Pragma("unroll") for (int g_ = 0; g_ < 2; ++g_) _Pragma("unroll") for (int c_ = 0; c_ < 2; ++c_) acc[a_][g_][c_] = (f32x4){0.f, 0.f, 0.f, 0.f}; } while (0)
#define SG_REDUCE(u_, pr_) do { \
        _Pragma("unroll") for (int a_ = 0; a_ < 2; ++a_) _Pragma("unroll") for (int g_ = 0; g_ < (PAIR ? 2 : 1); ++g_) _Pragma("unroll") for (int c_ = 0; c_ < 2; ++c_) _Pragma("unroll") for (int r = 0; r < 4; ++r) \
            red[(w * 32 + a_ * 16 + (lane >> 4) * 4 + r) * 64 + g_ * 32 + c_ * 16 + (lane & 15)] = acc[a_][g_][c_][r]; \
        SG_BAR(); \
        const int rbq = (u_) & 7, cpq = (u_) >> 3, n0q = PAIR ? ((cpq >> 2) * 256 + (cpq & 3) * 32) : cpq * 32; \
        float x1[2] = {0.f, 0.f}, x2[2] = {0.f, 0.f}; \
        _Pragma("unroll") for (int ww = 0; ww < 8; ++ww) { const f32x2 p0 = *(const LAS f32x2*)(red + (ww * 32 + row) * 64 + 2 * jq); x1[0] += p0.x; x1[1] += p0.y; \
            if (PAIR) { const f32x2 p1 = *(const LAS f32x2*)(red + (ww * 32 + row) * 64 + 32 + 2 * jq); x2[0] += p1.x; x2[1] += p1.y; } } \
        epi(rbq * 32 + row, n0q + 2 * jq, x1, x2, pr_); \
        SG_BAR(); } while (0)
    f32x4 acc[2][2][2];
    if (K == 1024) {
        bf16x8 fa[4][2], fb0[4][2], fb1[4][2];
        { SG_PTRS(unit)
#pragma unroll
          for (int s = 0; s < 4; ++s) SG_LOAD(fa, fb0, fb1, s, 32 * s); }
#pragma unroll 1
        for (;;) {
            SG_ZERO();
#pragma unroll
            for (int s = 0; s < 4; ++s) SG_MMA(fa, fb0, fb1, s);
            const int cur = unit; unit += GG; const bool has = unit < nUnits;
            SPre pr; { const int rbc = cur & 7, cpc = cur >> 3, n0c = PAIR ? ((cpc >> 2) * 256 + (cpc & 3) * 32) : cpc * 32; pr = epi.pre(rbc * 32 + row, n0c + 2 * jq); }
            if (has) { SG_PTRS(unit)
#pragma unroll
                for (int s = 0; s < 4; ++s) SG_LOAD(fa, fb0, fb1, s, 32 * s); }
            SG_REDUCE(cur, pr);
            if (!has) break;
        }
    } else {
#pragma unroll 1
        for (; unit < nUnits; unit += GG) {
            SG_PTRS(unit)
            const SPre pr = epi.pre(rb_ * 32 + row, n0_ + 2 * jq);
            SG_ZERO();
#pragma unroll 1
            for (int ks = 0; ks < kw; ks += 256) {
                bf16x8 fa[8][2], fb0[8][2], fb1[8][2];
#pragma unroll
                for (int s = 0; s < 8; ++s) SG_LOAD(fa, fb0, fb1, s, ks + 32 * s);
#pragma unroll
                for (int s = 0; s < 8; ++s) SG_MMA(fa, fb0, fb1, s);
            }
            SG_REDUCE(unit, pr);
        }
    }
    asm volatile("s_waitcnt vmcnt(0) lgkmcnt(0)" ::: "memory");
    __syncthreads();
#undef SG_PTRS
#undef SG_LOAD
#undef SG_MMA
#undef SG_ZERO
#undef SG_REDUCE
}
#define SEPI_ARGS int rl, int n, const float (&x1)[2], const float (&x2)[2]
struct SEpiB1 {
    unsigned char* ws;
    __device__ __forceinline__ SPre pre(int rl, int n) const {
        SPre p_{}; p_.f0 = ((const fx_t*)(ws + WS_SSQA))[NPT + rl];
        const f32x2* tab = (const f32x2*)(ws + WS_TAB); const int d = n & 127, pos = PAST + (rl & 31);
        p_.g0 = tab[(size_t)pos * 128 + d]; p_.g1 = tab[(size_t)pos * 128 + d + 1];
        return p_;
    }
    __device__ __forceinline__ void operator()(int rl, int n, const float (&y1)[2], const float (&y2)[2], const SPre& pr) const {
        const float rs_ = rstd_of(fx_get(pr.f0));
        const float x1[2] = {y1[0] * rs_, y1[1] * rs_}, x2[2] = {y2[0] * rs_, y2[1] * rs_};
        if (n < 2048) {
            const int head = (n >> 8) & 3, d = n & 255;
            const f32x2 c0 = pr.g0, c1 = pr.g1;
            float o1[2], o2[2];
            o1[0] = x1[0] * c0.x - x2[0] * c0.y; o2[0] = x2[0] * c0.x + x1[0] * c0.y;
            o1[1] = x1[1] * c1.x - x2[1] * c1.y; o2[1] = x2[1] * c1.x + x1[1] * c1.y;
            if (n < 1024) {
                bf16_t* q = (bf16_t*)(ws + WS_Q) + (size_t)(NPT + rl) * 1024 + head * 256 + d;
                *(unsigned*)q = cvt_pk_bf16(o1[0], o1[1]); *(unsigned*)(q + 128) = cvt_pk_bf16(o2[0], o2[1]);
            } else {
                bf16_t* k = (bf16_t*)(ws + WS_KS) + (size_t)rl * 1024 + head * 256 + d;
                *(unsigned*)k = cvt_pk_bf16(o1[0] * 0.0625f, o1[1] * 0.0625f); *(unsigned*)(k + 128) = cvt_pk_bf16(o2[0] * 0.0625f, o2[1] * 0.0625f);
                const float dec = 0.0625f * __expf(lgdec(head) * (float)(DSEQ - 1 - (rl & 31)));
                bf16_t* kt = (bf16_t*)(ws + WS_KTS) + (size_t)(head * 256 + d) * 256 + rl;
                const unsigned wa = cvt_pk_bf16(o1[0] * dec, o1[1] * dec), wb = cvt_pk_bf16(o2[0] * dec, o2[1] * dec);
                kt[0] = (bf16_t)(wa & 0xffffu); kt[256] = (bf16_t)(wa >> 16); kt[128 * 256] = (bf16_t)(wb & 0xffffu); kt[129 * 256] = (bf16_t)(wb >> 16);
            }
        } else {
            bf16_t* vt = (bf16_t*)(ws + WS_VTS) + (size_t)(n - 2048) * 256 + rl;
            const unsigned wa = cvt_pk_bf16(x1[0], x1[1]), wb = cvt_pk_bf16(x2[0], x2[1]);
            vt[0] = (bf16_t)(wa & 0xffffu); vt[256] = (bf16_t)(wa >> 16); vt[128 * 256] = (bf16_t)(wb & 0xffffu); vt[129 * 256] = (bf16_t)(wb >> 16);
        }
    }
};
struct SEpiB2 {
    unsigned char* ws; const float* gn_g;
    __device__ __forceinline__ SPre pre(int rl, int n) const {
        SPre p_{}; p_.f0 = ((const fx_t*)(ws + WS_SSQA))[NPT + rl];
        const int col = (n - 2048) & 2047, head = col >> 9;
        const fx_t* sp2 = (const fx_t*)(ws + WS_STATS) + (size_t)rl * 8 + head * 2; p_.f1 = sp2[0]; p_.f2 = sp2[1];
        const bf16_t* o = (const bf16_t*)(ws + WS_OS) + (size_t)rl * 2048 + col; p_.u0 = *(const unsigned*)o; p_.u1 = *(const unsigned*)(o + 128);
        p_.g0 = *(const f32x2*)(gn_g + col); p_.g1 = *(const f32x2*)(gn_g + col + 128);
        return p_;
    }
    __device__ __forceinline__ void operator()(int rl, int n, const float (&y1)[2], const float (&y2)[2], const SPre& pr) const {
        const float rs_ = rstd_of(fx_get(pr.f0));
        const float x1[2] = {y1[0] * rs_, y1[1] * rs_}, x2[2] = {y2[0] * rs_, y2[1] * rs_};
        if (n < 2048) {
            bf16_t* o = (bf16_t*)(ws + WS_GLU) + (size_t)(NPT + rl) * 1024 + (n >> 8) * 128 + (n & 127);
            *(unsigned*)o = cvt_pk_bf16(x1[0] * sigm(x2[0]), x1[1] * sigm(x2[1]));
        } else if (n < 4096) {
            const int col = n - 2048, head = col >> 9;
            const f32x2 sq = {fx_get(pr.f1), fx_get(pr.f2)};
            const float mu = sq.x * (1.0f / 512.0f); const float var = fmaxf(sq.y * (1.0f / 512.0f) - mu * mu, 0.f); const float rstd = __builtin_amdgcn_rsqf(var + LN_EPS);
            bf16_t* o = (bf16_t*)(ws + WS_OS) + (size_t)rl * 2048 + col;
            const unsigned oa = pr.u0, ob = pr.u1;
            const f32x2 ga = pr.g0, gb = pr.g1;
            *(unsigned*)o = cvt_pk_bf16(x1[0] * sigm(x1[0]) * ((bflo(oa) - mu) * rstd * ga.x), x1[1] * sigm(x1[1]) * ((bfhi(oa) - mu) * rstd * ga.y));
            *(unsigned*)(o + 128) = cvt_pk_bf16(x2[0] * sigm(x2[0]) * ((bflo(ob) - mu) * rstd * gb.x), x2[1] * sigm(x2[1]) * ((bfhi(ob) - mu) * rstd * gb.y));
        } else {
            bf16_t* o = (bf16_t*)(ws + (n < 5120 ? WS_GC : WS_GR)) + (size_t)(NPT + rl) * 1024 + ((n - 4096) & 1023);
            *(unsigned*)o = cvt_pk_bf16(sigm(x1[0]), sigm(x1[1])); *(unsigned*)(o + 128) = cvt_pk_bf16(sigm(x2[0]), sigm(x2[1]));
        }
    }
};
template <int MODE, bool PAIR> struct SEpiEW {
    unsigned char* ws; float* x; fx_t* ssq;
    __device__ __forceinline__ SPre pre(int rl, int n) const {
        SPre p_{}; const size_t row = (size_t)(NPT + rl);
        if (MODE == 0) { const bf16_t* g = (const bf16_t*)(ws + WS_GC) + row * 1024 + n; p_.u0 = *(const unsigned*)g; if (PAIR) p_.u1 = *(const unsigned*)(g + 128); }
        else if (MODE == 1) { const bf16_t* g = (const bf16_t*)(ws + WS_GR) + row * 1024 + n; const bf16_t* t = (const bf16_t*)(ws + WS_T) + row * 1024 + n;
            p_.u0 = *(const unsigned*)g; p_.u2 = *(const unsigned*)t; if (PAIR) { p_.u1 = *(const unsigned*)(g + 128); p_.u3 = *(const unsigned*)(t + 128); } }
        else if (MODE == 2) { const bf16_t* xb = (const bf16_t*)(ws + WS_H) + row * 1024 + n; p_.u0 = *(const unsigned*)xb; if (PAIR) p_.u1 = *(const unsigned*)(xb + 128); }
        else p_.f0 = ssq[row];
        return p_;
    }
    __device__ __forceinline__ void operator()(SEPI_ARGS, const SPre& pr) const {
        const size_t row = (size_t)(NPT + rl);
        if (MODE == 0) {
            bf16_t* t = (bf16_t*)(ws + WS_T) + row * 1024 + n;
            const unsigned ga = pr.u0, gb = pr.u1;
            *(unsigned*)t = cvt_pk_bf16(x1[0] * bflo(ga), x1[1] * bfhi(ga)); if (PAIR) *(unsigned*)(t + 128) = cvt_pk_bf16(x2[0] * bflo(gb), x2[1] * bfhi(gb));
        } else if (MODE == 1) {
            bf16_t* t = (bf16_t*)(ws + WS_T) + row * 1024 + n;
            const unsigned ga = pr.u0, gb = pr.u1, ta = pr.u2, tb = pr.u3;
            *(unsigned*)t = cvt_pk_bf16(bflo(ta) + x1[0] * bflo(ga), bfhi(ta) + x1[1] * bfhi(ga)); if (PAIR) *(unsigned*)(t + 128) = cvt_pk_bf16(bflo(tb) + x2[0] * bflo(gb), bfhi(tb) + x2[1] * bfhi(gb));
        } else if (MODE == 2) {
            bf16_t* xb = (bf16_t*)(ws + WS_H) + row * 1024 + n; const unsigned xa = pr.u0, xc = PAIR ? pr.u1 : 0u;
            f32x2 a = {bflo(xa) + x1[0], bfhi(xa) + x1[1]}, b = {bflo(xc) + x2[0], bfhi(xc) + x2[1]};
            *(unsigned*)xb = cvt_pk_bf16(a.x, a.y); if (PAIR) *(unsigned*)(xb + 128) = cvt_pk_bf16(b.x, b.y);
            float q = a.x * a.x + a.y * a.y; if (PAIR) q += b.x * b.x + b.y * b.y;
            q += shx<1>(q); q += shx<2>(q); q += shx<4>(q); q += shx<8>(q);
            if ((lane_id() & 15) == 0) fx_add(ssq + row, q);
        } else {
            bf16_t* u = (bf16_t*)(ws + WS_U) + row * 4096 + n;
            const float r3 = rstd_of(fx_get(pr.f0));
            const float a0 = fmaxf(x1[0], 0.f) * r3, a1 = fmaxf(x1[1], 0.f) * r3, b0 = fmaxf(x2[0], 0.f) * r3, b1 = fmaxf(x2[1], 0.f) * r3;
            *(unsigned*)u = cvt_pk_bf16(a0 * a0, a1 * a1); if (PAIR) *(unsigned*)(u + 128) = cvt_pk_bf16(b0 * b0, b1 * b1);
        }
    }
};

#define XB_TMO      128
#define XB_XCNT(j)  (256  + 64 * (j))
#define XB_XSUB(j)  (1280 + 64 * (j))
#define XB_XGEN(j)  (2304 + 64 * (j))
#define XB_TOP      3328
#define XB_TOPGEN   3392
#define XCD_BAR_WORDS 3456
#define XB_SPIN_CAP (1u << 18)

__device__ __forceinline__ unsigned xb_ld(unsigned* p)              { return __hip_atomic_load(p, __ATOMIC_RELAXED, __HIP_MEMORY_SCOPE_AGENT); }
__device__ __forceinline__ unsigned xb_add(unsigned* p, unsigned v) { return __hip_atomic_fetch_add(p, v, __ATOMIC_RELAXED, __HIP_MEMORY_SCOPE_AGENT); }
__device__ __forceinline__ unsigned xb_xcc_id() { return (unsigned)__builtin_amdgcn_s_getreg((3 << 11) | 20) & 0xFu; }
#define XB_SPIN(cond, bar) do { unsigned _sp = 0; while (cond) { __builtin_amdgcn_s_sleep(1); \
    if ((++_sp & 255u) == 0u) { if (xb_ld(&(bar)[XB_TMO])) break; if (_sp > XB_SPIN_CAP) { atomicAdd(&(bar)[XB_TMO], 1u); break; } } } } while (0)

struct XcdBarrier {
    unsigned* bar; unsigned x;
    volatile LAS unsigned* st;
};

__device__ __forceinline__ XcdBarrier xcd_barrier_post(unsigned* bar, volatile LAS unsigned* st, int wv) {
    XcdBarrier b; b.bar = bar; b.x = xb_xcc_id(); b.st = st;
    if (wv == 0 && lane_id() == 0) (void)xb_add(&bar[XB_XCNT(b.x)], 1u);
    return b;
}
__device__ __forceinline__ void xcd_barrier_complete(unsigned* bar, unsigned x, unsigned& nloc, unsigned& nx) {
    const unsigned G = gridDim.x * gridDim.y * gridDim.z;
    unsigned sum, cnt, mine, sp = 0u;
    for (;;) {
        sum = 0u; cnt = 0u; mine = 0u;
#pragma unroll
        for (unsigned j = 0; j < 16; ++j) { const unsigned c = xb_ld(&bar[XB_XCNT(j)]); sum += c; cnt += (c > 0u) ? 1u : 0u; mine = (j == x) ? c : mine; }
        if (sum == G) break;
        __builtin_amdgcn_s_sleep(1);
        if ((++sp & 255u) == 0u) { if (xb_ld(&bar[XB_TMO])) break; if (sp > XB_SPIN_CAP) { atomicAdd(&bar[XB_TMO], 1u); break; } }
    }
    nloc = mine > 0u ? mine : 1u; nx = cnt > 0u ? cnt : 1u;
}

__device__ __forceinline__ void xcd_barrier(const XcdBarrier& b, int wv) {
    asm volatile("s_waitcnt vmcnt(0)" ::: "memory");
    __syncthreads();
    if (wv == 0 && lane_id() == 0) {
        unsigned* bar = b.bar;
        __builtin_amdgcn_s_waitcnt(0);
        unsigned nloc = b.st[0], nx = b.st[1];
        if (nloc == 0u) { xcd_barrier_complete(bar, b.x, nloc, nx); b.st[0] = nloc; b.st[1] = nx; }
        const unsigned old = xb_add(&bar[XB_XSUB(b.x)], 1u);
        const unsigned gen = old / nloc;
        if (old + 1u == (gen + 1u) * nloc) {
            __builtin_amdgcn_fence(__ATOMIC_RELEASE, "agent");
            asm volatile("s_waitcnt vmcnt(0)" ::: "memory");
            const unsigned og = xb_add(&bar[XB_TOP], 1u);
            const unsigned tg = og / nx;
            if (og + 1u == (tg + 1u) * nx) xb_add(&bar[XB_TOPGEN], 1u);
            else XB_SPIN(xb_ld(&bar[XB_TOPGEN]) == tg, bar);
            __builtin_amdgcn_fence(__ATOMIC_ACQUIRE, "agent");
            xb_add(&bar[XB_XGEN(b.x)], 1u);
            asm volatile("s_waitcnt vmcnt(0)" ::: "memory");
        } else {
            XB_SPIN(xb_ld(&bar[XB_XGEN(b.x)]) == gen, bar);
            __builtin_amdgcn_fence(__ATOMIC_ACQUIRE, "agent");
            asm volatile("s_waitcnt vmcnt(0)" ::: "memory");
        }
    }
    __syncthreads();
}


constexpr int LDS_BYTES = 131072 + 4096;
#define LCV ({ int c_ = (int)blockIdx.x; asm volatile("" : "+s"(c_)); c_; })
__global__ void __launch_bounds__(512, 2) fwd_megakernel(Params p) {
    extern __shared__ __attribute__((aligned(16))) unsigned char lds_raw[];
    LAS unsigned char* lds = (LAS unsigned char*)lds_raw;
    cg::grid_group grid = cg::this_grid();
    const int G = gridDim.x, c = blockIdx.x;
    unsigned char* ws = p.ws;
    int wv = __builtin_amdgcn_readfirstlane((int)(threadIdx.x >> 6)); asm volatile("" : "+s"(wv));
    volatile LAS unsigned* stw = (volatile LAS unsigned*)(lds + 131072);
    if (wv == 0) stw[lane_id()] = 0u;
    __syncthreads();
    XcdBarrier xbar = xcd_barrier_post((unsigned*)(ws + WS_BAR), stw, wv);
    if (p.ws == nullptr) grid.sync();
#define GSYNC() xcd_barrier(xbar, wv)
#pragma unroll 1
    for (int l = 0; l < 2; ++l) {
        phase0(wv, p, l, lds, 0);
        GSYNC();
        {
            SchedB1 S{G, LCV, (const char*)(ws + WS_H), (const char*)(ws + WS_WIN)}; EpiB1 E{ws};
            pg8::gemm_phase(wv, lds, pg8::Gemm{1024, 16, 1024, 1024}, S, E);
            sgemm_phase<true>(wv, lds, (const bf16_t*)(ws + WS_H) + (size_t)NPT * 1024, (const bf16_t*)(ws + WS_WIN), 1024, 8 * 64, SEpiB1{ws});
        }
        GSYNC();
        {
            { SchedAtt S{G, LCV, ws}; EpiAtt E{ws}; pg8::gemm_phase(wv, lds, pg8::Gemm{256, 4, 1024, 1024}, S, E); }
            { SchedU S{G, LCV, ws}; EpiU E{ws}; pg8::gemm_phase(wv, lds, pg8::Gemm{256, 4, SEQ, SEQ}, S, E); }
            phase_sret(wv, p, l, lds);
            GSYNC();
            phase_scan(wv, p, l);
            GSYNC();
            { SchedE S{G, LCV, ws}; EpiE E{ws}; pg8::gemm_phase(wv, lds, pg8::Gemm{512, 4, 1024, SEQ}, S, E); }
            {
                const int t_ = wv * 64 + lane_id(), row_ = t_ >> 1, which_ = t_ & 1, idx_ = (int)blockIdx.x, h_ = idx_ & 3, j_ = (idx_ >> 2) & 31, b_ = idx_ >> 7;
                if (idx_ < 256) {
                    const float* sl_ = (const float*)(ws + WS_SLOTS) + (size_t)idx_ * 4096 + row_ * 16 + which_;
                    float a_ = 0.f;
#pragma unroll
                    for (int k_ = 0; k_ < 8; ++k_) a_ += sl_[k_ * 2];
                    ((float*)(ws + WS_STATF))[(size_t)(b_ * SEQ + j_ * CH + row_) * 8 + h_ * 2 + which_] = a_;
                }
            }
            GSYNC();
        }
        {
            SchedN S{G, LCV, 24, 0, (const char*)(ws + WS_H), (const char*)(ws + WS_WIN) + (size_t)16 * TILEB, TILEB, ws, TILEB};
            EpiB2 E{ws, p.in[11] + l * 2048};
            pg8::gemm_phase(wv, lds, pg8::Gemm{1024, 16, 1024, 1024}, S, E);
            sgemm_phase<true>(wv, lds, (const bf16_t*)(ws + WS_H) + (size_t)NPT * 1024, (const bf16_t*)(ws + WS_WIN) + (size_t)4096 * 1024, 1024, 8 * 96, SEpiB2{ws, p.in[11] + l * 2048});
        }
        GSYNC();
        phase0(wv, p, l, lds, 1);
        phase_conv(wv, p, l, lds);
        GSYNC();
        { SchedN S{G, LCV, 4, 0, (const char*)(ws + WS_YC), (const char*)(ws + WS_WC), TILEB, ws, TILEB}; EpiEW<0> E{ws, p.out, nullptr}; pg8::gemm_phase(wv, lds, pg8::Gemm{1024, 16, 1024, 1024}, S, E); }
        sgemm_phase<false>(wv, lds, (const bf16_t*)(ws + WS_YC) + (size_t)NPT * 1024, (const bf16_t*)(ws + WS_WC), 1024, 8 * 32, SEpiEW<0, false>{ws, p.out, nullptr});
        { SchedN S{G, LCV, 4, 1, nullptr, (const char*)(ws + WS_WR), 2 * TILEB, ws, 0}; EpiEW<1> E{ws, p.out, nullptr}; pg8::gemm_phase(wv, lds, pg8::Gemm{2048, 32, 2048, 2048}, S, E); }
        sgemm_phase<false>(wv, lds, (const bf16_t*)(ws + WS_OS), (const bf16_t*)(ws + WS_WR), 2048, 8 * 32, SEpiEW<1, false>{ws, p.out, nullptr});
        GSYNC();
        { SchedN S{G, LCV, 4, 0, (const char*)(ws + WS_T), (const char*)(ws + WS_WO), TILEB, ws, TILEB}; EpiEW<2> E{ws, p.out, (fx_t*)(ws + WS_SSQB)}; pg8::gemm_phase(wv, lds, pg8::Gemm{1024, 16, 1024, 1024}, S, E); }
        sgemm_phase<false>(wv, lds, (const bf16_t*)(ws + WS_T) + (size_t)NPT * 1024, (const bf16_t*)(ws + WS_WO), 1024, 8 * 32, SEpiEW<2, false>{ws, p.out, (fx_t*)(ws + WS_SSQB)});
        GSYNC();
        { SchedN S{G, LCV, 16, 0, (const char*)(ws + WS_H), (const char*)(ws + WS_WM1), TILEB, ws, TILEB}; EpiEW<3> E{ws, p.out, (fx_t*)(ws + WS_SSQB)}; pg8::gemm_phase(wv, lds, pg8::Gemm{1024, 16, 1024, 1024}, S, E); }
        sgemm_phase<true>(wv, lds, (const bf16_t*)(ws + WS_H) + (size_t)NPT * 1024, (const bf16_t*)(ws + WS_WM1), 1024, 8 * 64, SEpiEW<3, true>{ws, p.out, (fx_t*)(ws + WS_SSQB)});
        GSYNC();
        { SchedN S{G, LCV, 4, 0, (const char*)(ws + WS_U), (const char*)(ws + WS_WM2), 4 * TILEB, ws, 4 * TILEB}; EpiEW<2> E{ws, p.out, (fx_t*)(ws + WS_SSQA)}; pg8::gemm_phase(wv, lds, pg8::Gemm{4096, 64, 4096, 4096}, S, E); }
        sgemm_phase<false>(wv, lds, (const bf16_t*)(ws + WS_U) + (size_t)NPT * 4096, (const bf16_t*)(ws + WS_WM2), 4096, 8 * 32, SEpiEW<2, false>{ws, p.out, (fx_t*)(ws + WS_SSQA)});
        GSYNC();
    }
    phase_final(wv, p);
}

extern "C" void kernel_launch(void* const* d_in, const int* in_sizes, int n_in, void* d_out, int out_size, void* d_ws, size_t ws_size, hipStream_t stream) {
    static int grid = 0;
    if (grid == 0) {
        if (n_in != 18 || ws_size < WS_END) { fprintf(stderr, "kernel_launch: unexpected n_in %d / ws_size %zu (need %zu)\n", n_in, ws_size, (size_t)WS_END); grid = -1; return; }
        int dev = 0, cus = 0, per_cu = 0;
        hipGetDevice(&dev); hipDeviceGetAttribute(&cus, hipDeviceAttributeMultiprocessorCount, dev);
        hipFuncSetAttribute((const void*)fwd_megakernel, hipFuncAttributeMaxDynamicSharedMemorySize, LDS_BYTES);
        hipOccupancyMaxActiveBlocksPerMultiprocessor(&per_cu, (const void*)fwd_megakernel, 512, LDS_BYTES);
        (void)hipGetLastError();
        if (per_cu < 1) per_cu = 1;
        grid = cus;
        fprintf(stderr, "kernel_launch: cus %d per_cu %d grid %d\n", cus, per_cu, grid);
    }
    if (grid < 0) return;
    if (hipMemsetAsync((char*)d_ws + WS_BAR, 0, 16384, stream) != hipSuccess) { fprintf(stderr, "memset failed\n"); return; }
    Params p{};
    for (int i = 0; i < 18; ++i) p.in[i] = (const float*)d_in[i];
    p.out = (float*)d_out; p.ws = (unsigned char*)d_ws;
    void* args[] = {&p};
    hipError_t e = hipLaunchCooperativeKernel((const void*)fwd_megakernel, dim3(grid), dim3(512), args, LDS_BYTES, stream);
    if (e != hipSuccess) fprintf(stderr, "cooperative launch failed: %s (grid %d)\n", hipGetErrorString(e), grid);
}
```

```cpp
#include <hip/hip_runtime.h>
#include <hip/hip_cooperative_groups.h>
#include <cstdio>
#include <cstdint>
namespace cg = cooperative_groups;

#define LAS __attribute__((address_space(3)))
typedef unsigned short bf16_t;
typedef short bf16x8 __attribute__((ext_vector_type(8)));
typedef float f32x4 __attribute__((ext_vector_type(4)));
typedef float f32x2 __attribute__((ext_vector_type(2)));
typedef float f32x16 __attribute__((ext_vector_type(16)));
typedef unsigned u32x4 __attribute__((ext_vector_type(4)));
typedef unsigned u32x2 __attribute__((ext_vector_type(2)));

constexpr int DM = 1024, SEQ = 8192, NPT = 16384, NTOK = 16640, DSEQ = 32, PAST = 4096;
constexpr int DFF = 4096, RV = 2048, CH = 256;
constexpr float RMS_EPS = 1e-6f, LN_EPS = 1e-5f;
constexpr size_t MiB = 1u << 20;
constexpr size_t TILEB = 256 * 1024 * 2;
constexpr size_t WS_STATF = 313 * MiB + MiB / 2;
constexpr size_t WS_SLOTS = 314 * MiB;
constexpr size_t WS_STATS = 313 * MiB;
constexpr size_t WS_BAR = 640 * 1024;
constexpr size_t WS_SSQA = 318 * MiB, WS_SSQB = 319 * MiB;
constexpr size_t WS_TAB = 1 * MiB;
constexpr size_t WS_WIN = 9 * MiB;
constexpr size_t WS_WC = 29 * MiB, WS_WR = 31 * MiB, WS_WO = 35 * MiB, WS_WM1 = 37 * MiB, WS_WM2 = 45 * MiB;
constexpr size_t WS_H = 53 * MiB;
constexpr size_t WS_Q = WS_H + 32 * MiB + MiB / 2;
constexpr size_t WS_KB0 = 118 * MiB, WS_KTB0 = 134 * MiB, WS_KB1 = 150 * MiB, WS_KTB1 = 166 * MiB, WS_KS = 182 * MiB, WS_KTS = WS_KS + MiB / 2;
constexpr size_t WS_VTB0 = 183 * MiB, WS_VTB1 = 215 * MiB, WS_VTS = 247 * MiB;
constexpr size_t WS_ATT = 248 * MiB;
constexpr size_t WS_S = 280 * MiB;
constexpr size_t WS_OS = 312 * MiB;
constexpr size_t WS_END = 320 * MiB;
constexpr size_t WS_GLU = WS_Q, WS_T = WS_Q, WS_U = WS_Q, WS_GC = WS_VTB0, WS_GR = WS_VTB0 + 32 * MiB + MiB / 2, WS_YC = WS_ATT;
constexpr size_t WS_OB0 = WS_KB0, WS_OB1 = WS_KB1;
static_assert(WS_Q == 85 * MiB + MiB / 2 && WS_Q + 32 * MiB + MiB / 2 == WS_KB0, "map");
static_assert(WS_U + (size_t)NTOK * DFF * 2 <= WS_END, "map");
constexpr size_t OUT_CONVP = 17039360, OUT_RETP = 17162240, OUT_CONVS = 19259392, OUT_RETS = 19750912;

struct Params { const float* in[18]; float* out; unsigned char* ws; };

typedef __bf16 bf16x2_t __attribute__((ext_vector_type(2)));
__device__ __forceinline__ unsigned cvt_pk_bf16(float lo, float hi) { const f32x2 v = {lo, hi}; return __builtin_bit_cast(unsigned, __builtin_convertvector(v, bf16x2_t)); }
__device__ __forceinline__ float bflo(unsigned w) { return __uint_as_float(w << 16); }
__device__ __forceinline__ float bfhi(unsigned w) { return __uint_as_float(w & 0xffff0000u); }
__device__ __forceinline__ float bf2f(bf16_t v) { return __uint_as_float((unsigned)v << 16); }
__device__ __forceinline__ float lgdec(int h) { return h == 0 ? -0.0317486983145803f : (h == 1 ? -0.015748356968139168f : (h == 2 ? -0.007843177461025893f : -0.003913899321136329f)); }
typedef unsigned long long fx_t;
constexpr float FX_SCALE = 16777216.0f, FX_INV = 1.0f / 16777216.0f;
__device__ __forceinline__ fx_t fx_of(float v) { return (fx_t)(long long)(v * FX_SCALE); }
__device__ __forceinline__ void fx_add(fx_t* p, float v) { atomicAdd(p, fx_of(v)); }
__device__ __forceinline__ float fx_get(fx_t v) { return (float)(long long)v * FX_INV; }
__device__ __forceinline__ float rstd_of(float ssq) { return __builtin_amdgcn_rsqf(ssq * (1.0f / 1024.0f) + RMS_EPS); }
__device__ __forceinline__ float sigm(float x) { return __builtin_amdgcn_rcpf(1.0f + __expf(-x)); }
__device__ __forceinline__ u32x4 pack8(const f32x4 a, const f32x4 b) { u32x4 w; w.x = cvt_pk_bf16(a[0], a[1]); w.y = cvt_pk_bf16(a[2], a[3]); w.z = cvt_pk_bf16(b[0], b[1]); w.w = cvt_pk_bf16(b[2], b[3]); return w; }
__device__ __forceinline__ void unpack8(const u32x4 w, f32x4& a, f32x4& b) { a = (f32x4){bflo(w.x), bfhi(w.x), bflo(w.y), bfhi(w.y)}; b = (f32x4){bflo(w.z), bfhi(w.z), bflo(w.w), bfhi(w.w)}; }
__device__ __forceinline__ int lane_id() { return (int)__builtin_amdgcn_mbcnt_hi(~0u, __builtin_amdgcn_mbcnt_lo(~0u, 0u)); }
__device__ __forceinline__ int gdim() { int g = (int)gridDim.x; asm volatile("" : "+s"(g)); return g; }
template <int K> __device__ __forceinline__ float shx(float v) {
    if constexpr (K < 32) return __builtin_bit_cast(float, __builtin_amdgcn_ds_swizzle(__builtin_bit_cast(int, v), (K << 10) | 0x1f));
    else { int l = lane_id(); asm volatile("" : "+v"(l)); return __builtin_bit_cast(float, __builtin_amdgcn_ds_bpermute((l ^ 32) << 2, __builtin_bit_cast(int, v))); }
}
template <int CTRL> __device__ __forceinline__ float dpp_f(float v) { return __builtin_bit_cast(float, __builtin_amdgcn_update_dpp(0, __builtin_bit_cast(int, v), CTRL, 0xf, 0xf, true)); }
__device__ __forceinline__ float wave_sum(float v) {
    v += dpp_f<0xB1>(v);
    v += dpp_f<0x4E>(v);
    v += dpp_f<0x141>(v);
    v += dpp_f<0x140>(v);
    const int iv = __builtin_bit_cast(int, v);
    return (__builtin_bit_cast(float, __builtin_amdgcn_readlane(iv, 0)) + __builtin_bit_cast(float, __builtin_amdgcn_readlane(iv, 16))) +
           (__builtin_bit_cast(float, __builtin_amdgcn_readlane(iv, 32)) + __builtin_bit_cast(float, __builtin_amdgcn_readlane(iv, 48)));
}

namespace pg8 {
constexpr int BM = 256, BK = 64, HALF = 128, HTB = HALF * BK * 2, STAGE_BYTES = 8 * HTB;
__host__ __device__ __forceinline__ int lds_byte(int r, int c) { const int st = (r >> 4) * 2 + (c >> 5), rr = r & 15, cc = c & 31, ob = rr * 64 + cc * 2; return st * 1024 + (ob ^ (((ob >> 9) & 1) << 5)); }
__host__ __device__ __forceinline__ void stage_rc(int b, int& R, int& C) { const int st = b / 1024, sb = b % 1024, swz = sb ^ (((sb >> 9) & 1) << 5); R = (st >> 1) * 16 + swz / 64; C = (st & 1) * 32 + (swz % 64) / 2; }
__host__ __device__ __forceinline__ int perm32(int rho) { const int n = rho >> 4, i = rho & 15; return 8 * (i >> 2) + 4 * n + (i & 3); }

struct Unit { const char* a; const char* b; long a2d, b2d; int kind, pm, pn, aux; };
struct Gemm { int K, nt1, lda, ldb; };

__device__ __forceinline__ void xcd_remap(int& wgid, int nwg) { const int q = nwg / 8, r = nwg % 8, xcd = wgid % 8, off = wgid / 8; wgid = (xcd < r ? xcd * (q + 1) : r * (q + 1) + (xcd - r) * q) + off; }
__device__ __forceinline__ void grp_decode(int wgid, int nM, int nN, int& pm, int& pn) { const int nig = 8 * nN, gid = wgid / nig, fm = gid * 8, gsz = (nM - fm) < 8 ? (nM - fm) : 8; pm = fm + ((wgid % nig) % gsz); pn = (wgid % nig) / gsz; }

template <class Epi, class Sched>
__device__ __forceinline__ void gemm_phase(int wv, LAS unsigned char* lds, const Gemm g, const Sched& S, const Epi& E) {
    int wv_ = wv; asm volatile("" : "+s"(wv_)); int tid = wv_ * 64 + lane_id(); asm volatile("" : "+v"(tid));
    const int wid = __builtin_amdgcn_readfirstlane(tid >> 6), lane = tid & 63, wr = wid >> 2, wc = wid & 3, fr = lane & 15, fq = lane >> 4;
    const int nt = g.K / BK, nt1 = g.nt1;
    unsigned voffA[2], voffB[2];
#pragma unroll
    for (int i = 0; i < 2; ++i) { int R, C; stage_rc(tid * 16 + i * 8192, R, C); const int Rb = (R & ~31) + perm32(R & 31);
        voffA[i] = (unsigned)(R * g.lda + C) * 2u; voffB[i] = (unsigned)(Rb * g.ldb + C) * 2u; }
    const size_t kstep = (size_t)(BK * 2);
    const size_t hstepA = (size_t)HALF * g.lda * 2, hstepB = (size_t)HALF * g.ldb * 2;
    const unsigned ldsw = (unsigned)wid * 1024u;
    const int aoff = lds_byte(wr * 64 + fr, fq * 8), boff = lds_byte(wc * 32 + fr, fq * 8);
#define PG8_SA(b, h) (((b) * 2 + (h)) * HTB)
#define PG8_SB(b, h) ((4 + (b) * 2 + (h)) * HTB)
#define PG8_STAGE(bufoff, gbase, voff) do { _Pragma("unroll") for (int _i = 0; _i < 2; ++_i) \
        __builtin_amdgcn_global_load_lds((const unsigned*)((const char*)(gbase) + (voff)[_i]), (LAS unsigned*)(lds + (bufoff) + ldsw + _i * 8192), 16, 0, 0); } while (0)
#define PG8_LDA(dst, b, h) do { _Pragma("unroll") for (int m = 0; m < 4; ++m) _Pragma("unroll") for (int k = 0; k < 2; ++k) dst[m][k] = *(const LAS bf16x8*)(lds + PG8_SA(b, h) + aoff + m * 2048 + k * 1024); } while (0)
#define PG8_LDB(dst, b, h) do { _Pragma("unroll") for (int n = 0; n < 2; ++n) _Pragma("unroll") for (int k = 0; k < 2; ++k) dst[n][k] = *(const LAS bf16x8*)(lds + PG8_SB(b, h) + boff + n * 2048 + k * 1024); } while (0)
#define PG8_MMA(ai, bj, At, Bt) do { __builtin_amdgcn_s_setprio(1); _Pragma("unroll") for (int m = 0; m < 4; ++m) _Pragma("unroll") for (int n = 0; n < 2; ++n) _Pragma("unroll") for (int k = 0; k < 2; ++k) \
        acc[ai][bj][m][n] = __builtin_amdgcn_mfma_f32_16x16x32_bf16(Bt[n][k], At[m][k], acc[ai][bj][m][n], 0, 0, 0); __builtin_amdgcn_s_setprio(0); } while (0)
#define PG8_WAIT_V(n) asm volatile("s_waitcnt vmcnt(" #n ")" ::: "memory")
#define PG8_WAIT_L(n) asm volatile("s_waitcnt lgkmcnt(" #n ")" ::: "memory")
#define PG8_BAR __builtin_amdgcn_s_barrier()
#define PG8_SCHED __builtin_amdgcn_sched_barrier(0)
#define PG8_TPA(u, t) ((u).a + (size_t)(t) * kstep + (((t) >= nt1) ? (u).a2d : 0l))
#define PG8_TPB(u, t) ((u).b + (size_t)(t) * kstep + (((t) >= nt1) ? (u).b2d : 0l))
    Unit cur, nxt; int ui = 0;
    if (!S.next(0, cur)) return;
    {
        const char* cA = cur.a; const char* cB = cur.b;
        PG8_STAGE(PG8_SB(0, 0), cB, voffB); PG8_STAGE(PG8_SB(0, 1), cB + hstepB, voffB); PG8_STAGE(PG8_SA(0, 0), cA, voffA); PG8_STAGE(PG8_SA(0, 1), cA + hstepA, voffA);
        if (wr == 1) PG8_BAR;
        PG8_WAIT_V(2); PG8_BAR;
        PG8_STAGE(PG8_SB(1, 0), cB + kstep, voffB); PG8_STAGE(PG8_SA(1, 0), cA + kstep, voffA); PG8_STAGE(PG8_SB(1, 1), cB + hstepB + kstep, voffB);
        PG8_WAIT_V(6); PG8_BAR;
    }
    f32x4 acc[2][2][4][2];
#pragma unroll
    for (int a = 0; a < 2; ++a)
#pragma unroll
        for (int b = 0; b < 2; ++b)
#pragma unroll
            for (int m = 0; m < 4; ++m)
#pragma unroll
                for (int n = 0; n < 2; ++n) acc[a][b][m][n] = (f32x4){0.f, 0.f, 0.f, 0.f};
    bf16x8 At[4][2], B0[2][2], B1[2][2];
#pragma unroll 1
    for (;;) {
        const bool has_next = S.next(ui + 1, nxt);
        if (!has_next) nxt = cur;
#pragma unroll 1
        for (int t = 0; t < nt; t += 2) {
            const bool last = (t == nt - 2);
            const char* a1 = PG8_TPA(cur, t + 1);
            const char* a2 = last ? PG8_TPA(nxt, 0) : PG8_TPA(cur, t + 2); const char* b2 = last ? PG8_TPB(nxt, 0) : PG8_TPB(cur, t + 2);
            const char* a3 = a2 + kstep; const char* b3 = b2 + kstep;
            PG8_LDB(B0, 0, 0); PG8_LDB(B1, 0, 1); PG8_SCHED; PG8_LDA(At, 0, 0); PG8_STAGE(PG8_SA(1, 1), a1 + hstepA, voffA);
            PG8_WAIT_V(8); PG8_WAIT_L(0); PG8_BAR; PG8_MMA(0, 0, At, B0); PG8_MMA(0, 1, At, B1); PG8_BAR; PG8_SCHED;
            PG8_LDA(At, 0, 1); PG8_STAGE(PG8_SB(0, 0), b2, voffB); PG8_STAGE(PG8_SB(0, 1), b2 + hstepB, voffB); PG8_STAGE(PG8_SA(0, 0), a2, voffA);
            PG8_WAIT_V(8); PG8_WAIT_L(0); PG8_BAR; PG8_MMA(1, 0, At, B0); PG8_MMA(1, 1, At, B1); PG8_BAR; PG8_SCHED;
            PG8_LDB(B0, 1, 0); PG8_LDB(B1, 1, 1); PG8_SCHED; PG8_LDA(At, 1, 0); PG8_STAGE(PG8_SA(0, 1), a2 + hstepA, voffA);
            PG8_WAIT_V(8); PG8_WAIT_L(0); PG8_BAR; PG8_MMA(0, 0, At, B0); PG8_MMA(0, 1, At, B1); PG8_BAR; PG8_SCHED;
            PG8_LDA(At, 1, 1); PG8_STAGE(PG8_SB(1, 0), b3, voffB); PG8_STAGE(PG8_SB(1, 1), b3 + hstepB, voffB); PG8_STAGE(PG8_SA(1, 0), a3, voffA);
            PG8_WAIT_V(8); PG8_WAIT_L(0); PG8_BAR; PG8_MMA(1, 0, At, B0); PG8_MMA(1, 1, At, B1); PG8_BAR; PG8_SCHED;
        }
        if (wr == 0) PG8_BAR;
        { int fr2 = fr, fq2 = fq; asm volatile("" : "+v"(fr2), "+v"(fq2)); E(acc, cur, wr, wc, fr2, fq2); }
        if (!has_next) break;
#pragma unroll
        for (int a = 0; a < 2; ++a)
#pragma unroll
            for (int b = 0; b < 2; ++b)
#pragma unroll
                for (int m = 0; m < 4; ++m)
#pragma unroll
                    for (int n = 0; n < 2; ++n) acc[a][b][m][n] = (f32x4){0.f, 0.f, 0.f, 0.f};
        cur = nxt; ++ui;
        if (wr == 1) PG8_BAR;
    }
    PG8_WAIT_V(0);
    PG8_BAR;
    asm volatile("s_waitcnt vmcnt(0) lgkmcnt(0)" ::: "memory");
    __syncthreads();
#undef PG8_SA
#undef PG8_SB
#undef PG8_STAGE
#undef PG8_LDA
#undef PG8_LDB
#undef PG8_MMA
#undef PG8_WAIT_V
#undef PG8_WAIT_L
#undef PG8_BAR
#undef PG8_SCHED
#undef PG8_TPA
#undef PG8_TPB
}
}
using pg8::Unit;

__device__ __forceinline__ bf16_t* k_tile(unsigned char* ws, int pm) { return (bf16_t*)(ws + (pm < 32 ? WS_KB0 + (size_t)pm * TILEB : (pm < 64 ? WS_KB1 + (size_t)(pm - 32) * TILEB : WS_KS))); }
__device__ __forceinline__ bf16_t* o_tile(unsigned char* ws, int pm) { return (bf16_t*)(ws + (pm < 32 ? WS_OB0 + (size_t)pm * 2 * TILEB : (pm < 64 ? WS_OB1 + (size_t)(pm - 32) * 2 * TILEB : WS_OS))); }

__device__ __forceinline__ bf16_t* s_head(unsigned char* ws, int b, int h) {
    const size_t off = b == 0 ? WS_S + (size_t)h * 8 * MiB : (h == 0 ? WS_TAB : (h == 1 ? WS_WC : (h == 2 ? WS_WM1 : WS_WM2)));
    return (bf16_t*)(ws + off);
}
struct SchedB1 {
    int G, c; const char* H; const char* W;
    __device__ __forceinline__ bool next(int i, Unit& u) const {
        const long L = (long)i * G + c; if (L >= 1024) return false;
        int wgid = (int)L; pg8::xcd_remap(wgid, 1024);
        { const int x = wgid >> 7, w = wgid & 127; wgid = w < 64 ? x * 64 + w : 512 + x * 64 + (w - 64); }
        u.a2d = 0; u.b2d = 0; u.aux = 0;
        if (wgid < 512) { pg8::grp_decode(wgid, 64, 8, u.pm, u.pn); u.kind = 0; u.a = H + (size_t)u.pm * TILEB; u.b = W + (size_t)u.pn * TILEB; }
        else { pg8::grp_decode(wgid - 512, 8, 64, u.pm, u.pn); u.pm += 4; u.kind = 1; u.a = W + (size_t)(4 + u.pm) * TILEB; u.b = H + (size_t)u.pn * TILEB; }
        return true;
    }
};
struct SchedN {
    int G, c, nN, amode; const char* A; const char* B; size_t bTile; unsigned char* ws; size_t aTile;
    __device__ __forceinline__ bool next(int i, Unit& u) const {
        const int nwg = 64 * nN; const long L = (long)i * G + c; if (L >= nwg) return false;
        int wgid = (int)L; pg8::xcd_remap(wgid, nwg); pg8::grp_decode(wgid, 64, nN, u.pm, u.pn);
        u.a2d = 0; u.b2d = 0; u.aux = 0; u.kind = 0;
        u.a = amode ? (const char*)o_tile(ws, u.pm) : A + (size_t)u.pm * aTile; u.b = B + (size_t)u.pn * bTile;
        return true;
    }
};
struct SchedAtt {
    int G, c; unsigned char* ws;
    __device__ __forceinline__ bool next(int i, Unit& u) const {
        const int L = i * G + c; if (L >= 256) return false;
        const int h = L & 3, j = (L >> 2) & 31, b = L >> 7;
        u.a2d = 0; u.b2d = 0; u.kind = 0; u.pm = j; u.pn = b; u.aux = h;
        u.a = (const char*)(ws + WS_Q) + ((size_t)(b * SEQ + j * CH) * 1024 + h * 256) * 2;
        u.b = (const char*)(ws + (b ? WS_KB1 : WS_KB0)) + ((size_t)(j * CH) * 1024 + h * 256) * 2;
        return true;
    }
};
struct SchedU {
    int G, c; unsigned char* ws;
    __device__ __forceinline__ bool next(int i, Unit& u) const {
        const int L = i * G + c; if (L >= 512) return false;
        const int pmt = L & 1, h = (L >> 1) & 3, j = (L >> 3) & 31, b = L >> 8;
        u.a2d = 0; u.b2d = 0; u.kind = b; u.pm = j; u.pn = 0; u.aux = h * 2 + pmt;
        u.a = (const char*)(ws + (b ? WS_VTB1 : WS_VTB0)) + ((size_t)(h * 512 + pmt * 256) * SEQ + j * CH) * 2;
        u.b = (const char*)(ws + (b ? WS_KTB1 : WS_KTB0)) + ((size_t)(h * 256) * SEQ + j * CH) * 2;
        return true;
    }
};
struct SchedE {
    int G, c; unsigned char* ws;
    __device__ __forceinline__ bool next(int i, Unit& u) const {
        const int L = i * G + c; if (L >= 512) return false;
        const int idx = L & 255, pnt = L >> 8, h = idx & 3, j = (idx >> 2) & 31, b = idx >> 7;
        u.kind = b; u.pm = j; u.pn = pnt; u.aux = h;
        const char* a1 = (const char*)(ws + WS_ATT) + ((size_t)(b * SEQ + j * CH) * 1024 + h * 256) * 2;
        const char* a2 = (const char*)(ws + WS_Q) + ((size_t)(b * SEQ + j * CH) * 1024 + h * 256) * 2;
        const char* b1 = (const char*)(ws + (b ? WS_VTB1 : WS_VTB0)) + ((size_t)(h * 512 + pnt * 256) * SEQ + j * CH) * 2;
        const char* b2 = (const char*)(s_head(ws, b, h) + (size_t)(pnt * 256) * SEQ + j * CH);
        u.a = a1; u.b = b1; u.a2d = (long)(a2 - a1) - 4 * 128; u.b2d = (long)(b2 - b1) - 4 * 128;
        return true;
    }
};

#define EPI_FENCE asm volatile("" ::: "memory")
#define EPI_ARGS const f32x4 (&acc)[2][2][4][2], const Unit& u, int wr, int wc, int fr, int fq
struct EpiB1 {
    unsigned char* ws;
    __device__ __forceinline__ void operator()(EPI_ARGS) const {
        const f32x2* tab = (const f32x2*)(ws + WS_TAB); const fx_t* ssq = (const fx_t*)(ws + WS_SSQA);
        if (u.kind == 0) {
            const int head = u.pn & 3; const bool isk = u.pn >= 4;
            bf16_t* dst = isk ? k_tile(ws, u.pm) : (bf16_t*)(ws + WS_Q) + (size_t)u.pm * 256 * 1024;
            const float sc = isk ? 0.0625f : 1.0f;
            const __amdgpu_buffer_rsrc_t ktr = __builtin_amdgcn_make_buffer_rsrc((void*)(ws + (u.pm < 32 ? WS_KTB0 : WS_KTB1)), (short)0, (int)(16 * MiB), 0x00020000);
            const int d0 = wc * 32 + fq * 8;
#pragma unroll
            for (int aih = 0; aih < 2; ++aih) {
                const int ai = aih, mb = 0;
                f32x4 tb[4][4]; float rsq[4];
#pragma unroll
                for (int m = mb; m < mb + 4; ++m) {
                    const int row = ai * 128 + wr * 64 + m * 16 + fr;
                    const int pos = u.pm < 64 ? ((u.pm & 31) * 256 + row) : (PAST + (row & 31));
                    const f32x4* tp = (const f32x4*)(tab + (size_t)pos * 128 + d0);
                    tb[m][0] = tp[0]; tb[m][1] = tp[1]; tb[m][2] = tp[2]; tb[m][3] = tp[3];
                    rsq[m] = fx_get(ssq[(size_t)u.pm * 256 + row]);
                }
                EPI_FENCE;
#pragma unroll
                for (int m = mb; m < mb + 4; ++m) {
                    const int row = ai * 128 + wr * 64 + m * 16 + fr;
                    const f32x4 c01 = tb[m][0], c23 = tb[m][1], c45 = tb[m][2], c67 = tb[m][3];
                    const f32x4 cs0 = (f32x4){c01[0], c01[2], c23[0], c23[2]}, sn0 = (f32x4){c01[1], c01[3], c23[1], c23[3]};
                    const f32x4 cs1 = (f32x4){c45[0], c45[2], c67[0], c67[2]}, sn1 = (f32x4){c45[1], c45[3], c67[1], c67[3]};
                    const f32x4 x1a = acc[ai][0][m][0], x1b = acc[ai][0][m][1], x2a = acc[ai][1][m][0], x2b = acc[ai][1][m][1];
                    const float scr_ = sc * rstd_of(rsq[m]);
                    const f32x4 o1a = (x1a * cs0 - x2a * sn0) * scr_, o1b = (x1b * cs1 - x2b * sn1) * scr_;
                    const f32x4 o2a = (x2a * cs0 + x1a * sn0) * scr_, o2b = (x2b * cs1 + x1b * sn1) * scr_;
                    bf16_t* rp = dst + (size_t)row * 1024 + head * 256 + d0;
                    *(u32x4*)rp = pack8(o1a, o1b); *(u32x4*)(rp + 128) = pack8(o2a, o2b);
                    if (isk) {
                        const float dk = __expf(lgdec(head) * (float)(CH - 1 - (row & (CH - 1))));
                        const unsigned voff = (unsigned)((d0 * SEQ + row) * 2);
                        const unsigned sbase = (unsigned)(((head * 256) * SEQ + (u.pm & 31) * 256) * 2);
                        const u32x4 t1 = pack8(o1a * dk, o1b * dk);
#pragma unroll
                        for (int jj = 0; jj < 4; ++jj) {
                            __builtin_amdgcn_raw_buffer_store_b16((short)(t1[jj] & 0xffffu), ktr, voff, sbase + (unsigned)(2 * jj) * SEQ * 2u, 0);
                            __builtin_amdgcn_raw_buffer_store_b16((short)(t1[jj] >> 16), ktr, voff, sbase + (unsigned)(2 * jj + 1) * SEQ * 2u, 0); }
                        const u32x4 t2 = pack8(o2a * dk, o2b * dk);
#pragma unroll
                        for (int jj = 0; jj < 4; ++jj) {
                            __builtin_amdgcn_raw_buffer_store_b16((short)(t2[jj] & 0xffffu), ktr, voff, sbase + (unsigned)(128 + 2 * jj) * SEQ * 2u, 0);
                            __builtin_amdgcn_raw_buffer_store_b16((short)(t2[jj] >> 16), ktr, voff, sbase + (unsigned)(129 + 2 * jj) * SEQ * 2u, 0); }
                    }
                }
                EPI_FENCE;
            }
        } else {
            bf16_t* dst; int ld;
            if (u.pn < 32) { dst = (bf16_t*)(ws + WS_VTB0) + (size_t)u.pn * 256; ld = SEQ; }
            else if (u.pn < 64) { dst = (bf16_t*)(ws + WS_VTB1) + (size_t)(u.pn - 32) * 256; ld = SEQ; }
            else { dst = (bf16_t*)(ws + WS_VTS); ld = 256; }
            f32x4 rsv[2][2];
#pragma unroll
            for (int bj = 0; bj < 2; ++bj) { const fx_t* sp8 = ssq + (size_t)u.pn * 256 + bj * 128 + wc * 32 + fq * 8;
#pragma unroll
                for (int n = 0; n < 2; ++n) rsv[bj][n] = (f32x4){rstd_of(fx_get(sp8[4 * n])), rstd_of(fx_get(sp8[4 * n + 1])), rstd_of(fx_get(sp8[4 * n + 2])), rstd_of(fx_get(sp8[4 * n + 3]))}; }
#pragma unroll
            for (int ai = 0; ai < 2; ++ai)
#pragma unroll
                for (int m = 0; m < 4; ++m) {
                    const int e = (u.pm - 4) * 256 + ai * 128 + wr * 64 + m * 16 + fr;
                    bf16_t* rp = dst + (size_t)e * ld + wc * 32 + fq * 8;
#pragma unroll
                    for (int bj = 0; bj < 2; ++bj) *(u32x4*)(rp + bj * 128) = pack8(acc[ai][bj][m][0] * rsv[bj][0], acc[ai][bj][m][1] * rsv[bj][1]);
                    EPI_FENCE;
                }
        }
    }
};
struct EpiAtt {
    unsigned char* ws;
    __device__ __forceinline__ void operator()(EPI_ARGS) const {
        const int h = u.aux; const float lg = lgdec(h);
        bf16_t* dst = (bf16_t*)(ws + WS_ATT) + (size_t)(u.pn * SEQ + u.pm * CH) * 1024 + h * 256;
        float cf[2][8];
#pragma unroll
        for (int bj = 0; bj < 2; ++bj)
#pragma unroll
            for (int j = 0; j < 8; ++j) cf[bj][j] = __expf(-lg * (float)(bj * 128 + wc * 32 + fq * 8 + j + 1));
#pragma unroll
        for (int ai = 0; ai < 2; ++ai)
#pragma unroll
            for (int m = 0; m < 4; ++m) {
                const int n = ai * 128 + wr * 64 + m * 16 + fr;
#pragma unroll
                for (int bj = 0; bj < 2; ++bj) {
                    const int m0 = bj * 128 + wc * 32 + fq * 8;
                    float o[8];
#pragma unroll
                    for (int j = 0; j < 8; ++j) o[j] = __uint_as_float(__float_as_uint(acc[ai][bj][m][j >> 2][j & 3] * cf[bj][j]) & ~(unsigned)((n - m0 - j) >> 31));
                    *(u32x4*)(dst + (size_t)n * 1024 + m0) = pack8((f32x4){o[0], o[1], o[2], o[3]}, (f32x4){o[4], o[5], o[6], o[7]});
                }
                EPI_FENCE;
            }
    }
};
struct EpiU {
    unsigned char* ws;
    __device__ __forceinline__ void operator()(EPI_ARGS) const {
        bf16_t* dst = s_head(ws, u.kind, u.aux >> 1) + (size_t)((u.aux & 1) * 256) * SEQ + u.pm * CH;
#pragma unroll
        for (int ai = 0; ai < 2; ++ai)
#pragma unroll
            for (int m = 0; m < 4; ++m) {
                bf16_t* rp = dst + (size_t)(ai * 128 + wr * 64 + m * 16 + fr) * SEQ + wc * 32 + fq * 8;
#pragma unroll
                for (int bj = 0; bj < 2; ++bj) *(u32x4*)(rp + bj * 128) = pack8(acc[ai][bj][m][0], acc[ai][bj][m][1]);
                    EPI_FENCE;
            }
    }
};
struct EpiE {
    unsigned char* ws;
    __device__ __forceinline__ void operator()(EPI_ARGS) const {
        const int h = u.aux, b = u.kind; const float lg = lgdec(h);
        bf16_t* dst = (bf16_t*)(ws + (b ? WS_OB1 : WS_OB0)) + (size_t)(u.pm * CH) * 2048 + h * 512 + u.pn * 256;
        float* sl = (float*)(ws + WS_SLOTS) + (size_t)blockIdx.x * 4096 + (u.pn * 4 + wc) * 2;
#pragma unroll
        for (int ai = 0; ai < 2; ++ai)
#pragma unroll
            for (int m = 0; m < 4; ++m) {
                const int n = ai * 128 + wr * 64 + m * 16 + fr; const float rs = __expf(lg * (float)(n + 1));
                float s = 0.f, q = 0.f;
#pragma unroll
                for (int bj = 0; bj < 2; ++bj) {
                    const f32x4 v0 = acc[ai][bj][m][0] * rs, v1 = acc[ai][bj][m][1] * rs;
                    s += (v0[0] + v0[1]) + (v0[2] + v0[3]) + (v1[0] + v1[1]) + (v1[2] + v1[3]);
                    q += (v0[0] * v0[0] + v0[1] * v0[1]) + (v0[2] * v0[2] + v0[3] * v0[3]) + (v1[0] * v1[0] + v1[1] * v1[1]) + (v1[2] * v1[2] + v1[3] * v1[3]);
                    *(u32x4*)(dst + (size_t)n * 2048 + bj * 128 + wc * 32 + fq * 8) = pack8(v0, v1);
                }
                s += shx<16>(s); s += shx<32>(s); q += shx<16>(q); q += shx<32>(q);
                if (fq == 0) *(f32x2*)(sl + (size_t)n * 16) = (f32x2){s, q};
                EPI_FENCE;
            }
    }
};
struct EpiB2 {
    unsigned char* ws; const float* gn_g;
    __device__ __forceinline__ void operator()(EPI_ARGS) const {
        const fx_t* ssq = (const fx_t*)(ws + WS_SSQA) + (size_t)u.pm * 256;
        float rsr[2][4];
#pragma unroll
        for (int ai = 0; ai < 2; ++ai)
#pragma unroll
            for (int m = 0; m < 4; ++m) rsr[ai][m] = fx_get(ssq[ai * 128 + wr * 64 + m * 16 + fr]);
#pragma unroll
        for (int ai = 0; ai < 2; ++ai)
#pragma unroll
            for (int m = 0; m < 4; ++m) rsr[ai][m] = rstd_of(rsr[ai][m]);
        if (u.pn < 8) {
            bf16_t* dst = (bf16_t*)(ws + WS_GLU) + (size_t)u.pm * 256 * 1024 + u.pn * 128 + wc * 32 + fq * 8;
#pragma unroll
            for (int ai = 0; ai < 2; ++ai)
#pragma unroll
                for (int m = 0; m < 4; ++m) {
                    const int row = ai * 128 + wr * 64 + m * 16 + fr;
                    const float rs = rsr[ai][m];
                    f32x4 a0 = acc[ai][0][m][0] * rs, a1 = acc[ai][0][m][1] * rs; const f32x4 b0 = acc[ai][1][m][0] * rs, b1 = acc[ai][1][m][1] * rs;
#pragma unroll
                    for (int j = 0; j < 4; ++j) { a0[j] *= sigm(b0[j]); a1[j] *= sigm(b1[j]); }
                    *(u32x4*)(dst + (size_t)row * 1024) = pack8(a0, a1);
                    EPI_FENCE;
                }
        } else if (u.pn < 16) {
            const int t = u.pn - 8, head = t >> 1;
            bf16_t* ob = o_tile(ws, u.pm) + t * 256 + wc * 32 + fq * 8;
            const float* st = (const float*)(ws + WS_STATF) + (size_t)u.pm * 256 * 8 + head * 2;
            f32x4 gg[2][2];
#pragma unroll
            for (int bj = 0; bj < 2; ++bj) { const f32x4* gp = (const f32x4*)(gn_g + t * 256 + bj * 128 + wc * 32 + fq * 8); gg[bj][0] = gp[0]; gg[bj][1] = gp[1]; }
#pragma unroll
            for (int aih = 0; aih < 4; ++aih) {
                const int ai = aih >> 1, mb = (aih & 1) * 2;
                f32x2 sqv[4]; u32x4 ov[4][2];
#pragma unroll
                for (int m = mb; m < mb + 2; ++m) {
                    const int row = ai * 128 + wr * 64 + m * 16 + fr;
                    sqv[m] = *(const f32x2*)(st + (size_t)row * 8);
#pragma unroll
                    for (int bj = 0; bj < 2; ++bj) ov[m][bj] = *(const u32x4*)(ob + (size_t)row * 2048 + bj * 128);
                }
                EPI_FENCE;
#pragma unroll
                for (int m = mb; m < mb + 2; ++m) {
                    const int row = ai * 128 + wr * 64 + m * 16 + fr;
                    const f32x2 sq = sqv[m]; const float rsn = rsr[ai][m];
                    const float mu = sq.x * (1.0f / 512.0f); const float var = fmaxf(sq.y * (1.0f / 512.0f) - mu * mu, 0.f); const float rstd = __builtin_amdgcn_rsqf(var + LN_EPS);
#pragma unroll
                    for (int bj = 0; bj < 2; ++bj) {
                        bf16_t* rp = ob + (size_t)row * 2048 + bj * 128;
                        f32x4 o0, o1; unpack8(ov[m][bj], o0, o1);
                        f32x4 g0 = acc[ai][bj][m][0] * rsn, g1 = acc[ai][bj][m][1] * rsn;
#pragma unroll
                        for (int j = 0; j < 4; ++j) { g0[j] = g0[j] * sigm(g0[j]) * ((o0[j] - mu) * rstd * gg[bj][0][j]); g1[j] = g1[j] * sigm(g1[j]) * ((o1[j] - mu) * rstd * gg[bj][1][j]); }
                        *(u32x4*)rp = pack8(g0, g1);
                    }
                }
                EPI_FENCE;
            }
        } else {
            const int t = (u.pn - 16) & 3;
            bf16_t* dst = (bf16_t*)(ws + (u.pn < 20 ? WS_GC : WS_GR)) + (size_t)u.pm * 256 * 1024 + t * 256 + wc * 32 + fq * 8;
#pragma unroll
            for (int ai = 0; ai < 2; ++ai)
#pragma unroll
                for (int m = 0; m < 4; ++m) {
                    const int row = ai * 128 + wr * 64 + m * 16 + fr; const float rs = rsr[ai][m];
#pragma unroll
                    for (int bj = 0; bj < 2; ++bj) {
                        f32x4 a0 = acc[ai][bj][m][0] * rs, a1 = acc[ai][bj][m][1] * rs;
#pragma unroll
                        for (int j = 0; j < 4; ++j) { a0[j] = sigm(a0[j]); a1[j] = sigm(a1[j]); }
                        *(u32x4*)(dst + (size_t)row * 1024 + bj * 128) = pack8(a0, a1);
                    }
                    EPI_FENCE;
                }
        }
    }
};
template <int MODE> struct EpiEW {
    unsigned char* ws; float* x; fx_t* ssq;
    __device__ __forceinline__ void operator()(EPI_ARGS) const {
        const int c0 = u.pn * 256 + wc * 32 + fq * 8;
#pragma unroll
        for (int ai = 0; ai < 2; ++ai) {
            u32x4 gv[4][2], tv[4][2]; float sqs[4] = {0.f, 0.f, 0.f, 0.f}, rs3[4];
            if (MODE == 3) {
#pragma unroll
                for (int m = 0; m < 4; ++m) rs3[m] = rstd_of(fx_get(ssq[(size_t)u.pm * 256 + ai * 128 + wr * 64 + m * 16 + fr]));
            }
            if (MODE != 3) {
#pragma unroll
                for (int m = 0; m < 4; ++m) {
                    const size_t row = (size_t)u.pm * 256 + ai * 128 + wr * 64 + m * 16 + fr;
#pragma unroll
                    for (int bj = 0; bj < 2; ++bj) {
                        if (MODE == 0) gv[m][bj] = *(const u32x4*)((const bf16_t*)(ws + WS_GC) + row * 1024 + c0 + bj * 128);
                        if (MODE == 1) { gv[m][bj] = *(const u32x4*)((const bf16_t*)(ws + WS_GR) + row * 1024 + c0 + bj * 128); tv[m][bj] = *(const u32x4*)((const bf16_t*)(ws + WS_T) + row * 1024 + c0 + bj * 128); }
                        if (MODE == 2) tv[m][bj] = *(const u32x4*)((const bf16_t*)(ws + WS_H) + row * 1024 + c0 + bj * 128);
                    }
                }
                EPI_FENCE;
            }
#pragma unroll
            for (int m = 0; m < 4; ++m) {
                const size_t row = (size_t)u.pm * 256 + ai * 128 + wr * 64 + m * 16 + fr;
#pragma unroll
                for (int bj = 0; bj < 2; ++bj) {
                    f32x4 a0 = acc[ai][bj][m][0], a1 = acc[ai][bj][m][1];
                    if (MODE == 0) {
                        f32x4 g0, g1; unpack8(gv[m][bj], g0, g1);
                        *(u32x4*)((bf16_t*)(ws + WS_T) + row * 1024 + c0 + bj * 128) = pack8(a0 * g0, a1 * g1);
                    } else if (MODE == 1) {
                        f32x4 g0, g1, t0, t1; unpack8(gv[m][bj], g0, g1); unpack8(tv[m][bj], t0, t1);
                        *(u32x4*)((bf16_t*)(ws + WS_T) + row * 1024 + c0 + bj * 128) = pack8(t0 + a0 * g0, t1 + a1 * g1);
                    } else if (MODE == 2) {
                        f32x4 x0, x1; unpack8(tv[m][bj], x0, x1);
                        a0 = x0 + a0; a1 = x1 + a1;
                        *(u32x4*)((bf16_t*)(ws + WS_H) + row * 1024 + c0 + bj * 128) = pack8(a0, a1);
                        sqs[m] += (a0[0] * a0[0] + a0[1] * a0[1]) + (a0[2] * a0[2] + a0[3] * a0[3]) + (a1[0] * a1[0] + a1[1] * a1[1]) + (a1[2] * a1[2] + a1[3] * a1[3]);
                    } else {
#pragma unroll
                        for (int j = 0; j < 4; ++j) { const float r0 = fmaxf(a0[j], 0.f) * rs3[m], r1 = fmaxf(a1[j], 0.f) * rs3[m]; a0[j] = r0 * r0; a1[j] = r1 * r1; }
                        *(u32x4*)((bf16_t*)(ws + WS_U) + row * 4096 + c0 + bj * 128) = pack8(a0, a1);
                    }
                }
                if (MODE == 2) { float q = sqs[m]; q += shx<16>(q); q += shx<32>(q); if (fq == 0) fx_add(ssq + row, q); }
            }
            EPI_FENCE;
        }
    }
};

__device__ __forceinline__ void transpose_item(const float* W, int K, int N, bf16_t* WT, int k0, int n0, int drow0, LAS float* scr, int lane, const float* gk = nullptr) {
    float tv[32];
#pragma unroll
    for (int i = 0; i < 32; ++i) { const int kk = 2 * i + (lane >> 5); tv[i] = W[(size_t)(k0 + kk) * N + n0 + (lane & 31)]; }
#pragma unroll
    for (int i = 0; i < 32; ++i) { const int kk = 2 * i + (lane >> 5); scr[kk * 33 + (lane & 31)] = gk ? tv[i] * gk[k0 + kk] : tv[i]; }
    asm volatile("s_waitcnt lgkmcnt(0)" ::: "memory");
    const int c = lane & 7;
#pragma unroll
    for (int j = 0; j < 4; ++j) { const int n = (lane >> 3) + 8 * j; const LAS float* s = scr + (8 * c) * 33 + n;
        u32x4 o; o.x = cvt_pk_bf16(s[0 * 33], s[1 * 33]); o.y = cvt_pk_bf16(s[2 * 33], s[3 * 33]); o.z = cvt_pk_bf16(s[4 * 33], s[5 * 33]); o.w = cvt_pk_bf16(s[6 * 33], s[7 * 33]);
        *(u32x4*)(WT + (size_t)(drow0 + n) * K + k0 + 8 * c) = o; }
    asm volatile("s_waitcnt lgkmcnt(0)" ::: "memory");
}
struct TItem { const float* W; const float* gk; bf16_t* WT; int K, N, k0, n0, drow0; };
__device__ __forceinline__ void titem_load(const TItem& t, int lane, float (&tv)[32], f32x4& g0, f32x4& g1) {
#pragma unroll
    for (int i = 0; i < 32; ++i) { const int kk = 2 * i + (lane >> 5); tv[i] = t.W[(size_t)(t.k0 + kk) * t.N + t.n0 + (lane & 31)]; }
    g0 = (f32x4){1.f, 1.f, 1.f, 1.f}; g1 = g0;
    if (t.gk) { const f32x4* gp = (const f32x4*)(t.gk + t.k0 + 8 * (lane & 7)); g0 = gp[0]; g1 = gp[1]; }
}
__device__ __forceinline__ void titem_store(const TItem& t, int lane, const float (&tv)[32], const f32x4 g0, const f32x4 g1, LAS float* scr) {
#pragma unroll
    for (int i = 0; i < 32; ++i) { const int kk = 2 * i + (lane >> 5); scr[kk * 33 + (lane & 31)] = tv[i]; }
    asm volatile("s_waitcnt lgkmcnt(0)" ::: "memory");
    const int c = lane & 7;
#pragma unroll
    for (int j = 0; j < 4; ++j) { const int n = (lane >> 3) + 8 * j; const LAS float* sp = scr + (8 * c) * 33 + n;
        u32x4 o; o.x = cvt_pk_bf16(sp[0 * 33] * g0[0], sp[1 * 33] * g0[1]); o.y = cvt_pk_bf16(sp[2 * 33] * g0[2], sp[3 * 33] * g0[3]);
        o.z = cvt_pk_bf16(sp[4 * 33] * g1[0], sp[5 * 33] * g1[1]); o.w = cvt_pk_bf16(sp[6 * 33] * g1[2], sp[7 * 33] * g1[3]);
        *(u32x4*)(t.WT + (size_t)(t.drow0 + n) * t.K + t.k0 + 8 * c) = o; }
    asm volatile("s_waitcnt lgkmcnt(0)" ::: "memory");
}
__device__ __forceinline__ int win_drow(int n0) {
    if (n0 < 2048) { const int bj = n0 >> 10, jj = n0 & 1023; return 4096 + 256 * (jj >> 7) + 128 * bj + (jj & 127); }
    if (n0 < 6144) return n0 - 2048;
    return n0;
}
__device__ __forceinline__ void rms_row(const float* xrow, const float* g, bf16_t* orow, float* copy, int lane) {
    const f32x4* xr = (const f32x4*)xrow + lane; const f32x4* gr = (const f32x4*)g + lane;
    f32x4 v[4]; float s = 0.f;
#pragma unroll
    for (int j = 0; j < 4; ++j) { v[j] = xr[64 * j]; s += (v[j][0] * v[j][0] + v[j][1] * v[j][1]) + (v[j][2] * v[j][2] + v[j][3] * v[j][3]); }
    const float r = 1.0f / sqrtf(wave_sum(s) * (1.0f / 1024.0f) + RMS_EPS);
    u32x2* o8 = (u32x2*)orow + lane;
#pragma unroll
    for (int j = 0; j < 4; ++j) { const f32x4 gg = gr[64 * j]; if (copy) ((f32x4*)copy + lane)[64 * j] = v[j];
        u32x2 w; w.x = cvt_pk_bf16(v[j][0] * r * gg[0], v[j][1] * r * gg[1]); w.y = cvt_pk_bf16(v[j][2] * r * gg[2], v[j][3] * r * gg[3]); o8[64 * j] = w; }
}

__device__ __forceinline__ void phase0(int wv, const Params& p, int l, LAS unsigned char* lds, int part) {
    int wv_ = wv; asm volatile("" : "+s"(wv_)); int tid = wv_ * 64 + lane_id(); asm volatile("" : "+v"(tid));
    const int lane = tid & 63, wave = tid >> 6, G = gdim();
    const int gw = blockIdx.x * 8 + wave, NGW = G * 8;
    unsigned char* ws = p.ws;
    LAS float* scr = (LAS float*)(lds + wave * 16384);
    const float* w_in = p.in[5] + (size_t)l * 1024 * 10240; const float* w_c = p.in[10] + (size_t)l * 1024 * 1024; const float* w_r = p.in[12] + (size_t)l * 2048 * 1024;
    const float* w_o = p.in[13] + (size_t)l * 1024 * 1024; const float* w_1 = p.in[15] + (size_t)l * 1024 * 4096; const float* w_2 = p.in[16] + (size_t)l * 4096 * 1024;
    constexpr int I_IN = 16 * 320, I_C = 16 * 32, I_R = 32 * 32, I_O = 16 * 32, I_1 = 16 * 128, I_2 = 64 * 32, NIT = I_IN + I_C + I_R + I_O + I_1 + I_2;
#define TI_DECODE(it_, T_) do { int r = (it_); \
        if (r < I_IN) { const int kb = r / 320, nb = r % 320; T_ = TItem{w_in, p.in[4] + l * 1024, (bf16_t*)(ws + WS_WIN), 1024, 10240, kb * 64, nb * 32, win_drow(nb * 32)}; break; } r -= I_IN; \
        if (r < I_C) { const int kb = r / 32, nb = r % 32; T_ = TItem{w_c, nullptr, (bf16_t*)(ws + WS_WC), 1024, 1024, kb * 64, nb * 32, nb * 32}; break; } r -= I_C; \
        if (r < I_R) { const int kb = r / 32, nb = r % 32; T_ = TItem{w_r, nullptr, (bf16_t*)(ws + WS_WR), 2048, 1024, kb * 64, nb * 32, nb * 32}; break; } r -= I_R; \
        if (r < I_O) { const int kb = r / 32, nb = r % 32; T_ = TItem{w_o, nullptr, (bf16_t*)(ws + WS_WO), 1024, 1024, kb * 64, nb * 32, nb * 32}; break; } r -= I_O; \
        if (r < I_1) { const int kb = r / 128, nb = r % 128; T_ = TItem{w_1, p.in[14] + l * 1024, (bf16_t*)(ws + WS_WM1), 1024, 4096, kb * 64, nb * 32, nb * 32}; break; } r -= I_1; \
        { const int kb = r / 32, nb = r % 32; T_ = TItem{w_2, nullptr, (bf16_t*)(ws + WS_WM2), 4096, 1024, kb * 64, nb * 32, nb * 32}; } } while (0)
    const int it_first = part == 0 ? 0 : I_IN, it_last = part == 0 ? I_IN : NIT;
    if (it_first + gw < it_last) {
        int it = it_first + gw; TItem cur; TI_DECODE(it, cur);
        float tv[32]; f32x4 g0, g1; titem_load(cur, lane, tv, g0, g1);
#pragma unroll 1
        for (;;) {
            const int nit = it + NGW; const bool has = nit < it_last;
            TItem nx = cur; float tn[32]; f32x4 h0 = g0, h1 = g1;
            if (has) { TI_DECODE(nit, nx); titem_load(nx, lane, tn, h0, h1); }
            titem_store(cur, lane, tv, g0, g1, scr);
            if (!has) break;
            cur = nx; it = nit; g0 = h0; g1 = h1;
#pragma unroll
            for (int i = 0; i < 32; ++i) tv[i] = tn[i];
        }
    }
#undef TI_DECODE
    if (part != 0) { asm volatile("s_waitcnt vmcnt(0) lgkmcnt(0)" ::: "memory"); __syncthreads(); return; }
    if (l == 0) {
        for (int m0 = gw; m0 < NTOK; m0 += 2 * NGW) {
            f32x4 v[2][4];
#pragma unroll
            for (int k = 0; k < 2; ++k) { const int m = m0 + k * NGW; if (m < NTOK) { const float* src = m < NPT ? p.in[0] + (size_t)m * 1024 : p.in[1] + (size_t)(m - NPT) * 1024; const f32x4* xr = (const f32x4*)src + lane;
#pragma unroll
                    for (int j = 0; j < 4; ++j) v[k][j] = xr[64 * j]; } }
#pragma unroll
            for (int k = 0; k < 2; ++k) { const int m = m0 + k * NGW; if (m < NTOK) { float sq = 0.f;
#pragma unroll
                    for (int j = 0; j < 4; ++j) sq += (v[k][j][0] * v[k][j][0] + v[k][j][1] * v[k][j][1]) + (v[k][j][2] * v[k][j][2] + v[k][j][3] * v[k][j][3]);
                    sq = wave_sum(sq);
                    u32x2* o8 = (u32x2*)((bf16_t*)(ws + WS_H) + (size_t)m * 1024) + lane;
#pragma unroll
                    for (int j = 0; j < 4; ++j) { u32x2 wv; wv.x = cvt_pk_bf16(v[k][j][0], v[k][j][1]); wv.y = cvt_pk_bf16(v[k][j][2], v[k][j][3]); o8[64 * j] = wv; }
                    if (lane == 0) ((fx_t*)(ws + WS_SSQA))[m] = fx_of(sq); } }
        }
    }
    { unsigned z = 0u; asm volatile("" : "+v"(z)); unsigned* sb = (unsigned*)(ws + WS_SSQB); for (int i = blockIdx.x * 512 + tid; i < NTOK * 2; i += G * 512) sb[i] = z; }
    { unsigned z = 0u; asm volatile("" : "+v"(z)); unsigned* st = (unsigned*)(ws + WS_STATS); for (int i = blockIdx.x * 512 + tid; i < 256 * 16; i += G * 512) st[i] = z; }
    {
        f32x2* tab = (f32x2*)(ws + WS_TAB);
        for (int i = blockIdx.x * 512 + tid; i < 8192 * 128; i += G * 512) {
            const int pos = i >> 7, k = i & 127;
            const float inv = powf(10000.0f, -(float)(2 * k) / 256.0f); const float ang = (float)pos * inv;
            float sn, cs; sincosf(ang, &sn, &cs); tab[i] = (f32x2){cs, sn};
        }
    }
}

__device__ __forceinline__ void phase_scan(int wv, const Params& p, int l) {
    int wv_ = wv; asm volatile("" : "+s"(wv_)); int tid = wv_ * 64 + lane_id(); asm volatile("" : "+v"(tid));
    const int gt = blockIdx.x * 512 + tid;
    if (gt >= 2048 * 64) return;
    const int row = gt >> 6, d4 = (gt & 63) * 4, h = row >> 9, e = row & 511;
    const float sd = __expf(lgdec(h) * (float)CH);
#pragma unroll 1
    for (int b = 0; b < 2; ++b) {
        bf16_t* sp = s_head(p.ws, b, h) + (size_t)e * SEQ + d4;
        float a[4] = {0.f, 0.f, 0.f, 0.f};
#pragma unroll 1
        for (int j0 = 0; j0 < 32; j0 += 16) {
            u32x2 w[16];
#pragma unroll
            for (int j = 0; j < 16; ++j) w[j] = *(const u32x2*)(sp + (j0 + j) * CH);
#pragma unroll
            for (int j = 0; j < 16; ++j) {
                u32x2 o; o.x = cvt_pk_bf16(a[0], a[1]); o.y = cvt_pk_bf16(a[2], a[3]);
                *(u32x2*)(sp + (j0 + j) * CH) = o;
                a[0] = a[0] * sd + bflo(w[j].x); a[1] = a[1] * sd + bfhi(w[j].x); a[2] = a[2] * sd + bflo(w[j].y); a[3] = a[3] * sd + bfhi(w[j].y);
            }
        }
        float* o = p.out + OUT_RETP + ((size_t)((l * 2 + b) * 4 + h) * 256 + d4) * 512 + e;
#pragma unroll
        for (int j = 0; j < 4; ++j) o[(size_t)j * 512] = a[j];
    }
}

__device__ __forceinline__ void phase_sret(int wv, const Params& p, int l, LAS unsigned char* lds) {
    int wv_ = wv; asm volatile("" : "+s"(wv_)); int tid = wv_ * 64 + lane_id(); asm volatile("" : "+v"(tid));
    const int lane = tid & 63, w = __builtin_amdgcn_readfirstlane(tid >> 6);
    unsigned char* ws = p.ws;
    LAS float* attL = (LAS float*)lds;
    LAS float* red = (LAS float*)(lds + 8192);
    for (int unit = blockIdx.x, GG = gdim(); unit < 256; unit += GG) {
        const int es = unit & 7, h = (unit >> 3) & 3, bs = unit >> 5;
        const float lg = lgdec(h);
        const bf16_t* q = (const bf16_t*)(ws + WS_Q) + (size_t)(NPT + bs * 32) * 1024 + h * 256;
        const bf16_t* k = (const bf16_t*)(ws + WS_KS) + (size_t)(bs * 32) * 1024 + h * 256;
        const bf16_t* kT = (const bf16_t*)(ws + WS_KTS) + (size_t)(h * 256) * 256 + bs * 32;
        const bf16_t* vT = (const bf16_t*)(ws + WS_VTS) + (size_t)(h * 512 + es * 64) * 256 + bs * 32;
        if (w == 0) {
            f32x16 accq;
#pragma unroll
            for (int r = 0; r < 16; ++r) accq[r] = 0.f;
            const bf16_t* qa = q + (size_t)(lane & 31) * 1024 + (lane >> 5) * 8; const bf16_t* kb = k + (size_t)(lane & 31) * 1024 + (lane >> 5) * 8;
#pragma unroll
            for (int sk = 0; sk < 16; ++sk) { const bf16x8 af = *(const bf16x8*)(qa + 16 * sk), bfr = *(const bf16x8*)(kb + 16 * sk); accq = __builtin_amdgcn_mfma_f32_32x32x16_bf16(af, bfr, accq, 0, 0, 0); }
            const int m = lane & 31;
#pragma unroll
            for (int r = 0; r < 16; ++r) { const int n = (r & 3) + 8 * (r >> 2) + 4 * (lane >> 5); attL[n * 33 + m] = (m <= n) ? accq[r] * __expf(lg * (float)(n - m)) : 0.f; }
        }
        const int e = es * 64 + lane;
        const float* S0 = p.in[3] + ((size_t)((l * 8 + bs) * 4 + h) * 256 + w * 32) * 512 + e;
        float s0[32];
#pragma unroll
        for (int dd = 0; dd < 32; ++dd) s0[dd] = S0[(size_t)dd * 512];
        float v[32];
        { const u32x4* vp = (const u32x4*)(vT + (size_t)lane * 256);
#pragma unroll
          for (int c = 0; c < 4; ++c) { f32x4 a, b2; unpack8(vp[c], a, b2); v[8 * c] = a[0]; v[8 * c + 1] = a[1]; v[8 * c + 2] = a[2]; v[8 * c + 3] = a[3]; v[8 * c + 4] = b2[0]; v[8 * c + 5] = b2[1]; v[8 * c + 6] = b2[2]; v[8 * c + 7] = b2[3]; } }
        {
            float* So = p.out + OUT_RETS + ((size_t)((l * 8 + bs) * 4 + h) * 256 + w * 32) * 512 + e;
            const float sd = __expf(lg * 32.0f);
#pragma unroll 4
            for (int dd = 0; dd < 32; ++dd) {
                const u32x4* kr = (const u32x4*)(kT + (size_t)(w * 32 + dd) * 256); float a = s0[dd] * sd;
#pragma unroll
                for (int c4 = 0; c4 < 4; ++c4) { f32x4 k0, k1; unpack8(kr[c4], k0, k1);
                    a += (k0[0] * v[8 * c4] + k0[1] * v[8 * c4 + 1]) + (k0[2] * v[8 * c4 + 2] + k0[3] * v[8 * c4 + 3]) + (k1[0] * v[8 * c4 + 4] + k1[1] * v[8 * c4 + 5]) + (k1[2] * v[8 * c4 + 6] + k1[3] * v[8 * c4 + 7]); }
                So[(size_t)dd * 512] = a;
            }
        }
#pragma unroll 2
        for (int n = 0; n < 32; ++n) {
            const u32x4* qr = (const u32x4*)(q + (size_t)n * 1024 + w * 32); float a = 0.f;
#pragma unroll
            for (int c4 = 0; c4 < 4; ++c4) { f32x4 k0, k1; unpack8(qr[c4], k0, k1);
                a += (k0[0] * s0[8 * c4] + k0[1] * s0[8 * c4 + 1]) + (k0[2] * s0[8 * c4 + 2] + k0[3] * s0[8 * c4 + 3]) + (k1[0] * s0[8 * c4 + 4] + k1[1] * s0[8 * c4 + 5]) + (k1[2] * s0[8 * c4 + 6] + k1[3] * s0[8 * c4 + 7]); }
            red[(w * 32 + n) * 64 + lane] = a * __expf(lg * (float)(n + 1));
        }
        __syncthreads();
        bf16_t* O = (bf16_t*)(ws + WS_OS) + (size_t)(bs * 32) * 2048 + h * 512 + e;
        fx_t* st = (fx_t*)(ws + WS_STATS) + (size_t)(bs * 32) * 8 + h * 2;
#pragma unroll
        for (int r = 0; r < 4; ++r) {
            const int n = w * 4 + r; float a = 0.f;
#pragma unroll
            for (int ww = 0; ww < 8; ++ww) a += red[(ww * 32 + n) * 64 + lane];
#pragma unroll
            for (int m = 0; m < 32; ++m) a += attL[n * 33 + m] * v[m];
            O[(size_t)n * 2048] = (bf16_t)(cvt_pk_bf16(a, 0.f) & 0xffffu);
            const float s = wave_sum(a), qq = wave_sum(a * a);
            if (lane == 0) { fx_add(st + (size_t)n * 8, s); fx_add(st + (size_t)n * 8 + 1, qq); }
        }
        __syncthreads();
    }
}

__device__ __forceinline__ void phase_conv(int wv, const Params& p, int l, LAS unsigned char* lds) {
    int wv_ = wv; asm volatile("" : "+s"(wv_)); int tid = wv_ * 64 + lane_id(); asm volatile("" : "+v"(tid));
    const int lane = tid & 63, wave = tid >> 6;
    unsigned char* ws = p.ws;
    LAS float* red = (LAS float*)lds;
    const int c0 = tid * 2;
    const float* cw = p.in[6] + (size_t)l * 31 * 1024 + c0;
    float w0[31], w1[31];
#pragma unroll
    for (int j = 0; j < 31; ++j) { const f32x2 t = *(const f32x2*)(cw + (size_t)j * 1024); w0[j] = t.x; w1[j] = t.y; }
    const f32x2 cb = *(const f32x2*)(p.in[7] + l * 1024 + c0), lg = *(const f32x2*)(p.in[8] + l * 1024 + c0), lb = *(const f32x2*)(p.in[9] + l * 1024 + c0);
    const int GG = gdim();
    { unsigned z = 0u; asm volatile("" : "+v"(z)); unsigned* sa = (unsigned*)(ws + WS_SSQA); for (int i = blockIdx.x * 512 + tid; i < NTOK * 2; i += GG * 512) sa[i] = z; }
    for (int tok = blockIdx.x; tok < 256; tok += GG) {
        const int sb = tok >> 5, t = tok & 31;
        const bf16_t* gl = (const bf16_t*)(ws + WS_GLU) + (size_t)(NPT + sb * 32) * 1024 + c0;
        const float* cst = p.in[2] + (size_t)(l * 8 + sb) * 30 * 1024 + c0;
        unsigned xg[31]; f32x2 xs[31];
#pragma unroll
        for (int j = 0; j < 31; ++j) { const int tt = t + j - 30; const int tg = tt < 0 ? 0 : tt, tsx = tt + 30 > 29 ? 29 : tt + 30;
            xg[j] = *(const unsigned*)(gl + (size_t)tg * 1024); xs[j] = *(const f32x2*)(cst + (size_t)tsx * 1024); }
        float a0 = cb.x, a1 = cb.y;
#pragma unroll
        for (int j = 0; j < 31; ++j) { const bool fromg = (t + j - 30) >= 0; const float x0 = fromg ? bflo(xg[j]) : xs[j].x, x1 = fromg ? bfhi(xg[j]) : xs[j].y; a0 += x0 * w0[j]; a1 += x1 * w1[j]; }
        if (t >= 2) *(f32x2*)(p.out + OUT_CONVS + ((size_t)(l * 8 + sb) * 30 + (t - 2)) * 1024 + c0) = (f32x2){bflo(xg[30]), bfhi(xg[30])};
        { const float s = wave_sum(a0 + a1), q = wave_sum(a0 * a0 + a1 * a1); if (lane == 0) { red[wave] = s; red[128 + wave] = q; } }
        __syncthreads();
        { float s = 0.f, q = 0.f;
#pragma unroll
          for (int ww = 0; ww < 8; ++ww) { s += red[ww]; q += red[128 + ww]; }
          const float mu = s * (1.0f / 1024.0f); const float var = fmaxf(q * (1.0f / 1024.0f) - mu * mu, 0.f); const float rstd = __builtin_amdgcn_rsqf(var + LN_EPS);
          float y0 = (a0 - mu) * rstd * lg.x + lb.x, y1 = (a1 - mu) * rstd * lg.y + lb.y; y0 *= sigm(y0); y1 *= sigm(y1);
          *(unsigned*)((bf16_t*)(ws + WS_YC) + (size_t)(NPT + tok) * 1024 + c0) = cvt_pk_bf16(y0, y1); }
        __syncthreads();
    }
    for (int unit = blockIdx.x; unit < NPT / 16; unit += GG) {
        const int g0 = unit * 16, t0 = g0 & (SEQ - 1), pb = g0 >> 13;
        const bool lastt = (t0 == SEQ - 16);
        const bf16_t* gl = (const bf16_t*)(ws + WS_GLU) + (size_t)g0 * 1024 + c0;
        float* cso = p.out + OUT_CONVP + (size_t)(l * 2 + pb) * 30 * 1024 + c0;
        unsigned xin[46];
#pragma unroll
        for (int r = 0; r < 46; ++r) { const int tt = t0 - 30 + r; const long off = tt >= 0 ? (long)(r - 30) : 0l; xin[r] = *(const unsigned*)(gl + off * 1024); if (tt < 0) xin[r] = 0u; }
        f32x2 xv[46];
#pragma unroll
        for (int r = 0; r < 46; ++r) { xv[r] = (f32x2){bflo(xin[r]), bfhi(xin[r])}; if (r >= 16 && lastt) *(f32x2*)(cso + (size_t)(r - 16) * 1024) = xv[r]; }
        float a0[16], a1[16];
#pragma unroll
        for (int tq = 0; tq < 16; tq += 4) {
            f32x2 v0 = cb, v1 = cb, v2 = cb, v3 = cb;
#pragma unroll
            for (int j = 0; j < 31; ++j) {
                const f32x2 wv = {w0[j], w1[j]};
                asm volatile("v_pk_fma_f32 %0, %4, %8, %0\n\tv_pk_fma_f32 %1, %5, %8, %1\n\tv_pk_fma_f32 %2, %6, %8, %2\n\tv_pk_fma_f32 %3, %7, %8, %3"
                             : "+v"(v0), "+v"(v1), "+v"(v2), "+v"(v3) : "v"(xv[tq + j]), "v"(xv[tq + 1 + j]), "v"(xv[tq + 2 + j]), "v"(xv[tq + 3 + j]), "v"(wv));
            }
            a0[tq] = v0.x; a1[tq] = v0.y; a0[tq + 1] = v1.x; a1[tq + 1] = v1.y; a0[tq + 2] = v2.x; a1[tq + 2] = v2.y; a0[tq + 3] = v3.x; a1[tq + 3] = v3.y;
        }
#pragma unroll
        for (int t = 0; t < 16; ++t) { const float s = wave_sum(a0[t] + a1[t]), q = wave_sum(a0[t] * a0[t] + a1[t] * a1[t]); if (lane == 0) { red[t * 8 + wave] = s; red[128 + t * 8 + wave] = q; } }
        asm volatile("s_waitcnt lgkmcnt(0)" ::: "memory"); __builtin_amdgcn_s_barrier(); asm volatile("" ::: "memory");
        bf16_t* yo = (bf16_t*)(ws + WS_YC) + (size_t)g0 * 1024 + c0;
#pragma unroll
        for (int t = 0; t < 16; ++t) { float s = 0.f, q = 0.f;
#pragma unroll
            for (int ww = 0; ww < 8; ++ww) { s += red[t * 8 + ww]; q += red[128 + t * 8 + ww]; }
            const float mu = s * (1.0f / 1024.0f); const float var = fmaxf(q * (1.0f / 1024.0f) - mu * mu, 0.f);
            const float rstd = __builtin_amdgcn_rsqf(var + LN_EPS);
            float y0 = (a0[t] - mu) * rstd * lg.x + lb.x, y1 = (a1[t] - mu) * rstd * lg.y + lb.y;
            y0 *= sigm(y0); y1 *= sigm(y1);
            *(unsigned*)(yo + (size_t)t * 1024) = cvt_pk_bf16(y0, y1); }
        asm volatile("s_waitcnt lgkmcnt(0)" ::: "memory"); __builtin_amdgcn_s_barrier(); asm volatile("" ::: "memory");
    }
    asm volatile("s_waitcnt vmcnt(0) lgkmcnt(0)" ::: "memory");
    __syncthreads();
}

__device__ __forceinline__ void phase_rms2(int wv, const Params& p, int l) {
    int wv_ = wv; asm volatile("" : "+s"(wv_)); int tid = wv_ * 64 + lane_id(); asm volatile("" : "+v"(tid));
    const int lane = tid & 63, gw = blockIdx.x * 8 + (tid >> 6), NGW = gdim() * 8;
    const float* g2 = p.in[14] + l * 1024;
    for (int m = gw; m < NTOK; m += NGW) rms_row(p.out + (size_t)m * 1024, g2, (bf16_t*)(p.ws + WS_H) + (size_t)m * 1024, nullptr, lane);
}
__device__ __forceinline__ void phase_final(int wv, const Params& p) {
    int wv_ = wv; asm volatile("" : "+s"(wv_)); int tid = wv_ * 64 + lane_id(); asm volatile("" : "+v"(tid));
    const int lane = tid & 63, gw = blockIdx.x * 8 + (tid >> 6), NGW = gdim() * 8;
    const f32x4* gr = (const f32x4*)p.in[17] + lane; const fx_t* ssq = (const fx_t*)(p.ws + WS_SSQA);
    f32x4 gg[4];
#pragma unroll
    for (int j = 0; j < 4; ++j) gg[j] = gr[64 * j];
    for (int m = gw; m < NTOK; m += 4 * NGW) {
        u32x2 w[4][4]; fx_t sq[4];
#pragma unroll
        for (int k = 0; k < 4; ++k) { const int mk = m + k * NGW; if (mk < NTOK) { const u32x2* xr = (const u32x2*)((const bf16_t*)(p.ws + WS_H) + (size_t)mk * 1024) + lane; sq[k] = ssq[mk];
#pragma unroll
                for (int j = 0; j < 4; ++j) w[k][j] = xr[64 * j]; } }
#pragma unroll
        for (int k = 0; k < 4; ++k) { const int mk = m + k * NGW; if (mk < NTOK) { f32x4* yr = (f32x4*)(p.out + (size_t)mk * 1024) + lane; const float r = rstd_of(fx_get(sq[k]));
#pragma unroll
                for (int j = 0; j < 4; ++j) { const f32x4 xv = {bflo(w[k][j].x), bfhi(w[k][j].x), bflo(w[k][j].y), bfhi(w[k][j].y)}; yr[64 * j] = xv * r * gg[j]; } } }
    }
}

struct SPre { fx_t f0, f1, f2; unsigned u0, u1, u2, u3; f32x2 g0, g1; };
#define SG_BAR() do { asm volatile("s_waitcnt lgkmcnt(0)" ::: "memory"); __builtin_amdgcn_s_barrier(); asm volatile("" ::: "memory"); } while (0)
template <bool PAIR, class EpiS>
__device__ __forceinline__ void sgemm_phase(int wv, LAS unsigned char* lds, const bf16_t* A, const bf16_t* Wt, int K, int nUnits, const EpiS& epi) {
    int wv_ = wv; asm volatile("" : "+s"(wv_)); int tid = wv_ * 64 + lane_id(); asm volatile("" : "+v"(tid));
    const int lane = tid & 63, w = __builtin_amdgcn_readfirstlane(tid >> 6);
    LAS float* red = (LAS float*)lds;
    const int kw = K >> 3, GG = gdim();
    const size_t loff = (size_t)(lane & 15) * K + w * kw + (lane >> 4) * 8;
    const size_t r16 = (size_t)16 * K;
    const int row = tid >> 4, jq = tid & 15;
    int unit = blockIdx.x;
    if (unit >= nUnits) return;
#define SG_PTRS(u_) const int rb_ = (u_) & 7, cp_ = (u_) >> 3, n0_ = PAIR ? ((cp_ >> 2) * 256 + (cp_ & 3) * 32) : cp_ * 32; \
        const bf16_t* ap = A + (size_t)(rb_ * 32) * K + loff; const bf16_t* bp0 = Wt + (size_t)n0_ * K + loff; const bf16_t* bp1 = bp0 + (size_t)128 * K;
#define SG_LOAD(fa_, fb0_, fb1_, s_, ks_) do { fa_[s_][0] = *(const bf16x8*)(ap + (ks_)); fa_[s_][1] = *(const bf16x8*)(ap + r16 + (ks_)); \
        fb0_[s_][0] = *(const bf16x8*)(bp0 + (ks_)); fb0_[s_][1] = *(const bf16x8*)(bp0 + r16 + (ks_)); \
        if (PAIR) { fb1_[s_][0] = *(const bf16x8*)(bp1 + (ks_)); fb1_[s_][1] = *(const bf16x8*)(bp1 + r16 + (ks_)); } } while (0)
#define SG_MMA(fa_, fb0_, fb1_, s_) do { _Pragma("unroll") for (int a_ = 0; a_ < 2; ++a_) _Pragma("unroll") for (int c_ = 0; c_ < 2; ++c_) { \
        acc[a_][0][c_] = __builtin_amdgcn_mfma_f32_16x16x32_bf16(fa_[s_][a_], fb0_[s_][c_], acc[a_][0][c_], 0, 0, 0); \
        if (PAIR) acc[a_][1][c_] = __builtin_amdgcn_mfma_f32_16x16x32_bf16(fa_[s_][a_], fb1_[s_][c_], acc[a_][1][c_], 0, 0, 0); } } while (0)
#define SG_ZERO() do { _Pragma("unroll") for (int a_ = 0; a_ < 2; ++a_) _Pragma("unroll") for (int g_ = 0; g_ < 2; ++g_) _Pragma("unroll") for (int c_ = 0; c_ < 2; ++c_) acc[a_][g_][c_] = (f32x4){0.f, 0.f, 0.f, 0.f}; } while (0)
#define SG_REDUCE(u_, pr_) do { \
        _Pragma("unroll") for (int a_ = 0; a_ < 2; ++a_) _Pragma("unroll") for (int g_ = 0; g_ < (PAIR ? 2 : 1); ++g_) _Pragma("unroll") for (int c_ = 0; c_ < 2; ++c_) _Pragma("unroll") for (int r = 0; r < 4; ++r) \
            red[(w * 32 + a_ * 16 + (lane >> 4) * 4 + r) * 64 + g_ * 32 + c_ * 16 + (lane & 15)] = acc[a_][g_][c_][r]; \
        SG_BAR(); \
        const int rbq = (u_) & 7, cpq = (u_) >> 3, n0q = PAIR ? ((cpq >> 2) * 256 + (cpq & 3) * 32) : cpq * 32; \
        float x1[2] = {0.f, 0.f}, x2[2] = {0.f, 0.f}; \
        _Pragma("unroll") for (int ww = 0; ww < 8; ++ww) { const f32x2 p0 = *(const LAS f32x2*)(red + (ww * 32 + row) * 64 + 2 * jq); x1[0] += p0.x; x1[1] += p0.y; \
            if (PAIR) { const f32x2 p1 = *(const LAS f32x2*)(red + (ww * 32 + row) * 64 + 32 + 2 * jq); x2[0] += p1.x; x2[1] += p1.y; } } \
        epi(rbq * 32 + row, n0q + 2 * jq, x1, x2, pr_); \
        SG_BAR(); } while (0)
    f32x4 acc[2][2][2];
    if (K == 1024) {
        bf16x8 fa[4][2], fb0[4][2], fb1[4][2];
        { SG_PTRS(unit)
#pragma unroll
          for (int s = 0; s < 4; ++s) SG_LOAD(fa, fb0, fb1, s, 32 * s); }
#pragma unroll 1
        for (;;) {
            SG_ZERO();
#pragma unroll
            for (int s = 0; s < 4; ++s) SG_MMA(fa, fb0, fb1, s);
            const int cur = unit; unit += GG; const bool has = unit < nUnits;
            SPre pr; { const int rbc = cur & 7, cpc = cur >> 3, n0c = PAIR ? ((cpc >> 2) * 256 + (cpc & 3) * 32) : cpc * 32; pr = epi.pre(rbc * 32 + row, n0c + 2 * jq); }
            if (has) { SG_PTRS(unit)
#pragma unroll
                for (int s = 0; s < 4; ++s) SG_LOAD(fa, fb0, fb1, s, 32 * s); }
            SG_REDUCE(cur, pr);
            if (!has) break;
        }
    } else {
#pragma unroll 1
        for (; unit < nUnits; unit += GG) {
            SG_PTRS(unit)
            const SPre pr = epi.pre(rb_ * 32 + row, n0_ + 2 * jq);
            SG_ZERO();
#pragma unroll 1
            for (int ks = 0; ks < kw; ks += 256) {
                bf16x8 fa[8][2], fb0[8][2], fb1[8][2];
#pragma unroll
                for (int s = 0; s < 8; ++s) SG_LOAD(fa, fb0, fb1, s, ks + 32 * s);
#pragma unroll
                for (int s = 0; s < 8; ++s) SG_MMA(fa, fb0, fb1, s);
            }
            SG_REDUCE(unit, pr);
        }
    }
    asm volatile("s_waitcnt vmcnt(0) lgkmcnt(0)" ::: "memory");
    __syncthreads();
#undef SG_PTRS
#undef SG_LOAD
#undef SG_MMA
#undef SG_ZERO
#undef SG_REDUCE
}
#define SEPI_ARGS int rl, int n, const float (&x1)[2], const float (&x2)[2]
struct SEpiB1 {
    unsigned char* ws;
    __device__ __forceinline__ SPre pre(int rl, int n) const {
        SPre p_{}; p_.f0 = ((const fx_t*)(ws + WS_SSQA))[NPT + rl];
        const f32x2* tab = (const f32x2*)(ws + WS_TAB); const int d = n & 127, pos = PAST + (rl & 31);
        p_.g0 = tab[(size_t)pos * 128 + d]; p_.g1 = tab[(size_t)pos * 128 + d + 1];
        return p_;
    }
    __device__ __forceinline__ void operator()(int rl, int n, const float (&y1)[2], const float (&y2)[2], const SPre& pr) const {
        const float rs_ = rstd_of(fx_get(pr.f0));
        const float x1[2] = {y1[0] * rs_, y1[1] * rs_}, x2[2] = {y2[0] * rs_, y2[1] * rs_};
        if (n < 2048) {
            const int head = (n >> 8) & 3, d = n & 255;
            const f32x2 c0 = pr.g0, c1 = pr.g1;
            float o1[2], o2[2];
            o1[0] = x1[0] * c0.x - x2[0] * c0.y; o2[0] = x2[0] * c0.x + x1[0] * c0.y;
            o1[1] = x1[1] * c1.x - x2[1] * c1.y; o2[1] = x2[1] * c1.x + x1[1] * c1.y;
            if (n < 1024) {
                bf16_t* q = (bf16_t*)(ws + WS_Q) + (size_t)(NPT + rl) * 1024 + head * 256 + d;
                *(unsigned*)q = cvt_pk_bf16(o1[0], o1[1]); *(unsigned*)(q + 128) = cvt_pk_bf16(o2[0], o2[1]);
            } else {
                bf16_t* k = (bf16_t*)(ws + WS_KS) + (size_t)rl * 1024 + head * 256 + d;
                *(unsigned*)k = cvt_pk_bf16(o1[0] * 0.0625f, o1[1] * 0.0625f); *(unsigned*)(k + 128) = cvt_pk_bf16(o2[0] * 0.0625f, o2[1] * 0.0625f);
                const float dec = 0.0625f * __expf(lgdec(head) * (float)(DSEQ - 1 - (rl & 31)));
                bf16_t* kt = (bf16_t*)(ws + WS_KTS) + (size_t)(head * 256 + d) * 256 + rl;
                const unsigned wa = cvt_pk_bf16(o1[0] * dec, o1[1] * dec), wb = cvt_pk_bf16(o2[0] * dec, o2[1] * dec);
                kt[0] = (bf16_t)(wa & 0xffffu); kt[256] = (bf16_t)(wa >> 16); kt[128 * 256] = (bf16_t)(wb & 0xffffu); kt[129 * 256] = (bf16_t)(wb >> 16);
            }
        } else {
            bf16_t* vt = (bf16_t*)(ws + WS_VTS) + (size_t)(n - 2048) * 256 + rl;
            const unsigned wa = cvt_pk_bf16(x1[0], x1[1]), wb = cvt_pk_bf16(x2[0], x2[1]);
            vt[0] = (bf16_t)(wa & 0xffffu); vt[256] = (bf16_t)(wa >> 16); vt[128 * 256] = (bf16_t)(wb & 0xffffu); vt[129 * 256] = (bf16_t)(wb >> 16);
        }
    }
};
struct SEpiB2 {
    unsigned char* ws; const float* gn_g;
    __device__ __forceinline__ SPre pre(int rl, int n) const {
        SPre p_{}; p_.f0 = ((const fx_t*)(ws + WS_SSQA))[NPT + rl];
        const int col = (n - 2048) & 2047, head = col >> 9;
        const fx_t* sp2 = (const fx_t*)(ws + WS_STATS) + (size_t)rl * 8 + head * 2; p_.f1 = sp2[0]; p_.f2 = sp2[1];
        const bf16_t* o = (const bf16_t*)(ws + WS_OS) + (size_t)rl * 2048 + col; p_.u0 = *(const unsigned*)o; p_.u1 = *(const unsigned*)(o + 128);
        p_.g0 = *(const f32x2*)(gn_g + col); p_.g1 = *(const f32x2*)(gn_g + col + 128);
        return p_;
    }
    __device__ __forceinline__ void operator()(int rl, int n, const float (&y1)[2], const float (&y2)[2], const SPre& pr) const {
        const float rs_ = rstd_of(fx_get(pr.f0));
        const float x1[2] = {y1[0] * rs_, y1[1] * rs_}, x2[2] = {y2[0] * rs_, y2[1] * rs_};
        if (n < 2048) {
            bf16_t* o = (bf16_t*)(ws + WS_GLU) + (size_t)(NPT + rl) * 1024 + (n >> 8) * 128 + (n & 127);
            *(unsigned*)o = cvt_pk_bf16(x1[0] * sigm(x2[0]), x1[1] * sigm(x2[1]));
        } else if (n < 4096) {
            const int col = n - 2048, head = col >> 9;
            const f32x2 sq = {fx_get(pr.f1), fx_get(pr.f2)};
            const float mu = sq.x * (1.0f / 512.0f); const float var = fmaxf(sq.y * (1.0f / 512.0f) - mu * mu, 0.f); const float rstd = __builtin_amdgcn_rsqf(var + LN_EPS);
            bf16_t* o = (bf16_t*)(ws + WS_OS) + (size_t)rl * 2048 + col;
            const unsigned oa = pr.u0, ob = pr.u1;
            const f32x2 ga = pr.g0, gb = pr.g1;
            *(unsigned*)o = cvt_pk_bf16(x1[0] * sigm(x1[0]) * ((bflo(oa) - mu) * rstd * ga.x), x1[1] * sigm(x1[1]) * ((bfhi(oa) - mu) * rstd * ga.y));
            *(unsigned*)(o + 128) = cvt_pk_bf16(x2[0] * sigm(x2[0]) * ((bflo(ob) - mu) * rstd * gb.x), x2[1] * sigm(x2[1]) * ((bfhi(ob) - mu) * rstd * gb.y));
        } else {
            bf16_t* o = (bf16_t*)(ws + (n < 5120 ? WS_GC : WS_GR)) + (size_t)(NPT + rl) * 1024 + ((n - 4096) & 1023);
            *(unsigned*)o = cvt_pk_bf16(sigm(x1[0]), sigm(x1[1])); *(unsigned*)(o + 128) = cvt_pk_bf16(sigm(x2[0]), sigm(x2[1]));
        }
    }
};
template <int MODE, bool PAIR> struct SEpiEW {
    unsigned char* ws; float* x; fx_t* ssq;
    __device__ __forceinline__ SPre pre(int rl, int n) const {
        SPre p_{}; const size_t row = (size_t)(NPT + rl);
        if (MODE == 0) { const bf16_t* g = (const bf16_t*)(ws + WS_GC) + row * 1024 + n; p_.u0 = *(const unsigned*)g; if (PAIR) p_.u1 = *(const unsigned*)(g + 128); }
        else if (MODE == 1) { const bf16_t* g = (const bf16_t*)(ws + WS_GR) + row * 1024 + n; const bf16_t* t = (const bf16_t*)(ws + WS_T) + row * 1024 + n;
            p_.u0 = *(const unsigned*)g; p_.u2 = *(const unsigned*)t; if (PAIR) { p_.u1 = *(const unsigned*)(g + 128); p_.u3 = *(const unsigned*)(t + 128); } }
        else if (MODE == 2) { const bf16_t* xb = (const bf16_t*)(ws + WS_H) + row * 1024 + n; p_.u0 = *(const unsigned*)xb; if (PAIR) p_.u1 = *(const unsigned*)(xb + 128); }
        else p_.f0 = ssq[row];
        return p_;
    }
    __device__ __forceinline__ void operator()(SEPI_ARGS, const SPre& pr) const {
        const size_t row = (size_t)(NPT + rl);
        if (MODE == 0) {
            bf16_t* t = (bf16_t*)(ws + WS_T) + row * 1024 + n;
            const unsigned ga = pr.u0, gb = pr.u1;
            *(unsigned*)t = cvt_pk_bf16(x1[0] * bflo(ga), x1[1] * bfhi(ga)); if (PAIR) *(unsigned*)(t + 128) = cvt_pk_bf16(x2[0] * bflo(gb), x2[1] * bfhi(gb));
        } else if (MODE == 1) {
            bf16_t* t = (bf16_t*)(ws + WS_T) + row * 1024 + n;
            const unsigned ga = pr.u0, gb = pr.u1, ta = pr.u2, tb = pr.u3;
            *(unsigned*)t = cvt_pk_bf16(bflo(ta) + x1[0] * bflo(ga), bfhi(ta) + x1[1] * bfhi(ga)); if (PAIR) *(unsigned*)(t + 128) = cvt_pk_bf16(bflo(tb) + x2[0] * bflo(gb), bfhi(tb) + x2[1] * bfhi(gb));
        } else if (MODE == 2) {
            bf16_t* xb = (bf16_t*)(ws + WS_H) + row * 1024 + n; const unsigned xa = pr.u0, xc = PAIR ? pr.u1 : 0u;
            f32x2 a = {bflo(xa) + x1[0], bfhi(xa) + x1[1]}, b = {bflo(xc) + x2[0], bfhi(xc) + x2[1]};
            *(unsigned*)xb = cvt_pk_bf16(a.x, a.y); if (PAIR) *(unsigned*)(xb + 128) = cvt_pk_bf16(b.x, b.y);
            float q = a.x * a.x + a.y * a.y; if (PAIR) q += b.x * b.x + b.y * b.y;
            q += shx<1>(q); q += shx<2>(q); q += shx<4>(q); q += shx<8>(q);
            if ((lane_id() & 15) == 0) fx_add(ssq + row, q);
        } else {
            bf16_t* u = (bf16_t*)(ws + WS_U) + row * 4096 + n;
            const float r3 = rstd_of(fx_get(pr.f0));
            const float a0 = fmaxf(x1[0], 0.f) * r3, a1 = fmaxf(x1[1], 0.f) * r3, b0 = fmaxf(x2[0], 0.f) * r3, b1 = fmaxf(x2[1], 0.f) * r3;
            *(unsigned*)u = cvt_pk_bf16(a0 * a0, a1 * a1); if (PAIR) *(unsigned*)(u + 128) = cvt_pk_bf16(b0 * b0, b1 * b1);
        }
    }
};

#define XB_TMO      128
#define XB_XCNT(j)  (256  + 64 * (j))
#define XB_XSUB(j)  (1280 + 64 * (j))
#define XB_XGEN(j)  (2304 + 64 * (j))
#define XB_TOP      3328
#define XB_TOPGEN   3392
#define XCD_BAR_WORDS 3456
#define XB_SPIN_CAP (1u << 18)

__device__ __forceinline__ unsigned xb_ld(unsigned* p)              { return __hip_atomic_load(p, __ATOMIC_RELAXED, __HIP_MEMORY_SCOPE_AGENT); }
__device__ __forceinline__ unsigned xb_add(unsigned* p, unsigned v) { return __hip_atomic_fetch_add(p, v, __ATOMIC_RELAXED, __HIP_MEMORY_SCOPE_AGENT); }
__device__ __forceinline__ unsigned xb_xcc_id() { return (unsigned)__builtin_amdgcn_s_getreg((3 << 11) | 20) & 0xFu; }
#define XB_SPIN(cond, bar) do { unsigned _sp = 0; while (cond) { __builtin_amdgcn_s_sleep(1); \
    if ((++_sp & 255u) == 0u) { if (xb_ld(&(bar)[XB_TMO])) break; if (_sp > XB_SPIN_CAP) { atomicAdd(&(bar)[XB_TMO], 1u); break; } } } } while (0)

struct XcdBarrier {
    unsigned* bar; unsigned x;
    volatile LAS unsigned* st;
};

__device__ __forceinline__ XcdBarrier xcd_barrier_post(unsigned* bar, volatile LAS unsigned* st, int wv) {
    XcdBarrier b; b.bar = bar; b.x = xb_xcc_id(); b.st = st;
    if (wv == 0 && lane_id() == 0) (void)xb_add(&bar[XB_XCNT(b.x)], 1u);
    return b;
}
__device__ __forceinline__ void xcd_barrier_complete(unsigned* bar, unsigned x, unsigned& nloc, unsigned& nx) {
    const unsigned G = gridDim.x * gridDim.y * gridDim.z;
    unsigned sum, cnt, mine, sp = 0u;
    for (;;) {
        sum = 0u; cnt = 0u; mine = 0u;
#pragma unroll
        for (unsigned j = 0; j < 16; ++j) { const unsigned c = xb_ld(&bar[XB_XCNT(j)]); sum += c; cnt += (c > 0u) ? 1u : 0u; mine = (j == x) ? c : mine; }
        if (sum == G) break;
        __builtin_amdgcn_s_sleep(1);
        if ((++sp & 255u) == 0u) { if (xb_ld(&bar[XB_TMO])) break; if (sp > XB_SPIN_CAP) { atomicAdd(&bar[XB_TMO], 1u); break; } }
    }
    nloc = mine > 0u ? mine : 1u; nx = cnt > 0u ? cnt : 1u;
}

__device__ __forceinline__ void xcd_barrier(const XcdBarrier& b, int wv) {
    asm volatile("s_waitcnt vmcnt(0)" ::: "memory");
    __syncthreads();
    if (wv == 0 && lane_id() == 0) {
        unsigned* bar = b.bar;
        __builtin_amdgcn_s_waitcnt(0);
        unsigned nloc = b.st[0], nx = b.st[1];
        if (nloc == 0u) { xcd_barrier_complete(bar, b.x, nloc, nx); b.st[0] = nloc; b.st[1] = nx; }
        const unsigned old = xb_add(&bar[XB_XSUB(b.x)], 1u);
        const unsigned gen = old / nloc;
        if (old + 1u == (gen + 1u) * nloc) {
            __builtin_amdgcn_fence(__ATOMIC_RELEASE, "agent");
            asm volatile("s_waitcnt vmcnt(0)" ::: "memory");
            const unsigned og = xb_add(&bar[XB_TOP], 1u);
            const unsigned tg = og / nx;
            if (og + 1u == (tg + 1u) * nx) xb_add(&bar[XB_TOPGEN], 1u);
            else XB_SPIN(xb_ld(&bar[XB_TOPGEN]) == tg, bar);
            __builtin_amdgcn_fence(__ATOMIC_ACQUIRE, "agent");
            xb_add(&bar[XB_XGEN(b.x)], 1u);
            asm volatile("s_waitcnt vmcnt(0)" ::: "memory");
        } else {
            XB_SPIN(xb_ld(&bar[XB_XGEN(b.x)]) == gen, bar);
            __builtin_amdgcn_fence(__ATOMIC_ACQUIRE, "agent");
            asm volatile("s_waitcnt vmcnt(0)" ::: "memory");
        }
    }
    __syncthreads();
}


constexpr int LDS_BYTES = 131072 + 4096;
#define LCV ({ int c_ = (int)blockIdx.x; asm volatile("" : "+s"(c_)); c_; })
__global__ void __launch_bounds__(512, 2) fwd_megakernel(Params p) {
    extern __shared__ __attribute__((aligned(16))) unsigned char lds_raw[];
    LAS unsigned char* lds = (LAS unsigned char*)lds_raw;
    cg::grid_group grid = cg::this_grid();
    const int G = gridDim.x, c = blockIdx.x;
    unsigned char* ws = p.ws;
    int wv = __builtin_amdgcn_readfirstlane((int)(threadIdx.x >> 6)); asm volatile("" : "+s"(wv));
    volatile LAS unsigned* stw = (volatile LAS unsigned*)(lds + 131072);
    if (wv == 0) stw[lane_id()] = 0u;
    __syncthreads();
    XcdBarrier xbar = xcd_barrier_post((unsigned*)(ws + WS_BAR), stw, wv);
    if (p.ws == nullptr) grid.sync();
#define GSYNC() xcd_barrier(xbar, wv)
#pragma unroll 1
    for (int l = 0; l < 2; ++l) {
        phase0(wv, p, l, lds, 0);
        GSYNC();
        {
            SchedB1 S{G, LCV, (const char*)(ws + WS_H), (const char*)(ws + WS_WIN)}; EpiB1 E{ws};
            pg8::gemm_phase(wv, lds, pg8::Gemm{1024, 16, 1024, 1024}, S, E);
            sgemm_phase<true>(wv, lds, (const bf16_t*)(ws + WS_H) + (size_t)NPT * 1024, (const bf16_t*)(ws + WS_WIN), 1024, 8 * 64, SEpiB1{ws});
        }
        GSYNC();
        {
            { SchedAtt S{G, LCV, ws}; EpiAtt E{ws}; pg8::gemm_phase(wv, lds, pg8::Gemm{256, 4, 1024, 1024}, S, E); }
            { SchedU S{G, LCV, ws}; EpiU E{ws}; pg8::gemm_phase(wv, lds, pg8::Gemm{256, 4, SEQ, SEQ}, S, E); }
            phase_sret(wv, p, l, lds);
            GSYNC();
            phase_scan(wv, p, l);
            GSYNC();
            { SchedE S{G, LCV, ws}; EpiE E{ws}; pg8::gemm_phase(wv, lds, pg8::Gemm{512, 4, 1024, SEQ}, S, E); }
            {
                const int t_ = wv * 64 + lane_id(), row_ = t_ >> 1, which_ = t_ & 1, idx_ = (int)blockIdx.x, h_ = idx_ & 3, j_ = (idx_ >> 2) & 31, b_ = idx_ >> 7;
                if (idx_ < 256) {
                    const float* sl_ = (const float*)(ws + WS_SLOTS) + (size_t)idx_ * 4096 + row_ * 16 + which_;
                    float a_ = 0.f;
#pragma unroll
                    for (int k_ = 0; k_ < 8; ++k_) a_ += sl_[k_ * 2];
                    ((float*)(ws + WS_STATF))[(size_t)(b_ * SEQ + j_ * CH + row_) * 8 + h_ * 2 + which_] = a_;
                }
            }
            GSYNC();
        }
        {
            SchedN S{G, LCV, 24, 0, (const char*)(ws + WS_H), (const char*)(ws + WS_WIN) + (size_t)16 * TILEB, TILEB, ws, TILEB};
            EpiB2 E{ws, p.in[11] + l * 2048};
            pg8::gemm_phase(wv, lds, pg8::Gemm{1024, 16, 1024, 1024}, S, E);
            sgemm_phase<true>(wv, lds, (const bf16_t*)(ws + WS_H) + (size_t)NPT * 1024, (const bf16_t*)(ws + WS_WIN) + (size_t)4096 * 1024, 1024, 8 * 96, SEpiB2{ws, p.in[11] + l * 2048});
        }
        GSYNC();
        phase0(wv, p, l, lds, 1);
        phase_conv(wv, p, l, lds);
        GSYNC();
        { SchedN S{G, LCV, 4, 0, (const char*)(ws + WS_YC), (const char*)(ws + WS_WC), TILEB, ws, TILEB}; EpiEW<0> E{ws, p.out, nullptr}; pg8::gemm_phase(wv, lds, pg8::Gemm{1024, 16, 1024, 1024}, S, E); }
        sgemm_phase<false>(wv, lds, (const bf16_t*)(ws + WS_YC) + (size_t)NPT * 1024, (const bf16_t*)(ws + WS_WC), 1024, 8 * 32, SEpiEW<0, false>{ws, p.out, nullptr});
        { SchedN S{G, LCV, 4, 1, nullptr, (const char*)(ws + WS_WR), 2 * TILEB, ws, 0}; EpiEW<1> E{ws, p.out, nullptr}; pg8::gemm_phase(wv, lds, pg8::Gemm{2048, 32, 2048, 2048}, S, E); }
        sgemm_phase<false>(wv, lds, (const bf16_t*)(ws + WS_OS), (const bf16_t*)(ws + WS_WR), 2048, 8 * 32, SEpiEW<1, false>{ws, p.out, nullptr});
        GSYNC();
        { SchedN S{G, LCV, 4, 0, (const char*)(ws + WS_T), (const char*)(ws + WS_WO), TILEB, ws, TILEB}; EpiEW<2> E{ws, p.out, (fx_t*)(ws + WS_SSQB)}; pg8::gemm_phase(wv, lds, pg8::Gemm{1024, 16, 1024, 1024}, S, E); }
        sgemm_phase<false>(wv, lds, (const bf16_t*)(ws + WS_T) + (size_t)NPT * 1024, (const bf16_t*)(ws + WS_WO), 1024, 8 * 32, SEpiEW<2, false>{ws, p.out, (fx_t*)(ws + WS_SSQB)});
        GSYNC();
        { SchedN S{G, LCV, 16, 0, (const char*)(ws + WS_H), (const char*)(ws + WS_WM1), TILEB, ws, TILEB}; EpiEW<3> E{ws, p.out, (fx_t*)(ws + WS_SSQB)}; pg8::gemm_phase(wv, lds, pg8::Gemm{1024, 16, 1024, 1024}, S, E); }
        sgemm_phase<true>(wv, lds, (const bf16_t*)(ws + WS_H) + (size_t)NPT * 1024, (const bf16_t*)(ws + WS_WM1), 1024, 8 * 64, SEpiEW<3, true>{ws, p.out, (fx_t*)(ws + WS_SSQB)});
        GSYNC();
        { SchedN S{G, LCV, 4, 0, (const char*)(ws + WS_U), (const char*)(ws + WS_WM2), 4 * TILEB, ws, 4 * TILEB}; EpiEW<2> E{ws, p.out, (fx_t*)(ws + WS_SSQA)}; pg8::gemm_phase(wv, lds, pg8::Gemm{4096, 64, 4096, 4096}, S, E); }
        sgemm_phase<false>(wv, lds, (const bf16_t*)(ws + WS_U) + (size_t)NPT * 4096, (const bf16_t*)(ws + WS_WM2), 4096, 8 * 32, SEpiEW<2, false>{ws, p.out, (fx_t*)(ws + WS_SSQA)});
        GSYNC();
    }
    phase_final(wv, p);
}

extern "C" void kernel_launch(void* const* d_in, const int* in_sizes, int n_in, void* d_out, int out_size, void* d_ws, size_t ws_size, hipStream_t stream) {
    static int grid = 0;
    if (grid == 0) {
        if (n_in != 18 || ws_size < WS_END) { fprintf(stderr, "kernel_launch: unexpected n_in %d / ws_size %zu (need %zu)\n", n_in, ws_size, (size_t)WS_END); grid = -1; return; }
        int dev = 0, cus = 0, per_cu = 0;
        hipGetDevice(&dev); hipDeviceGetAttribute(&cus, hipDeviceAttributeMultiprocessorCount, dev);
        hipFuncSetAttribute((const void*)fwd_megakernel, hipFuncAttributeMaxDynamicSharedMemorySize, LDS_BYTES);
        hipOccupancyMaxActiveBlocksPerMultiprocessor(&per_cu, (const void*)fwd_megakernel, 512, LDS_BYTES);
        (void)hipGetLastError();
        if (per_cu < 1) per_cu = 1;
        grid = cus;
        fprintf(stderr, "kernel_launch: cus %d per_cu %d grid %d\n", cus, per_cu, grid);
    }
    if (grid < 0) return;
    if (hipMemsetAsync((char*)d_ws + WS_BAR, 0, 16384, stream) != hipSuccess) { fprintf(stderr, "memset failed\n"); return; }
    Params p{};
    for (int i = 0; i < 18; ++i) p.in[i] = (const float*)d_in[i];
    p.out = (float*)d_out; p.ws = (unsigned char*)d_ws;
    void* args[] = {&p};
    hipError_t e = hipLaunchCooperativeKernel((const void*)fwd_megakernel, dim3(grid), dim3(512), args, LDS_BYTES, stream);
    if (e != hipSuccess) fprintf(stderr, "cooperative launch failed: %s (grid %d)\n", hipGetErrorString(e), grid);
}
```
